# Optimizing an MI355X kernel written in HIP

```python
import math
import jax, jax.numpy as jnp
from jax import lax
import numpy as np

D_MODEL = 1024
BATCH = 1
SEQ = 16384
DEPTH = 2

D_MIX = D_MODEL
N_GROUPS = 4
GROUP_W = D_MIX // N_GROUPS

A_HEADS = 4
A_QK_DIM = GROUP_W // A_HEADS // 2
A_V_DIM = 2 * A_QK_DIM

B_HEADS = 4
B_HEAD_DIM = GROUP_W // B_HEADS
MOBA_BLOCK = 256
MOBA_TOPK = 3

C_HEADS = 4
C_V_DIM = GROUP_W // C_HEADS
C_K_DIM = C_V_DIM // 2
GLA_RANK = 16
GLA_TAU = 16.0
GLA_CHUNK = 64

D_WIDTH = GROUP_W
D_BLOCKS = 4
D_BLOCK_DIM = D_WIDTH // D_BLOCKS
CONV_W = 4
LRU_C = 8.0

N_EXPERTS = 32
TOP_K = 4
D_FF = D_MODEL
SWIGLU_ALPHA = 1.702
SWIGLU_LIMIT = 7.0
MOE_BLOCK = 128

Q_BLOCK = 128
EPS = 1e-6

A_Q = A_HEADS * 2 * A_QK_DIM
A_K = A_HEADS * 2 * A_QK_DIM
A_V = A_HEADS * A_V_DIM
B_Q = GROUP_W
B_K = GROUP_W
B_V = GROUP_W
C_Q = C_HEADS * C_K_DIM
C_K = C_HEADS * C_K_DIM
C_V = C_HEADS * C_V_DIM
C_G = GLA_RANK
C_R = C_HEADS * C_V_DIM
D_X = D_WIDTH
D_G = D_WIDTH
D_IN = A_Q + A_K + A_V + B_Q + B_K + B_V + C_Q + C_K + C_V + C_G + C_R + D_X + D_G

kernel_name = "hybrid_parallel_heads_moe_block"


def rms_norm(x, gain):
    xf = x.astype(jnp.float32)
    y = xf * lax.rsqrt(jnp.mean(xf * xf, axis=-1, keepdims=True) + EPS)
    return (y * gain.astype(jnp.float32)).astype(x.dtype)


def to_heads(t, n):
    b, s, f = t.shape
    return t.reshape(b, s, n, f // n).transpose(0, 2, 1, 3)


def merge_heads(t):
    b, h, s, d = t.shape
    return t.transpose(0, 2, 1, 3).reshape(b, s, h * d)


def split_columns(proj):
    sizes = (A_Q, A_K, A_V, B_Q, B_K, B_V, C_Q, C_K, C_V, C_G, C_R, D_X, D_G)
    out, off = [], 0
    for sz in sizes:
        out.append(proj[..., off:off + sz])
        off += sz
    return out


def diff_attention(q, k, v, q_gain, k_gain, lam_q1, lam_k1, lam_q2, lam_k2, out_gain, layer_idx):
    bsz, s, _ = q.shape
    q = rms_norm(q.reshape(bsz, s, A_HEADS, 2, A_QK_DIM), q_gain).transpose(0, 2, 3, 1, 4)
    k = rms_norm(k.reshape(bsz, s, A_HEADS, 2, A_QK_DIM), k_gain).transpose(0, 2, 3, 1, 4)
    v = to_heads(v, A_HEADS)
    lam_init = 0.8 - 0.6 * math.exp(-0.3 * layer_idx)
    lam = (jnp.exp(jnp.sum(lam_q1.astype(jnp.float32) * lam_k1.astype(jnp.float32)))
           - jnp.exp(jnp.sum(lam_q2.astype(jnp.float32) * lam_k2.astype(jnp.float32))) + lam_init)
    scale = A_QK_DIM ** -0.5
    nq = s // Q_BLOCK
    qb = q.reshape(bsz, A_HEADS, 2, nq, Q_BLOCK, A_QK_DIM).transpose(3, 0, 1, 2, 4, 5)
    kpos = jnp.arange(s)

    def block(args):
        j, qj = args
        qpos = j * Q_BLOCK + jnp.arange(Q_BLOCK)
        sc = jnp.einsum('bhiqd,bhikd->bhiqk', qj, k).astype(jnp.float32) * scale
        sc = jnp.where(kpos[None, :] <= qpos[:, None], sc, -jnp.inf)
        p = jax.nn.softmax(sc, axis=-1)
        w = p[:, :, 0] - lam * p[:, :, 1]
        return jnp.einsum('bhqk,bhkd->bhqd', w.astype(v.dtype), v)

    o = lax.map(block, (jnp.arange(nq), qb))
    o = o.transpose(1, 2, 0, 3, 4).reshape(bsz, A_HEADS, s, A_V_DIM)
    o = rms_norm(o, out_gain) * (1.0 - lam_init)
    return merge_heads(o)


def moba_attention(q, k, v, q_gain, k_gain):
    bsz, s, _ = q.shape
    q = rms_norm(to_heads(q, B_HEADS), q_gain)
    k = rms_norm(to_heads(k, B_HEADS), k_gain)
    v = to_heads(v, B_HEADS)
    nb = -(-s // MOBA_BLOCK)
    pad = nb * MOBA_BLOCK - s
    k_p = jnp.pad(k, ((0, 0), (0, 0), (0, pad), (0, 0)))
    v_p = jnp.pad(v, ((0, 0), (0, 0), (0, pad), (0, 0)))
    kb = k_p.reshape(bsz, B_HEADS, nb, MOBA_BLOCK, B_HEAD_DIM)
    vb = v_p.reshape(bsz, B_HEADS, nb, MOBA_BLOCK, B_HEAD_DIM)
    k_mean = jnp.mean(kb.astype(jnp.float32), axis=3)
    topk = min(MOBA_TOPK, nb)
    scale = B_HEAD_DIM ** -0.5
    nq = s // Q_BLOCK
    qb = q.reshape(bsz, B_HEADS, nq, Q_BLOCK, B_HEAD_DIM).transpose(2, 0, 1, 3, 4)
    b_idx = jnp.arange(bsz)[:, None, None, None]
    h_idx = jnp.arange(B_HEADS)[None, :, None, None]
    blk_ids = jnp.arange(nb)

    def block(args):
        j, qj = args
        qpos = j * Q_BLOCK + jnp.arange(Q_BLOCK)
        own = (j * Q_BLOCK) // MOBA_BLOCK
        gate = jnp.einsum('bhqd,bhnd->bhqn', qj.astype(jnp.float32), k_mean)
        gate = jnp.where(blk_ids < own, gate, -jnp.inf)
        _, sel = lax.top_k(gate, topk)
        valid = sel < own
        k_sel = kb[b_idx, h_idx, sel]
        v_sel = vb[b_idx, h_idx, sel]
        s_sel = jnp.einsum('bhqd,bhqnkd->bhqnk', qj, k_sel).astype(jnp.float32) * scale
        s_sel = jnp.where(valid[..., None], s_sel, -jnp.inf).reshape(bsz, B_HEADS, Q_BLOCK, topk * MOBA_BLOCK)
        k_own = lax.dynamic_slice_in_dim(k_p, own * MOBA_BLOCK, MOBA_BLOCK, axis=2)
        v_own = lax.dynamic_slice_in_dim(v_p, own * MOBA_BLOCK, MOBA_BLOCK, axis=2)
        kpos = own * MOBA_BLOCK + jnp.arange(MOBA_BLOCK)
        s_own = jnp.einsum('bhqd,bhkd->bhqk', qj, k_own).astype(jnp.float32) * scale
        s_own = jnp.where(kpos[None, :] <= qpos[:, None], s_own, -jnp.inf)
        p = jax.nn.softmax(jnp.concatenate([s_sel, s_own], axis=-1), axis=-1).astype(v.dtype)
        p_sel = p[..., :topk * MOBA_BLOCK].reshape(bsz, B_HEADS, Q_BLOCK, topk, MOBA_BLOCK)
        p_own = p[..., topk * MOBA_BLOCK:]
        return (jnp.einsum('bhqnk,bhqnkd->bhqd', p_sel, v_sel)
                + jnp.einsum('bhqk,bhkd->bhqd', p_own, v_own))

    o = lax.map(block, (jnp.arange(nq), qb))
    o = o.transpose(1, 2, 0, 3, 4).reshape(bsz, B_HEADS, s, B_HEAD_DIM)
    return merge_heads(o)


def gla(q, k, v, g_low, r, w_g2, b_g, out_gain):
    bsz, s, _ = q.shape
    dt = q.dtype
    f32 = jnp.float32
    q = to_heads(q, C_HEADS).astype(f32) * (C_K_DIM ** -0.5)
    k = to_heads(k, C_HEADS).astype(f32)
    v = to_heads(v, C_HEADS).astype(f32)
    g = jax.nn.log_sigmoid((g_low @ w_g2 + b_g).astype(f32)) / GLA_TAU
    g = to_heads(g, C_HEADS)
    nc = s // GLA_CHUNK

    def chunks(t):
        return t.reshape(bsz, C_HEADS, nc, GLA_CHUNK, t.shape[-1]).transpose(2, 0, 1, 3, 4)

    causal = jnp.tril(jnp.ones((GLA_CHUNK, GLA_CHUNK), bool))

    def step(state, inp):
        qc, kc, vc, gc = inp
        bcum = jnp.cumsum(gc, axis=2)
        o_inter = jnp.einsum('bhcd,bhde->bhce', qc * jnp.exp(bcum), state)
        diff = bcum[:, :, :, None, :] - bcum[:, :, None, :, :]
        decay = jnp.exp(jnp.where(causal[:, :, None], diff, -jnp.inf))
        att = jnp.einsum('bhid,bhjd,bhijd->bhij', qc, kc, decay)
        o_intra = jnp.einsum('bhij,bhje->bhie', att, vc)
        b_last = bcum[:, :, -1:, :]
        state = (jnp.exp(b_last[:, :, 0, :])[..., None] * state
                 + jnp.einsum('bhcd,bhce->bhde', kc * jnp.exp(b_last - bcum), vc))
        return state, o_inter + o_intra

    state0 = jnp.zeros((bsz, C_HEADS, C_K_DIM, C_V_DIM), f32)
    _, o = lax.scan(step, state0, (chunks(q), chunks(k), chunks(v), chunks(g)))
    o = o.transpose(1, 2, 0, 3, 4).reshape(bsz, C_HEADS, s, C_V_DIM)
    o = merge_heads(rms_norm(o, out_gain)) * jax.nn.silu(r.astype(f32))
    return o.astype(dt)


def rg_lru(xb, gate_in, conv_w, conv_b, w_a, b_a, w_x, b_x, lam):
    bsz, s, cw = xb.shape
    f32 = jnp.float32
    xc = lax.conv_general_dilated(xb, conv_w[:, None, :], window_strides=(1,),
                                  padding=[(CONV_W - 1, 0)],
                                  dimension_numbers=('NWC', 'WIO', 'NWC'),
                                  feature_group_count=cw) + conv_b
    xs = xc.reshape(bsz, s, D_BLOCKS, D_BLOCK_DIM)
    r_gate = jax.nn.sigmoid((jnp.einsum('bsnd,nde->bsne', xs, w_a).reshape(bsz, s, cw) + b_a).astype(f32))
    i_gate = jax.nn.sigmoid((jnp.einsum('bsnd,nde->bsne', xs, w_x).reshape(bsz, s, cw) + b_x).astype(f32))
    log_a = LRU_C * r_gate * jax.nn.log_sigmoid(lam.astype(f32))
    a = jnp.exp(log_a)
    bt = jnp.sqrt(-jnp.expm1(2.0 * log_a)) * (i_gate * xc.astype(f32))

    def combine(c1, c2):
        a1, b1 = c1
        a2, b2 = c2
        return a1 * a2, a2 * b1 + b2

    _, h = lax.associative_scan(combine, (a, bt), axis=1)
    return (h * jax.nn.gelu(gate_in.astype(f32))).astype(xb.dtype)


def hybrid_mixer(h, w_in, w_out, a_q_gain, a_k_gain, a_lam_q1, a_lam_k1, a_lam_q2, a_lam_k2,
                 a_out_gain, b_q_gain, b_k_gain, c_w_g2, c_b_g, c_out_gain, d_conv_w, d_conv_b,
                 d_w_a, d_b_a, d_w_x, d_b_x, d_lambda, layer_idx):
    proj = h @ w_in
    aq, ak, av, bq, bk, bv, cq, ck, cv, cg, cr, dx, dg = split_columns(proj)
    o_a = diff_attention(aq, ak, av, a_q_gain, a_k_gain, a_lam_q1, a_lam_k1, a_lam_q2, a_lam_k2,
                         a_out_gain, layer_idx)
    o_b = moba_attention(bq, bk, bv, b_q_gain, b_k_gain)
    o_c = gla(cq, ck, cv, cg, cr, c_w_g2, c_b_g, c_out_gain)
    o_d = rg_lru(dx, dg, d_conv_w, d_conv_b, d_w_a, d_b_a, d_w_x, d_b_x, d_lambda)
    y = jnp.concatenate([o_a.astype(h.dtype), o_b.astype(h.dtype), o_c, o_d], axis=-1)
    return y @ w_out


def moe(h, router_w, router_b, w_up, b_up, w_down, b_down):
    bsz, s, d = h.shape
    t = bsz * s
    xt = h.reshape(t, d)
    logits = (xt @ router_w + router_b).astype(jnp.float32)
    top_vals, top_idx = lax.top_k(logits, TOP_K)
    gates = jax.nn.softmax(top_vals, axis=-1)
    n = t * TOP_K
    e_flat = top_idx.reshape(n)
    tok_flat = jnp.arange(n, dtype=jnp.int32) // TOP_K
    g_flat = gates.reshape(n)
    order = jnp.argsort(e_flat)
    e_sorted = e_flat[order]
    tok_sorted = tok_flat[order]
    g_sorted = g_flat[order]
    counts = jax.ops.segment_sum(jnp.ones((n,), jnp.int32), e_flat, num_segments=N_EXPERTS)
    starts = jnp.cumsum(counts) - counts
    padded = (counts + MOE_BLOCK - 1) // MOE_BLOCK * MOE_BLOCK
    pad_ends = jnp.cumsum(padded)
    pad_starts = pad_ends - padded
    dest = pad_starts[e_sorted] + (jnp.arange(n, dtype=jnp.int32) - starts[e_sorted])
    n_rows = -(-n // MOE_BLOCK) * MOE_BLOCK + N_EXPERTS * MOE_BLOCK
    n_blocks = n_rows // MOE_BLOCK
    row_tok = jnp.full((n_rows,), t, jnp.int32).at[dest].set(tok_sorted)
    row_gate = jnp.zeros((n_rows,), jnp.float32).at[dest].set(g_sorted)
    blk_expert = jnp.minimum(jnp.searchsorted(pad_ends, jnp.arange(n_blocks) * MOE_BLOCK, side='right'),
                             N_EXPERTS - 1)
    x_pad = jnp.concatenate([xt, jnp.zeros((1, d), xt.dtype)], axis=0)
    x_rows = x_pad[row_tok].reshape(n_blocks, MOE_BLOCK, d)

    def expert_block(args):
        e, xb = args
        hu = xb @ w_up[e] + b_up[e]
        g = jnp.minimum(hu[:, :D_FF], SWIGLU_LIMIT)
        lin = jnp.clip(hu[:, D_FF:], -SWIGLU_LIMIT, SWIGLU_LIMIT)
        glu = g * jax.nn.sigmoid(SWIGLU_ALPHA * g)
        return ((lin + 1.0) * glu) @ w_down[e] + b_down[e]

    y_rows = lax.map(expert_block, (blk_expert, x_rows)).reshape(n_rows, d)
    y = jax.ops.segment_sum(y_rows * row_gate[:, None].astype(y_rows.dtype), row_tok, num_segments=t + 1)[:t]
    return y.reshape(bsz, s, d)


def setup_inputs(seed: int = 0) -> dict:
    key = jax.random.key(seed)
    ks = iter(jax.random.split(key, 40))
    L = DEPTH
    f32 = jnp.float32

    def nrm(shape, scale):
        return jax.random.normal(next(ks), shape, f32) * scale

    def gain(shape):
        return 1.0 + nrm(shape, 0.05)

    x = nrm((BATCH, SEQ, D_MODEL), 1.0)
    c = nrm((BATCH, D_MODEL), 1.0)
    ada_w = nrm((L, D_MODEL, 6 * D_MODEL), 0.5 * D_MODEL ** -0.5)
    ada_b = nrm((L, 6 * D_MODEL), 0.02)
    norm1_g = gain((L, D_MODEL))
    norm2_g = gain((L, D_MODEL))
    w_in = nrm((L, D_MODEL, D_IN), D_MODEL ** -0.5)
    w_out = nrm((L, D_MIX, D_MODEL), D_MIX ** -0.5)
    a_q_gain = gain((L, A_QK_DIM))
    a_k_gain = gain((L, A_QK_DIM))
    a_lam_q1 = nrm((L, A_QK_DIM), 0.1)
    a_lam_k1 = nrm((L, A_QK_DIM), 0.1)
    a_lam_q2 = nrm((L, A_QK_DIM), 0.1)
    a_lam_k2 = nrm((L, A_QK_DIM), 0.1)
    a_out_gain = gain((L, A_V_DIM))
    b_q_gain = gain((L, B_HEAD_DIM))
    b_k_gain = gain((L, B_HEAD_DIM))
    c_w_g2 = nrm((L, GLA_RANK, C_HEADS * C_K_DIM), GLA_RANK ** -0.5)
    c_b_g = nrm((L, C_HEADS * C_K_DIM), 0.1)
    c_out_gain = gain((L, C_V_DIM))
    d_conv_w = nrm((L, CONV_W, D_WIDTH), CONV_W ** -0.5)
    d_conv_b = nrm((L, D_WIDTH), 0.02)
    d_w_a = nrm((L, D_BLOCKS, D_BLOCK_DIM, D_BLOCK_DIM), D_BLOCK_DIM ** -0.5)
    d_b_a = nrm((L, D_WIDTH), 0.02)
    d_w_x = nrm((L, D_BLOCKS, D_BLOCK_DIM, D_BLOCK_DIM), D_BLOCK_DIM ** -0.5)
    d_b_x = nrm((L, D_WIDTH), 0.02)
    u = jax.random.uniform(next(ks), (L, D_WIDTH), f32, 0.9, 0.999)
    p = u ** (1.0 / LRU_C)
    d_lambda = jnp.log(p) - jnp.log1p(-p)
    router_w = nrm((L, D_MODEL, N_EXPERTS), D_MODEL ** -0.5)
    router_b = nrm((L, N_EXPERTS), 0.01)
    exp_w_up = nrm((L, N_EXPERTS, D_MODEL, 2 * D_FF), D_MODEL ** -0.5)
    exp_b_up = nrm((L, N_EXPERTS, 2 * D_FF), 0.01)
    exp_w_down = nrm((L, N_EXPERTS, D_FF, D_MODEL), D_FF ** -0.5)
    exp_b_down = nrm((L, N_EXPERTS, D_MODEL), 0.01)
    return {"x": x, "c": c, "ada_w": ada_w, "ada_b": ada_b, "norm1_g": norm1_g, "norm2_g": norm2_g,
            "w_in": w_in, "w_out": w_out, "a_q_gain": a_q_gain, "a_k_gain": a_k_gain,
            "a_lam_q1": a_lam_q1, "a_lam_k1": a_lam_k1, "a_lam_q2": a_lam_q2, "a_lam_k2": a_lam_k2,
            "a_out_gain": a_out_gain, "b_q_gain": b_q_gain, "b_k_gain": b_k_gain,
            "c_w_g2": c_w_g2, "c_b_g": c_b_g, "c_out_gain": c_out_gain,
            "d_conv_w": d_conv_w, "d_conv_b": d_conv_b, "d_w_a": d_w_a, "d_b_a": d_b_a,
            "d_w_x": d_w_x, "d_b_x": d_b_x, "d_lambda": d_lambda,
            "router_w": router_w, "router_b": router_b, "exp_w_up": exp_w_up, "exp_b_up": exp_b_up,
            "exp_w_down": exp_w_down, "exp_b_down": exp_b_down}


def reference(x, c, ada_w, ada_b, norm1_g, norm2_g, w_in, w_out, a_q_gain, a_k_gain,
              a_lam_q1, a_lam_k1, a_lam_q2, a_lam_k2, a_out_gain, b_q_gain, b_k_gain,
              c_w_g2, c_b_g, c_out_gain, d_conv_w, d_conv_b, d_w_a, d_b_a, d_w_x, d_b_x, d_lambda,
              router_w, router_b, exp_w_up, exp_b_up, exp_w_down, exp_b_down):
    cond = jax.nn.silu(c)
    for l in range(DEPTH):
        mod = cond @ ada_w[l] + ada_b[l]
        sh1, sc1, g1, sh2, sc2, g2 = jnp.split(mod, 6, axis=-1)
        h = rms_norm(x, norm1_g[l]) * (1.0 + sc1[:, None, :]) + sh1[:, None, :]
        y = hybrid_mixer(h, w_in[l], w_out[l], a_q_gain[l], a_k_gain[l], a_lam_q1[l], a_lam_k1[l],
                         a_lam_q2[l], a_lam_k2[l], a_out_gain[l], b_q_gain[l], b_k_gain[l],
                         c_w_g2[l], c_b_g[l], c_out_gain[l], d_conv_w[l], d_conv_b[l],
                         d_w_a[l], d_b_a[l], d_w_x[l], d_b_x[l], d_lambda[l], l)
        x = x + g1[:, None, :] * y
        h = rms_norm(x, norm2_g[l]) * (1.0 + sc2[:, None, :]) + sh2[:, None, :]
        y = moe(h, router_w[l], router_b[l], exp_w_up[l], exp_b_up[l], exp_w_down[l], exp_b_down[l])
        x = x + g2[:, None, :] * y
    return x
```

```cpp
#include <hip/hip_runtime.h>
#include <hip/hip_cooperative_groups.h>
#include <cstdio>
#include <cstdint>
namespace cg = cooperative_groups;

#ifndef MK_SINGLE
#define MK_SINGLE 0
#endif

constexpr int S = 16384, D = 1024, DIN = 2832, NE = 32;
constexpr int NT = 512;
constexpr size_t MiB = 1u << 20;
constexpr size_t WS_MOD = 0;
constexpr size_t WS_CNT = 64 * 1024;
constexpr size_t WS_KMEAN = 1 * MiB;
constexpr size_t WS_GATE = 3 * MiB;
constexpr size_t WS_LIST = 4 * MiB;
constexpr size_t WS_H = 8 * MiB;
constexpr size_t WS_PROJ = 72 * MiB;
constexpr size_t WS_Y = 250 * MiB;
constexpr size_t WS_X1 = 314 * MiB;
constexpr size_t WS_XA = 378 * MiB;
constexpr size_t WS_QA = 442 * MiB;
constexpr size_t WS_KA = 458 * MiB;
constexpr size_t WS_QB = 474 * MiB;
constexpr size_t WS_KB = 490 * MiB;
constexpr size_t WS_GA = 506 * MiB;
constexpr size_t WS_LA = 514 * MiB;
constexpr size_t WS_LB = 530 * MiB;
constexpr size_t WS_OA = 546 * MiB;
constexpr size_t WS_OC = 578 * MiB;
constexpr size_t WS_ACT = 594 * MiB;
constexpr size_t WS_YR = 850 * MiB;

struct Params {
  const float* in[33];
  float* out;
  char* ws;
};

constexpr int PC_AQ = 0, PC_AK = 256, PC_AV = 512, PC_BQ = 768, PC_BK = 1024, PC_BV = 1280, PC_CQ = 1536, PC_CK = 1664,
              PC_CV = 1792, PC_CG = 2048, PC_CR = 2064, PC_DX = 2320, PC_DG = 2576;

__device__ __forceinline__ float wave_sum(float v) {
#pragma unroll
  for (int o = 1; o < 64; o <<= 1) v += __shfl_xor(v, o);
  return v;
}
__device__ __forceinline__ float sigmoidf_(float x) { return 1.f / (1.f + __expf(-x)); }
__device__ __forceinline__ float logsigmoidf_(float z) { return fminf(z, 0.f) - log1pf(__expf(-fabsf(z))); }
__device__ __forceinline__ float gelu_tanh(float x) {
  float u = 0.7978845608028654f * (x + 0.044715f * x * x * x);
  float t = 1.f - 2.f / (__expf(2.f * u) + 1.f);
  return 0.5f * x * (1.f + t);
}
__device__ __forceinline__ float lam_init_of(int l) { return l == 0 ? 0.2f : (0.8f - 0.6f * 0.7408182206817179f); }
__device__ __forceinline__ float lam_of(const Params& p, int l) {
  float s1 = 0.f, s2 = 0.f;
  for (int i = 0; i < 32; ++i) {
    s1 += p.in[10][l * 32 + i] * p.in[11][l * 32 + i];
    s2 += p.in[12][l * 32 + i] * p.in[13][l * 32 + i];
  }
  return __expf(s1) - __expf(s2) + lam_init_of(l);
}

__device__ void ph_mod(const Params& p) {
  int gtid = blockIdx.x * NT + threadIdx.x, gn = gridDim.x * NT;
  float* mod = (float*)(p.ws + WS_MOD);
  const float* c = p.in[1];
  for (int idx = gtid; idx < 2 * 6144; idx += gn) {
    int l = idx / 6144, j = idx % 6144;
    const float* w = p.in[2] + (size_t)l * 1024 * 6144 + j;
    float acc = 0.f;
    for (int i = 0; i < 1024; ++i) {
      float cv = c[i];
      float sv = cv / (1.f + __expf(-cv));
      acc += sv * w[(size_t)i * 6144];
    }
    mod[idx] = acc + p.in[3][idx];
  }
  if (blockIdx.x == 0 && threadIdx.x < 64) ((int*)(p.ws + WS_CNT))[threadIdx.x] = 0;
}

__device__ void ph_norm(const Params& p, int l, int which, float* sm) {
  const int lane = threadIdx.x & 63, wave = threadIdx.x >> 6;
  const float* mod = (const float*)(p.ws + WS_MOD) + l * 6144;
  const float* xin = which == 0 ? (l == 0 ? p.in[0] : (const float*)(p.ws + WS_XA)) : (const float*)(p.ws + WS_X1);
  const float* gain = (which == 0 ? p.in[4] : p.in[5]) + l * 1024;
  const float* sh = mod + (which == 0 ? 0 : 3) * 1024;
  const float* sc = mod + (which == 0 ? 1 : 4) * 1024;
  float* H = (float*)(p.ws + WS_H);
  const float* rw = p.in[27] + (size_t)l * 1024 * 32;
  const float* rb = p.in[28] + l * 32;
  int* cnt = (int*)(p.ws + WS_CNT) + l * 32;
  int* list = (int*)(p.ws + WS_LIST);
  float* gatebuf = (float*)(p.ws + WS_GATE);
  for (int rbase = blockIdx.x * 8; rbase < S; rbase += gridDim.x * 8) {
    const int row = rbase + wave;
    const float4* xr = (const float4*)(xin + (size_t)row * 1024) + lane;
    float4 v[4];
    float ss = 0.f;
#pragma unroll
    for (int j = 0; j < 4; ++j) {
      v[j] = xr[64 * j];
      ss += v[j].x * v[j].x + v[j].y * v[j].y + v[j].z * v[j].z + v[j].w * v[j].w;
    }
    ss = wave_sum(ss);
    float r = rsqrtf(ss * (1.f / 1024.f) + 1e-6f);
    float4* hr = (float4*)(H + (size_t)row * 1024) + lane;
#pragma unroll
    for (int j = 0; j < 4; ++j) {
      int col = (lane + 64 * j) * 4;
      float4 g = *(const float4*)(gain + col), a = *(const float4*)(sc + col), b = *(const float4*)(sh + col);
      v[j].x = v[j].x * r * g.x * (1.f + a.x) + b.x;
      v[j].y = v[j].y * r * g.y * (1.f + a.y) + b.y;
      v[j].z = v[j].z * r * g.z * (1.f + a.z) + b.z;
      v[j].w = v[j].w * r * g.w * (1.f + a.w) + b.w;
      hr[64 * j] = v[j];
    }
    if (which == 1) {
      float* hs = sm + wave * 1024;
      __syncthreads();
#pragma unroll
      for (int j = 0; j < 4; ++j) *(float4*)(hs + (lane + 64 * j) * 4) = v[j];
      __syncthreads();
      const int e = lane & 31, kh = lane >> 5;
      float acc = 0.f;
      const float* wp = rw + (size_t)(kh * 512) * 32 + e;
      const float* hp = hs + kh * 512;
#pragma unroll 8
      for (int k = 0; k < 512; ++k) acc += hp[k] * wp[(size_t)k * 32];
      acc += __shfl_xor(acc, 32);
      float val = acc + rb[e];
      if (lane >= 32) val = -INFINITY;
      const int idx = e;
      float tv0, tv1, tv2, tv3; int ti0, ti1, ti2, ti3;
#define TOPK_ROUND(TV, TI)                                                              \
      { float bv = val; int bi = idx;                                                   \
        _Pragma("unroll") for (int o = 1; o < 64; o <<= 1) {                            \
          float ov = __shfl_xor(bv, o); int oi = __shfl_xor(bi, o);                     \
          if (ov > bv || (ov == bv && oi < bi)) { bv = ov; bi = oi; } }                 \
        TV = bv; TI = bi; if (idx == bi) val = -INFINITY; }
      TOPK_ROUND(tv0, ti0) TOPK_ROUND(tv1, ti1) TOPK_ROUND(tv2, ti2) TOPK_ROUND(tv3, ti3)
#undef TOPK_ROUND
      float e1 = __expf(tv1 - tv0), e2 = __expf(tv2 - tv0), e3 = __expf(tv3 - tv0);
      float inv = 1.f / (1.f + e1 + e2 + e3);
      if (lane == 0) {
        int pos;
        pos = atomicAdd(&cnt[ti0], 1); list[ti0 * S + pos] = row * 4 + 0; gatebuf[row * 4 + 0] = inv;
        pos = atomicAdd(&cnt[ti1], 1); list[ti1 * S + pos] = row * 4 + 1; gatebuf[row * 4 + 1] = e1 * inv;
        pos = atomicAdd(&cnt[ti2], 1); list[ti2 * S + pos] = row * 4 + 2; gatebuf[row * 4 + 2] = e2 * inv;
        pos = atomicAdd(&cnt[ti3], 1); list[ti3 * S + pos] = row * 4 + 3; gatebuf[row * 4 + 3] = e3 * inv;
      }
    }
  }
}

template <class AF, class BF, class EF>
__device__ __forceinline__ void gemm_tile(AF arow, BF bptr, int ldb, int K, EF epi, float* sm) {
  float(*As)[132] = (float(*)[132])sm;
  float(*Bs)[132] = (float(*)[132])(sm + 16 * 132);
  const int tid = threadIdx.x, ty = tid >> 4, tx = tid & 15;
  float acc[4][8];
#pragma unroll
  for (int r = 0; r < 4; ++r)
#pragma unroll
    for (int c = 0; c < 8; ++c) acc[r][c] = 0.f;
  const int ar = tid >> 2, ak = (tid & 3) * 4;
  const float* ap = arow(ar);
  const int bk = tid >> 5, bj = (tid & 31) * 4;
  const float* bp = bptr(bj);
  for (int k0 = 0; k0 < K; k0 += 16) {
    float4 av = ap ? *(const float4*)(ap + k0 + ak) : make_float4(0.f, 0.f, 0.f, 0.f);
    float4 bv = bp ? *(const float4*)(bp + (size_t)(k0 + bk) * ldb) : make_float4(0.f, 0.f, 0.f, 0.f);
    __syncthreads();
    As[ak + 0][ar] = av.x; As[ak + 1][ar] = av.y; As[ak + 2][ar] = av.z; As[ak + 3][ar] = av.w;
    *(float4*)&Bs[bk][bj] = bv;
    __syncthreads();
#pragma unroll
    for (int k = 0; k < 16; ++k) {
      float4 a = *(const float4*)&As[k][ty * 4];
      float4 b0 = *(const float4*)&Bs[k][tx * 4], b1 = *(const float4*)&Bs[k][64 + tx * 4];
      float aa[4] = {a.x, a.y, a.z, a.w};
      float bb[8] = {b0.x, b0.y, b0.z, b0.w, b1.x, b1.y, b1.z, b1.w};
#pragma unroll
      for (int r = 0; r < 4; ++r)
#pragma unroll
        for (int c = 0; c < 8; ++c) acc[r][c] += aa[r] * bb[c];
    }
  }
  epi(ty, tx, acc);
  __syncthreads();
}

__device__ void ph_inproj(const Params& p, int l, float* sm) {
  const float* H = (const float*)(p.ws + WS_H);
  const float* W = p.in[6] + (size_t)l * 1024 * DIN;
  float* P = (float*)(p.ws + WS_PROJ);
  const int nN = (DIN + 127) / 128;
  for (int it = blockIdx.x; it < (S / 128) * nN; it += gridDim.x) {
    int mt = it / nN, nt = it % nN, m0 = mt * 128, n0 = nt * 128;
    gemm_tile([&](int i) { return H + (size_t)(m0 + i) * 1024; },
              [&](int j) { return (n0 + j < DIN) ? W + n0 + j : (const float*)nullptr; }, DIN, 1024,
              [&](int ty, int tx, float(&acc)[4][8]) {
#pragma unroll
                for (int r = 0; r < 4; ++r) {
                  float* o = P + (size_t)(m0 + ty * 4 + r) * DIN + n0;
                  int c0 = tx * 4, c1 = 64 + tx * 4;
                  if (n0 + c0 < DIN) *(float4*)(o + c0) = make_float4(acc[r][0], acc[r][1], acc[r][2], acc[r][3]);
                  if (n0 + c1 < DIN) *(float4*)(o + c1) = make_float4(acc[r][4], acc[r][5], acc[r][6], acc[r][7]);
                }
              },
              sm);
  }
}

__device__ void ph_prep(const Params& p, int l, float* sm) {
  const int lane = threadIdx.x & 63, wave = threadIdx.x >> 6;
  const float* P = (const float*)(p.ws + WS_PROJ);
  float* QA = (float*)(p.ws + WS_QA); float* KA = (float*)(p.ws + WS_KA);
  float* QB = (float*)(p.ws + WS_QB); float* KB = (float*)(p.ws + WS_KB);
  float* GA = (float*)(p.ws + WS_GA);
  const float* aqg = p.in[8] + l * 32; const float* akg = p.in[9] + l * 32;
  const float* bqg = p.in[15] + l * 64; const float* bkg = p.in[16] + l * 64;
  const float* wg2 = p.in[17] + l * 16 * 128; const float* bg = p.in[18] + l * 128;
  for (int row = blockIdx.x * 8 + wave; row < S; row += gridDim.x * 8) {
    const float* pr = P + (size_t)row * DIN;
    {
      float4 q = *(const float4*)(pr + PC_AQ + lane * 4), k = *(const float4*)(pr + PC_AK + lane * 4);
      float sq = q.x * q.x + q.y * q.y + q.z * q.z + q.w * q.w, sk = k.x * k.x + k.y * k.y + k.z * k.z + k.w * k.w;
#pragma unroll
      for (int o = 1; o < 8; o <<= 1) { sq += __shfl_xor(sq, o); sk += __shfl_xor(sk, o); }
      float rq = rsqrtf(sq * (1.f / 32.f) + 1e-6f) * 0.17677669529663687f, rk = rsqrtf(sk * (1.f / 32.f) + 1e-6f);
      int c = (lane * 4) & 31;
      float4 gq = *(const float4*)(aqg + c), gk = *(const float4*)(akg + c);
      *(float4*)(QA + (size_t)row * 256 + lane * 4) = make_float4(q.x * rq * gq.x, q.y * rq * gq.y, q.z * rq * gq.z, q.w * rq * gq.w);
      *(float4*)(KA + (size_t)row * 256 + lane * 4) = make_float4(k.x * rk * gk.x, k.y * rk * gk.y, k.z * rk * gk.z, k.w * rk * gk.w);
    }
    {
      float4 q = *(const float4*)(pr + PC_BQ + lane * 4), k = *(const float4*)(pr + PC_BK + lane * 4);
      float sq = q.x * q.x + q.y * q.y + q.z * q.z + q.w * q.w, sk = k.x * k.x + k.y * k.y + k.z * k.z + k.w * k.w;
#pragma unroll
      for (int o = 1; o < 16; o <<= 1) { sq += __shfl_xor(sq, o); sk += __shfl_xor(sk, o); }
      float rq = rsqrtf(sq * (1.f / 64.f) + 1e-6f), rk = rsqrtf(sk * (1.f / 64.f) + 1e-6f);
      int c = (lane * 4) & 63;
      float4 gq = *(const float4*)(bqg + c), gk = *(const float4*)(bkg + c);
      *(float4*)(QB + (size_t)row * 256 + lane * 4) = make_float4(q.x * rq * gq.x, q.y * rq * gq.y, q.z * rq * gq.z, q.w * rq * gq.w);
      *(float4*)(KB + (size_t)row * 256 + lane * 4) = make_float4(k.x * rk * gk.x, k.y * rk * gk.y, k.z * rk * gk.z, k.w * rk * gk.w);
    }
    {
      float z0 = bg[lane], z1 = bg[lane + 64];
#pragma unroll
      for (int r = 0; r < 16; ++r) {
        float g = pr[PC_CG + r];
        z0 += g * wg2[r * 128 + lane];
        z1 += g * wg2[r * 128 + lane + 64];
      }
      GA[(size_t)row * 128 + lane] = __expf(logsigmoidf_(z0) * (1.f / 16.f));
      GA[(size_t)row * 128 + lane + 64] = __expf(logsigmoidf_(z1) * (1.f / 16.f));
    }
  }
  float* LA = (float*)(p.ws + WS_LA); float* LB = (float*)(p.ws + WS_LB);
  const float* cw = p.in[20] + l * 4 * 256; const float* cb = p.in[21] + l * 256;
  const float* wa = p.in[22] + (size_t)l * 4 * 64 * 64; const float* ba = p.in[23] + l * 256;
  const float* wx = p.in[24] + (size_t)l * 4 * 64 * 64; const float* bx = p.in[25] + l * 256;
  const float* lam = p.in[26] + l * 256;
  float(*xcs)[256] = (float(*)[256])sm;
  __syncthreads();
  for (int tile = blockIdx.x; tile < S / 16; tile += gridDim.x) {
    int t0 = tile * 16;
    for (int i = threadIdx.x; i < 16 * 256; i += NT) {
      int tt = i >> 8, ch = i & 255, t = t0 + tt;
      float acc = cb[ch];
#pragma unroll
      for (int w = 0; w < 4; ++w) {
        int ts = t + w - 3;
        if (ts >= 0) acc += cw[w * 256 + ch] * P[(size_t)ts * DIN + PC_DX + ch];
      }
      xcs[tt][ch] = acc;
    }
    __syncthreads();
    {
      int ch = threadIdx.x & 255, half = threadIdx.x >> 8, n = ch >> 6, e = ch & 63;
      float ar[8], ai[8];
#pragma unroll
      for (int i = 0; i < 8; ++i) { ar[i] = 0.f; ai[i] = 0.f; }
      for (int d = 0; d < 64; ++d) {
        float w1 = wa[(n * 64 + d) * 64 + e], w2 = wx[(n * 64 + d) * 64 + e];
#pragma unroll
        for (int i = 0; i < 8; ++i) {
          float xv = xcs[half * 8 + i][n * 64 + d];
          ar[i] += xv * w1; ai[i] += xv * w2;
        }
      }
      float ls = logsigmoidf_(lam[ch]);
      float bav = ba[ch], bxv = bx[ch];
#pragma unroll
      for (int i = 0; i < 8; ++i) {
        int t = t0 + half * 8 + i;
        float rg = sigmoidf_(ar[i] + bav), ig = sigmoidf_(ai[i] + bxv);
        float la = 8.f * rg * ls;
        float a = __expf(la);
        float bt = sqrtf(-expm1f(2.f * la)) * (ig * xcs[half * 8 + i][ch]);
        LA[(size_t)t * 256 + ch] = a;
        LB[(size_t)t * 256 + ch] = bt;
      }
    }
    __syncthreads();
  }
}

__device__ void ph_kmean(const Params& p, float* sm) {
  const float* KB = (const float*)(p.ws + WS_KB);
  float* KM = (float*)(p.ws + WS_KMEAN);
  __syncthreads();
  for (int it = blockIdx.x; it < 64 * 4; it += gridDim.x) {
    int n = it >> 2, h = it & 3;
    int c = threadIdx.x & 63, part = threadIdx.x >> 6;
    float s = 0.f;
    for (int i = 0; i < 32; ++i) s += KB[(size_t)(n * 256 + part * 32 + i) * 256 + h * 64 + c];
    sm[part * 64 + c] = s;
    __syncthreads();
    if (threadIdx.x < 64) {
      float t = 0.f;
#pragma unroll
      for (int q = 0; q < 8; ++q) t += sm[q * 64 + c];
      KM[(h * 64 + n) * 64 + c] = t * (1.f / 256.f);
    }
    __syncthreads();
  }
}

__device__ void attnA_item(const Params& p, int hm, int qb, float* sm) {
  const float* QA = (const float*)(p.ws + WS_QA); const float* KA = (const float*)(p.ws + WS_KA);
  const float* P = (const float*)(p.ws + WS_PROJ);
  float* OA = (float*)(p.ws + WS_OA);
  float(*Ks)[32] = (float(*)[32])sm;
  float(*Vs)[64] = (float(*)[64])(sm + 64 * 32);
  const int tid = threadIdx.x, ql = tid >> 1, half = tid & 1, h = hm >> 1;
  const int qi = qb * 256 + ql;
  float q[32], o[32];
  {
    const float4* qp = (const float4*)(QA + (size_t)qi * 256 + hm * 32);
#pragma unroll
    for (int i = 0; i < 8; ++i) { float4 t = qp[i]; q[4 * i] = t.x; q[4 * i + 1] = t.y; q[4 * i + 2] = t.z; q[4 * i + 3] = t.w; }
  }
#pragma unroll
  for (int i = 0; i < 32; ++i) o[i] = 0.f;
  float m = -INFINITY, lsum = 0.f;
  const int nkt = (qb * 256 + 256) / 64;
  for (int kt = 0; kt < nkt; ++kt) {
    __syncthreads();
    {
      int kr = tid >> 3, kc = (tid & 7) * 4;
      *(float4*)&Ks[kr][kc] = *(const float4*)(KA + (size_t)(kt * 64 + kr) * 256 + hm * 32 + kc);
#pragma unroll
      for (int u = 0; u < 2; ++u) {
        int idx = tid + u * 512, vr = idx >> 4, vc = (idx & 15) * 4;
        *(float4*)&Vs[vr][vc] = *(const float4*)(P + (size_t)(kt * 64 + vr) * DIN + PC_AV + h * 64 + vc);
      }
    }
    __syncthreads();
    for (int g = 0; g < 4; ++g) {
      int kbase = kt * 64 + g * 16;
      if (kbase > qi) break;
      float s[16];
      float gmax = -INFINITY;
#pragma unroll
      for (int j = 0; j < 16; ++j) {
        float a = 0.f;
#pragma unroll
        for (int d4 = 0; d4 < 8; ++d4) {
          float4 kv = *(const float4*)&Ks[g * 16 + j][d4 * 4];
          a += q[d4 * 4] * kv.x + q[d4 * 4 + 1] * kv.y + q[d4 * 4 + 2] * kv.z + q[d4 * 4 + 3] * kv.w;
        }
        s[j] = (kbase + j <= qi) ? a : -INFINITY;
        gmax = fmaxf(gmax, s[j]);
      }
      float mn = fmaxf(m, gmax);
      float alpha = __expf(m - mn);
      m = mn;
      lsum *= alpha;
#pragma unroll
      for (int i = 0; i < 32; ++i) o[i] *= alpha;
#pragma unroll
      for (int j = 0; j < 16; ++j) {
        float pj = __expf(s[j] - mn);
        lsum += pj;
#pragma unroll
        for (int d4 = 0; d4 < 8; ++d4) {
          float4 vv = *(const float4*)&Vs[g * 16 + j][half * 32 + d4 * 4];
          o[d4 * 4] += pj * vv.x; o[d4 * 4 + 1] += pj * vv.y; o[d4 * 4 + 2] += pj * vv.z; o[d4 * 4 + 3] += pj * vv.w;
        }
      }
    }
  }
  float inv = 1.f / lsum;
  float* op = OA + ((size_t)qi * 8 + hm) * 64 + half * 32;
#pragma unroll
  for (int i = 0; i < 8; ++i) *(float4*)(op + 4 * i) = make_float4(o[4 * i] * inv, o[4 * i + 1] * inv, o[4 * i + 2] * inv, o[4 * i + 3] * inv);
}

__device__ void moba_item(const Params& p, int it) {
  const float* QB = (const float*)(p.ws + WS_QB); const float* KB = (const float*)(p.ws + WS_KB);
  const float* KM = (const float*)(p.ws + WS_KMEAN);
  const float* P = (const float*)(p.ws + WS_PROJ);
  float* Y = (float*)(p.ws + WS_Y);
  const int h = it & 3, qi = (it >> 2) * 256 + (threadIdx.x >> 1), half = threadIdx.x & 1;
  const int own = qi >> 8;
  float q[64], o[32];
  {
    const float4* qp = (const float4*)(QB + (size_t)qi * 256 + h * 64);
#pragma unroll
    for (int i = 0; i < 16; ++i) { float4 t = qp[i]; q[4 * i] = t.x; q[4 * i + 1] = t.y; q[4 * i + 2] = t.z; q[4 * i + 3] = t.w; }
  }
  int s0 = -1, s1 = -1, s2 = -1;
  float g0 = -INFINITY, g1 = -INFINITY, g2 = -INFINITY;
#pragma unroll 1
  for (int n = 0; n < own; ++n) {
    const float4* kmp = (const float4*)(KM + (h * 64 + n) * 64);
    float a = 0.f;
#pragma unroll
    for (int i = 0; i < 16; ++i) { float4 t = kmp[i]; a += q[4 * i] * t.x + q[4 * i + 1] * t.y + q[4 * i + 2] * t.z + q[4 * i + 3] * t.w; }
    if (a > g0) { g2 = g1; s2 = s1; g1 = g0; s1 = s0; g0 = a; s0 = n; }
    else if (a > g1) { g2 = g1; s2 = s1; g1 = a; s1 = n; }
    else if (a > g2) { g2 = a; s2 = n; }
  }
#pragma unroll
  for (int i = 0; i < 32; ++i) o[i] = 0.f;
  float m = -INFINITY, lsum = 0.f;
#pragma unroll 1
  for (int src = 0; src < 4; ++src) {
    int blk = src == 0 ? s0 : src == 1 ? s1 : src == 2 ? s2 : own;
    if (blk < 0) continue;
    int nkeys = (src == 3) ? (qi - own * 256 + 1) : 256;
#pragma unroll 1
    for (int j = 0; j < nkeys; ++j) {
      int kj = blk * 256 + j;
      const float4* kp = (const float4*)(KB + (size_t)kj * 256 + h * 64);
      float a = 0.f;
#pragma unroll
      for (int i = 0; i < 16; ++i) { float4 t = kp[i]; a += q[4 * i] * t.x + q[4 * i + 1] * t.y + q[4 * i + 2] * t.z + q[4 * i + 3] * t.w; }
      a *= 0.125f;
      float mn = fmaxf(m, a);
      float alpha = __expf(m - mn), pj = __expf(a - mn);
      m = mn;
      lsum = lsum * alpha + pj;
      const float4* vp = (const float4*)(P + (size_t)kj * DIN + PC_BV + h * 64 + half * 32);
#pragma unroll
      for (int i = 0; i < 8; ++i) {
        float4 t = vp[i];
        o[4 * i] = o[4 * i] * alpha + pj * t.x; o[4 * i + 1] = o[4 * i + 1] * alpha + pj * t.y;
        o[4 * i + 2] = o[4 * i + 2] * alpha + pj * t.z; o[4 * i + 3] = o[4 * i + 3] * alpha + pj * t.w;
      }
    }
  }
  float inv = 1.f / lsum;
  float* op = Y + (size_t)qi * 1024 + 256 + h * 64 + half * 32;
#pragma unroll
  for (int i = 0; i < 8; ++i) *(float4*)(op + 4 * i) = make_float4(o[4 * i] * inv, o[4 * i + 1] * inv, o[4 * i + 2] * inv, o[4 * i + 3] * inv);
}

__device__ void gla_item(const Params& p, int h, float* sm) {
  const float* P = (const float*)(p.ws + WS_PROJ);
  const float* GA = (const float*)(p.ws + WS_GA);
  float* OC = (float*)(p.ws + WS_OC);
  float(*qs)[32] = (float(*)[32])sm;
  float(*ks)[32] = (float(*)[32])(sm + 2048);
  float(*as)[32] = (float(*)[32])(sm + 4096);
  float(*vs)[64] = (float(*)[64])(sm + 6144);
  const int tid = threadIdx.x, e = tid >> 3, dg = tid & 7;
  float st[4] = {0.f, 0.f, 0.f, 0.f};
  for (int c = 0; c < S / 64; ++c) {
    __syncthreads();
    {
      int r = tid >> 3, cc = (tid & 7) * 4;
      size_t t = (size_t)c * 64 + r;
      float4 qv = *(const float4*)(P + t * DIN + PC_CQ + h * 32 + cc);
      const float sc = 0.17677669529663687f;
      *(float4*)&qs[r][cc] = make_float4(qv.x * sc, qv.y * sc, qv.z * sc, qv.w * sc);
      *(float4*)&ks[r][cc] = *(const float4*)(P + t * DIN + PC_CK + h * 32 + cc);
      *(float4*)&as[r][cc] = *(const float4*)(GA + t * 128 + h * 32 + cc);
#pragma unroll
      for (int u = 0; u < 2; ++u) {
        int idx = tid + u * 512, vr = idx >> 4, vc = (idx & 15) * 4;
        *(float4*)&vs[vr][vc] = *(const float4*)(P + ((size_t)c * 64 + vr) * DIN + PC_CV + h * 64 + vc);
      }
    }
    __syncthreads();
    for (int t = 0; t < 64; ++t) {
      float4 a = *(const float4*)&as[t][dg * 4], k = *(const float4*)&ks[t][dg * 4], qq = *(const float4*)&qs[t][dg * 4];
      float v = vs[t][e];
      st[0] = a.x * st[0] + k.x * v; st[1] = a.y * st[1] + k.y * v; st[2] = a.z * st[2] + k.z * v; st[3] = a.w * st[3] + k.w * v;
      float part = qq.x * st[0] + qq.y * st[1] + qq.z * st[2] + qq.w * st[3];
      part += __shfl_xor(part, 1); part += __shfl_xor(part, 2); part += __shfl_xor(part, 4);
      if (dg == 0) OC[((size_t)c * 64 + t) * 256 + h * 64 + e] = part;
    }
  }
}

__device__ void lru_item(const Params& p, int it, float* sm) {
  const float* LA = (const float*)(p.ws + WS_LA); const float* LB = (const float*)(p.ws + WS_LB);
  const float* P = (const float*)(p.ws + WS_PROJ);
  float* Y = (float*)(p.ws + WS_Y);
  const int tid = threadIdx.x, cl = tid & 3, seg = tid >> 2, ch = it * 4 + cl;
  float* sA = sm; float* sH = sm + 512; float* sC = sm + 1024;
  __syncthreads();
  float A = 1.f, Hh = 0.f;
  for (int i = 0; i < 128; ++i) {
    size_t t = (size_t)seg * 128 + i;
    float a = LA[t * 256 + ch], b = LB[t * 256 + ch];
    Hh = a * Hh + b; A *= a;
  }
  sA[cl * 128 + seg] = A; sH[cl * 128 + seg] = Hh;
  __syncthreads();
  if (tid < 4) {
    float carry = 0.f;
    for (int s = 0; s < 128; ++s) {
      sC[tid * 128 + s] = carry;
      carry = sA[tid * 128 + s] * carry + sH[tid * 128 + s];
    }
  }
  __syncthreads();
  Hh = sC[cl * 128 + seg];
  for (int i = 0; i < 128; ++i) {
    size_t t = (size_t)seg * 128 + i;
    float a = LA[t * 256 + ch], b = LB[t * 256 + ch];
    Hh = a * Hh + b;
    float g = P[t * DIN + PC_DG + ch];
    Y[t * 1024 + 768 + ch] = Hh * gelu_tanh(g);
  }
}

__device__ void ph_mix(const Params& p, int l, float* sm) {
  for (int it = blockIdx.x; it < 4; it += gridDim.x) gla_item(p, it, sm);
  for (int it = blockIdx.x; it < 260; it += gridDim.x) {
    if (it < 4) continue;
    int w = it - 4, hm = w >> 5, s = w & 31;
#pragma unroll 1
    for (int k = 0; k < 2; ++k) attnA_item(p, hm, k == 0 ? s : 63 - s, sm);
  }
  for (int it = blockIdx.x; it < 516; it += gridDim.x) {
    if (it < 260) continue;
    moba_item(p, it - 260);
  }
  for (int it = blockIdx.x; it < 580; it += gridDim.x) {
    if (it < 516) continue;
    lru_item(p, it - 516, sm);
  }
}

__device__ void ph_fin(const Params& p, int l) {
  const int lane = threadIdx.x & 63, wave = threadIdx.x >> 6;
  const float* OA = (const float*)(p.ws + WS_OA); const float* OC = (const float*)(p.ws + WS_OC);
  const float* P = (const float*)(p.ws + WS_PROJ);
  float* Y = (float*)(p.ws + WS_Y);
  const float lam = lam_of(p, l), li = lam_init_of(l);
  const float* aog = p.in[14] + l * 64; const float* cog = p.in[19] + l * 64;
  for (int row = blockIdx.x * 8 + wave; row < S; row += gridDim.x * 8) {
    int h = lane >> 4, c = (lane & 15) * 4;
    {
      float4 o1 = *(const float4*)(OA + ((size_t)row * 8 + h * 2) * 64 + c), o2 = *(const float4*)(OA + ((size_t)row * 8 + h * 2 + 1) * 64 + c);
      float4 o = make_float4(o1.x - lam * o2.x, o1.y - lam * o2.y, o1.z - lam * o2.z, o1.w - lam * o2.w);
      float ss = o.x * o.x + o.y * o.y + o.z * o.z + o.w * o.w;
#pragma unroll
      for (int k = 1; k < 16; k <<= 1) ss += __shfl_xor(ss, k);
      float r = rsqrtf(ss * (1.f / 64.f) + 1e-6f) * (1.f - li);
      float4 g = *(const float4*)(aog + c);
      *(float4*)(Y + (size_t)row * 1024 + h * 64 + c) = make_float4(o.x * r * g.x, o.y * r * g.y, o.z * r * g.z, o.w * r * g.w);
    }
    {
      float4 o = *(const float4*)(OC + (size_t)row * 256 + h * 64 + c);
      float ss = o.x * o.x + o.y * o.y + o.z * o.z + o.w * o.w;
#pragma unroll
      for (int k = 1; k < 16; k <<= 1) ss += __shfl_xor(ss, k);
      float r = rsqrtf(ss * (1.f / 64.f) + 1e-6f);
      float4 g = *(const float4*)(cog + c);
      float4 rr = *(const float4*)(P + (size_t)row * DIN + PC_CR + h * 64 + c);
      *(float4*)(Y + (size_t)row * 1024 + 512 + h * 64 + c) =
          make_float4(o.x * r * g.x * rr.x * sigmoidf_(rr.x), o.y * r * g.y * rr.y * sigmoidf_(rr.y), o.z * r * g.z * rr.z * sigmoidf_(rr.z),
                      o.w * r * g.w * rr.w * sigmoidf_(rr.w));
    }
  }
}

__device__ void ph_outproj(const Params& p, int l, float* sm) {
  const float* Y = (const float*)(p.ws + WS_Y);
  const float* W = p.in[7] + (size_t)l * 1024 * 1024;
  const float* xin = l == 0 ? p.in[0] : (const float*)(p.ws + WS_XA);
  const float* g1 = (const float*)(p.ws + WS_MOD) + l * 6144 + 2 * 1024;
  float* X1 = (float*)(p.ws + WS_X1);
  for (int it = blockIdx.x; it < (S / 128) * 8; it += gridDim.x) {
    int mt = it >> 3, nt = it & 7, m0 = mt * 128, n0 = nt * 128;
    gemm_tile([&](int i) { return Y + (size_t)(m0 + i) * 1024; }, [&](int j) { return W + n0 + j; }, 1024, 1024,
              [&](int ty, int tx, float(&acc)[4][8]) {
#pragma unroll
                for (int r = 0; r < 4; ++r) {
                  size_t base = (size_t)(m0 + ty * 4 + r) * 1024 + n0;
#pragma unroll
                  for (int hf = 0; hf < 2; ++hf) {
                    int c = hf * 64 + tx * 4;
                    float4 xv = *(const float4*)(xin + base + c), gv = *(const float4*)(g1 + n0 + c);
                    *(float4*)(X1 + base + c) = make_float4(xv.x + gv.x * acc[r][hf * 4], xv.y + gv.y * acc[r][hf * 4 + 1], xv.z + gv.z * acc[r][hf * 4 + 2],
                                                            xv.w + gv.w * acc[r][hf * 4 + 3]);
                  }
                }
              },
              sm);
  }
}

__device__ __forceinline__ bool moe_item(const int* cnt, int mtile, int& e, int& mt) {
  int acc = 0;
  for (e = 0; e < NE; ++e) {
    int t = (cnt[e] + 127) >> 7;
    if (mtile < acc + t) { mt = mtile - acc; return true; }
    acc += t;
  }
  return false;
}

__device__ void ph_up(const Params& p, int l, float* sm) {
  const float* H = (const float*)(p.ws + WS_H);
  const int* cnt = (const int*)(p.ws + WS_CNT) + l * 32;
  const int* list = (const int*)(p.ws + WS_LIST);
  float* ACT = (float*)(p.ws + WS_ACT);
  for (int it = blockIdx.x;; it += gridDim.x) {
    int e, mt;
    if (!moe_item(cnt, it >> 4, e, mt)) break;
    int nt = it & 15, n0 = nt * 64, m0 = mt * 128, ce = cnt[e];
    const float* W = p.in[29] + ((size_t)l * NE + e) * 1024 * 2048;
    const float* bu = p.in[30] + ((size_t)l * NE + e) * 2048;
    const int* le = list + e * S;
    gemm_tile([&](int i) { return (m0 + i < ce) ? H + (size_t)(le[m0 + i] >> 2) * 1024 : (const float*)nullptr; },
              [&](int j) { return j < 64 ? W + n0 + j : W + 1024 + n0 + (j - 64); }, 2048, 1024,
              [&](int ty, int tx, float(&acc)[4][8]) {
#pragma unroll
                for (int r = 0; r < 4; ++r) {
                  int i = m0 + ty * 4 + r;
                  if (i < ce) {
                    int rid = le[i];
                    float ov[4];
#pragma unroll
                    for (int c = 0; c < 4; ++c) {
                      int col = n0 + tx * 4 + c;
                      float g = fminf(acc[r][c] + bu[col], 7.f);
                      float lin = fminf(fmaxf(acc[r][4 + c] + bu[1024 + col], -7.f), 7.f);
                      float glu = g * sigmoidf_(1.702f * g);
                      ov[c] = (lin + 1.f) * glu;
                    }
                    *(float4*)(ACT + (size_t)rid * 1024 + n0 + tx * 4) = make_float4(ov[0], ov[1], ov[2], ov[3]);
                  }
                }
              },
              sm);
  }
}

__device__ void ph_down(const Params& p, int l, float* sm) {
  const int* cnt = (const int*)(p.ws + WS_CNT) + l * 32;
  const int* list = (const int*)(p.ws + WS_LIST);
  const float* ACT = (const float*)(p.ws + WS_ACT);
  float* YR = (float*)(p.ws + WS_YR);
  for (int it = blockIdx.x;; it += gridDim.x) {
    int e, mt;
    if (!moe_item(cnt, it >> 3, e, mt)) break;
    int nt = it & 7, n0 = nt * 128, m0 = mt * 128, ce = cnt[e];
    const float* W = p.in[31] + ((size_t)l * NE + e) * 1024 * 1024;
    const float* bd = p.in[32] + ((size_t)l * NE + e) * 1024;
    const int* le = list + e * S;
    gemm_tile([&](int i) { return (m0 + i < ce) ? ACT + (size_t)le[m0 + i] * 1024 : (const float*)nullptr; }, [&](int j) { return W + n0 + j; }, 1024, 1024,
              [&](int ty, int tx, float(&acc)[4][8]) {
#pragma unroll
                for (int r = 0; r < 4; ++r) {
                  int i = m0 + ty * 4 + r;
                  if (i < ce) {
                    int rid = le[i];
#pragma unroll
                    for (int hf = 0; hf < 2; ++hf) {
                      int c = n0 + hf * 64 + tx * 4;
                      float4 b = *(const float4*)(bd + c);
                      *(float4*)(YR + (size_t)rid * 1024 + c) =
                          make_float4(acc[r][hf * 4] + b.x, acc[r][hf * 4 + 1] + b.y, acc[r][hf * 4 + 2] + b.z, acc[r][hf * 4 + 3] + b.w);
                    }
                  }
                }
              },
              sm);
  }
}

__device__ void ph_combine(const Params& p, int l) {
  const float* X1 = (const float*)(p.ws + WS_X1); const float* YR = (const float*)(p.ws + WS_YR);
  const float* gatebuf = (const float*)(p.ws + WS_GATE);
  const float* g2 = (const float*)(p.ws + WS_MOD) + l * 6144 + 5 * 1024;
  float* xo = l == 0 ? (float*)(p.ws + WS_XA) : p.out;
  int gtid = blockIdx.x * NT + threadIdx.x, gn = gridDim.x * NT;
  for (int idx = gtid; idx < S * 256; idx += gn) {
    int row = idx >> 8, c = (idx & 255) * 4;
    float4 a = make_float4(0.f, 0.f, 0.f, 0.f);
#pragma unroll
    for (int k = 0; k < 4; ++k) {
      float gt = gatebuf[row * 4 + k];
      float4 y = *(const float4*)(YR + (size_t)(row * 4 + k) * 1024 + c);
      a.x += gt * y.x; a.y += gt * y.y; a.z += gt * y.z; a.w += gt * y.w;
    }
    float4 x = *(const float4*)(X1 + (size_t)row * 1024 + c), g = *(const float4*)(g2 + c);
    *(float4*)(xo + (size_t)row * 1024 + c) = make_float4(x.x + g.x * a.x, x.y + g.y * a.y, x.z + g.z * a.z, x.w + g.w * a.w);
  }
}

constexpr int PH_PER_LAYER = 11;
constexpr int NPH = 1 + 2 * PH_PER_LAYER;

template <int SUB>
__device__ __forceinline__ void run_sub(const Params& p, int l, float* sm) {
  asm volatile("" : "+s"(l));
  if (SUB == 0) ph_norm(p, l, 0, sm);
  else if (SUB == 1) ph_inproj(p, l, sm);
  else if (SUB == 2) ph_prep(p, l, sm);
  else if (SUB == 3) ph_kmean(p, sm);
  else if (SUB == 4) ph_mix(p, l, sm);
  else if (SUB == 5) ph_fin(p, l);
  else if (SUB == 6) ph_outproj(p, l, sm);
  else if (SUB == 7) ph_norm(p, l, 1, sm);
  else if (SUB == 8) ph_up(p, l, sm);
  else if (SUB == 9) ph_down(p, l, sm);
  else if (SUB == 10) ph_combine(p, l);
}

#if MK_SINGLE
__global__ void __launch_bounds__(NT, 2) mega(Params p) {
  __shared__ __attribute__((aligned(16))) float sm[10240];
  cg::grid_group grid = cg::this_grid();
  ph_mod(p);
  grid.sync();
#pragma unroll 1
  for (int l = 0; l < 2; ++l) {
    run_sub<0>(p, l, sm); grid.sync();
    run_sub<1>(p, l, sm); grid.sync();
    run_sub<2>(p, l, sm); grid.sync();
    run_sub<3>(p, l, sm); grid.sync();
    run_sub<4>(p, l, sm); grid.sync();
    run_sub<5>(p, l, sm); grid.sync();
    run_sub<6>(p, l, sm); grid.sync();
    run_sub<7>(p, l, sm); grid.sync();
    run_sub<8>(p, l, sm); grid.sync();
    run_sub<9>(p, l, sm); grid.sync();
    run_sub<10>(p, l, sm); grid.sync();
  }
}
#else
template <int SUB>
__global__ void __launch_bounds__(NT, 2) phk(Params p, int l) {
  __shared__ __attribute__((aligned(16))) float sm[10240];
  if (SUB < 0) ph_mod(p);
  else run_sub<(SUB < 0 ? 0 : SUB)>(p, l, sm);
}
#endif

extern "C" void kernel_launch(void* const* d_in, const int* in_sizes, int n_in, void* d_out, int out_size, void* d_ws, size_t ws_size,
                              hipStream_t stream) {
  Params p{};
  for (int i = 0; i < 33; ++i) p.in[i] = (const float*)d_in[i];
  p.out = (float*)d_out;
  p.ws = (char*)d_ws;
#if MK_SINGLE
  static int grid_blocks = 0;
  if (!grid_blocks) {
    int dev = 0, cus = 0, per_cu = 0;
    (void)hipGetDevice(&dev);
    (void)hipDeviceGetAttribute(&cus, hipDeviceAttributeMultiprocessorCount, dev);
    (void)hipOccupancyMaxActiveBlocksPerMultiprocessor(&per_cu, mega, NT, 0);
    if (per_cu < 1) per_cu = 1;
    if (per_cu > 1) per_cu = 1;
    grid_blocks = cus * per_cu;
  }
  void* args[] = {&p};
  hipError_t e = hipLaunchCooperativeKernel((void*)mega, dim3(grid_blocks), dim3(NT), args, 0, stream);
  if (e != hipSuccess) fprintf(stderr, "cooperative launch failed: %s (grid %d)\n", hipGetErrorString(e), grid_blocks);
#else
  const int G = 256;
  hipLaunchKernelGGL(phk<-1>, dim3(G), dim3(NT), 0, stream, p, 0);
  for (int l = 0; l < 2; ++l) {
    hipLaunchKernelGGL(phk<0>, dim3(G), dim3(NT), 0, stream, p, l);
    hipLaunchKernelGGL(phk<1>, dim3(G), dim3(NT), 0, stream, p, l);
    hipLaunchKernelGGL(phk<2>, dim3(G), dim3(NT), 0, stream, p, l);
    hipLaunchKernelGGL(phk<3>, dim3(G), dim3(NT), 0, stream, p, l);
    hipLaunchKernelGGL(phk<4>, dim3(G), dim3(NT), 0, stream, p, l);
    hipLaunchKernelGGL(phk<5>, dim3(G), dim3(NT), 0, stream, p, l);
    hipLaunchKernelGGL(phk<6>, dim3(G), dim3(NT), 0, stream, p, l);
    hipLaunchKernelGGL(phk<7>, dim3(G), dim3(NT), 0, stream, p, l);
    hipLaunchKernelGGL(phk<8>, dim3(G), dim3(NT), 0, stream, p, l);
    hipLaunchKernelGGL(phk<9>, dim3(G), dim3(NT), 0, stream, p, l);
    hipLaunchKernelGGL(phk<10>, dim3(G), dim3(NT), 0, stream, p, l);
  }
#endif
}
```

```cpp
#include <hip/hip_runtime.h>
#include <hip/hip_cooperative_groups.h>
#include <cstdio>
#include <cstdint>
namespace cg = cooperative_groups;

#ifndef MK_SINGLE
#define MK_SINGLE 1
#endif
#ifndef PROBE
#define PROBE 0
#endif

constexpr int S = 16384, D = 1024, DIN = 2832, NE = 32;
constexpr int NT = 512;
constexpr size_t MiB = 1u << 20;
constexpr size_t WS_MOD = 0;
constexpr size_t WS_CNT = 64 * 1024;
constexpr size_t WS_TEXP = 128 * 1024;
constexpr size_t WS_KMP = 1 * MiB;
constexpr size_t WS_BAR = 256 * 1024;
constexpr size_t WS_SROW = 320 * 1024;
constexpr size_t WS_RDY = 216 * 1024;
constexpr size_t WS_ZERO = 224 * 1024;
constexpr size_t WS_LCNT = 192 * 1024;
constexpr size_t WS_EIDX = 2 * MiB;
constexpr size_t WS_RPOS = 2 * MiB + 512 * 1024;
constexpr size_t WS_GATE = 3 * MiB;
constexpr size_t WS_H = 8 * MiB;
constexpr size_t WS_VBT = 40 * MiB;
constexpr size_t WS_ELIST = 66 * MiB;
constexpr size_t WS_MLIST = 48 * MiB;
constexpr size_t WS_ML = 64 * MiB;
constexpr size_t WS_PROJ = 72 * MiB;
constexpr size_t WS_Y = 250 * MiB;
constexpr size_t WS_X1 = 314 * MiB;
constexpr size_t WS_XA = 378 * MiB;
constexpr size_t WS_QA = 442 * MiB;
constexpr size_t WS_KA = 458 * MiB;
constexpr size_t WS_QB = 474 * MiB;
constexpr size_t WS_KB = 490 * MiB;
constexpr size_t WS_QBB = 498 * MiB;
constexpr size_t WS_GA = 506 * MiB;
constexpr size_t WS_LA = 514 * MiB;
constexpr size_t WS_LB = 530 * MiB;
constexpr size_t WS_OA = 546 * MiB;
constexpr size_t WS_VA = 562 * MiB;
constexpr size_t WS_SC = 578 * MiB;
constexpr size_t WS_DEC = 586 * MiB;
constexpr size_t WS_LTA = 587 * MiB;
constexpr size_t WS_LTH = 588 * MiB;
constexpr size_t WS_LC = 589 * MiB;
constexpr int MOE_ROWS = 73728;
constexpr size_t WS_ST = 1490 * MiB;
constexpr size_t WS_PART = 1426 * MiB;
constexpr size_t WS_VB = 594 * MiB;
constexpr size_t WS_XS = 602 * MiB;
constexpr size_t WS_ACT = 738 * MiB;
constexpr size_t WS_YS = 882 * MiB;
constexpr size_t WS_WIN = 1026 * MiB;
constexpr size_t WS_WOUT = 1038 * MiB;
constexpr size_t WS_WUP = 1042 * MiB;
constexpr size_t WS_WDN = 1298 * MiB;
constexpr int LDS_BYTES = 147456;

struct Params {
  const float* in[33];
  float* out;
  char* ws;
};

constexpr int PDIN = 1296;
constexpr int PC_CQ = 0, PC_CK = 128, PC_CV = 256, PC_CG = 512, PC_CR = 528, PC_DX = 784, PC_DG = 1040;

__device__ __forceinline__ int bidx() { int b = blockIdx.x; asm volatile("" : "+s"(b)); return b; }
__device__ __forceinline__ int tidx() { int t = threadIdx.x; asm volatile("" : "+v"(t)); return t; }
__device__ __forceinline__ float wave_sum(float v) {
#pragma unroll
  for (int o = 1; o < 64; o <<= 1) v += __shfl_xor(v, o);
  return v;
}
__device__ __forceinline__ float sigmoidf_(float x) { return __builtin_amdgcn_rcpf(1.f + __builtin_amdgcn_exp2f(-1.4426950408889634f * x)); }
__device__ __forceinline__ float logsigmoidf_(float z) { return fminf(z, 0.f) - log1pf(__expf(-fabsf(z))); }
__device__ __forceinline__ float gelu_tanh(float x) {
  float u = 0.7978845608028654f * (x + 0.044715f * x * x * x);
  float t = 1.f - 2.f * __builtin_amdgcn_rcpf(__expf(2.f * u) + 1.f);
  return 0.5f * x * (1.f + t);
}
__device__ __forceinline__ float lam_init_of(int l) { return l == 0 ? 0.2f : (0.8f - 0.6f * 0.7408182206817179f); }
__device__ __forceinline__ float lam_of(const Params& p, int l) {
  float s1 = 0.f, s2 = 0.f;
  for (int i = 0; i < 32; ++i) {
    s1 += p.in[10][l * 32 + i] * p.in[11][l * 32 + i];
    s2 += p.in[12][l * 32 + i] * p.in[13][l * 32 + i];
  }
  return __expf(s1) - __expf(s2) + lam_init_of(l);
}

typedef unsigned short bf16raw;
__device__ __forceinline__ unsigned f2bf(float f) { unsigned u = __builtin_bit_cast(unsigned, f); return (u + 0x7fffu + ((u >> 16) & 1u)) >> 16; }
typedef float f32x2v_ __attribute__((ext_vector_type(2))); typedef __bf16 bf16x2v_ __attribute__((ext_vector_type(2)));
__device__ __forceinline__ unsigned pk2(float lo, float hi) { f32x2v_ v = {lo, hi}; bf16x2v_ b = __builtin_convertvector(v, bf16x2v_); return __builtin_bit_cast(unsigned, b); }
__device__ __forceinline__ float4 ld4bf(const unsigned short* p) { const uint2 u = *(const uint2*)p; return make_float4(__builtin_bit_cast(float, u.x << 16), __builtin_bit_cast(float, u.x & 0xffff0000u), __builtin_bit_cast(float, u.y << 16), __builtin_bit_cast(float, u.y & 0xffff0000u)); }
__device__ __forceinline__ float bf2f(unsigned short h) { return __builtin_bit_cast(float, (unsigned)h << 16); }

namespace pg8 {
#define PG8_LAS __attribute__((address_space(3)))
typedef unsigned short bf16_t;
typedef short bf16x8 __attribute__((ext_vector_type(8)));
typedef float f32x4 __attribute__((ext_vector_type(4)));
typedef unsigned u32x4 __attribute__((ext_vector_type(4)));
constexpr int BM = 256, BK = 64, HALF = 128, HTB = HALF * BK * 2  , STAGE_BYTES = 8 * HTB, NXCD = 8, WGM = 8;

__host__ __device__ __forceinline__ int lds_byte(int r, int c) { const int st = (r >> 4) * 2 + (c >> 5), rr = r & 15, cc = c & 31, ob = rr * 64 + cc * 2; return st * 1024 + (ob ^ (((ob >> 9) & 1) << 5)); }
__host__ __device__ __forceinline__ void stage_rc(int b, int& R, int& C) {
  const int bid0_ = bidx(); const int st = b / 1024, sb = b % 1024, swz = sb ^ (((sb >> 9) & 1) << 5); R = (st >> 1) * 16 + swz / 64; C = (st & 1) * 32 + (swz % 64) / 2; }
__host__ __device__ __forceinline__ int perm32(int rho) { const int n = rho >> 4, i = rho & 15; return 8 * (i >> 2) + 4 * n + (i & 3); }

struct Unit { int pm, pn; };
struct Gemm { const bf16_t* A; const bf16_t* Bt; int M, N, K; };

struct StaticOrder {
    int nM, nN, nwg, G, c;
    __host__ __device__ void init(int M, int N, int G_, int c_) { nM = M / BM; nN = N / BM; nwg = nM * nN; G = G_; c = c_; }
    __host__ __device__ bool next(int i, Unit& u) const {
        const long L = (long)i * G + c; if (L >= nwg) return false;
        int wgid = (int)L; { const int q = nwg / NXCD, r = nwg % NXCD, xcd = wgid % NXCD, off = wgid / NXCD; wgid = (xcd < r ? xcd * (q + 1) : r * (q + 1) + (xcd - r) * q) + off; }
        const int nig = WGM * nN, gid = wgid / nig, fm = gid * WGM, gsz = (nM - fm) < WGM ? (nM - fm) : WGM;
        u.pm = fm + ((wgid % nig) % gsz); u.pn = (wgid % nig) / gsz; return true;
    }
    __device__ __forceinline__ void a_ready(const Unit&) const {}
    __device__ __forceinline__ void done(const Unit&) const {}
};

__device__ __forceinline__ unsigned cvt_pk_bf16(float lo, float hi) { unsigned r; asm volatile("v_cvt_pk_bf16_f32 %0, %1, %2" : "=v"(r) : "v"(lo), "v"(hi)); return r; }
typedef float f32x2 __attribute__((ext_vector_type(2)));
template <class Epi, class Sched, bool ALIGN_EPI = false, bool SP2 = false, bool GATHER = false>
__device__ __forceinline__ void gemm_phase(PG8_LAS unsigned char* lds, const Gemm g, const Sched& S, const Epi& E, const unsigned* rowoff = nullptr) {
    static_assert(!GATHER || SP2, "row gather is wired into the SP2 loop only");
    const int tid = tidx(), wid = __builtin_amdgcn_readfirstlane(tid >> 6), lane = tid & 63, wr = wid >> 2, wc = wid & 3, fr = lane & 15, fq = lane >> 4;
    const int K = g.K, nt = K / BK;
    unsigned voffA[2], voffB[2]; int RA[2], CA[2];
#pragma unroll
    for (int i = 0; i < 2; ++i) { int R, C; stage_rc(tid * 16 + i * 8192, R, C); const int Rb = Epi::PERM ? ((R & ~31) + perm32(R & 31)) : R;
        voffA[i] = (unsigned)(R * K + C) * 2u; voffB[i] = (unsigned)(Rb * K + C) * 2u; RA[i] = R; CA[i] = C; }
    const size_t kstep = (size_t)(BK * 2);
    const size_t hstep = (size_t)HALF * K * 2;
    const size_t tstep = 2 * hstep;
    const unsigned ldsw = (unsigned)wid * 1024u;
    const int aoff = lds_byte(wr * 64 + fr, fq * 8), boff = lds_byte(wc * 32 + fr, fq * 8);
#define PG8_SA(b, h) (((b) * 2 + (h)) * HTB)
#define PG8_SB(b, h) ((4 + (b) * 2 + (h)) * HTB)
#define PG8_STAGE(bufoff, gbase, voff) do { _Pragma("unroll") for (int _i = 0; _i < 2; ++_i) \
        __builtin_amdgcn_global_load_lds((const unsigned*)((const char*)(gbase) + (voff)[_i]), (PG8_LAS unsigned*)(lds + (bufoff) + ldsw + _i * 8192), 16, 0, 0); } while (0)
#define PG8_STAGE2(bufoff, gbase, o0, o1) do { \
        __builtin_amdgcn_global_load_lds((const unsigned*)((const char*)(gbase) + (o0)), (PG8_LAS unsigned*)(lds + (bufoff) + ldsw), 16, 0, 0); \
        __builtin_amdgcn_global_load_lds((const unsigned*)((const char*)(gbase) + (o1)), (PG8_LAS unsigned*)(lds + (bufoff) + ldsw + 8192), 16, 0, 0); } while (0)
#define PG8_GOFF(dst, pm_) do { _Pragma("unroll") for (int _h = 0; _h < 2; ++_h) _Pragma("unroll") for (int _i = 0; _i < 2; ++_i) \
        dst[_h][_i] = rowoff[(pm_) * BM + _h * HALF + RA[_i]] + (unsigned)CA[_i] * 2u; } while (0)
#define PG8_LDA(dst, b, h) do { _Pragma("unroll") for (int m = 0; m < 4; ++m) _Pragma("unroll") for (int k = 0; k < 2; ++k) dst[m][k] = *(const PG8_LAS bf16x8*)(lds + PG8_SA(b, h) + aoff + m * 2048 + k * 1024); } while (0)
#define PG8_LDB(dst, b, h) do { _Pragma("unroll") for (int n = 0; n < 2; ++n) _Pragma("unroll") for (int k = 0; k < 2; ++k) dst[n][k] = *(const PG8_LAS bf16x8*)(lds + PG8_SB(b, h) + boff + n * 2048 + k * 1024); } while (0)
#define PG8_MMA(ai, bj, At, Bt) do { __builtin_amdgcn_s_setprio(1); _Pragma("unroll") for (int m = 0; m < 4; ++m) _Pragma("unroll") for (int n = 0; n < 2; ++n) _Pragma("unroll") for (int k = 0; k < 2; ++k) \
        acc[ai][bj][m][n] = __builtin_amdgcn_mfma_f32_16x16x32_bf16(Bt[n][k], At[m][k], acc[ai][bj][m][n], 0, 0, 0); __builtin_amdgcn_s_setprio(0); } while (0)
#define PG8_WAIT_V(n) asm volatile("s_waitcnt vmcnt(" #n ")" ::: "memory")
#define PG8_WAIT_L(n) asm volatile("s_waitcnt lgkmcnt(" #n ")" ::: "memory")
#define PG8_BAR __builtin_amdgcn_s_barrier()
#define PG8_SCHED __builtin_amdgcn_sched_barrier(0)
    Unit cur, nxt; int ui = 0;
    if (!S.next(0, cur)) return;
    f32x4 acc[2][2][4][2];
#pragma unroll
    for (int a = 0; a < 2; ++a)
#pragma unroll
        for (int b = 0; b < 2; ++b)
#pragma unroll
            for (int m = 0; m < 4; ++m)
#pragma unroll
                for (int n = 0; n < 2; ++n) acc[a][b][m][n] = (f32x4){0.f, 0.f, 0.f, 0.f};
    bf16x8 At[4][2], B0[2][2], B1[2][2];
    const char* cA = GATHER ? (const char*)g.A : (const char*)g.A + (size_t)cur.pm * tstep; const char* cB = (const char*)g.Bt + (size_t)cur.pn * tstep;
    unsigned vA[2][2], vN[2][2];
    if constexpr (GATHER) { PG8_GOFF(vA, 0); _Pragma("unroll") for (int _h = 0; _h < 2; ++_h) _Pragma("unroll") for (int _i = 0; _i < 2; ++_i) vN[_h][_i] = vA[_h][_i]; }
#define PG8_STA(bufoff, ptr, h, nx) do { if constexpr (GATHER) { PG8_STAGE2(bufoff, ptr, (nx) ? vN[h][0] : vA[h][0], (nx) ? vN[h][1] : vA[h][1]); } else { PG8_STAGE(bufoff, (ptr) + (h) * hstep, voffA); } } while (0)
    S.a_ready(cur);
    if constexpr (SP2) {
        PG8_STAGE(PG8_SB(0, 0), cB, voffB); PG8_STAGE(PG8_SB(0, 1), cB + hstep, voffB); PG8_STA(PG8_SA(0, 0), cA, 0, false); PG8_STA(PG8_SA(0, 1), cA, 1, false);
        if (wr == 1) PG8_BAR;
        PG8_WAIT_V(2); PG8_BAR;
        PG8_STAGE(PG8_SB(1, 0), cB + kstep, voffB); PG8_STA(PG8_SA(1, 0), cA + kstep, 0, false); PG8_STAGE(PG8_SB(1, 1), cB + hstep + kstep, voffB);
        PG8_WAIT_V(6); PG8_BAR;
    } else {
        PG8_STAGE(PG8_SB(0, 0), cB, voffB); PG8_STAGE(PG8_SA(0, 0), cA, voffA); PG8_STAGE(PG8_SB(0, 1), cB + hstep, voffB); PG8_STAGE(PG8_SA(0, 1), cA + hstep, voffA);
        if (wr == 1) PG8_BAR;
        PG8_WAIT_V(4); PG8_BAR;
        PG8_STAGE(PG8_SB(1, 0), cB + kstep, voffB); PG8_STA(PG8_SA(1, 0), cA + kstep, 0, false); PG8_STAGE(PG8_SB(1, 1), cB + hstep + kstep, voffB);
        PG8_WAIT_V(6); PG8_BAR;
    }
    for (;;) {
        const bool has_next = S.next(ui + 1, nxt);
        const char* nA = GATHER ? cA : (has_next ? (const char*)g.A + (size_t)nxt.pm * tstep : cA); const char* nB = has_next ? (const char*)g.Bt + (size_t)nxt.pn * tstep : cB;
        if constexpr (GATHER) { if (has_next) { PG8_GOFF(vN, ui + 1); } }
        for (int t = 0; t < nt; t += 2) {
            const bool last = (t == nt - 2);
            const char* a1 = cA + (size_t)(t + 1) * kstep;
            const char* a2 = last ? nA : cA + (size_t)(t + 2) * kstep; const bool nx_ = GATHER && last; const char* b2 = last ? nB : cB + (size_t)(t + 2) * kstep;
            const char* a3 = a2 + kstep; const char* b3 = b2 + kstep;
            if (last && has_next) S.a_ready(nxt);
            if constexpr (SP2) {
            PG8_LDB(B0, 0, 0); PG8_LDB(B1, 0, 1); PG8_SCHED; PG8_LDA(At, 0, 0); PG8_STA(PG8_SA(1, 1), a1, 1, false);
            PG8_WAIT_V(8); PG8_WAIT_L(0); PG8_BAR; PG8_MMA(0, 0, At, B0); PG8_MMA(0, 1, At, B1); PG8_BAR; PG8_SCHED;
            PG8_LDA(At, 0, 1); PG8_STAGE(PG8_SB(0, 0), b2, voffB); PG8_STAGE(PG8_SB(0, 1), b2 + hstep, voffB); PG8_STA(PG8_SA(0, 0), a2, 0, nx_);
            PG8_WAIT_V(8); PG8_WAIT_L(0); PG8_BAR; PG8_MMA(1, 0, At, B0); PG8_MMA(1, 1, At, B1); PG8_BAR; PG8_SCHED;
            PG8_LDB(B0, 1, 0); PG8_LDB(B1, 1, 1); PG8_SCHED; PG8_LDA(At, 1, 0); PG8_STA(PG8_SA(0, 1), a2, 1, nx_);
            PG8_WAIT_V(8); PG8_WAIT_L(0); PG8_BAR; PG8_MMA(0, 0, At, B0); PG8_MMA(0, 1, At, B1); PG8_BAR; PG8_SCHED;
            PG8_LDA(At, 1, 1); PG8_STAGE(PG8_SB(1, 0), b3, voffB); PG8_STAGE(PG8_SB(1, 1), b3 + hstep, voffB); PG8_STA(PG8_SA(1, 0), a3, 0, nx_);
            PG8_WAIT_V(8); PG8_WAIT_L(0); PG8_BAR; PG8_MMA(1, 0, At, B0); PG8_MMA(1, 1, At, B1); PG8_BAR; PG8_SCHED;
            } else {
            PG8_LDB(B0, 0, 0); PG8_SCHED; PG8_LDA(At, 0, 0); PG8_STA(PG8_SA(1, 1), a1, 1, false);
            PG8_WAIT_L(8); PG8_BAR; PG8_WAIT_L(0); PG8_MMA(0, 0, At, B0); PG8_BAR; PG8_SCHED;
            PG8_LDB(B1, 0, 1); PG8_STAGE(PG8_SB(0, 0), b2, voffB);
            PG8_BAR; PG8_WAIT_L(0); PG8_MMA(0, 1, At, B1); PG8_BAR;
            PG8_LDA(At, 0, 1); PG8_STA(PG8_SA(0, 0), a2, 0, nx_);
            PG8_BAR; PG8_WAIT_L(0); PG8_MMA(1, 0, At, B0); PG8_BAR; PG8_SCHED;
            PG8_STAGE(PG8_SB(0, 1), b2 + hstep, voffB);
            PG8_WAIT_V(6); PG8_BAR; PG8_MMA(1, 1, At, B1); PG8_BAR;
            PG8_LDB(B0, 1, 0); PG8_SCHED; PG8_LDA(At, 1, 0); PG8_STA(PG8_SA(0, 1), a2, 1, nx_);
            PG8_WAIT_L(8); PG8_BAR; PG8_WAIT_L(0); PG8_MMA(0, 0, At, B0); PG8_BAR; PG8_SCHED;
            PG8_LDB(B1, 1, 1); PG8_STAGE(PG8_SB(1, 0), b3, voffB);
            PG8_BAR; PG8_WAIT_L(0); PG8_MMA(0, 1, At, B1); PG8_BAR;
            PG8_LDA(At, 1, 1); PG8_STA(PG8_SA(1, 0), a3, 0, nx_);
            PG8_BAR; PG8_WAIT_L(0); PG8_MMA(1, 0, At, B0); PG8_BAR; PG8_SCHED;
            PG8_STAGE(PG8_SB(1, 1), b3 + hstep, voffB);
            PG8_WAIT_V(6); PG8_BAR; PG8_MMA(1, 1, At, B1); PG8_BAR;
            }
        }
        if constexpr (ALIGN_EPI) { if (wr == 0) PG8_BAR; }
        if constexpr (!Epi::AFTER_DRAIN) { E(acc, cur, wr, wc, fr, fq); S.done(cur); }
        if (!has_next) break;
#pragma unroll
        for (int a = 0; a < 2; ++a)
#pragma unroll
            for (int b = 0; b < 2; ++b)
#pragma unroll
                for (int m = 0; m < 4; ++m)
#pragma unroll
                    for (int n = 0; n < 2; ++n) acc[a][b][m][n] = (f32x4){0.f, 0.f, 0.f, 0.f};
        cur = nxt; cA = nA; cB = nB; ++ui;
        if constexpr (GATHER) { _Pragma("unroll") for (int _h = 0; _h < 2; ++_h) _Pragma("unroll") for (int _i = 0; _i < 2; ++_i) vA[_h][_i] = vN[_h][_i]; }
        if constexpr (ALIGN_EPI) { if (wr == 1) PG8_BAR; }
    }
    PG8_WAIT_V(0);
    if constexpr (!ALIGN_EPI) { if (wr == 0) PG8_BAR; }
    PG8_BAR;
    if constexpr (Epi::AFTER_DRAIN) { E.fused(acc, cur, wr, wc, fr, fq, lds, wid, lane); S.done(cur); }
#undef PG8_SA
#undef PG8_SB
#undef PG8_STAGE
#undef PG8_STAGE2
#undef PG8_GOFF
#undef PG8_STA
#undef PG8_LDA
#undef PG8_LDB
#undef PG8_MMA
#undef PG8_WAIT_V
#undef PG8_WAIT_L
#undef PG8_BAR
#undef PG8_SCHED
}
}

namespace pg8 {
struct EpiInproj {
  static constexpr bool PERM = true, AFTER_DRAIN = false;
  bf16_t* QAb; bf16_t* KAb; bf16_t* VAb;
  float* QB; bf16_t* QBb; bf16_t* KBb; bf16_t* VB; float* KMP;
  bf16_t* P2;
  const float* aqg; const float* akg; const float* bqg; const float* bkg; float c2;
  __device__ __forceinline__ static u32x4 pk8(const f32x4& a, const f32x4& b) { u32x4 w; w.x = cvt_pk_bf16(a[0], a[1]); w.y = cvt_pk_bf16(a[2], a[3]); w.z = cvt_pk_bf16(b[0], b[1]); w.w = cvt_pk_bf16(b[2], b[3]); return w; }
  __device__ __forceinline__ void operator()(const f32x4 (&acc)[2][2][4][2], const Unit& u, int wr, int wc, int fr, int fq) const {
    const int row0 = u.pm * BM + wr * 64 + fr, t = u.pn;
    if (t >= 6) {
      const int col0 = (t - 6) * BM + wc * 32 + 8 * fq;
#pragma unroll
      for (int ai = 0; ai < 2; ++ai)
#pragma unroll
        for (int m = 0; m < 4; ++m) {
          bf16_t* rp = P2 + (size_t)(row0 + ai * HALF + m * 16) * 1296;
#pragma unroll
          for (int bj = 0; bj < 2; ++bj) { const int col = col0 + bj * HALF; if (col < 1296) *(u32x4*)(rp + col) = pk8(acc[ai][bj][m][0], acc[ai][bj][m][1]); }
        }
    } else if (t <= 1) {
      const float* gp = (t == 0 ? aqg : akg) + 8 * fq;
      const f32x4 g0 = *(const f32x4*)gp, g1 = *(const f32x4*)(gp + 4);
      bf16_t* dst = t == 0 ? QAb : KAb;
      const float sc = t == 0 ? c2 : 1.f;
#pragma unroll
      for (int ai = 0; ai < 2; ++ai)
#pragma unroll
        for (int m = 0; m < 4; ++m)
#pragma unroll
          for (int bj = 0; bj < 2; ++bj) {
            const f32x4 v0 = acc[ai][bj][m][0], v1 = acc[ai][bj][m][1];
            float ss = (v0[0] * v0[0] + v0[1] * v0[1]) + (v0[2] * v0[2] + v0[3] * v0[3]) + (v1[0] * v1[0] + v1[1] * v1[1]) + (v1[2] * v1[2] + v1[3] * v1[3]);
            ss += __shfl_xor(ss, 16); ss += __shfl_xor(ss, 32);
            const float r = rsqrtf(ss * (1.f / 32.f) + 1e-6f) * sc;
            bf16_t* o = dst + (size_t)(row0 + ai * HALF + m * 16) * 512 + (bj * 4 + wc) * 64 + 8 * fq;
            *(u32x4*)o = pk8(v0 * g0 * r, v1 * g1 * r);
          }
    } else if (t == 2) {
#pragma unroll
      for (int ai = 0; ai < 2; ++ai)
#pragma unroll
        for (int m = 0; m < 4; ++m)
#pragma unroll
          for (int bj = 0; bj < 2; ++bj) {
            const u32x4 w = pk8(acc[ai][bj][m][0], acc[ai][bj][m][1]);
            *(u32x4*)(VAb + (size_t)(row0 + ai * HALF + m * 16) * 256 + bj * HALF + wc * 32 + 8 * fq) = w;
          }
    } else if (t == 5) {
#pragma unroll
      for (int ai = 0; ai < 2; ++ai)
#pragma unroll
        for (int m = 0; m < 4; ++m)
#pragma unroll
          for (int bj = 0; bj < 2; ++bj)
            *(u32x4*)(VB + (size_t)(row0 + ai * HALF + m * 16) * 256 + bj * HALF + wc * 32 + 8 * fq) = pk8(acc[ai][bj][m][0], acc[ai][bj][m][1]);
    } else {
      const float* gp = (t == 3 ? bqg : bkg) + 8 * fq;
      f32x4 g[2][2];
#pragma unroll
      for (int bj = 0; bj < 2; ++bj) { g[bj][0] = *(const f32x4*)(gp + 32 * bj); g[bj][1] = *(const f32x4*)(gp + 32 * bj + 4); }
#pragma unroll
      for (int ai = 0; ai < 2; ++ai) {
        f32x4 cs[2][2];
#pragma unroll
        for (int bj = 0; bj < 2; ++bj) { cs[bj][0] = (f32x4){0.f, 0.f, 0.f, 0.f}; cs[bj][1] = (f32x4){0.f, 0.f, 0.f, 0.f}; }
#pragma unroll
        for (int m = 0; m < 4; ++m) {
          float ss = 0.f;
#pragma unroll
          for (int bj = 0; bj < 2; ++bj)
#pragma unroll
            for (int n = 0; n < 2; ++n) { const f32x4 v = acc[ai][bj][m][n]; ss += (v[0] * v[0] + v[1] * v[1]) + (v[2] * v[2] + v[3] * v[3]); }
          ss += __shfl_xor(ss, 16); ss += __shfl_xor(ss, 32);
          const float r = rsqrtf(ss * (1.f / 64.f) + 1e-6f);
          const size_t ro = (size_t)(row0 + ai * HALF + m * 16) * 256 + wc * 64 + 8 * fq;
#pragma unroll
          for (int bj = 0; bj < 2; ++bj) {
            const f32x4 n0 = acc[ai][bj][m][0] * g[bj][0] * r, n1 = acc[ai][bj][m][1] * g[bj][1] * r;
            if (t == 3) {
              *(f32x4*)(QB + ro + 32 * bj) = n0; *(f32x4*)(QB + ro + 32 * bj + 4) = n1;
              const float qs = 0.125f * 1.4426950408889634f;
              *(u32x4*)(QBb + ro + 32 * bj) = pk8(n0 * qs, n1 * qs);
            } else {
              *(u32x4*)(KBb + ro + 32 * bj) = pk8(n0, n1);
              cs[bj][0] += n0; cs[bj][1] += n1;
            }
          }
        }
        if (t == 4) {
#pragma unroll
          for (int bj = 0; bj < 2; ++bj)
#pragma unroll
            for (int n = 0; n < 2; ++n)
#pragma unroll
              for (int j = 0; j < 4; ++j) { float v = cs[bj][n][j]; v += __shfl_xor(v, 1); v += __shfl_xor(v, 2); v += __shfl_xor(v, 4); v += __shfl_xor(v, 8); cs[bj][n][j] = v; }
          if (fr == 0) {
            float* kp = KMP + (size_t)(u.pm * 4 + ai * 2 + wr) * 256 + wc * 64 + 8 * fq;
#pragma unroll
            for (int bj = 0; bj < 2; ++bj) { *(f32x4*)(kp + 32 * bj) = cs[bj][0]; *(f32x4*)(kp + 32 * bj + 4) = cs[bj][1]; }
          }
        }
      }
    }
  }
};
struct EpiOutproj {
  static constexpr bool PERM = true, AFTER_DRAIN = false;
  const float* xin32; const bf16_t* xin16; const float* g1; bf16_t* X1;
  __device__ __forceinline__ void operator()(const f32x4 (&acc)[2][2][4][2], const Unit& u, int wr, int wc, int fr, int fq) const {
    const int row0 = u.pm * BM + wr * 64 + fr, col0 = u.pn * BM + wc * 32 + 8 * fq;
#pragma unroll
    for (int bj = 0; bj < 2; ++bj) {
      const int col = col0 + bj * HALF;
      const f32x4 g0 = *(const f32x4*)(g1 + col), g1v = *(const f32x4*)(g1 + col + 4);
#pragma unroll
      for (int ai = 0; ai < 2; ++ai)
#pragma unroll
        for (int m = 0; m < 4; ++m) {
          const size_t off = (size_t)(row0 + ai * HALF + m * 16) * 1024 + col;
          f32x4 x0, x1;
          if (xin32) { x0 = *(const f32x4*)(xin32 + off); x1 = *(const f32x4*)(xin32 + off + 4); }
          else {
            const u32x4 w = *(const u32x4*)(xin16 + off);
            x0 = (f32x4){__builtin_bit_cast(float, w.x << 16), __builtin_bit_cast(float, w.x & 0xffff0000u), __builtin_bit_cast(float, w.y << 16), __builtin_bit_cast(float, w.y & 0xffff0000u)};
            x1 = (f32x4){__builtin_bit_cast(float, w.z << 16), __builtin_bit_cast(float, w.z & 0xffff0000u), __builtin_bit_cast(float, w.w << 16), __builtin_bit_cast(float, w.w & 0xffff0000u)};
          }
          const f32x4 v0 = x0 + g0 * acc[ai][bj][m][0], v1 = x1 + g1v * acc[ai][bj][m][1];
          u32x4 o; o.x = cvt_pk_bf16(v0[0], v0[1]); o.y = cvt_pk_bf16(v0[2], v0[3]); o.z = cvt_pk_bf16(v1[0], v1[1]); o.w = cvt_pk_bf16(v1[2], v1[3]);
          *(u32x4*)(X1 + off) = o;
        }
    }
  }
};
struct EpiUp {
  static constexpr bool PERM = true, AFTER_DRAIN = false;
  __amdgpu_buffer_rsrc_t act;
  const float* bup;
  __device__ __forceinline__ void operator()(const f32x4 (&acc)[2][2][4][2], const Unit& u, int wr, int wc, int fr, int fq) const {
    const int e = u.pn >> 3, j = u.pn & 7;
    const int row0 = u.pm * BM + wr * 64 + fr, col0 = j * 128 + wc * 32 + 8 * fq;
    const float* bg = bup + (size_t)e * 2048 + col0; const float* bl = bg + 1024;
    f32x4 bgv[2], blv[2];
#pragma unroll
    for (int n = 0; n < 2; ++n) { bgv[n] = *(const f32x4*)(bg + 4 * n); blv[n] = *(const f32x4*)(bl + 4 * n); }
#pragma unroll
    for (int ai = 0; ai < 2; ++ai)
#pragma unroll
      for (int m = 0; m < 4; ++m) {
        float o[8];
#pragma unroll
        for (int n = 0; n < 2; ++n) {
          const f32x4 gg = acc[ai][0][m][n] + bgv[n], ll = acc[ai][1][m][n] + blv[n];
#pragma unroll
          for (int c = 0; c < 4; ++c) {
            float g = fminf(gg[c], 7.f), lin = fminf(fmaxf(ll[c], -7.f), 7.f);
            float glu = g * __builtin_amdgcn_rcpf(1.f + __builtin_amdgcn_exp2f(-1.702f * 1.4426950408889634f * g));
            o[n * 4 + c] = (lin + 1.f) * glu;
          }
        }
        u32x4 w; w.x = cvt_pk_bf16(o[0], o[1]); w.y = cvt_pk_bf16(o[2], o[3]); w.z = cvt_pk_bf16(o[4], o[5]); w.w = cvt_pk_bf16(o[6], o[7]);
        __builtin_amdgcn_raw_buffer_store_b128(w, act, (unsigned)(((row0 + ai * HALF + m * 16) * 1024 + col0) * 2), 0,   16);
      }
  }
};
struct EpiDown {
  static constexpr bool PERM = true, AFTER_DRAIN = false;
  bf16_t* YS; const float* bdn;
  __device__ __forceinline__ void operator()(const f32x4 (&acc)[2][2][4][2], const Unit& u, int wr, int wc, int fr, int fq) const {
    const int e = u.pn >> 2, j = u.pn & 3;
    const int row0 = u.pm * BM + wr * 64 + fr, col0 = j * 256 + wc * 32 + 8 * fq;
    f32x4 bv[2][2];
#pragma unroll
    for (int bj = 0; bj < 2; ++bj)
#pragma unroll
      for (int n = 0; n < 2; ++n) bv[bj][n] = *(const f32x4*)(bdn + (size_t)e * 1024 + col0 + bj * HALF + 4 * n);
#pragma unroll
    for (int ai = 0; ai < 2; ++ai)
#pragma unroll
      for (int m = 0; m < 4; ++m) {
        bf16_t* rp = YS + (size_t)(row0 + ai * HALF + m * 16) * 1024 + col0;
#pragma unroll
        for (int bj = 0; bj < 2; ++bj) {
          const f32x4 v0 = acc[ai][bj][m][0] + bv[bj][0], v1 = acc[ai][bj][m][1] + bv[bj][1];
          u32x4 w; w.x = cvt_pk_bf16(v0[0], v0[1]); w.y = cvt_pk_bf16(v0[2], v0[3]); w.z = cvt_pk_bf16(v1[0], v1[1]); w.w = cvt_pk_bf16(v1[2], v1[3]);
          *(u32x4*)(rp + bj * HALF) = w;
        }
      }
  }
};
#ifndef MOE_ORDER
#define MOE_ORDER 0
#endif
template <int NJ> __device__ __forceinline__ void moe_build_units(const int* cnt, int G, int c, int* tab, int tid, bool rotate = false) {
  if (tid < 24) {
    int pm = -1, pn = -1, ex = 0, r0 = 0;
    {
      int cc = c;
      if (rotate) {
        int T = 0; for (int e = 0; e < 32; ++e) T += (cnt[e] + 255) >> 8;
        int r8 = 8 * T; while (r8 >= G) r8 -= G;
        cc = c - r8; if (cc < 0) cc += G;
      }
      const long L = (long)tid * G + cc; const int t = (int)(L / NJ);
      int acc = 0;
      for (int e = 0; e < 32; ++e) {
        const int ne = (cnt[e] + 255) >> 8;
        if (pm < 0 && t < acc + ne) { pm = t; pn = e * NJ + (int)(L % NJ); ex = e; r0 = (t - acc) << 8; }
        acc += ne;
      }
    }
    tab[4 * tid] = pm; tab[4 * tid + 1] = pn; tab[4 * tid + 2] = ex; tab[4 * tid + 3] = r0;
  }
  __syncthreads();
}
__device__ __forceinline__ void moe_build_rowoff(const int* elist, const int* cnt, const int* tab, unsigned* rowoff, int tid) {
  for (int i = tid; i < 13 * 256; i += 512) {
    const int u = i >> 8, pm = tab[4 * u];
    unsigned v = 0u;
    if (pm >= 0) { const int e = tab[4 * u + 2], r = tab[4 * u + 3] + (i & 255); if (r < cnt[e]) v = (unsigned)elist[e * 16384 + r] * 2048u; }
    rowoff[i] = v;
  }
  __syncthreads();
}
template <int NJ, int MODE = 0> struct MoeOrder {
  const int* tab;
  unsigned* rdy;
  __device__ __forceinline__ bool next(int i, Unit& u) const {
    if (i >= 24) return false;
    const int pm = tab[4 * i]; if (pm < 0) return false;
    u.pm = pm; u.pn = tab[4 * i + 1]; return true;
  }
  __device__ __forceinline__ void a_ready(const Unit& u) const {
    if constexpr (MODE == 2) {
      if (threadIdx.x < 64) {
        unsigned polls = 0;
        while ((unsigned)__builtin_amdgcn_readfirstlane(__hip_atomic_load(rdy + u.pm, __ATOMIC_RELAXED, __HIP_MEMORY_SCOPE_AGENT)) < 64u) {
          if (++polls > (1u << 22)) break;
          __builtin_amdgcn_s_sleep(2);
        }
        __builtin_amdgcn_fence(__ATOMIC_ACQUIRE, "agent");
        asm volatile("s_waitcnt vmcnt(0)" ::: "memory");
      }
      asm volatile("" ::: "memory"); __builtin_amdgcn_s_barrier(); asm volatile("" ::: "memory");
    }
  }
  __device__ __forceinline__ void done(const Unit& u) const {
    if constexpr (MODE == 1) {
      asm volatile("s_waitcnt vmcnt(0)" ::: "memory");
      if ((threadIdx.x & 63) == 0) __hip_atomic_fetch_add(rdy + u.pm, 1u, __ATOMIC_RELAXED, __HIP_MEMORY_SCOPE_AGENT);
    }
  }
};
}

#include <hip/hip_bf16.h>
#include <cmath>
namespace attn_body {
using bf16=__hip_bfloat16;
using bf16x8=__attribute__((ext_vector_type(8)))short;
using s16x4=__attribute__((ext_vector_type(4)))short;
using f32x16=__attribute__((ext_vector_type(16)))float;
using u32x4=__attribute__((ext_vector_type(4)))unsigned;
constexpr int BATCH=1,NHEAD=8,SEQ=16384,D=64,DM=NHEAD*D;
constexpr int NW=8,QBLK=32,QB=QBLK*NW,KVBLK=64,NQB=SEQ/QB;
constexpr int ATTN_PITCH=DM, ATTN_UNIT_ROWS=QB;
__device__ __forceinline__ int crow(int r,int hi){return (r&3)+8*(r>>2)+4*hi;}
#define SBAR() __builtin_amdgcn_sched_barrier(0)
__device__ __forceinline__ void cmask(f32x16&p0,f32x16&p1,int jb,int qrel,int hi){
  const float NEG=-INFINITY; int kb=64*jb+4*hi;
  #pragma unroll
  for(int r=0;r<16;++r){int kv=kb+(r&3)+8*(r>>2); if(kv>qrel)p0[r]=NEG; if(kv+32>qrel)p1[r]=NEG;}
}

constexpr int NSLOT=3, SLOTB=8192;
constexpr int LDS_K=0, LDS_V=NSLOT*SLOTB, LDS_WS=2*NSLOT*SLOTB, LDS_OST=LDS_WS+NW*64*4, LDS_BYTES=LDS_OST+NW*4096;
constexpr float C2=0.17677669529663687f*1.4426950408889634f;
__device__ __forceinline__ void glds16(const void*gsrc,unsigned lds_dst){unsigned keep;
  asm volatile("s_mov_b32 %0, m0\n\ts_mov_b32 m0, %2\n\ts_nop 0\n\tglobal_load_lds_dwordx4 %1, off\n\ts_mov_b32 m0, %0":"=&s"(keep):"v"(gsrc),"s"(lds_dst):"memory");}
__device__ __forceinline__ float max3f(float a,float b,float c){float r;asm("v_max3_f32 %0, %1, %2, %3":"=v"(r):"v"(a),"v"(b),"v"(c));return r;}
__device__ __forceinline__ float max2f(float a,float b){float r;asm("v_max_f32_e32 %0, %1, %2":"=v"(r):"v"(a),"v"(b));return r;}
__device__ __forceinline__ float fadd_s(float a,float b){float r;asm("v_add_f32_e32 %0, %1, %2":"=v"(r):"v"(a),"v"(b));return r;}
__device__ __forceinline__ float fsub_s(float a,float b){float r;asm("v_sub_f32_e32 %0, %1, %2":"=v"(r):"v"(a),"v"(b));return r;}
typedef float f32x2_t __attribute__((ext_vector_type(2))); typedef __bf16 bf16x2_t __attribute__((ext_vector_type(2)));
__device__ __forceinline__ unsigned cvtpk_s(float lo,float hi){f32x2_t v={lo,hi};bf16x2_t b=__builtin_convertvector(v,bf16x2_t);return __builtin_bit_cast(unsigned,b);}
#define WAIT_BAR(N) asm volatile("s_waitcnt vmcnt(" #N ") lgkmcnt(0)\n\ts_barrier":::"memory")

__device__ __forceinline__ void qkt(f32x16&p0,f32x16&p1,const char*Kslot,const bf16x8*qr,const f32x16&negm,int r32,int hi){
  const char*kb=Kslot+hi*1024+r32*16;
  #pragma unroll
  for(int d0=0;d0<2;++d0){
    const bf16x8 b0=*reinterpret_cast<const bf16x8*>(kb+d0*2048);
    const bf16x8 b1=*reinterpret_cast<const bf16x8*>(kb+d0*2048+512);
    if(d0==0){p0=__builtin_amdgcn_mfma_f32_32x32x16_bf16(b0,qr[0],negm,0,0,0);p1=__builtin_amdgcn_mfma_f32_32x32x16_bf16(b1,qr[0],negm,0,0,0);}
    else{p0=__builtin_amdgcn_mfma_f32_32x32x16_bf16(b0,qr[d0],p0,0,0,0);p1=__builtin_amdgcn_mfma_f32_32x32x16_bf16(b1,qr[d0],p1,0,0,0);}}
}
typedef __attribute__((address_space(3))) const char* lds_cptr;
typedef short v4i16_t __attribute__((ext_vector_type(4)));
__device__ __forceinline__ void kload8(bf16x8*kf,lds_cptr kp){
  kf[0]=*(const __attribute__((address_space(3))) bf16x8*)(kp);      kf[1]=*(const __attribute__((address_space(3))) bf16x8*)(kp+512);
  kf[2]=*(const __attribute__((address_space(3))) bf16x8*)(kp+2048); kf[3]=*(const __attribute__((address_space(3))) bf16x8*)(kp+2560);
  kf[4]=*(const __attribute__((address_space(3))) bf16x8*)(kp+4096); kf[5]=*(const __attribute__((address_space(3))) bf16x8*)(kp+4608);
  kf[6]=*(const __attribute__((address_space(3))) bf16x8*)(kp+6144); kf[7]=*(const __attribute__((address_space(3))) bf16x8*)(kp+6656);
}
__device__ __forceinline__ void kload2(bf16x8*kf,lds_cptr kp,int j){ kf[2*j]=*(const __attribute__((address_space(3))) bf16x8*)(kp+j*2048); kf[2*j+1]=*(const __attribute__((address_space(3))) bf16x8*)(kp+j*2048+512); }
__device__ __forceinline__ s16x4 vtr(lds_cptr p){ return __builtin_bit_cast(s16x4,__builtin_amdgcn_ds_read_tr16_b64_v4i16((__attribute__((address_space(3))) v4i16_t*)p)); }
__device__ __forceinline__ float rowmax(const f32x16&p0,const f32x16&p1){
  float a=max3f(p0[0],p0[1],p1[0]),b=max3f(p0[2],p0[3],p1[1]);a=max3f(a,p1[2],p1[3]);
  #pragma unroll
  for(int r=4;r<16;r+=4){a=max3f(a,p0[r],p0[r+1]);b=max3f(b,p0[r+2],p0[r+3]);a=max3f(a,p1[r],p1[r+1]);b=max3f(b,p1[r+2],p1[r+3]);}
  const float m=max2f(a,b);
  auto rr=__builtin_amdgcn_permlane32_swap(__float_as_uint(m),__float_as_uint(m),false,false);
  return max2f(__uint_as_float(rr[0]),__uint_as_float(rr[1]));
}
__device__ __forceinline__ void pv(f32x16*o,int vb,bf16x8 pa0,bf16x8 pa1,bf16x8 pa2,bf16x8 pa3){
  #pragma unroll
  for(int d0=0;d0<2;++d0){s16x4 lo[4],hi[4];
    #pragma unroll
    for(int ks=0;ks<4;++ks){
      asm volatile("ds_read_b64_tr_b16 %0,%1 offset:%c2":"=&v"(lo[ks]):"v"(vb),"i"(d0*4096+ks*1024):"memory");
      asm volatile("ds_read_b64_tr_b16 %0,%1 offset:%c2":"=&v"(hi[ks]):"v"(vb),"i"(d0*4096+ks*1024+512):"memory");}
    asm volatile("s_waitcnt lgkmcnt(0)":::"memory");SBAR();
    #define PK(k) (bf16x8){lo[k][0],lo[k][1],lo[k][2],lo[k][3],hi[k][0],hi[k][1],hi[k][2],hi[k][3]}
    o[d0]=__builtin_amdgcn_mfma_f32_32x32x16_bf16(pa0,PK(0),o[d0],0,0,0);
    o[d0]=__builtin_amdgcn_mfma_f32_32x32x16_bf16(pa1,PK(1),o[d0],0,0,0);
    o[d0]=__builtin_amdgcn_mfma_f32_32x32x16_bf16(pa2,PK(2),o[d0],0,0,0);
    o[d0]=__builtin_amdgcn_mfma_f32_32x32x16_bf16(pa3,PK(3),o[d0],0,0,0);
    #undef PK
  }
}

#ifndef ATTN_STORE16
#define ATTN_STORE16(p,v) (*(u32x4*)(p)=(v))
#endif
template<int THRL> __device__ __forceinline__ void attn_unit(int b,int h,int qb,const bf16*Q,const bf16*__restrict__ K,const bf16*__restrict__ V,bf16*O,char*shm,const bf16*ATTN_ZERO16){
  const int tid=tidx(),lane=tid&63,r32=lane&31,hi=lane>>5; const int wid=__builtin_amdgcn_readfirstlane(tid>>6);
  const long rowbase=(long)b*SEQ; const int q0=qb*QB;
  const bf16*Qw=Q+(rowbase+q0+wid*QBLK)*DM+h*D;
  constexpr int VP=DM/2;
  const bf16*Kh=K+rowbase*DM+h*D,*Vh=V+rowbase*VP+(h>>1)*D;
  const unsigned lds0=(unsigned)(uintptr_t)shm;
  float*wsf=(float*)(shm+LDS_WS)+wid*64;
  const bf16*ksrc=(wid<4)?Kh+(long)lane*DM+wid*8:ATTN_ZERO16; const long kstep_=(wid<4)?(long)KVBLK*DM:0L;
  const bf16*vsrc=Vh+(long)(16*(wid&3)+(lane>>2))*VP+(wid>>2)*32+(lane&3)*8;
  const unsigned kdst=lds0+LDS_K+wid*1024, vdst=lds0+LDS_V+wid*1024;
  #define DMA_K(t,slot) glds16(ksrc+(long)(t)*kstep_,(unsigned)__builtin_amdgcn_readfirstlane(kdst+(slot)))
  #define DMA_V(t,slot) glds16(vsrc+(long)(t)*KVBLK*VP,(unsigned)__builtin_amdgcn_readfirstlane(vdst+(slot)))
  const int vb0=(int)(lds0+LDS_V)+((lane>>4)&1)*32+(lane&3)*8+(4*hi+((lane&15)>>2))*64;
  const char*Kbase=shm+LDS_K; bf16x8 kf[8];
  const lds_cptr shm3=(lds_cptr)shm; const lds_cptr kp0=shm3+LDS_K+hi*1024+r32*16; const lds_cptr vp0=shm3+LDS_V+((lane>>4)&1)*32+(lane&3)*8+(4*hi+((lane&15)>>2))*64;
  const int NT=(q0+QB)/KVBLK;
  DMA_K(0,0);DMA_V(0,0);DMA_K(1,SLOTB);
  bf16x8 qr[4];
  #pragma unroll
  for(int d0=0;d0<4;++d0)qr[d0]=*reinterpret_cast<const bf16x8*>(&Qw[(long)r32*DM+d0*16+hi*8]);
  float mhat=0.f,l_reg=0.f;f32x16 o[2];o[0]=f32x16{};o[1]=f32x16{};f32x16 negm=f32x16{};asm volatile("":"+v"(negm));
  const int qrel=wid*QBLK+r32;
  #define CMASK(P0,P1,t) do{int jb_=(t)-(NT-4); if(jb_>=0)cmask(P0,P1,jb_,qrel,hi);}while(0)
  bool resc=false;
  #define START(P0,P1) do{ const float rm=rowmax(P0,P1); resc=false; \
    { const float dl=rm; mhat=fadd_s(mhat,dl); \
      _Pragma("unroll") for(int r=0;r<16;++r){P0[r]=fsub_s(P0[r],dl);P1[r]=fsub_s(P1[r],dl);} \
      _Pragma("unroll") for(int r=0;r<16;++r)negm[r]=-mhat; asm volatile("":"+v"(negm)); } \
    _Pragma("unroll") for(int r=0;r<16;++r)P0[r]=__builtin_amdgcn_exp2f(P0[r]); }while(0)
  #define RESC() do{ if(resc){ asm volatile("s_waitcnt lgkmcnt(0)":::"memory"); \
      _Pragma("unroll") for(int d_=0;d_<2;++d_) _Pragma("unroll") for(int r=0;r<16;++r)o[d_][r]*=wsf[crow(r,hi)]; } }while(0)
  f32x16 pA0,pA1,pB0,pB1;
  int sl_prev=0,sl_cur=0,sl_next=SLOTB;
  #define ROT() do{sl_prev=sl_cur;sl_cur=sl_next;sl_next=(sl_next==(NSLOT-1)*SLOTB)?0:sl_next+SLOTB;}while(0)
  DMA_K(2,2*SLOTB);
  WAIT_BAR(3);
  qkt(pA0,pA1,Kbase,qr,negm,r32,hi);asm volatile("s_nop 15\n\ts_nop 7":"+v"(pA0),"+v"(pA1));CMASK(pA0,pA1,0);
  START(pA0,pA1);
  _Pragma("unroll") for(int r=0;r<16;++r)pA1[r]=__builtin_amdgcn_exp2f(pA1[r]);
  WAIT_BAR(0);
  DMA_K(3,0);DMA_V(1,SLOTB);
  ROT();
  kload8(kf,kp0+sl_cur);
  WAIT_BAR(2);
  s16x4 vlo[8],vhi[8]; u32x4 pw0,pw1,pw2,pw3;
  #define PKW(P,B) cvtpk_s(P[B],P[B+1])
  #define PAF(k) __builtin_bit_cast(bf16x8,pw##k)
  #define VFR(i) (bf16x8){vlo[i][0],vlo[i][1],vlo[i][2],vlo[i][3],vhi[i][0],vhi[i][1],vhi[i][2],vhi[i][3]}
  #define PIN(x) asm volatile("":"+v"(x))
  #define MX3(a,b,c) __builtin_fmaxf(__builtin_fmaxf((a),(b)),(c))
  #define GAPA(MF,A0,A1,A2,A3,W0,W1,PW) do{ MF; sacc+=A0; sacc+=A1; sacc+=A2; sacc+=A3; PIN(sacc); W0; W1; PIN(PW); SBAR(); }while(0)
  #define EX(v) __builtin_amdgcn_exp2f(v)
  #define GAPB(MF,X,B) do{ MF; X[B]=EX(X[B]); X[B+1]=EX(X[B+1]); X[B+2]=EX(X[B+2]); X[B+3]=EX(X[B+3]); PIN(X); SBAR(); }while(0)
  #define VRD(i) do{ vlo[i]=vtr(vp_+(((i)>>2)*4096+((i)&3)*1024)); vhi[i]=vtr(vp_+(((i)>>2)*4096+((i)&3)*1024+512)); }while(0)
  #define KRD(G,j) do{ if(G){ kload2(kf,kp0+sl_next,j); SBAR(); } }while(0)
  #define STEP(C0,C1,P0,P1,t,GK,GV,GL) do{ SBAR(); \
    const lds_cptr vp_=vp0+sl_prev; \
    VRD(0); SBAR(); float sacc=(P0[0]+P0[1]); \
    GAPA(C0=__builtin_amdgcn_mfma_f32_32x32x16_bf16(kf[0],qr[0],negm,0,0,0), P0[2],P0[3],P0[4],P0[5],     pw0[0]=PKW(P0,0), pw0[1]=PKW(P0,2), pw0); \
    VRD(4); SBAR(); GAPA(C1=__builtin_amdgcn_mfma_f32_32x32x16_bf16(kf[1],qr[0],negm,0,0,0), P0[6],P0[7],P0[8],P0[9],     pw0[2]=PKW(P0,4), pw0[3]=PKW(P0,6), pw0); \
    VRD(1); SBAR(); GAPA(C0=__builtin_amdgcn_mfma_f32_32x32x16_bf16(kf[2],qr[1],C0,0,0,0),   P0[10],P0[11],P0[12],P0[13], pw1[0]=PKW(P0,8), pw1[1]=PKW(P0,10), pw1); \
    VRD(5); SBAR(); GAPA(C1=__builtin_amdgcn_mfma_f32_32x32x16_bf16(kf[3],qr[1],C1,0,0,0),   P0[14],P0[15],P1[0],P1[1],   pw1[2]=PKW(P0,12),pw1[3]=PKW(P0,14), pw1); \
    VRD(2); SBAR(); GAPA((void)0,   P1[2],P1[3],P1[4],P1[5],     pw2[0]=PKW(P1,0), pw2[1]=PKW(P1,2), pw2); \
    VRD(6); SBAR(); GAPA((void)0,   P1[6],P1[7],P1[8],P1[9],     pw2[2]=PKW(P1,4), pw2[3]=PKW(P1,6), pw2); \
    VRD(3); SBAR(); GAPA((void)0,   P1[10],P1[11],P1[12],P1[13], pw3[0]=PKW(P1,8), pw3[1]=PKW(P1,10), pw3); \
    VRD(7); SBAR(); GAPA((void)0,   P1[14],P1[15],0.f,0.f,       pw3[2]=PKW(P1,12),pw3[3]=PKW(P1,14), pw3); \
    l_reg+=sacc; \
    if(GK){DMA_K((t)+3,sl_cur);} if(GV){DMA_V((t)+1,sl_next);} \
    CMASK(C0,C1,t); \
    { float a=MX3(C0[0],C0[1],C1[0]),b=MX3(C0[2],C0[3],C1[1]); a=MX3(a,C1[2],C1[3]); \
      _Pragma("unroll") for(int r=4;r<16;r+=4){a=MX3(a,C0[r],C0[r+1]);b=MX3(b,C0[r+2],C0[r+3]);a=MX3(a,C1[r],C1[r+1]);b=MX3(b,C1[r+2],C1[r+3]);} \
      float rm=__builtin_fmaxf(a,b); { auto rr=__builtin_amdgcn_permlane32_swap(__float_as_uint(rm),__float_as_uint(rm),false,false); rm=__builtin_fmaxf(__uint_as_float(rr[0]),__uint_as_float(rr[1])); } \
      resc=false; \
      if(__builtin_expect(__any(rm>(float)THRL),0)){ const float dl=__builtin_fmaxf(rm,0.f); mhat+=dl; \
        _Pragma("unroll") for(int r=0;r<16;++r){C0[r]-=dl;C1[r]-=dl;} \
        _Pragma("unroll") for(int r=0;r<16;++r)negm[r]=-mhat; asm volatile("":"+v"(negm)); \
        const float f=__builtin_amdgcn_exp2f(-dl); l_reg*=f; if(hi==0)wsf[r32]=f; resc=true; } } \
    SBAR(); \
    GAPB(o[0]=__builtin_amdgcn_mfma_f32_32x32x16_bf16(PAF(0),VFR(0),o[0],0,0,0), C0,0); \
    GAPB(o[1]=__builtin_amdgcn_mfma_f32_32x32x16_bf16(PAF(0),VFR(4),o[1],0,0,0), C0,4); \
    KRD(GL,0); GAPB(o[0]=__builtin_amdgcn_mfma_f32_32x32x16_bf16(PAF(1),VFR(1),o[0],0,0,0), C0,8); \
    KRD(GL,1); GAPB(o[1]=__builtin_amdgcn_mfma_f32_32x32x16_bf16(PAF(1),VFR(5),o[1],0,0,0), C0,12); \
    KRD(GL,2); GAPB(o[0]=__builtin_amdgcn_mfma_f32_32x32x16_bf16(PAF(2),VFR(2),o[0],0,0,0), C1,0); \
    KRD(GL,3); GAPB(o[1]=__builtin_amdgcn_mfma_f32_32x32x16_bf16(PAF(2),VFR(6),o[1],0,0,0), C1,4); \
    GAPB(o[0]=__builtin_amdgcn_mfma_f32_32x32x16_bf16(PAF(3),VFR(3),o[0],0,0,0), C1,8); \
    GAPB(o[1]=__builtin_amdgcn_mfma_f32_32x32x16_bf16(PAF(3),VFR(7),o[1],0,0,0), C1,12); \
    }while(0)
  int t=1;
  #undef CMASK
  #define CMASK(P0,P1,t) do{}while(0)
  for(;t+5<NT;t+=2){
    STEP(pB0,pB1,pA0,pA1,t,true,true,true);     WAIT_BAR(2); RESC(); ROT();
    STEP(pA0,pA1,pB0,pB1,t+1,true,true,true);   WAIT_BAR(2); RESC(); ROT();
  }
  #undef CMASK
  #define CMASK(P0,P1,t) do{int jb_=(t)-(NT-4); if(jb_>=0)cmask(P0,P1,jb_,qrel,hi);}while(0)
  #define ENDW(tt) do{ if((tt)+3<NT){WAIT_BAR(2);} else if((tt)+2<NT){WAIT_BAR(1);} else {WAIT_BAR(0);} }while(0)
  for(;t+1<NT;t+=2){
    STEP(pB0,pB1,pA0,pA1,t,(t+3<NT),(t+1<NT),(t+1<NT));       ENDW(t);   RESC(); ROT();
    STEP(pA0,pA1,pB0,pB1,t+1,(t+4<NT),(t+2<NT),(t+2<NT));     ENDW(t+1); RESC(); ROT();
  }
  STEP(pB0,pB1,pA0,pA1,NT-1,false,false,false); RESC();
  { float sacc=pB0[0]+pB0[1]; _Pragma("unroll") for(int r=2;r<16;++r)sacc+=pB0[r]; _Pragma("unroll") for(int r=0;r<16;++r)sacc+=pB1[r]; l_reg+=sacc;
    pw0=(u32x4){PKW(pB0,0),PKW(pB0,2),PKW(pB0,4),PKW(pB0,6)};pw1=(u32x4){PKW(pB0,8),PKW(pB0,10),PKW(pB0,12),PKW(pB0,14)};pw2=(u32x4){PKW(pB1,0),PKW(pB1,2),PKW(pB1,4),PKW(pB1,6)};pw3=(u32x4){PKW(pB1,8),PKW(pB1,10),PKW(pB1,12),PKW(pB1,14)};
    SBAR(); pv(o,vb0+sl_cur,PAF(0),PAF(1),PAF(2),PAF(3)); }
  #undef PKW
  #undef PAF
  #undef VFR
  #undef PIN
  #undef MX3
  #undef GAPA
  #undef GAPB
  #undef EX
  #undef VRD
  #undef KRD
  #undef STEP
  #undef ENDW
  {auto rr=__builtin_amdgcn_permlane32_swap(__float_as_uint(l_reg),__float_as_uint(l_reg),false,false);l_reg=__uint_as_float(rr[0])+__uint_as_float(rr[1]);}
  if(hi==0)wsf[32+r32]=l_reg;asm volatile("s_waitcnt lgkmcnt(0)":::"memory");
  float rli[16];
  #pragma unroll
  for(int r=0;r<16;++r)rli[r]=__builtin_amdgcn_rcpf(wsf[32+crow(r,hi)]);
  bf16*Ow=O+(rowbase+q0+wid*QBLK)*DM+h*D;
  { bf16*stg=(bf16*)(shm+LDS_OST)+wid*2048;
    #pragma unroll
    for(int r=0;r<16;++r){const int orow=crow(r,hi);
      #pragma unroll
      for(int d0=0;d0<2;++d0)stg[orow*64+d0*32+r32]=__float2bfloat16(o[d0][r]*rli[r]);}
    asm volatile("s_waitcnt lgkmcnt(0)":::"memory");
    #pragma unroll
    for(int i=0;i<4;++i){const int row=i*8+(lane>>3),ch=lane&7; const u32x4 v=*(const u32x4*)(stg+row*64+ch*8); ATTN_STORE16(Ow+(long)row*DM+ch*8,v);} }
  asm volatile("s_waitcnt lgkmcnt(0)\n\ts_barrier":::"memory");
  #undef DMA_K
  #undef DMA_V
  #undef CMASK
  #undef START
  #undef RESC
  #undef ROT
}
constexpr int ATTN_LDS_BYTES=LDS_BYTES;
struct AttnTensors { const bf16* Q; const bf16* K; const bf16* V; bf16* O; const bf16* Z; };
struct AttnUnit { int bh; int qb; };
struct StaticOrder {
  int vcu,grid;
  __device__ __forceinline__ explicit StaticOrder(int grid_,int block):vcu((block%8)*(grid_/8)+block/8),grid(grid_){}
  __device__ __forceinline__ bool next(int i,AttnUnit&u)const{ const int L=(i>>1)*grid+vcu; if(L>=256)return false; const int s=L&31; u.bh=L>>5; u.qb=(i&1)?63-s:s; return true; }
  __device__ __forceinline__ void a_ready(const AttnUnit&)const{}
  __device__ __forceinline__ void done(const AttnUnit&)const{}
};
template<class Sched,int THRL=8> __device__ __forceinline__ void attn_phase(char*lds,const AttnTensors&T,const Sched&S){
  AttnUnit u;
  for(int i=0;S.next(i,u);++i){ S.a_ready(u); attn_unit<THRL>(u.bh/NHEAD,u.bh%NHEAD,u.qb,T.Q,T.K,T.V,T.O,lds,T.Z); S.done(u); }
}
#undef SBAR
#undef WAIT_BAR
}

__device__ __forceinline__ void transpose_item(const float* W, int N, int k0, int n0, bf16raw* WT, int drow0, float* scr, int lane, int hi_off = 32) {
  const int c4 = (lane & 15) * 4, r0 = lane >> 4;
  const bool inb = (n0 + c4) < N;
  float4 v[16];
  typedef float f32x4nt_ __attribute__((ext_vector_type(4)));
#pragma unroll
  for (int i = 0; i < 16; ++i) {
    if (inb) { const f32x4nt_ t = __builtin_nontemporal_load((const f32x4nt_*)(W + (size_t)(k0 + 4 * i + r0) * N + n0 + c4)); v[i] = make_float4(t[0], t[1], t[2], t[3]); }
    else v[i] = make_float4(0.f, 0.f, 0.f, 0.f);
  }
#pragma unroll
  for (int i = 0; i < 16; ++i) {
    float* sp = scr + (4 * i + r0) * 65 + c4;
    sp[0] = v[i].x; sp[1] = v[i].y; sp[2] = v[i].z; sp[3] = v[i].w;
  }
  __builtin_amdgcn_fence(__ATOMIC_RELEASE, "wavefront"); __builtin_amdgcn_wave_barrier(); __builtin_amdgcn_fence(__ATOMIC_ACQUIRE, "wavefront");
  const int c = lane & 7;
#pragma unroll
  for (int j = 0; j < 8; ++j) {
    const int n = (lane >> 3) + 8 * j;
    const float* sp = scr + (8 * c) * 65 + n;
    uint4 o;
    o.x = pk2(sp[0 * 65], sp[1 * 65]); o.y = pk2(sp[2 * 65], sp[3 * 65]); o.z = pk2(sp[4 * 65], sp[5 * 65]); o.w = pk2(sp[6 * 65], sp[7 * 65]);
    if (n0 + n < N) { typedef unsigned u32x4nt_ __attribute__((ext_vector_type(4))); const u32x4nt_ ov = {o.x, o.y, o.z, o.w}; __builtin_nontemporal_store(ov, (u32x4nt_*)(WT + (size_t)(drow0 + (n & 31) + (n >> 5) * hi_off) * 1024 + k0 + 8 * c)); }
  }
  __builtin_amdgcn_fence(__ATOMIC_RELEASE, "wavefront"); __builtin_amdgcn_wave_barrier(); __builtin_amdgcn_fence(__ATOMIC_ACQUIRE, "wavefront");
}
constexpr int CV_IN = 16 * 45, CV_OUT = 16 * 16, CV_UP = 32 * 16 * 32, CV_DN = 32 * 16 * 16;
__device__ __forceinline__ void convert_one(const Params& p, int l, int r, float* scr, int lane) {
  if (r < CV_IN) {
    const int kb = r / 45, nb = r % 45;
    const int n0 = nb * 64;
    int drow = n0, hio = 32;
    if (n0 >= 768 && n0 < 1280) { const int t = n0 - 768; drow = 768 + (t >> 8) * 256 + ((t >> 6) & 3) * 32; hio = 128; }
    transpose_item(p.in[6] + (size_t)l * 1024 * DIN, DIN, kb * 64, n0, (bf16raw*)(p.ws + WS_WIN) + (size_t)l * 3072 * 1024, drow, scr, lane, hio);
    return;
  }
  r -= CV_IN;
  if (r < CV_OUT) {
    const int kb = r / 16, nb = r % 16;
    transpose_item(p.in[7] + (size_t)l * 1024 * 1024, 1024, kb * 64, nb * 64, (bf16raw*)(p.ws + WS_WOUT) + (size_t)l * 1024 * 1024, nb * 64, scr, lane);
    return;
  }
  r -= CV_OUT;
  if (r < CV_UP) {
    const int e = r / (16 * 32), r2 = r % (16 * 32), kb = r2 / 32, nb = r2 % 32, n0 = nb * 64;
    const int drow = n0 < 1024 ? (n0 >> 7) * 256 + (n0 & 127) : ((n0 - 1024) >> 7) * 256 + 128 + ((n0 - 1024) & 127);
    transpose_item(p.in[29] + ((size_t)l * NE + e) * 1024 * 2048, 2048, kb * 64, n0, (bf16raw*)(p.ws + WS_WUP) + ((size_t)l * NE + e) * 2048 * 1024, drow, scr, lane);
    return;
  }
  r -= CV_UP;
  {
    const int e = r / (16 * 16), r2 = r % (16 * 16), kb = r2 / 16, nb = r2 % 16;
    transpose_item(p.in[31] + ((size_t)l * NE + e) * 1024 * 1024, 1024, kb * 64, nb * 64, (bf16raw*)(p.ws + WS_WDN) + ((size_t)l * NE + e) * 1024 * 1024, nb * 64, scr, lane);
  }
}
__device__ __forceinline__ void ph_convert(const Params& p, float* sm) {
  const int bid0_ = bidx();
  const int tid0_ = tidx();
  const int lane = tid0_ & 63, wave = tid0_ >> 6;
  float* scr = sm + wave * (64 * 65 + 16);
  const int gw = bid0_ * 8 + wave, NGW = gridDim.x * 8;
  for (int it = gw; it < 2 * CV_IN; it += NGW) convert_one(p, it / CV_IN, it % CV_IN, scr, lane);
  for (int i = bid0_ * NT + tid0_; i < 2 * 240 * 128; i += gridDim.x * NT) {
    const int l = i / (240 * 128), r = i % (240 * 128);
    *(uint4*)((bf16raw*)(p.ws + WS_WIN) + (size_t)l * 3072 * 1024 + (size_t)2832 * 1024 + (size_t)r * 8) = make_uint4(0u, 0u, 0u, 0u);
  }
}
__device__ __forceinline__ void convert_rest(const Params& p, float* sm, int l) {
  const int bid0_ = bidx();
  const int tid0_ = tidx();
  const int lane = tid0_ & 63, wave = tid0_ >> 6;
  float* scr = sm + wave * (64 * 65 + 16);
  const int gw = bid0_ * 8 + wave, NGW = gridDim.x * 8;
  for (int it = gw; it < CV_OUT + CV_UP + CV_DN; it += NGW) convert_one(p, l, CV_IN + it, scr, lane);
}

__device__ __forceinline__ void ph_mod(const Params& p, float* sm) {
  const int bid0_ = bidx();
  const int tid0_ = tidx();
  float* mod = (float*)(p.ws + WS_MOD);
  const float* c = p.in[1];
  if (bid0_ == 0 && tid0_ < 64) ((int*)(p.ws + WS_CNT))[tid0_] = 0;
  if (bid0_ == 0) ((int*)(p.ws + WS_LCNT))[tid0_] = 0;
  if (bid0_ == 0 && tid0_ < 16) ((int*)(p.ws + WS_ZERO))[tid0_] = 0;
  if (bid0_ == 0) for (int i = tid0_; i < 640; i += NT) ((unsigned*)(p.ws + WS_RDY))[i] = 0u;
  float* cs = sm;
  float* red = sm + 1024;
  for (int it = bid0_; it < 96; it += gridDim.x) {
    const int l = it / 48, col0 = (it % 48) * 128;
    __syncthreads();
    for (int i = tid0_; i < 1024; i += NT) { const float cv = c[i]; cs[i] = cv / (1.f + __expf(-cv)); }
    __syncthreads();
    const int cg4 = (tid0_ & 31) * 4, kc = tid0_ >> 5;
    const float* w = p.in[2] + (size_t)l * 1024 * 6144 + (size_t)(kc * 64) * 6144 + col0 + cg4;
    float4 acc = make_float4(0.f, 0.f, 0.f, 0.f);
#pragma unroll 16
    for (int i = 0; i < 64; ++i) {
      const float4 wv = *(const float4*)(w + (size_t)i * 6144);
      const float sv = cs[kc * 64 + i];
      acc.x += sv * wv.x; acc.y += sv * wv.y; acc.z += sv * wv.z; acc.w += sv * wv.w;
    }
    *(float4*)(red + kc * 128 + cg4) = acc;
    __syncthreads();
    if (tid0_ < 128) {
      float t = 0.f;
#pragma unroll
      for (int k = 0; k < 16; ++k) t += red[k * 128 + tid0_];
      mod[l * 6144 + col0 + tid0_] = t + p.in[3][l * 6144 + col0 + tid0_];
    }
  }
  __syncthreads();
}

__device__ __forceinline__ void ph_norm(const Params& p, int l, int which, float* sm) {
  const int bid0_ = bidx();
  const int tid0_ = tidx();
  const int lane = tid0_ & 63, wave = tid0_ >> 6;
  const float* mod = (const float*)(p.ws + WS_MOD) + l * 6144;
  const float* xin = which == 0 ? (l == 0 ? p.in[0] : (const float*)(p.ws + WS_XA)) : (const float*)(p.ws + WS_X1);
  const float* gain = (which == 0 ? p.in[4] : p.in[5]) + l * 1024;
  const float* sh = mod + (which == 0 ? 0 : 3) * 1024;
  const float* sc = mod + (which == 0 ? 1 : 4) * 1024;
  bf16raw* H = (bf16raw*)(p.ws + WS_H);
  const float* rw = p.in[27] + (size_t)l * 1024 * 32;
  const float* rb = p.in[28] + l * 32;
  int* cnt = (int*)(p.ws + WS_CNT) + l * 32;
  int* eidx = (int*)(p.ws + WS_EIDX);
  float* gatebuf = (float*)(p.ws + WS_GATE);
  for (int rbase = bid0_ * 8; rbase < S; rbase += gridDim.x * 8) {
    const int row = rbase + wave;
    const float4* xr = (const float4*)(xin + (size_t)row * 1024) + lane;
    float4 v[4];
    float ss = 0.f;
#pragma unroll
    for (int j = 0; j < 4; ++j) {
      v[j] = xr[64 * j];
      ss += v[j].x * v[j].x + v[j].y * v[j].y + v[j].z * v[j].z + v[j].w * v[j].w;
    }
    ss = wave_sum(ss);
    float r = rsqrtf(ss * (1.f / 1024.f) + 1e-6f);
    uint2* hr = (uint2*)(H + (size_t)row * 1024) + lane;
#pragma unroll
    for (int j = 0; j < 4; ++j) {
      int col = (lane + 64 * j) * 4;
      float4 g = *(const float4*)(gain + col), a = *(const float4*)(sc + col), b = *(const float4*)(sh + col);
      v[j].x = v[j].x * r * g.x * (1.f + a.x) + b.x;
      v[j].y = v[j].y * r * g.y * (1.f + a.y) + b.y;
      v[j].z = v[j].z * r * g.z * (1.f + a.z) + b.z;
      v[j].w = v[j].w * r * g.w * (1.f + a.w) + b.w;
      hr[64 * j] = make_uint2(pk2(v[j].x, v[j].y), pk2(v[j].z, v[j].w));
    }
  }
}

__device__ __forceinline__ void ph_norm2(const Params& p, int l, float* sm) {
  const int bid0_ = bidx();
  const int tid = tidx();
  const int lane = tid & 63, wave = tid >> 6;
  const float* mod = (const float*)(p.ws + WS_MOD) + l * 6144;
  const bf16raw* xin = (const bf16raw*)(p.ws + WS_X1);
  const float* gain = p.in[5] + l * 1024;
  const float* sh = mod + 3 * 1024; const float* sc = mod + 4 * 1024;
  bf16raw* H = (bf16raw*)(p.ws + WS_H);
  const float* rw = p.in[27] + (size_t)l * 1024 * 32;
  const float* rb = p.in[28] + l * 32;
  int* cnt = (int*)(p.ws + WS_CNT) + l * 32;
  int* eidx = (int*)(p.ws + WS_EIDX);
  int* elist = (int*)(p.ws + WS_ELIST);
  float* gatebuf = (float*)(p.ws + WS_GATE);
  float* hs = sm;
  float* wsm = sm + 64 * 132;
  float* rstd = wsm + 4096;
  int* lcnt = (int*)(rstd + 64);
  int* lbase = lcnt + 32;
  for (int rbase = bid0_ * 64; rbase < S; rbase += gridDim.x * 64) {
    __syncthreads();
    if (tid < 32) lcnt[tid] = 0;
#pragma unroll 2
    for (int ri = 0; ri < 8; ++ri) {
      const int row = rbase + wave * 8 + ri;
      const bf16raw* xr = xin + (size_t)row * 1024 + lane * 4;
      float4 v[4];
      float ss = 0.f;
#pragma unroll
      for (int j = 0; j < 4; ++j) { v[j] = ld4bf(xr + 256 * j); ss += v[j].x * v[j].x + v[j].y * v[j].y + v[j].z * v[j].z + v[j].w * v[j].w; }
      ss = wave_sum(ss);
      const float r = rsqrtf(ss * (1.f / 1024.f) + 1e-6f);
      if (lane == 0) rstd[wave * 8 + ri] = r;
      uint2* hr = (uint2*)(H + (size_t)row * 1024) + lane;
#pragma unroll
      for (int j = 0; j < 4; ++j) {
        const int col = (lane + 64 * j) * 4;
        const float4 g = *(const float4*)(gain + col), a = *(const float4*)(sc + col), b = *(const float4*)(sh + col);
        hr[64 * j] = make_uint2(pk2(v[j].x * r * g.x * (1.f + a.x) + b.x, v[j].y * r * g.y * (1.f + a.y) + b.y),
                                pk2(v[j].z * r * g.z * (1.f + a.z) + b.z, v[j].w * r * g.w * (1.f + a.w) + b.w));
      }
    }
    const int row_l = tid >> 3, eg = tid & 7;
    float acc[4] = {0.f, 0.f, 0.f, 0.f};
#pragma unroll 1
    for (int k0 = 0; k0 < 1024; k0 += 128) {
      __syncthreads();
#pragma unroll
      for (int u = 0; u < 4; ++u) {
        const int idx = tid + u * 512, rr = idx >> 5, c4 = (idx & 31) * 4;
        const float4 x = ld4bf(xin + (size_t)(rbase + rr) * 1024 + k0 + c4);
        const float4 g = *(const float4*)(gain + k0 + c4), a = *(const float4*)(sc + k0 + c4), b = *(const float4*)(sh + k0 + c4);
        const float r = rstd[rr];
        *(float4*)(hs + rr * 132 + c4) = make_float4(x.x * r * g.x * (1.f + a.x) + b.x, x.y * r * g.y * (1.f + a.y) + b.y, x.z * r * g.z * (1.f + a.z) + b.z,
                                                      x.w * r * g.w * (1.f + a.w) + b.w);
      }
#pragma unroll
      for (int u = 0; u < 2; ++u) { const int idx = tid + u * 512; *(float4*)(wsm + idx * 4) = *(const float4*)(rw + (size_t)k0 * 32 + idx * 4); }
      __syncthreads();
#pragma unroll 8
      for (int k4 = 0; k4 < 32; ++k4) {
        const float4 hv = *(const float4*)(hs + row_l * 132 + k4 * 4);
        const float4 w0 = *(const float4*)(wsm + (k4 * 4 + 0) * 32 + eg * 4), w1 = *(const float4*)(wsm + (k4 * 4 + 1) * 32 + eg * 4);
        const float4 w2 = *(const float4*)(wsm + (k4 * 4 + 2) * 32 + eg * 4), w3 = *(const float4*)(wsm + (k4 * 4 + 3) * 32 + eg * 4);
        acc[0] += hv.x * w0.x + hv.y * w1.x + hv.z * w2.x + hv.w * w3.x;
        acc[1] += hv.x * w0.y + hv.y * w1.y + hv.z * w2.y + hv.w * w3.y;
        acc[2] += hv.x * w0.z + hv.y * w1.z + hv.z * w2.z + hv.w * w3.z;
        acc[3] += hv.x * w0.w + hv.y * w1.w + hv.z * w2.w + hv.w * w3.w;
      }
    }
    {
      const float4 b4 = *(const float4*)(rb + eg * 4);
      acc[0] += b4.x; acc[1] += b4.y; acc[2] += b4.z; acc[3] += b4.w;
    }
    float tv[4]; int ti[4];
#pragma unroll
    for (int rd = 0; rd < 4; ++rd) {
      float bv = acc[0]; int bi = eg * 4;
#pragma unroll
      for (int c = 1; c < 4; ++c) if (acc[c] > bv) { bv = acc[c]; bi = eg * 4 + c; }
#pragma unroll
      for (int o = 1; o < 8; o <<= 1) {
        const float ov = __shfl_xor(bv, o); const int oi = __shfl_xor(bi, o);
        if (ov > bv || (ov == bv && oi < bi)) { bv = ov; bi = oi; }
      }
      tv[rd] = bv; ti[rd] = bi;
#pragma unroll
      for (int c = 0; c < 4; ++c) if (bi == eg * 4 + c) acc[c] = -INFINITY;
    }
    int rk[4] = {0, 0, 0, 0};
    if (eg == 0) {
#pragma unroll
      for (int k = 0; k < 4; ++k) rk[k] = atomicAdd(&lcnt[ti[k]], 1);
    }
    __syncthreads();
    if (tid < 32) { const int c = lcnt[tid]; lbase[tid] = c > 0 ? atomicAdd(&cnt[tid], c) : 0; }
    __syncthreads();
    if (eg == 0) {
      const int row = rbase + row_l;
      const float e1 = __expf(tv[1] - tv[0]), e2 = __expf(tv[2] - tv[0]), e3 = __expf(tv[3] - tv[0]);
      const float inv = 1.f / (1.f + e1 + e2 + e3);
      *(int4*)(eidx + row * 4) = make_int4(ti[0] | ((lbase[ti[0]] + rk[0]) << 8), ti[1] | ((lbase[ti[1]] + rk[1]) << 8), ti[2] | ((lbase[ti[2]] + rk[2]) << 8),
                                           ti[3] | ((lbase[ti[3]] + rk[3]) << 8));
      *(float4*)(gatebuf + row * 4) = make_float4(inv, e1 * inv, e2 * inv, e3 * inv);
#pragma unroll
      for (int k = 0; k < 4; ++k) elist[ti[k] * S + lbase[ti[k]] + rk[k]] = row;
    }
  }
}

__device__ __forceinline__ void ph_inproj(const Params& p, int l, float* sm) {
  const int bid0_ = bidx();
  pg8::Gemm g{(const pg8::bf16_t*)(p.ws + WS_H), (const pg8::bf16_t*)(p.ws + WS_WIN) + (size_t)l * 3072 * 1024, S, 3072, 1024};
  pg8::StaticOrder so; so.init(S, 3072, (int)gridDim.x, bid0_);
  pg8::EpiInproj E{(pg8::bf16_t*)(p.ws + WS_QA), (pg8::bf16_t*)(p.ws + WS_KA), (pg8::bf16_t*)(p.ws + WS_VA), (float*)(p.ws + WS_QB), (pg8::bf16_t*)(p.ws + WS_QBB), (pg8::bf16_t*)(p.ws + WS_KB),
                   (pg8::bf16_t*)(p.ws + WS_VB), (float*)(p.ws + WS_KMP), (pg8::bf16_t*)(p.ws + WS_PROJ), p.in[8] + l * 32, p.in[9] + l * 32, p.in[15] + l * 64, p.in[16] + l * 64, attn_body::C2};
  pg8::gemm_phase<pg8::EpiInproj, pg8::StaticOrder, true, true>((PG8_LAS unsigned char*)sm, g, so, E);
}

__device__ __forceinline__ void gla_local_item(const Params& p, int l, int c, float* sm) {
  const int tid = tidx();
  const bf16raw* P = (const bf16raw*)(p.ws + WS_PROJ);
  float* BC = (float*)(p.ws + WS_GA);
  float* SC = (float*)(p.ws + WS_SC); float* DEC = (float*)(p.ws + WS_DEC);
  const float* wg2 = p.in[17] + l * 16 * 128; const float* bg = p.in[18] + l * 128;
  float* gs = sm; float* ks = sm + 8192; float* vs = sm + 16384; float* part = sm + 32768;
  const size_t t0 = (size_t)c * 64;
  {
    const int t = tid >> 3, d0 = (tid & 7) * 16;
    float gl[16];
#pragma unroll
    for (int r4 = 0; r4 < 4; ++r4) { float4 x = ld4bf(P + (t0 + t) * PDIN + PC_CG + r4 * 4); gl[r4 * 4] = x.x; gl[r4 * 4 + 1] = x.y; gl[r4 * 4 + 2] = x.z; gl[r4 * 4 + 3] = x.w; }
#pragma unroll
    for (int d = 0; d < 16; ++d) {
      float z = bg[d0 + d];
#pragma unroll
      for (int r = 0; r < 16; ++r) z += gl[r] * wg2[r * 128 + d0 + d];
      gs[t * 128 + d0 + d] = logsigmoidf_(z) * (1.f / 16.f);
    }
#pragma unroll
    for (int u = 0; u < 4; ++u) { int idx = tid + u * 512, row = idx >> 5, c4 = (idx & 31) * 4; *(float4*)(ks + row * 128 + c4) = ld4bf(P + (t0 + row) * PDIN + PC_CK + c4); }
#pragma unroll
    for (int u = 0; u < 8; ++u) { int idx = tid + u * 512, row = idx >> 6, c4 = (idx & 63) * 4; *(float4*)(vs + row * 256 + c4) = ld4bf(P + (t0 + row) * PDIN + PC_CV + c4); }
  }
  __syncthreads();
  const int d = tid & 127, qtr = tid >> 7;
  {
    float run = 0.f;
#pragma unroll
    for (int i = 0; i < 16; ++i) { run += gs[(qtr * 16 + i) * 128 + d]; gs[(qtr * 16 + i) * 128 + d] = run; }
    part[qtr * 128 + d] = run;
  }
  __syncthreads();
  {
    float off = 0.f;
#pragma unroll
    for (int q = 0; q < 3; ++q) if (q < qtr) off += part[q * 128 + d];
#pragma unroll
    for (int i = 0; i < 16; ++i) { float v = gs[(qtr * 16 + i) * 128 + d] + off; gs[(qtr * 16 + i) * 128 + d] = v; BC[(t0 + qtr * 16 + i) * 128 + d] = v; }
  }
  __syncthreads();
  {
    const float bl = gs[63 * 128 + d];
#pragma unroll
    for (int i = 0; i < 16; ++i) { int t = qtr * 16 + i; ks[t * 128 + d] *= __expf(bl - gs[t * 128 + d]); }
  }
  __syncthreads();
  {
    const int h = tid >> 7, dd = (tid >> 2) & 31, e0 = (tid & 3) * 16;
    float acc[16];
#pragma unroll
    for (int i = 0; i < 16; ++i) acc[i] = 0.f;
    for (int t = 0; t < 64; ++t) {
      const float kv = ks[t * 128 + h * 32 + dd];
#pragma unroll
      for (int q = 0; q < 4; ++q) {
        float4 v4 = *(const float4*)(vs + t * 256 + h * 64 + e0 + q * 4);
        acc[q * 4] += kv * v4.x; acc[q * 4 + 1] += kv * v4.y; acc[q * 4 + 2] += kv * v4.z; acc[q * 4 + 3] += kv * v4.w;
      }
    }
    float* o = SC + (((size_t)c * 4 + h) * 32 + dd) * 64 + e0;
#pragma unroll
    for (int q = 0; q < 4; ++q) *(float4*)(o + q * 4) = make_float4(acc[q * 4], acc[q * 4 + 1], acc[q * 4 + 2], acc[q * 4 + 3]);
    if ((tid & 3) == 0) DEC[(size_t)c * 128 + h * 32 + dd] = __expf(gs[63 * 128 + h * 32 + dd]);
  }
  __syncthreads();
}

__device__ __forceinline__ void lru_local_item(const Params& p, int l, int c, float* sm) {
  const int tid = tidx();
  const bf16raw* P = (const bf16raw*)(p.ws + WS_PROJ);
  float* LA = (float*)(p.ws + WS_LA); float* LB = (float*)(p.ws + WS_LB);
  float* LTA = (float*)(p.ws + WS_LTA); float* LTH = (float*)(p.ws + WS_LTH);
  const float* cw = p.in[20] + l * 4 * 256; const float* cb = p.in[21] + l * 256;
  const float* wa = p.in[22] + (size_t)l * 4 * 64 * 64; const float* ba = p.in[23] + l * 256;
  const float* wx = p.in[24] + (size_t)l * 4 * 64 * 64; const float* bx = p.in[25] + l * 256;
  const float* lam = p.in[26] + l * 256;
  float* xcs = sm;
  const int t0 = c * 64;
  for (int i = tid; i < 64 * 256; i += NT) {
    int tt = i >> 8, ch = i & 255, t = t0 + tt;
    float acc = cb[ch];
#pragma unroll
    for (int w = 0; w < 4; ++w) { int ts = t + w - 3; if (ts >= 0) acc += cw[w * 256 + ch] * bf2f(P[(size_t)ts * PDIN + PC_DX + ch]); }
    xcs[tt * 256 + ch] = acc;
  }
  __syncthreads();
  {
    const int ch = tid & 255, half = tid >> 8, n = ch >> 6, e = ch & 63;
    const float ls = logsigmoidf_(lam[ch]), bav = ba[ch], bxv = bx[ch];
    float Hh = 0.f, Ac = 1.f;
    {
      const int tb = half * 32;
      float ar[32], ai[32];
#pragma unroll
      for (int i = 0; i < 32; ++i) { ar[i] = 0.f; ai[i] = 0.f; }
#pragma unroll 1
      for (int d4 = 0; d4 < 16; ++d4) {
        float w1[4], w2[4];
#pragma unroll
        for (int q = 0; q < 4; ++q) { w1[q] = wa[(n * 64 + d4 * 4 + q) * 64 + e]; w2[q] = wx[(n * 64 + d4 * 4 + q) * 64 + e]; }
#pragma unroll
        for (int i = 0; i < 32; ++i) {
          const float4 xv = *(const float4*)(xcs + (tb + i) * 256 + n * 64 + d4 * 4);
          ar[i] += xv.x * w1[0] + xv.y * w1[1] + xv.z * w1[2] + xv.w * w1[3];
          ai[i] += xv.x * w2[0] + xv.y * w2[1] + xv.z * w2[2] + xv.w * w2[3];
        }
      }
#pragma unroll
      for (int i = 0; i < 32; ++i) {
        const int t = t0 + tb + i;
        float rg = sigmoidf_(ar[i] + bav), ig = sigmoidf_(ai[i] + bxv);
        float la = 8.f * rg * ls;
        float a = __expf(la);
        float bt = sqrtf(fmaxf(1.f - a * a, 0.f)) * (ig * xcs[(tb + i) * 256 + ch]);
        Hh = a * Hh + bt; Ac *= a;
        LA[(size_t)t * 256 + ch] = Ac; LB[(size_t)t * 256 + ch] = Hh;
      }
    }
    LTA[(size_t)(c * 2 + half) * 256 + ch] = Ac; LTH[(size_t)(c * 2 + half) * 256 + ch] = Hh;
  }
  __syncthreads();
}

__device__ __forceinline__ void ph_prep(const Params& p, int l, float* sm) {
  const int bid0_ = bidx();
  const int tid0_ = tidx();
  const int lane = tid0_ & 63, wave = tid0_ >> 6;
  const bf16raw* P = (const bf16raw*)(p.ws + WS_PROJ);
  bf16raw* QAb = (bf16raw*)(p.ws + WS_QA); bf16raw* KAb = (bf16raw*)(p.ws + WS_KA); bf16raw* VAb = (bf16raw*)(p.ws + WS_VA);
  float* QB = (float*)(p.ws + WS_QB); bf16raw* KBb = (bf16raw*)(p.ws + WS_KB); bf16raw* QBb = (bf16raw*)(p.ws + WS_QBB);
  float* KMP = (float*)(p.ws + WS_KMP); bf16raw* VBt = (bf16raw*)(p.ws + WS_VBT);
  const float* aqg = p.in[8] + l * 32; const float* akg = p.in[9] + l * 32;
  const float* bqg = p.in[15] + l * 64; const float* bkg = p.in[16] + l * 64;
  const float* wg2 = p.in[17] + l * 16 * 128; const float* bg = p.in[18] + l * 128;
  bf16raw* vsl = (bf16raw*)sm;
  const bf16raw* VBn = (const bf16raw*)(p.ws + WS_VB);
  for (int tile = bid0_; tile < S / 64; tile += gridDim.x) {
    __syncthreads();
#pragma unroll
    for (int u = 0; u < 4; ++u) { const int idx = tid0_ + u * 512, r = idx >> 5, c8 = (idx & 31) * 8; *(uint4*)(vsl + r * 264 + c8) = *(const uint4*)(VBn + (size_t)(tile * 64 + r) * 256 + c8); }
    __syncthreads();
    {
      const int col = tid0_ & 255, half = tid0_ >> 8;
      unsigned w[16];
#pragma unroll
      for (int i = 0; i < 16; ++i) w[i] = (unsigned)vsl[(half * 32 + 2 * i) * 264 + col] | ((unsigned)vsl[(half * 32 + 2 * i + 1) * 264 + col] << 16);
      uint4* dst = (uint4*)(VBt + (size_t)col * S + tile * 64 + half * 32);
#pragma unroll
      for (int i = 0; i < 4; ++i) dst[i] = make_uint4(w[4 * i], w[4 * i + 1], w[4 * i + 2], w[4 * i + 3]);
    }
  }
  __syncthreads();
  for (int c = bid0_; c < S / 64; c += gridDim.x) gla_local_item(p, l, c, sm);
  for (int c = bid0_; c < S / 64; c += gridDim.x) lru_local_item(p, l, c, sm);
}

__device__ __forceinline__ void ph_scan(const Params& p, float* sm) {
  const int bid0_ = bidx();
  const int tid = tidx();
  const float* SC = (const float*)(p.ws + WS_SC); const float* DEC = (const float*)(p.ws + WS_DEC); float* STo = (float*)(p.ws + WS_ST);
  float* gA = sm; float* gH = sm + 512; float* gC = sm + 1024;
  for (int b = bid0_; b < 256; b += gridDim.x) {
    const int chain = tid & 31, grp = tid >> 5, gid = b * 32 + chain;
    float sv[16], dv[16];
#pragma unroll
    for (int i = 0; i < 16; ++i) { const int c = grp * 16 + i; sv[i] = SC[(size_t)c * 8192 + gid]; dv[i] = DEC[c * 128 + (gid >> 6)]; }
    float A = 1.f, H = 0.f;
#pragma unroll
    for (int i = 0; i < 16; ++i) { H = dv[i] * H + sv[i]; A *= dv[i]; }
    __syncthreads();
    gA[tid] = A; gH[tid] = H;
    __syncthreads();
    if (tid < 32) {
      float carry = 0.f;
#pragma unroll
      for (int g = 0; g < 16; ++g) { gC[g * 32 + tid] = carry; carry = gA[g * 32 + tid] * carry + gH[g * 32 + tid]; }
    }
    __syncthreads();
    float st = gC[tid];
#pragma unroll
    for (int i = 0; i < 16; ++i) { const int c = grp * 16 + i; STo[(size_t)c * 8192 + gid] = st; st = dv[i] * st + sv[i]; }
  }
}
__device__ __forceinline__ void ph_scan_lru(const Params& p, float* sm) {
  const int bid0_ = bidx();
  const int tid = tidx();
  const float* LTA = (const float*)(p.ws + WS_LTA); const float* LTH = (const float*)(p.ws + WS_LTH); float* LC = (float*)(p.ws + WS_LC);
  for (int b = bid0_; b < 48; b += gridDim.x) {
    if (b < 16) continue;
    const int ch = (b - 16) * 8 + (tid & 7), grp = tid >> 3;
    float a[8], h[8];
#pragma unroll
    for (int i = 0; i < 8; ++i) { a[i] = LTA[(grp * 8 + i) * 256 + ch]; h[i] = LTH[(grp * 8 + i) * 256 + ch]; }
    float A = 1.f, H = 0.f;
#pragma unroll
    for (int i = 0; i < 8; ++i) { H = a[i] * H + h[i]; A *= a[i]; }
    __syncthreads();
    sm[tid] = A; sm[512 + tid] = H;
    __syncthreads();
    if (tid < 8) {
      float carry = 0.f;
      for (int g = 0; g < 64; ++g) { const float ga = sm[g * 8 + tid], gh = sm[512 + g * 8 + tid]; sm[1024 + g * 8 + tid] = carry; carry = ga * carry + gh; }
    }
    __syncthreads();
    float carry = sm[1024 + tid];
#pragma unroll
    for (int i = 0; i < 8; ++i) { LC[(grp * 8 + i) * 256 + ch] = carry; carry = a[i] * carry + h[i]; }
  }
}

__device__ __forceinline__ void moba_gate_item(const Params& p, int l, int it, float* sm) {
  const int tid = tidx();
  const int h = it & 3, qg = it >> 2, qi = qg * 512 + tid, own = qi >> 8;
  const float* QB = (const float*)(p.ws + WS_QB); const float* KMP = (const float*)(p.ws + WS_KMP);
  int* LCNT = (int*)(p.ws + WS_LCNT) + l * 256; int* LIST = (int*)(p.ws + WS_MLIST); float2* ML = (float2*)(p.ws + WS_ML);
  float* km = sm;
  int* lcnt = (int*)(sm + 4096); int* lbase = lcnt + 64;
  const int nmax = 2 * qg + 1;
  __syncthreads();
  for (int idx = tid; idx < nmax * 64; idx += NT) {
    const int n = idx >> 6, c = idx & 63;
    const float* kp = KMP + (size_t)(4 * n) * 256 + h * 64 + c;
    km[idx] = (kp[0] + kp[256] + kp[512] + kp[768]) * (1.f / 256.f);
  }
  if (tid < 64) lcnt[tid] = 0;
  __syncthreads();
  float q[64];
  {
    const float4* qp = (const float4*)(QB + (size_t)qi * 256 + h * 64);
#pragma unroll
    for (int i = 0; i < 16; ++i) { float4 t = qp[i]; q[4 * i] = t.x; q[4 * i + 1] = t.y; q[4 * i + 2] = t.z; q[4 * i + 3] = t.w; }
  }
  int s0 = -1, s1 = -1, s2 = -1;
  float g0 = -INFINITY, g1 = -INFINITY, g2 = -INFINITY;
#pragma unroll 1
  for (int n = 0; n < own; ++n) {
    const float4* kmp = (const float4*)(km + n * 64);
    float a = 0.f;
#pragma unroll
    for (int i = 0; i < 16; ++i) { float4 t = kmp[i]; a += q[4 * i] * t.x + q[4 * i + 1] * t.y + q[4 * i + 2] * t.z + q[4 * i + 3] * t.w; }
    if (a > g0) { g2 = g1; s2 = s1; g1 = g0; s1 = s0; g0 = a; s0 = n; }
    else if (a > g1) { g2 = g1; s2 = s1; g1 = a; s1 = n; }
    else if (a > g2) { g2 = a; s2 = n; }
  }
  int r0 = 0, r1 = 0, r2 = 0;
  if (s0 >= 0) r0 = atomicAdd(&lcnt[s0], 1);
  if (s1 >= 0) r1 = atomicAdd(&lcnt[s1], 1);
  if (s2 >= 0) r2 = atomicAdd(&lcnt[s2], 1);
  __syncthreads();
  if (tid < 64) { const int c = lcnt[tid]; lbase[tid] = c > 0 ? atomicAdd(&LCNT[h * 64 + tid], c) : 0; }
  __syncthreads();
  const float2 dead = make_float2(-INFINITY, 0.f);
  const size_t sl = ((size_t)qi * 4 + h) * 4;
  if (s0 >= 0) LIST[(size_t)(h * 64 + s0) * 16384 + lbase[s0] + r0] = qi | (0 << 16); else ML[sl + 0] = dead;
  if (s1 >= 0) LIST[(size_t)(h * 64 + s1) * 16384 + lbase[s1] + r1] = qi | (1 << 16); else ML[sl + 1] = dead;
  if (s2 >= 0) LIST[(size_t)(h * 64 + s2) * 16384 + lbase[s2] + r2] = qi | (2 << 16); else ML[sl + 2] = dead;
}

__device__ __forceinline__ void moba_attn_item(const Params& p, int h, int n, int chunk, int own, int len, float* sm) {
  typedef short bf16x8_t __attribute__((ext_vector_type(8)));
  typedef short bf16x4_t __attribute__((ext_vector_type(4)));
  typedef float f32x4_t __attribute__((ext_vector_type(4)));
  const int tid = tidx(), lane = tid & 63, wave = tid >> 6, qc = lane & 15, kg = lane >> 4;
  const bf16raw* KBb = (const bf16raw*)(p.ws + WS_KB); const bf16raw* QBb = (const bf16raw*)(p.ws + WS_QBB); const bf16raw* VBt = (const bf16raw*)(p.ws + WS_VBT);
  const int* LIST = (const int*)(p.ws + WS_MLIST); float2* ML = (float2*)(p.ws + WS_ML); bf16raw* PART = (bf16raw*)(p.ws + WS_PART);
  bf16raw* Ks = (bf16raw*)sm;
  bf16raw* Vt = (bf16raw*)sm + 256 * 72;
  __syncthreads();
#pragma unroll
  for (int u = 0; u < 4; ++u) {
    const int idx = tid + u * 512, key = idx >> 3, ch = idx & 7;
    *(uint4*)(Ks + key * 72 + ch * 8) = *(const uint4*)(KBb + (size_t)(n * 256 + key) * 256 + h * 64 + ch * 8);
    const int d = idx >> 5, c2 = idx & 31;
    *(uint4*)(Vt + d * 264 + c2 * 8) = *(const uint4*)(VBt + (size_t)(h * 64 + d) * S + n * 256 + c2 * 8);
  }
#pragma unroll 1
  for (int sub = 0; sub < 2; ++sub) {
  if (!own && chunk * 256 + sub * 128 >= len) break;
  const int slot_in = chunk * 256 + sub * 128 + wave * 16 + qc;
  int qi, src; bool valid = true;
  if (own) { qi = n * 256 + slot_in; src = 3; }
  else { valid = slot_in < len; const int e = LIST[(size_t)(h * 64 + n) * 16384 + (valid ? slot_in : 0)]; qi = e & 0xffff; src = e >> 16; }
  const bf16x8_t q0 = *(const bf16x8_t*)(QBb + (size_t)qi * 256 + h * 64 + kg * 8), q1 = *(const bf16x8_t*)(QBb + (size_t)qi * 256 + h * 64 + 32 + kg * 8);
  if (sub == 0) __syncthreads();
  const int nkeys = (own && sub == 0) ? 128 : 256;
  const int nkt = nkeys >> 4;
  f32x4_t sacc[16];
  float mx = -INFINITY;
  const int qpos = slot_in;
#pragma unroll
  for (int kt = 0; kt < 16; ++kt) {
    if (kt < nkt) {
      const bf16x8_t k0 = *(const bf16x8_t*)(Ks + (kt * 16 + qc) * 72 + kg * 8), k1 = *(const bf16x8_t*)(Ks + (kt * 16 + qc) * 72 + 32 + kg * 8);
      f32x4_t a = {0.f, 0.f, 0.f, 0.f};
      a = __builtin_amdgcn_mfma_f32_16x16x32_bf16(k0, q0, a, 0, 0, 0);
      a = __builtin_amdgcn_mfma_f32_16x16x32_bf16(k1, q1, a, 0, 0, 0);
      if (own) {
#pragma unroll
        for (int r = 0; r < 4; ++r) if (kt * 16 + kg * 4 + r > qpos) a[r] = -INFINITY;
      }
      sacc[kt] = a;
      mx = fmaxf(mx, fmaxf(fmaxf(a[0], a[1]), fmaxf(a[2], a[3])));
    } else sacc[kt] = (f32x4_t){-INFINITY, -INFINITY, -INFINITY, -INFINITY};
  }
  mx = fmaxf(mx, __shfl_xor(mx, 16)); mx = fmaxf(mx, __shfl_xor(mx, 32));
  float lsum = 0.f;
#pragma unroll
  for (int kt = 0; kt < 16; ++kt)
#pragma unroll
    for (int r = 0; r < 4; ++r) { const float pv = __builtin_amdgcn_exp2f(sacc[kt][r] - mx); sacc[kt][r] = pv; lsum += pv; }
  lsum += __shfl_xor(lsum, 16); lsum += __shfl_xor(lsum, 32);
  f32x4_t o[4];
#pragma unroll
  for (int dt = 0; dt < 4; ++dt) o[dt] = (f32x4_t){0.f, 0.f, 0.f, 0.f};
#pragma unroll
  for (int ks = 0; ks < 8; ++ks) {
    if (ks * 2 < nkt) {
      bf16x8_t pf;
      {
        const unsigned w0 = pk2(sacc[2 * ks][0], sacc[2 * ks][1]), w1 = pk2(sacc[2 * ks][2], sacc[2 * ks][3]);
        const unsigned w2 = pk2(sacc[2 * ks + 1][0], sacc[2 * ks + 1][1]), w3 = pk2(sacc[2 * ks + 1][2], sacc[2 * ks + 1][3]);
        const uint4 w = make_uint4(w0, w1, w2, w3);
        pf = __builtin_bit_cast(bf16x8_t, w);
      }
#pragma unroll
      for (int dt = 0; dt < 4; ++dt) {
        const bf16x4_t va = *(const bf16x4_t*)(Vt + (dt * 16 + qc) * 264 + ks * 32 + kg * 4), vb = *(const bf16x4_t*)(Vt + (dt * 16 + qc) * 264 + ks * 32 + 16 + kg * 4);
        const bf16x8_t vf = {va[0], va[1], va[2], va[3], vb[0], vb[1], vb[2], vb[3]};
        o[dt] = __builtin_amdgcn_mfma_f32_16x16x32_bf16(vf, pf, o[dt], 0, 0, 0);
      }
    }
  }
  if (valid) {
    const size_t sl = ((size_t)qi * 4 + h) * 4 + src;
    const float inv = 1.f / lsum;
#pragma unroll
    for (int dt = 0; dt < 4; ++dt) *(uint2*)(PART + sl * 64 + dt * 16 + kg * 4) = make_uint2(pk2(o[dt][0] * inv, o[dt][1] * inv), pk2(o[dt][2] * inv, o[dt][3] * inv));
    if (kg == 0) ML[sl] = make_float2(mx, lsum);
  }
  }
}

__device__ __forceinline__ void moba_attn(const Params& p, int l, float* sm) {
  const int bid0_ = bidx();
  const int tid = tidx();
  const int* LCNT = (const int*)(p.ws + WS_LCNT) + l * 256;
  int* pre = (int*)(sm + 36000);
  __syncthreads();
  if (tid < 64) {
    const int4 c4 = *(const int4*)(LCNT + tid * 4);
    const int n0 = (c4.x + 255) >> 8, n1 = (c4.y + 255) >> 8, n2 = (c4.z + 255) >> 8, n3 = (c4.w + 255) >> 8;
    const int tot = n0 + n1 + n2 + n3;
    int inc = tot;
#pragma unroll
    for (int o = 1; o < 64; o <<= 1) { const int t = __shfl_up(inc, o); if (tid >= o) inc += t; }
    const int ex = inc - tot;
    pre[tid * 4] = ex; pre[tid * 4 + 1] = ex + n0; pre[tid * 4 + 2] = ex + n0 + n1; pre[tid * 4 + 3] = ex + n0 + n1 + n2;
    if (tid == 63) pre[256] = inc;
  }
  __syncthreads();
  const int ng = pre[256];
  for (int it = bid0_; it < ng + 256; it += gridDim.x) {
    if (it < ng) {
      int lo = 0, hi = 255;
      while (lo < hi) { const int mid = (lo + hi + 1) >> 1; if (pre[mid] <= it) lo = mid; else hi = mid - 1; }
      moba_attn_item(p, lo >> 6, lo & 63, it - pre[lo], 0, LCNT[lo], sm);
    } else {
      const int w = it - ng;
      moba_attn_item(p, w & 3, w >> 2, 0, 1, 256, sm);
    }
  }
}

__device__ __forceinline__ void gla_out_item(const Params& p, int l, int it2, float* sm) {
  typedef short bf16x8_t __attribute__((ext_vector_type(8)));
  typedef short bf16x4_t __attribute__((ext_vector_type(4)));
  typedef float f32x4_t __attribute__((ext_vector_type(4)));
  const int tid = tidx(), lane = tid & 63, wave = tid >> 6, qc = lane & 15, kg = lane >> 4;
  const int c = it2 >> 1, hp = it2 & 1;
  const bf16raw* P = (const bf16raw*)(p.ws + WS_PROJ);
  const float* BC = (const float*)(p.ws + WS_GA);
  const float* ST = (const float*)(p.ws + WS_ST);
  bf16raw* Y = (bf16raw*)(p.ws + WS_Y);
  const float* cog = p.in[19] + l * 64;
  bf16raw* L = (bf16raw*)sm;
  const size_t t0 = (size_t)c * 64;
  __syncthreads();
  {
    const int hh = tid >> 8, h = hp * 2 + hh;
    bf16raw* Qs = L + hh * 12288; bf16raw* Ks = Qs + 2560; bf16raw* St = Ks + 2560; bf16raw* Vt = St + 2560;
    {
      const int t = (tid >> 2) & 63, d8 = (tid & 3) * 8;
      const bf16raw* qp = P + (t0 + t) * PDIN + PC_CQ + h * 32 + d8; const bf16raw* kp = P + (t0 + t) * PDIN + PC_CK + h * 32 + d8;
      const float4 qa = ld4bf(qp), qb = ld4bf(qp + 4), ka = ld4bf(kp), kb = ld4bf(kp + 4);
      const float4 ba = *(const float4*)(BC + (t0 + t) * 128 + h * 32 + d8), bb = *(const float4*)(BC + (t0 + t) * 128 + h * 32 + d8 + 4);
      const float sc = 0.17677669529663687f;
      *(uint4*)(Qs + t * 40 + d8) = make_uint4(pk2(qa.x * sc * __expf(ba.x), qa.y * sc * __expf(ba.y)), pk2(qa.z * sc * __expf(ba.z), qa.w * sc * __expf(ba.w)),
                                               pk2(qb.x * sc * __expf(bb.x), qb.y * sc * __expf(bb.y)), pk2(qb.z * sc * __expf(bb.z), qb.w * sc * __expf(bb.w)));
      *(uint4*)(Ks + t * 40 + d8) = make_uint4(pk2(ka.x * __expf(-ba.x), ka.y * __expf(-ba.y)), pk2(ka.z * __expf(-ba.z), ka.w * __expf(-ba.w)),
                                               pk2(kb.x * __expf(-bb.x), kb.y * __expf(-bb.y)), pk2(kb.z * __expf(-bb.z), kb.w * __expf(-bb.w)));
    }
    {
      const int j = (tid >> 2) & 63, e0 = (tid & 3) * 16;
      const bf16raw* vp = P + (t0 + j) * PDIN + PC_CV + h * 64 + e0;
      const uint4 va = *(const uint4*)vp, vb = *(const uint4*)(vp + 8);
      const unsigned w[8] = {va.x, va.y, va.z, va.w, vb.x, vb.y, vb.z, vb.w};
#pragma unroll
      for (int q = 0; q < 8; ++q) { Vt[(e0 + 2 * q) * 72 + j] = (bf16raw)(w[q] & 0xffff); Vt[(e0 + 2 * q + 1) * 72 + j] = (bf16raw)(w[q] >> 16); }
    }
    {
      const int d = (tid >> 3) & 31, e0 = (tid & 7) * 8;
      const float* sp = ST + ((size_t)c * 4 + h) * 2048 + d * 64 + e0;
      const float4 sa = *(const float4*)sp, sb = *(const float4*)(sp + 4);
      const float v[8] = {sa.x, sa.y, sa.z, sa.w, sb.x, sb.y, sb.z, sb.w};
#pragma unroll
      for (int q = 0; q < 8; ++q) St[(e0 + q) * 40 + d] = (bf16raw)(pk2(v[q], 0.f) & 0xffff);
    }
  }
  __syncthreads();
  {
    const int hh = wave >> 2, itile = wave & 3, h = hp * 2 + hh;
    const bf16raw* Qs = L + hh * 12288; const bf16raw* Ks = Qs + 2560; const bf16raw* St = Ks + 2560; const bf16raw* Vt = St + 2560;
    const bf16x8_t qf = *(const bf16x8_t*)(Qs + (itile * 16 + qc) * 40 + kg * 8);
    f32x4_t att[4];
#pragma unroll
    for (int jt = 0; jt < 4; ++jt) {
      f32x4_t a = {0.f, 0.f, 0.f, 0.f};
      if (jt <= itile) {
        const bf16x8_t kf = *(const bf16x8_t*)(Ks + (jt * 16 + qc) * 40 + kg * 8);
        a = __builtin_amdgcn_mfma_f32_16x16x32_bf16(kf, qf, a, 0, 0, 0);
        if (jt == itile) {
#pragma unroll
          for (int r = 0; r < 4; ++r) if (kg * 4 + r > qc) a[r] = 0.f;
        }
      }
      att[jt] = a;
    }
    bf16x8_t pf[2];
#pragma unroll
    for (int s2 = 0; s2 < 2; ++s2) {
      const uint4 w = make_uint4(pk2(att[2 * s2][0], att[2 * s2][1]), pk2(att[2 * s2][2], att[2 * s2][3]), pk2(att[2 * s2 + 1][0], att[2 * s2 + 1][1]),
                                 pk2(att[2 * s2 + 1][2], att[2 * s2 + 1][3]));
      pf[s2] = __builtin_bit_cast(bf16x8_t, w);
    }
    f32x4_t o[4];
    float ss = 0.f;
#pragma unroll
    for (int et = 0; et < 4; ++et) {
      f32x4_t acc = {0.f, 0.f, 0.f, 0.f};
      const bf16x8_t sf = *(const bf16x8_t*)(St + (et * 16 + qc) * 40 + kg * 8);
      acc = __builtin_amdgcn_mfma_f32_16x16x32_bf16(sf, qf, acc, 0, 0, 0);
#pragma unroll
      for (int s2 = 0; s2 < 2; ++s2) {
        if (2 * s2 <= itile) {
          const bf16x4_t va = *(const bf16x4_t*)(Vt + (et * 16 + qc) * 72 + s2 * 32 + kg * 4), vb = *(const bf16x4_t*)(Vt + (et * 16 + qc) * 72 + s2 * 32 + 16 + kg * 4);
          const bf16x8_t vf = {va[0], va[1], va[2], va[3], vb[0], vb[1], vb[2], vb[3]};
          acc = __builtin_amdgcn_mfma_f32_16x16x32_bf16(vf, pf[s2], acc, 0, 0, 0);
        }
      }
      o[et] = acc;
      ss += acc[0] * acc[0] + acc[1] * acc[1] + acc[2] * acc[2] + acc[3] * acc[3];
    }
    ss += __shfl_xor(ss, 16); ss += __shfl_xor(ss, 32);
    const float r = rsqrtf(ss * (1.f / 64.f) + 1e-6f);
    const size_t t = t0 + itile * 16 + qc;
#pragma unroll
    for (int et = 0; et < 4; ++et) {
      const int e = et * 16 + kg * 4;
      const float4 rr = ld4bf(P + t * PDIN + PC_CR + h * 64 + e), g = *(const float4*)(cog + e);
      *(uint2*)(Y + t * 1024 + 512 + h * 64 + e) = make_uint2(pk2(o[et][0] * r * g.x * rr.x * sigmoidf_(rr.x), o[et][1] * r * g.y * rr.y * sigmoidf_(rr.y)),
                                                             pk2(o[et][2] * r * g.z * rr.z * sigmoidf_(rr.z), o[et][3] * r * g.w * rr.w * sigmoidf_(rr.w)));
    }
  }
}

__device__ __forceinline__ void lru_out(const Params& p) {
  const int bid0_ = bidx();
  const int tid = tidx();
  const float* LA = (const float*)(p.ws + WS_LA); const float* LB = (const float*)(p.ws + WS_LB); const float* LC = (const float*)(p.ws + WS_LC);
  const bf16raw* P = (const bf16raw*)(p.ws + WS_PROJ);
  bf16raw* Y = (bf16raw*)(p.ws + WS_Y);
  for (int idx = bid0_ * NT + tid; idx < S * 64; idx += gridDim.x * NT) {
    const int t = idx >> 6, c4 = (idx & 63) * 4;
    const float4 a = *(const float4*)(LA + (size_t)t * 256 + c4), b = *(const float4*)(LB + (size_t)t * 256 + c4);
    const float4 cr = *(const float4*)(LC + (size_t)(t >> 5) * 256 + c4), g = ld4bf(P + (size_t)t * PDIN + PC_DG + c4);
    *(uint2*)(Y + (size_t)t * 1024 + 768 + c4) = make_uint2(pk2((b.x + a.x * cr.x) * gelu_tanh(g.x), (b.y + a.y * cr.y) * gelu_tanh(g.y)),
                                                          pk2((b.z + a.z * cr.z) * gelu_tanh(g.z), (b.w + a.w * cr.w) * gelu_tanh(g.w)));
  }
}

__device__ __forceinline__ void ph_mix(const Params& p, int l, float* sm) {
  const int bid0_ = bidx();
  const int grp = bid0_ % 3;
  if (grp == 0) { __syncthreads(); convert_rest(p, sm, l); __syncthreads(); }
  moba_attn(p, l, sm);
  for (int it = bid0_; it < 512; it += gridDim.x) gla_out_item(p, l, it, sm);
  lru_out(p);
  __syncthreads();
  if (grp == 1) { convert_rest(p, sm, l); __syncthreads(); }
  {
    const attn_body::AttnTensors AT{(const attn_body::bf16*)(p.ws + WS_QA), (const attn_body::bf16*)(p.ws + WS_KA), (const attn_body::bf16*)(p.ws + WS_VA),
                                    (attn_body::bf16*)(p.ws + WS_OA), (const attn_body::bf16*)(p.ws + WS_ZERO)};
    const attn_body::StaticOrder so((int)gridDim.x, bid0_);
    attn_body::attn_phase<attn_body::StaticOrder>((char*)sm, AT, so);
  }
  if (grp == 2) { __syncthreads(); convert_rest(p, sm, l); }
}

__device__ __forceinline__ void ph_fin(const Params& p, int l) {
  const int bid0_ = bidx();
  const int tid0_ = tidx();
  const int lane = tid0_ & 63, wave = tid0_ >> 6;
  const bf16raw* OA = (const bf16raw*)(p.ws + WS_OA);
  const bf16raw* P = (const bf16raw*)(p.ws + WS_PROJ);
  bf16raw* Y = (bf16raw*)(p.ws + WS_Y);
  const float lam = lam_of(p, l), li = lam_init_of(l);
  const float2* ML = (const float2*)(p.ws + WS_ML); const bf16raw* PART = (const bf16raw*)(p.ws + WS_PART);
  const float* aog = p.in[14] + l * 64; const float* cog = p.in[19] + l * 64;
#pragma unroll 2
  for (int row = bid0_ * 8 + wave; row < S; row += gridDim.x * 8) {
    int h = lane >> 4, c = (lane & 15) * 4;
    {
      const uint2 u1 = *(const uint2*)(OA + ((size_t)row * 8 + h * 2) * 64 + c), u2 = *(const uint2*)(OA + ((size_t)row * 8 + h * 2 + 1) * 64 + c);
      const float4 o1 = make_float4(bf2f(u1.x & 0xffff), bf2f(u1.x >> 16), bf2f(u1.y & 0xffff), bf2f(u1.y >> 16));
      const float4 o2 = make_float4(bf2f(u2.x & 0xffff), bf2f(u2.x >> 16), bf2f(u2.y & 0xffff), bf2f(u2.y >> 16));
      float4 o = make_float4(o1.x - lam * o2.x, o1.y - lam * o2.y, o1.z - lam * o2.z, o1.w - lam * o2.w);
      float ss = o.x * o.x + o.y * o.y + o.z * o.z + o.w * o.w;
#pragma unroll
      for (int k = 1; k < 16; k <<= 1) ss += __shfl_xor(ss, k);
      float r = rsqrtf(ss * (1.f / 64.f) + 1e-6f) * (1.f - li);
      float4 g = *(const float4*)(aog + c);
      *(uint2*)(Y + (size_t)row * 1024 + h * 64 + c) = make_uint2(pk2(o.x * r * g.x, o.y * r * g.y), pk2(o.z * r * g.z, o.w * r * g.w));
    }
    {
      const size_t sl = ((size_t)row * 4 + h) * 4;
      const float2 m0 = ML[sl], m1 = ML[sl + 1], m2 = ML[sl + 2], m3 = ML[sl + 3];
      const float M = fmaxf(fmaxf(m0.x, m1.x), fmaxf(m2.x, m3.x));
      const float w0 = m0.y * __builtin_amdgcn_exp2f(m0.x - M), w1 = m1.y * __builtin_amdgcn_exp2f(m1.x - M), w2 = m2.y * __builtin_amdgcn_exp2f(m2.x - M),
                  w3 = m3.y * __builtin_amdgcn_exp2f(m3.x - M);
      const float inv = 1.f / (w0 + w1 + w2 + w3);
      float4 o = make_float4(0.f, 0.f, 0.f, 0.f);
      if (w0 > 0.f) { const float4 t = ld4bf(PART + (sl + 0) * 64 + c); o.x += w0 * t.x; o.y += w0 * t.y; o.z += w0 * t.z; o.w += w0 * t.w; }
      if (w1 > 0.f) { const float4 t = ld4bf(PART + (sl + 1) * 64 + c); o.x += w1 * t.x; o.y += w1 * t.y; o.z += w1 * t.z; o.w += w1 * t.w; }
      if (w2 > 0.f) { const float4 t = ld4bf(PART + (sl + 2) * 64 + c); o.x += w2 * t.x; o.y += w2 * t.y; o.z += w2 * t.z; o.w += w2 * t.w; }
      { const float4 t = ld4bf(PART + (sl + 3) * 64 + c); o.x += w3 * t.x; o.y += w3 * t.y; o.z += w3 * t.z; o.w += w3 * t.w; }
      *(uint2*)(Y + (size_t)row * 1024 + 256 + h * 64 + c) = make_uint2(pk2(o.x * inv, o.y * inv), pk2(o.z * inv, o.w * inv));
    }
  }
}

__device__ __forceinline__ void ph_outproj(const Params& p, int l, float* sm) {
  const int bid0_ = bidx();
  pg8::Gemm g{(const pg8::bf16_t*)(p.ws + WS_Y), (const pg8::bf16_t*)(p.ws + WS_WOUT) + (size_t)l * 1024 * 1024, S, 1024, 1024};
  pg8::StaticOrder so; so.init(S, 1024, (int)gridDim.x, bid0_);
  pg8::EpiOutproj E{l == 0 ? p.in[0] : (const float*)nullptr, (const pg8::bf16_t*)(p.ws + WS_XA), (const float*)(p.ws + WS_MOD) + l * 6144 + 2 * 1024, (pg8::bf16_t*)(p.ws + WS_X1)};
  pg8::gemm_phase<pg8::EpiOutproj, pg8::StaticOrder, true, true>((PG8_LAS unsigned char*)sm, g, so, E);
}

__device__ __forceinline__ void ph_gather(const Params& p, int l, float* sm) {
  const int bid0_ = bidx();
  const int tid0_ = tidx();
  const int* cnt = (const int*)(p.ws + WS_CNT) + l * 32;
  int* ps = (int*)sm;
  __syncthreads();
  int* cl = ps + 64;
  if (tid0_ < 32) cl[tid0_] = (cnt[tid0_] + 255) & ~255;
  __syncthreads();
  if (tid0_ < 33) { int a = 0; for (int e = 0; e < tid0_; ++e) a += cl[e]; ps[tid0_] = a; }
  __syncthreads();
  int* srow = (int*)(p.ws + WS_SROW);
  if (bid0_ == 0) {
    int* texp = (int*)(p.ws + WS_TEXP);
    const int nt = ps[32] >> 8;
    if (tid0_ == 0) texp[0] = nt;
    if (tid0_ < 32) { texp[352 + tid0_] = ps[tid0_] >> 8; texp[384 + tid0_] = cl[tid0_] >> 8; }
    if (tid0_ < 320) {
      int e = 0;
      for (int k = 0; k < 32; ++k) if (tid0_ * 256 >= ps[k + 1]) e = k + 1;
      texp[1 + tid0_] = e < 32 ? e : 31;
    }
  }
  for (int e = bid0_; e < 32; e += gridDim.x)
    for (int i = cnt[e] + tid0_; i < cl[e]; i += NT) srow[ps[e] + i] = 0;
  const int* eidx = (const int*)(p.ws + WS_EIDX);
  int* rpos = (int*)(p.ws + WS_RPOS);
  for (int r = bid0_ * NT + tid0_; r < S * 4; r += gridDim.x * NT) {
    const int ei = eidx[r], e = ei & 255, rank = ei >> 8;
    const int dest = ps[e] + rank;
    srow[dest] = r >> 2;
    rpos[r] = dest;
  }
}

__device__ __forceinline__ void ph_up(const Params& p, int l, float* sm) {
  const int bid0_ = bidx();
  pg8::Gemm g{(const pg8::bf16_t*)(p.ws + WS_H), (const pg8::bf16_t*)(p.ws + WS_WUP) + (size_t)l * NE * 2048 * 1024, MOE_ROWS, 2048, 1024};
  int* tab = (int*)(sm + 33000);
  unsigned* rowoff = (unsigned*)(sm + 33104);
  const int t_ = tidx();
  const int* cnt = (const int*)(p.ws + WS_CNT) + l * 32;
  pg8::moe_build_units<8>(cnt, (int)gridDim.x, bid0_, tab, t_);
  pg8::moe_build_rowoff((const int*)(p.ws + WS_ELIST), cnt, tab, rowoff, t_);
  pg8::MoeOrder<8, 1> so{tab, (unsigned*)(p.ws + WS_RDY) + l * 320};
  pg8::EpiUp E{__builtin_amdgcn_make_buffer_rsrc((void*)(p.ws + WS_ACT), 0, (int)((size_t)MOE_ROWS * 1024 * 2), 0x00020000), p.in[30] + (size_t)l * NE * 2048};
  pg8::gemm_phase<pg8::EpiUp, pg8::MoeOrder<8, 1>, true, true, true>((PG8_LAS unsigned char*)sm, g, so, E, rowoff);
}

__device__ __forceinline__ void ph_down(const Params& p, int l, float* sm) {
  const int bid0_ = bidx();
  pg8::Gemm g{(const pg8::bf16_t*)(p.ws + WS_ACT), (const pg8::bf16_t*)(p.ws + WS_WDN) + (size_t)l * NE * 1024 * 1024, MOE_ROWS, 1024, 1024};
  int* tab = (int*)(sm + 33000);
  pg8::moe_build_units<4>((const int*)(p.ws + WS_CNT) + l * 32, (int)gridDim.x, bid0_, tab, tidx(), true);
  pg8::MoeOrder<4, 2> so{tab, (unsigned*)(p.ws + WS_RDY) + l * 320};
  pg8::EpiDown E{(pg8::bf16_t*)(p.ws + WS_YS), p.in[32] + (size_t)l * NE * 1024};
  pg8::gemm_phase<pg8::EpiDown, pg8::MoeOrder<4, 2>, true, true>((PG8_LAS unsigned char*)sm, g, so, E);
}

__device__ __forceinline__ void ph_combine(const Params& p, int l, float* sm) {
  const int bid0_ = bidx();
  const int tid0_ = tidx();
  const int lane = tid0_ & 63, wave = tid0_ >> 6;
  const bf16raw* X1 = (const bf16raw*)(p.ws + WS_X1); const bf16raw* YS = (const bf16raw*)(p.ws + WS_YS);
  const float* gatebuf = (const float*)(p.ws + WS_GATE);
  const int* eidx = (const int*)(p.ws + WS_EIDX);
  const int* cnt = (const int*)(p.ws + WS_CNT) + l * 32;
  const float* g2 = (const float*)(p.ws + WS_MOD) + l * 6144 + 5 * 1024;
  bf16raw* xa = (bf16raw*)(p.ws + WS_XA);
  const float* modn = (const float*)(p.ws + WS_MOD) + 6144;
  const float* gain = p.in[4] + 1024;
  bf16raw* H = (bf16raw*)(p.ws + WS_H);
  int* ps = (int*)sm;
  __syncthreads();
  if (tid0_ < 33) { int a = 0; for (int e = 0; e < tid0_; ++e) a += (cnt[e] + 255) & ~255; ps[tid0_] = a; }
  __syncthreads();
#pragma unroll 2
  for (int row = bid0_ * 8 + wave; row < S; row += gridDim.x * 8) {
    const float4 gt = *(const float4*)(gatebuf + row * 4);
    const int4 ei = *(const int4*)(eidx + row * 4);
    const int4 rp = make_int4(ps[ei.x & 255] + (ei.x >> 8), ps[ei.y & 255] + (ei.y >> 8), ps[ei.z & 255] + (ei.z >> 8), ps[ei.w & 255] + (ei.w >> 8));
    float4 v[4];
    float ss = 0.f;
#pragma unroll
    for (int j = 0; j < 4; ++j) {
      const int c = (lane + 64 * j) * 4;
      const uint2 y0 = *(const uint2*)(YS + (size_t)rp.x * 1024 + c), y1 = *(const uint2*)(YS + (size_t)rp.y * 1024 + c);
      const uint2 y2 = *(const uint2*)(YS + (size_t)rp.z * 1024 + c), y3 = *(const uint2*)(YS + (size_t)rp.w * 1024 + c);
      float4 a;
      a.x = gt.x * bf2f(y0.x & 0xffff) + gt.y * bf2f(y1.x & 0xffff) + gt.z * bf2f(y2.x & 0xffff) + gt.w * bf2f(y3.x & 0xffff);
      a.y = gt.x * bf2f(y0.x >> 16) + gt.y * bf2f(y1.x >> 16) + gt.z * bf2f(y2.x >> 16) + gt.w * bf2f(y3.x >> 16);
      a.z = gt.x * bf2f(y0.y & 0xffff) + gt.y * bf2f(y1.y & 0xffff) + gt.z * bf2f(y2.y & 0xffff) + gt.w * bf2f(y3.y & 0xffff);
      a.w = gt.x * bf2f(y0.y >> 16) + gt.y * bf2f(y1.y >> 16) + gt.z * bf2f(y2.y >> 16) + gt.w * bf2f(y3.y >> 16);
      const float4 x = ld4bf(X1 + (size_t)row * 1024 + c), g = *(const float4*)(g2 + c);
      v[j] = make_float4(x.x + g.x * a.x, x.y + g.y * a.y, x.z + g.z * a.z, x.w + g.w * a.w);
      if (l == 0) *(uint2*)(xa + (size_t)row * 1024 + c) = make_uint2(pk2(v[j].x, v[j].y), pk2(v[j].z, v[j].w)); else *(float4*)(p.out + (size_t)row * 1024 + c) = v[j];
      ss += v[j].x * v[j].x + v[j].y * v[j].y + v[j].z * v[j].z + v[j].w * v[j].w;
    }
    if (l == 0) {
      ss = wave_sum(ss);
      const float r = rsqrtf(ss * (1.f / 1024.f) + 1e-6f);
      uint2* hr = (uint2*)(H + (size_t)row * 1024) + lane;
#pragma unroll
      for (int j = 0; j < 4; ++j) {
        const int c = (lane + 64 * j) * 4;
        const float4 g = *(const float4*)(gain + c), a = *(const float4*)(modn + 1024 + c), b = *(const float4*)(modn + c);
        hr[64 * j] = make_uint2(pk2(v[j].x * r * g.x * (1.f + a.x) + b.x, v[j].y * r * g.y * (1.f + a.y) + b.y),
                                pk2(v[j].z * r * g.z * (1.f + a.z) + b.z, v[j].w * r * g.w * (1.f + a.w) + b.w));
      }
    }
  }
}

#define LAS __attribute__((address_space(3)))
#define XB_TMO      128
#define XB_XCNT(j)  (256  + 64 * (j))
#define XB_XSUB(j)  (1280 + 64 * (j))
#define XB_XGEN(j)  (2304 + 64 * (j))
#define XB_TOP      3328
#define XB_TOPGEN   3392
#define XCD_BAR_WORDS 3456
#define XB_SPIN_CAP (1u << 18)

__device__ __forceinline__ unsigned xb_ld(unsigned* p)              { return __hip_atomic_load(p, __ATOMIC_RELAXED, __HIP_MEMORY_SCOPE_AGENT); }
__device__ __forceinline__ unsigned xb_add(unsigned* p, unsigned v) { return __hip_atomic_fetch_add(p, v, __ATOMIC_RELAXED, __HIP_MEMORY_SCOPE_AGENT); }
__device__ __forceinline__ unsigned xb_xcc_id() { return (unsigned)__builtin_amdgcn_s_getreg((3 << 11) | 20) & 0xFu; }
#define XB_SPIN(cond, bar) do { unsigned _sp = 0; while (cond) { __builtin_amdgcn_s_sleep(1); \
    if ((++_sp & 255u) == 0u) { if (xb_ld(&(bar)[XB_TMO])) break; if (_sp > XB_SPIN_CAP) { atomicAdd(&(bar)[XB_TMO], 1u); break; } } } } while (0)

struct XcdBarrier {
    unsigned* bar; unsigned x;
    volatile LAS unsigned* st;
};

__device__ __forceinline__ XcdBarrier xcd_barrier_post(unsigned* bar, volatile LAS unsigned* st) {
    XcdBarrier b; b.bar = bar; b.x = xb_xcc_id(); b.st = st;
    if (threadIdx.x == 0) (void)xb_add(&bar[XB_XCNT(b.x)], 1u);
    return b;
}
__device__ __forceinline__ void xcd_barrier_complete(unsigned* bar, unsigned x, unsigned& nloc, unsigned& nx) {
    const unsigned G = gridDim.x * gridDim.y * gridDim.z;
    unsigned sum, cnt, mine, sp = 0u;
    for (;;) {
        sum = 0u; cnt = 0u; mine = 0u;
#pragma unroll
        for (unsigned j = 0; j < 16; ++j) { const unsigned c = xb_ld(&bar[XB_XCNT(j)]); sum += c; cnt += (c > 0u) ? 1u : 0u; mine = (j == x) ? c : mine; }
        if (sum == G) break;
        __builtin_amdgcn_s_sleep(1);
        if ((++sp & 255u) == 0u) { if (xb_ld(&bar[XB_TMO])) break; if (sp > XB_SPIN_CAP) { atomicAdd(&bar[XB_TMO], 1u); break; } }
    }
    nloc = mine > 0u ? mine : 1u; nx = cnt > 0u ? cnt : 1u;
}

__device__ __forceinline__ void xcd_barrier(const XcdBarrier& b) {
    asm volatile("s_waitcnt vmcnt(0)" ::: "memory");
    __syncthreads();
    if (threadIdx.x == 0) {
        unsigned* bar = b.bar; asm volatile("" : "+s"(bar));
        const unsigned bx_ = xb_xcc_id();
        __builtin_amdgcn_s_waitcnt(0);
        unsigned nloc = b.st[0], nx = b.st[1];
        if (nloc == 0u) { xcd_barrier_complete(bar, bx_, nloc, nx); b.st[0] = nloc; b.st[1] = nx; }
        const unsigned old = xb_add(&bar[XB_XSUB(bx_)], 1u);
        const unsigned gen = old / nloc;
        if (old + 1u == (gen + 1u) * nloc) {
            __builtin_amdgcn_fence(__ATOMIC_RELEASE, "agent");
            asm volatile("s_waitcnt vmcnt(0)" ::: "memory");
            const unsigned og = xb_add(&bar[XB_TOP], 1u);
            const unsigned tg = og / nx;
            if (og + 1u == (tg + 1u) * nx) xb_add(&bar[XB_TOPGEN], 1u);
            else XB_SPIN(xb_ld(&bar[XB_TOPGEN]) == tg, bar);
            __builtin_amdgcn_fence(__ATOMIC_ACQUIRE, "agent");
            xb_add(&bar[XB_XGEN(bx_)], 1u);
            asm volatile("s_waitcnt vmcnt(0)" ::: "memory");
        } else {
            XB_SPIN(xb_ld(&bar[XB_XGEN(bx_)]) == gen, bar);
            __builtin_amdgcn_fence(__ATOMIC_ACQUIRE, "agent");
            asm volatile("s_waitcnt vmcnt(0)" ::: "memory");
        }
    }
    __syncthreads();
}

template <int SUB>
__device__ __forceinline__ void run_sub(const Params& p, int l, float* sm) {
  const int bid0_ = bidx();
  asm volatile("" : "+s"(l));
  if (SUB == 0) ph_norm(p, l, 0, sm);
  else if (SUB == 1) ph_inproj(p, l, sm);
  else if (SUB == 2) ph_prep(p, l, sm);
  else if (SUB == 3) { ph_scan(p, sm); ph_scan_lru(p, sm); for (int it = bid0_ + 48; it < 176; it += gridDim.x) moba_gate_item(p, l, it - 48, sm); }
  else if (SUB == 4) ph_mix(p, l, sm);
  else if (SUB == 5) ph_fin(p, l);
  else if (SUB == 6) ph_outproj(p, l, sm);
  else if (SUB == 7) ph_norm2(p, l, sm);
  else if (SUB == 8) ph_gather(p, l, sm);
  else if (SUB == 9) ph_up(p, l, sm);
  else if (SUB == 10) ph_down(p, l, sm);
  else if (SUB == 11) ph_combine(p, l, sm);
}

#if MK_SINGLE
__global__ void __launch_bounds__(NT, 2) mega(Params p) {
  extern __shared__ __attribute__((aligned(16))) unsigned char lds_raw[];
  float* sm = (float*)lds_raw;
  cg::grid_group grid = cg::this_grid();
  unsigned* barw = (unsigned*)(p.ws + WS_BAR);
  volatile LAS unsigned* bst = (volatile LAS unsigned*)((LAS unsigned char*)lds_raw + (LDS_BYTES - 64));
  if (threadIdx.x < 2) bst[threadIdx.x] = 0u;
  if (blockIdx.x == 0) for (int i = threadIdx.x; i < XCD_BAR_WORDS; i += NT) barw[i] = 0u;
  ph_mod(p, sm);
  ph_convert(p, sm);
  grid.sync();
  const XcdBarrier gb = xcd_barrier_post(barw, bst);
#define GSYNC() xcd_barrier(gb)
  run_sub<0>(p, 0, sm); GSYNC();
#pragma unroll 1
  for (int l = 0; l < 2; ++l) {
    run_sub<1>(p, l, sm); GSYNC();
    run_sub<2>(p, l, sm); GSYNC();
    run_sub<3>(p, l, sm); GSYNC();
    run_sub<4>(p, l, sm); GSYNC();
    run_sub<5>(p, l, sm); GSYNC();
    run_sub<6>(p, l, sm); GSYNC();
    run_sub<7>(p, l, sm); GSYNC();
    run_sub<9>(p, l, sm);
    run_sub<10>(p, l, sm); GSYNC();
    run_sub<11>(p, l, sm);
    if (l == 0) GSYNC();
  }
#undef GSYNC
}
#else
template <int SUB>
__global__ void __launch_bounds__(NT, 2) phk(Params p, int l) {
  extern __shared__ __attribute__((aligned(16))) unsigned char lds_raw[];
  float* sm = (float*)lds_raw;
  if (SUB < 0) { ph_mod(p, sm); ph_convert(p, sm); }
  else run_sub<(SUB < 0 ? 0 : SUB)>(p, l, sm);
}
template <int SUB> static void launch_ph(const Params& p, int l, hipStream_t stream) {
  static bool attr = false;
  if (!attr) { (void)hipFuncSetAttribute((const void*)phk<SUB>, hipFuncAttributeMaxDynamicSharedMemorySize, LDS_BYTES); attr = true; }
  hipLaunchKernelGGL(phk<SUB>, dim3(256), dim3(NT), LDS_BYTES, stream, p, l);
}
#endif

extern "C" void kernel_launch(void* const* d_in, const int* in_sizes, int n_in, void* d_out, int out_size, void* d_ws, size_t ws_size,
                              hipStream_t stream) {
  Params p{};
  for (int i = 0; i < 33; ++i) p.in[i] = (const float*)d_in[i];
  p.out = (float*)d_out;
  p.ws = (char*)d_ws;
#if MK_SINGLE
  static int grid_blocks = 0;
  if (!grid_blocks) {
    int dev = 0, cus = 0, per_cu = 0;
    (void)hipGetDevice(&dev);
    (void)hipDeviceGetAttribute(&cus, hipDeviceAttributeMultiprocessorCount, dev);
    (void)hipFuncSetAttribute((const void*)mega, hipFuncAttributeMaxDynamicSharedMemorySize, LDS_BYTES);
    (void)hipOccupancyMaxActiveBlocksPerMultiprocessor(&per_cu, mega, NT, LDS_BYTES);
    if (per_cu < 1) per_cu = 1;
    if (per_cu > 1) per_cu = 1;
    grid_blocks = cus * per_cu;
  }
  void* args[] = {&p};
  hipError_t e = hipLaunchCooperativeKernel((void*)mega, dim3(grid_blocks), dim3(NT), args, LDS_BYTES, stream);
  if (e != hipSuccess) fprintf(stderr, "cooperative launch failed: %s (grid %d)\n", hipGetErrorString(e), grid_blocks);
#else
  launch_ph<-1>(p, 0, stream);
  for (int l = 0; l < 2; ++l) {
    if (l == 0) launch_ph<0>(p, l, stream);
    launch_ph<1>(p, l, stream); launch_ph<2>(p, l, stream); launch_ph<3>(p, l, stream);
    launch_ph<4>(p, l, stream); launch_ph<5>(p, l, stream); launch_ph<6>(p, l, stream); launch_ph<7>(p, l, stream);
    launch_ph<9>(p, l, stream); launch_ph<10>(p, l, stream); launch_ph<11>(p, l, stream);
  }
#endif
}
```

```cpp
#include <hip/hip_runtime.h>
#include <hip/hip_cooperative_groups.h>
#include <cstdio>
#include <cstdint>
namespace cg = cooperative_groups;

#ifndef MK_SINGLE
#define MK_SINGLE 1
#endif
#ifndef PROBE
#define PROBE 0
#endif

constexpr int S = 16384, D = 1024, DIN = 2832, NE = 32;
constexpr int NT = 512;
constexpr size_t MiB = 1u << 20;
constexpr size_t WS_MOD = 0;
constexpr size_t WS_CNT = 64 * 1024;
constexpr size_t WS_TEXP = 128 * 1024;
constexpr size_t WS_KMP = 1 * MiB;
constexpr size_t WS_BAR = 256 * 1024;
constexpr size_t WS_SROW = 320 * 1024;
constexpr size_t WS_RDY = 216 * 1024;
constexpr size_t WS_ZERO = 224 * 1024;
constexpr size_t WS_LCNT = 192 * 1024;
constexpr size_t WS_EIDX = 2 * MiB;
constexpr size_t WS_RPOS = 2 * MiB + 512 * 1024;
constexpr size_t WS_GATE = 3 * MiB;
constexpr size_t WS_H = 8 * MiB;
constexpr size_t WS_VBT = 40 * MiB;
constexpr size_t WS_ELIST = 66 * MiB;
constexpr size_t WS_MLIST = 48 * MiB;
constexpr size_t WS_ML = 64 * MiB;
constexpr size_t WS_PROJ = 72 * MiB;
constexpr size_t WS_Y = 250 * MiB;
constexpr size_t WS_X1 = 314 * MiB;
constexpr size_t WS_XA = 378 * MiB;
constexpr size_t WS_QA = 442 * MiB;
constexpr size_t WS_KA = 458 * MiB;
constexpr size_t WS_QB = 474 * MiB;
constexpr size_t WS_KB = 490 * MiB;
constexpr size_t WS_QBB = 498 * MiB;
constexpr size_t WS_GA = 506 * MiB;
constexpr size_t WS_LA = 514 * MiB;
constexpr size_t WS_LB = 530 * MiB;
constexpr size_t WS_OA = 546 * MiB;
constexpr size_t WS_VA = 562 * MiB;
constexpr size_t WS_SC = 578 * MiB;
constexpr size_t WS_DEC = 586 * MiB;
constexpr size_t WS_LTA = 587 * MiB;
constexpr size_t WS_LTH = 588 * MiB;
constexpr size_t WS_LC = 589 * MiB;
constexpr int MOE_ROWS = 73728;
constexpr size_t WS_ST = 1490 * MiB;
constexpr size_t WS_PART = 1426 * MiB;
constexpr size_t WS_VB = 594 * MiB;
constexpr size_t WS_XS = 602 * MiB;
constexpr size_t WS_ACT = 738 * MiB;
constexpr size_t WS_YS = 882 * MiB;
constexpr size_t WS_WIN = 1026 * MiB;
constexpr size_t WS_WOUT = 1038 * MiB;
constexpr size_t WS_WUP = 1042 * MiB;
constexpr size_t WS_WDN = 1298 * MiB;
constexpr int LDS_BYTES = 147456;

struct Params {
  const float* in[33];
  float* out;
  char* ws;
};

constexpr int PDIN = 1296;
constexpr int PC_CQ = 0, PC_CK = 128, PC_CV = 256, PC_CG = 512, PC_CR = 528, PC_DX = 784, PC_DG = 1040;

__device__ __forceinline__ int bidx() { int b = blockIdx.x; asm volatile("" : "+s"(b)); return b; }
__device__ __forceinline__ int tidx() { int t = threadIdx.x; asm volatile("" : "+v"(t)); return t; }
__device__ __forceinline__ float wave_sum(float v) {
#pragma unroll
  for (int o = 1; o < 64; o <<= 1) v += __shfl_xor(v, o);
  return v;
}
__device__ __forceinline__ float sigmoidf_(float x) { return __builtin_amdgcn_rcpf(1.f + __builtin_amdgcn_exp2f(-1.4426950408889634f * x)); }
__device__ __forceinline__ float logsigmoidf_(float z) { return fminf(z, 0.f) - log1pf(__expf(-fabsf(z))); }
__device__ __forceinline__ float gelu_tanh(float x) {
  float u = 0.7978845608028654f * (x + 0.044715f * x * x * x);
  float t = 1.f - 2.f * __builtin_amdgcn_rcpf(__expf(2.f * u) + 1.f);
  return 0.5f * x * (1.f + t);
}
__device__ __forceinline__ float lam_init_of(int l) { return l == 0 ? 0.2f : (0.8f - 0.6f * 0.7408182206817179f); }
__device__ __forceinline__ float lam_of(const Params& p, int l) {
  float s1 = 0.f, s2 = 0.f;
  for (int i = 0; i < 32; ++i) {
    s1 += p.in[10][l * 32 + i] * p.in[11][l * 32 + i];
    s2 += p.in[12][l * 32 + i] * p.in[13][l * 32 + i];
  }
  return __expf(s1) - __expf(s2) + lam_init_of(l);
}

typedef unsigned short bf16raw;
__device__ __forceinline__ unsigned f2bf(float f) { unsigned u = __builtin_bit_cast(unsigned, f); return (u + 0x7fffu + ((u >> 16) & 1u)) >> 16; }
typedef float f32x2v_ __attribute__((ext_vector_type(2))); typedef __bf16 bf16x2v_ __attribute__((ext_vector_type(2)));
__device__ __forceinline__ unsigned pk2(float lo, float hi) { f32x2v_ v = {lo, hi}; bf16x2v_ b = __builtin_convertvector(v, bf16x2v_); return __builtin_bit_cast(unsigned, b); }
__device__ __forceinline__ float4 ld4bf(const unsigned short* p) { const uint2 u = *(const uint2*)p; return make_float4(__builtin_bit_cast(float, u.x << 16), __builtin_bit_cast(float, u.x & 0xffff0000u), __builtin_bit_cast(float, u.y << 16), __builtin_bit_cast(float, u.y & 0xffff0000u)); }
__device__ __forceinline__ float bf2f(unsigned short h) { return __builtin_bit_cast(float, (unsigned)h << 16); }

namespace pg8 {
#define PG8_LAS __attribute__((address_space(3)))
typedef unsigned short bf16_t;
typedef short bf16x8 __attribute__((ext_vector_type(8)));
typedef float f32x4 __attribute__((ext_vector_type(4)));
typedef unsigned u32x4 __attribute__((ext_vector_type(4)));
constexpr int BM = 256, BK = 64, HALF = 128, HTB = HALF * BK * 2  , STAGE_BYTES = 8 * HTB, NXCD = 8, WGM = 8;

__host__ __device__ __forceinline__ int lds_byte(int r, int c) { const int st = (r >> 4) * 2 + (c >> 5), rr = r & 15, cc = c & 31, ob = rr * 64 + cc * 2; return st * 1024 + (ob ^ (((ob >> 9) & 1) << 5)); }
__host__ __device__ __forceinline__ void stage_rc(int b, int& R, int& C) {
  const int bid0_ = bidx(); const int st = b / 1024, sb = b % 1024, swz = sb ^ (((sb >> 9) & 1) << 5); R = (st >> 1) * 16 + swz / 64; C = (st & 1) * 32 + (swz % 64) / 2; }
__host__ __device__ __forceinline__ int perm32(int rho) { const int n = rho >> 4, i = rho & 15; return 8 * (i >> 2) + 4 * n + (i & 3); }

struct Unit { int pm, pn; };
struct Gemm { const bf16_t* A; const bf16_t* Bt; int M, N, K; };

struct StaticOrder {
    int nM, nN, nwg, G, c;
    __host__ __device__ void init(int M, int N, int G_, int c_) { nM = M / BM; nN = N / BM; nwg = nM * nN; G = G_; c = c_; }
    __host__ __device__ bool next(int i, Unit& u) const {
        const long L = (long)i * G + c; if (L >= nwg) return false;
        int wgid = (int)L; { const int q = nwg / NXCD, r = nwg % NXCD, xcd = wgid % NXCD, off = wgid / NXCD; wgid = (xcd < r ? xcd * (q + 1) : r * (q + 1) + (xcd - r) * q) + off; }
        const int nig = WGM * nN, gid = wgid / nig, fm = gid * WGM, gsz = (nM - fm) < WGM ? (nM - fm) : WGM;
        u.pm = fm + ((wgid % nig) % gsz); u.pn = (wgid % nig) / gsz; return true;
    }
    __device__ __forceinline__ void a_ready(const Unit&) const {}
    __device__ __forceinline__ void done(const Unit&) const {}
};

__device__ __forceinline__ unsigned cvt_pk_bf16(float lo, float hi) { unsigned r; asm volatile("v_cvt_pk_bf16_f32 %0, %1, %2" : "=v"(r) : "v"(lo), "v"(hi)); return r; }
typedef float f32x2 __attribute__((ext_vector_type(2)));
template <class Epi, class Sched, bool ALIGN_EPI = false, bool SP2 = false, bool GATHER = false>
__device__ __forceinline__ void gemm_phase(PG8_LAS unsigned char* lds, const Gemm g, const Sched& S, const Epi& E, const unsigned* rowoff = nullptr) {
    static_assert(!GATHER || SP2, "row gather is wired into the SP2 loop only");
    const int tid = tidx(), wid = __builtin_amdgcn_readfirstlane(tid >> 6), lane = tid & 63, wr = wid >> 2, wc = wid & 3, fr = lane & 15, fq = lane >> 4;
    const int K = g.K, nt = K / BK;
    unsigned voffA[2], voffB[2]; int RA[2], CA[2];
#pragma unroll
    for (int i = 0; i < 2; ++i) { int R, C; stage_rc(tid * 16 + i * 8192, R, C); const int Rb = Epi::PERM ? ((R & ~31) + perm32(R & 31)) : R;
        voffA[i] = (unsigned)(R * K + C) * 2u; voffB[i] = (unsigned)(Rb * K + C) * 2u; RA[i] = R; CA[i] = C; }
    const size_t kstep = (size_t)(BK * 2);
    const size_t hstep = (size_t)HALF * K * 2;
    const size_t tstep = 2 * hstep;
    const unsigned ldsw = (unsigned)wid * 1024u;
    const int aoff = lds_byte(wr * 64 + fr, fq * 8), boff = lds_byte(wc * 32 + fr, fq * 8);
#define PG8_SA(b, h) (((b) * 2 + (h)) * HTB)
#define PG8_SB(b, h) ((4 + (b) * 2 + (h)) * HTB)
#define PG8_STAGE(bufoff, gbase, voff) do { _Pragma("unroll") for (int _i = 0; _i < 2; ++_i) \
        __builtin_amdgcn_global_load_lds((const unsigned*)((const char*)(gbase) + (voff)[_i]), (PG8_LAS unsigned*)(lds + (bufoff) + ldsw + _i * 8192), 16, 0, 0); } while (0)
#define PG8_STAGE2(bufoff, gbase, o0, o1) do { \
        __builtin_amdgcn_global_load_lds((const unsigned*)((const char*)(gbase) + (o0)), (PG8_LAS unsigned*)(lds + (bufoff) + ldsw), 16, 0, 0); \
        __builtin_amdgcn_global_load_lds((const unsigned*)((const char*)(gbase) + (o1)), (PG8_LAS unsigned*)(lds + (bufoff) + ldsw + 8192), 16, 0, 0); } while (0)
#define PG8_GOFF(dst, pm_) do { _Pragma("unroll") for (int _h = 0; _h < 2; ++_h) _Pragma("unroll") for (int _i = 0; _i < 2; ++_i) \
        dst[_h][_i] = rowoff[(pm_) * BM + _h * HALF + RA[_i]] + (unsigned)CA[_i] * 2u; } while (0)
#define PG8_LDA(dst, b, h) do { _Pragma("unroll") for (int m = 0; m < 4; ++m) _Pragma("unroll") for (int k = 0; k < 2; ++k) dst[m][k] = *(const PG8_LAS bf16x8*)(lds + PG8_SA(b, h) + aoff + m * 2048 + k * 1024); } while (0)
#define PG8_LDB(dst, b, h) do { _Pragma("unroll") for (int n = 0; n < 2; ++n) _Pragma("unroll") for (int k = 0; k < 2; ++k) dst[n][k] = *(const PG8_LAS bf16x8*)(lds + PG8_SB(b, h) + boff + n * 2048 + k * 1024); } while (0)
#define PG8_MMA(ai, bj, At, Bt) do { __builtin_amdgcn_s_setprio(1); _Pragma("unroll") for (int m = 0; m < 4; ++m) _Pragma("unroll") for (int n = 0; n < 2; ++n) _Pragma("unroll") for (int k = 0; k < 2; ++k) \
        acc[ai][bj][m][n] = __builtin_amdgcn_mfma_f32_16x16x32_bf16(Bt[n][k], At[m][k], acc[ai][bj][m][n], 0, 0, 0); __builtin_amdgcn_s_setprio(0); } while (0)
#define PG8_WAIT_V(n) asm volatile("s_waitcnt vmcnt(" #n ")" ::: "memory")
#define PG8_WAIT_L(n) asm volatile("s_waitcnt lgkmcnt(" #n ")" ::: "memory")
#define PG8_BAR __builtin_amdgcn_s_barrier()
#define PG8_SCHED __builtin_amdgcn_sched_barrier(0)
    Unit cur, nxt; int ui = 0;
    if (!S.next(0, cur)) return;
    f32x4 acc[2][2][4][2];
#pragma unroll
    for (int a = 0; a < 2; ++a)
#pragma unroll
        for (int b = 0; b < 2; ++b)
#pragma unroll
            for (int m = 0; m < 4; ++m)
#pragma unroll
                for (int n = 0; n < 2; ++n) acc[a][b][m][n] = (f32x4){0.f, 0.f, 0.f, 0.f};
    bf16x8 At[4][2], B0[2][2], B1[2][2];
    const char* cA = GATHER ? (const char*)g.A : (const char*)g.A + (size_t)cur.pm * tstep; const char* cB = (const char*)g.Bt + (size_t)cur.pn * tstep;
    unsigned vA[2][2], vN[2][2];
    if constexpr (GATHER) { PG8_GOFF(vA, 0); _Pragma("unroll") for (int _h = 0; _h < 2; ++_h) _Pragma("unroll") for (int _i = 0; _i < 2; ++_i) vN[_h][_i] = vA[_h][_i]; }
#define PG8_STA(bufoff, ptr, h, nx) do { if constexpr (GATHER) { PG8_STAGE2(bufoff, ptr, (nx) ? vN[h][0] : vA[h][0], (nx) ? vN[h][1] : vA[h][1]); } else { PG8_STAGE(bufoff, (ptr) + (h) * hstep, voffA); } } while (0)
    S.a_ready(cur);
    if constexpr (SP2) {
        PG8_STAGE(PG8_SB(0, 0), cB, voffB); PG8_STAGE(PG8_SB(0, 1), cB + hstep, voffB); PG8_STA(PG8_SA(0, 0), cA, 0, false); PG8_STA(PG8_SA(0, 1), cA, 1, false);
        if (wr == 1) PG8_BAR;
        PG8_WAIT_V(2); PG8_BAR;
        PG8_STAGE(PG8_SB(1, 0), cB + kstep, voffB); PG8_STA(PG8_SA(1, 0), cA + kstep, 0, false); PG8_STAGE(PG8_SB(1, 1), cB + hstep + kstep, voffB);
        PG8_WAIT_V(6); PG8_BAR;
    } else {
        PG8_STAGE(PG8_SB(0, 0), cB, voffB); PG8_STAGE(PG8_SA(0, 0), cA, voffA); PG8_STAGE(PG8_SB(0, 1), cB + hstep, voffB); PG8_STAGE(PG8_SA(0, 1), cA + hstep, voffA);
        if (wr == 1) PG8_BAR;
        PG8_WAIT_V(4); PG8_BAR;
        PG8_STAGE(PG8_SB(1, 0), cB + kstep, voffB); PG8_STA(PG8_SA(1, 0), cA + kstep, 0, false); PG8_STAGE(PG8_SB(1, 1), cB + hstep + kstep, voffB);
        PG8_WAIT_V(6); PG8_BAR;
    }
    for (;;) {
        const bool has_next = S.next(ui + 1, nxt);
        const char* nA = GATHER ? cA : (has_next ? (const char*)g.A + (size_t)nxt.pm * tstep : cA); const char* nB = has_next ? (const char*)g.Bt + (size_t)nxt.pn * tstep : cB;
        if constexpr (GATHER) { if (has_next) { PG8_GOFF(vN, ui + 1); } }
        for (int t = 0; t < nt; t += 2) {
            const bool last = (t == nt - 2);
            const char* a1 = cA + (size_t)(t + 1) * kstep;
            const char* a2 = last ? nA : cA + (size_t)(t + 2) * kstep; const bool nx_ = GATHER && last; const char* b2 = last ? nB : cB + (size_t)(t + 2) * kstep;
            const char* a3 = a2 + kstep; const char* b3 = b2 + kstep;
            if (last && has_next) S.a_ready(nxt);
            if constexpr (SP2) {
            PG8_LDB(B0, 0, 0); PG8_LDB(B1, 0, 1); PG8_SCHED; PG8_LDA(At, 0, 0); PG8_STA(PG8_SA(1, 1), a1, 1, false);
            PG8_WAIT_V(8); PG8_WAIT_L(0); PG8_BAR; PG8_MMA(0, 0, At, B0); PG8_MMA(0, 1, At, B1); PG8_BAR; PG8_SCHED;
            PG8_LDA(At, 0, 1); PG8_STAGE(PG8_SB(0, 0), b2, voffB); PG8_STAGE(PG8_SB(0, 1), b2 + hstep, voffB); PG8_STA(PG8_SA(0, 0), a2, 0, nx_);
            PG8_WAIT_V(8); PG8_WAIT_L(0); PG8_BAR; PG8_MMA(1, 0, At, B0); PG8_MMA(1, 1, At, B1); PG8_BAR; PG8_SCHED;
            PG8_LDB(B0, 1, 0); PG8_LDB(B1, 1, 1); PG8_SCHED; PG8_LDA(At, 1, 0); PG8_STA(PG8_SA(0, 1), a2, 1, nx_);
            PG8_WAIT_V(8); PG8_WAIT_L(0); PG8_BAR; PG8_MMA(0, 0, At, B0); PG8_MMA(0, 1, At, B1); PG8_BAR; PG8_SCHED;
            PG8_LDA(At, 1, 1); PG8_STAGE(PG8_SB(1, 0), b3, voffB); PG8_STAGE(PG8_SB(1, 1), b3 + hstep, voffB); PG8_STA(PG8_SA(1, 0), a3, 0, nx_);
            PG8_WAIT_V(8); PG8_WAIT_L(0); PG8_BAR; PG8_MMA(1, 0, At, B0); PG8_MMA(1, 1, At, B1); PG8_BAR; PG8_SCHED;
            } else {
            PG8_LDB(B0, 0, 0); PG8_SCHED; PG8_LDA(At, 0, 0); PG8_STA(PG8_SA(1, 1), a1, 1, false);
            PG8_WAIT_L(8); PG8_BAR; PG8_WAIT_L(0); PG8_MMA(0, 0, At, B0); PG8_BAR; PG8_SCHED;
            PG8_LDB(B1, 0, 1); PG8_STAGE(PG8_SB(0, 0), b2, voffB);
            PG8_BAR; PG8_WAIT_L(0); PG8_MMA(0, 1, At, B1); PG8_BAR;
            PG8_LDA(At, 0, 1); PG8_STA(PG8_SA(0, 0), a2, 0, nx_);
            PG8_BAR; PG8_WAIT_L(0); PG8_MMA(1, 0, At, B0); PG8_BAR; PG8_SCHED;
            PG8_STAGE(PG8_SB(0, 1), b2 + hstep, voffB);
            PG8_WAIT_V(6); PG8_BAR; PG8_MMA(1, 1, At, B1); PG8_BAR;
            PG8_LDB(B0, 1, 0); PG8_SCHED; PG8_LDA(At, 1, 0); PG8_STA(PG8_SA(0, 1), a2, 1, nx_);
            PG8_WAIT_L(8); PG8_BAR; PG8_WAIT_L(0); PG8_MMA(0, 0, At, B0); PG8_BAR; PG8_SCHED;
            PG8_LDB(B1, 1, 1); PG8_STAGE(PG8_SB(1, 0), b3, voffB);
            PG8_BAR; PG8_WAIT_L(0); PG8_MMA(0, 1, At, B1); PG8_BAR;
            PG8_LDA(At, 1, 1); PG8_STA(PG8_SA(1, 0), a3, 0, nx_);
            PG8_BAR; PG8_WAIT_L(0); PG8_MMA(1, 0, At, B0); PG8_BAR; PG8_SCHED;
            PG8_STAGE(PG8_SB(1, 1), b3 + hstep, voffB);
            PG8_WAIT_V(6); PG8_BAR; PG8_MMA(1, 1, At, B1); PG8_BAR;
            }
        }
        if constexpr (ALIGN_EPI) { if (wr == 0) PG8_BAR; }
        if constexpr (!Epi::AFTER_DRAIN) { E(acc, cur, wr, wc, fr, fq); S.done(cur); }
        if (!has_next) break;
#pragma unroll
        for (int a = 0; a < 2; ++a)
#pragma unroll
            for (int b = 0; b < 2; ++b)
#pragma unroll
                for (int m = 0; m < 4; ++m)
#pragma unroll
                    for (int n = 0; n < 2; ++n) acc[a][b][m][n] = (f32x4){0.f, 0.f, 0.f, 0.f};
        cur = nxt; cA = nA; cB = nB; ++ui;
        if constexpr (GATHER) { _Pragma("unroll") for (int _h = 0; _h < 2; ++_h) _Pragma("unroll") for (int _i = 0; _i < 2; ++_i) vA[_h][_i] = vN[_h][_i]; }
        if constexpr (ALIGN_EPI) { if (wr == 1) PG8_BAR; }
    }
    PG8_WAIT_V(0);
    if constexpr (!ALIGN_EPI) { if (wr == 0) PG8_BAR; }
    PG8_BAR;
    if constexpr (Epi::AFTER_DRAIN) { E.fused(acc, cur, wr, wc, fr, fq, lds, wid, lane); S.done(cur); }
#undef PG8_SA
#undef PG8_SB
#undef PG8_STAGE
#undef PG8_STAGE2
#undef PG8_GOFF
#undef PG8_STA
#undef PG8_LDA
#undef PG8_LDB
#undef PG8_MMA
#undef PG8_WAIT_V
#undef PG8_WAIT_L
#undef PG8_BAR
#undef PG8_SCHED
}
}

namespace pg8 {
struct EpiInproj {
  static constexpr bool PERM = true, AFTER_DRAIN = false;
  bf16_t* QAb; bf16_t* KAb; bf16_t* VAb;
  float* QB; bf16_t* QBb; bf16_t* KBb; bf16_t* VB; float* KMP;
  bf16_t* P2;
  const float* aqg; const float* akg; const float* bqg; const float* bkg; float c2;
  __device__ __forceinline__ static u32x4 pk8(const f32x4& a, const f32x4& b) { u32x4 w; w.x = cvt_pk_bf16(a[0], a[1]); w.y = cvt_pk_bf16(a[2], a[3]); w.z = cvt_pk_bf16(b[0], b[1]); w.w = cvt_pk_bf16(b[2], b[3]); return w; }
  __device__ __forceinline__ void operator()(const f32x4 (&acc)[2][2][4][2], const Unit& u, int wr, int wc, int fr, int fq) const {
    const int row0 = u.pm * BM + wr * 64 + fr, t = u.pn;
    if (t >= 6) {
      const int col0 = (t - 6) * BM + wc * 32 + 8 * fq;
#pragma unroll
      for (int ai = 0; ai < 2; ++ai)
#pragma unroll
        for (int m = 0; m < 4; ++m) {
          bf16_t* rp = P2 + (size_t)(row0 + ai * HALF + m * 16) * 1296;
#pragma unroll
          for (int bj = 0; bj < 2; ++bj) { const int col = col0 + bj * HALF; if (col < 1296) *(u32x4*)(rp + col) = pk8(acc[ai][bj][m][0], acc[ai][bj][m][1]); }
        }
    } else if (t <= 1) {
      const float* gp = (t == 0 ? aqg : akg) + 8 * fq;
      const f32x4 g0 = *(const f32x4*)gp, g1 = *(const f32x4*)(gp + 4);
      bf16_t* dst = t == 0 ? QAb : KAb;
      const float sc = t == 0 ? c2 : 1.f;
#pragma unroll
      for (int ai = 0; ai < 2; ++ai)
#pragma unroll
        for (int m = 0; m < 4; ++m)
#pragma unroll
          for (int bj = 0; bj < 2; ++bj) {
            const f32x4 v0 = acc[ai][bj][m][0], v1 = acc[ai][bj][m][1];
            float ss = (v0[0] * v0[0] + v0[1] * v0[1]) + (v0[2] * v0[2] + v0[3] * v0[3]) + (v1[0] * v1[0] + v1[1] * v1[1]) + (v1[2] * v1[2] + v1[3] * v1[3]);
            ss += __shfl_xor(ss, 16); ss += __shfl_xor(ss, 32);
            const float r = rsqrtf(ss * (1.f / 32.f) + 1e-6f) * sc;
            bf16_t* o = dst + (size_t)(row0 + ai * HALF + m * 16) * 512 + (bj * 4 + wc) * 64 + 8 * fq;
            *(u32x4*)o = pk8(v0 * g0 * r, v1 * g1 * r);
          }
    } else if (t == 2) {
#pragma unroll
      for (int ai = 0; ai < 2; ++ai)
#pragma unroll
        for (int m = 0; m < 4; ++m)
#pragma unroll
          for (int bj = 0; bj < 2; ++bj) {
            const u32x4 w = pk8(acc[ai][bj][m][0], acc[ai][bj][m][1]);
            *(u32x4*)(VAb + (size_t)(row0 + ai * HALF + m * 16) * 256 + bj * HALF + wc * 32 + 8 * fq) = w;
          }
    } else if (t == 5) {
#pragma unroll
      for (int ai = 0; ai < 2; ++ai)
#pragma unroll
        for (int m = 0; m < 4; ++m)
#pragma unroll
          for (int bj = 0; bj < 2; ++bj)
            *(u32x4*)(VB + (size_t)(row0 + ai * HALF + m * 16) * 256 + bj * HALF + wc * 32 + 8 * fq) = pk8(acc[ai][bj][m][0], acc[ai][bj][m][1]);
    } else {
      const float* gp = (t == 3 ? bqg : bkg) + 8 * fq;
      f32x4 g[2][2];
#pragma unroll
      for (int bj = 0; bj < 2; ++bj) { g[bj][0] = *(const f32x4*)(gp + 32 * bj); g[bj][1] = *(const f32x4*)(gp + 32 * bj + 4); }
#pragma unroll
      for (int ai = 0; ai < 2; ++ai) {
        f32x4 cs[2][2];
#pragma unroll
        for (int bj = 0; bj < 2; ++bj) { cs[bj][0] = (f32x4){0.f, 0.f, 0.f, 0.f}; cs[bj][1] = (f32x4){0.f, 0.f, 0.f, 0.f}; }
#pragma unroll
        for (int m = 0; m < 4; ++m) {
          float ss = 0.f;
#pragma unroll
          for (int bj = 0; bj < 2; ++bj)
#pragma unroll
            for (int n = 0; n < 2; ++n) { const f32x4 v = acc[ai][bj][m][n]; ss += (v[0] * v[0] + v[1] * v[1]) + (v[2] * v[2] + v[3] * v[3]); }
          ss += __shfl_xor(ss, 16); ss += __shfl_xor(ss, 32);
          const float r = rsqrtf(ss * (1.f / 64.f) + 1e-6f);
          const size_t ro = (size_t)(row0 + ai * HALF + m * 16) * 256 + wc * 64 + 8 * fq;
#pragma unroll
          for (int bj = 0; bj < 2; ++bj) {
            const f32x4 n0 = acc[ai][bj][m][0] * g[bj][0] * r, n1 = acc[ai][bj][m][1] * g[bj][1] * r;
            if (t == 3) {
              *(f32x4*)(QB + ro + 32 * bj) = n0; *(f32x4*)(QB + ro + 32 * bj + 4) = n1;
              const float qs = 0.125f * 1.4426950408889634f;
              *(u32x4*)(QBb + ro + 32 * bj) = pk8(n0 * qs, n1 * qs);
            } else {
              *(u32x4*)(KBb + ro + 32 * bj) = pk8(n0, n1);
              cs[bj][0] += n0; cs[bj][1] += n1;
            }
          }
        }
        if (t == 4) {
#pragma unroll
          for (int bj = 0; bj < 2; ++bj)
#pragma unroll
            for (int n = 0; n < 2; ++n)
#pragma unroll
              for (int j = 0; j < 4; ++j) { float v = cs[bj][n][j]; v += __shfl_xor(v, 1); v += __shfl_xor(v, 2); v += __shfl_xor(v, 4); v += __shfl_xor(v, 8); cs[bj][n][j] = v; }
          if (fr == 0) {
            float* kp = KMP + (size_t)(u.pm * 4 + ai * 2 + wr) * 256 + wc * 64 + 8 * fq;
#pragma unroll
            for (int bj = 0; bj < 2; ++bj) { *(f32x4*)(kp + 32 * bj) = cs[bj][0]; *(f32x4*)(kp + 32 * bj + 4) = cs[bj][1]; }
          }
        }
      }
    }
  }
};
struct EpiOutproj {
  static constexpr bool PERM = true, AFTER_DRAIN = false;
  const float* xin32; const bf16_t* xin16; const float* g1; bf16_t* X1;
  __device__ __forceinline__ void operator()(const f32x4 (&acc)[2][2][4][2], const Unit& u, int wr, int wc, int fr, int fq) const {
    const int row0 = u.pm * BM + wr * 64 + fr, col0 = u.pn * BM + wc * 32 + 8 * fq;
#pragma unroll
    for (int bj = 0; bj < 2; ++bj) {
      const int col = col0 + bj * HALF;
      const f32x4 g0 = *(const f32x4*)(g1 + col), g1v = *(const f32x4*)(g1 + col + 4);
#pragma unroll
      for (int ai = 0; ai < 2; ++ai)
#pragma unroll
        for (int m = 0; m < 4; ++m) {
          const size_t off = (size_t)(row0 + ai * HALF + m * 16) * 1024 + col;
          f32x4 x0, x1;
          if (xin32) { x0 = *(const f32x4*)(xin32 + off); x1 = *(const f32x4*)(xin32 + off + 4); }
          else {
            const u32x4 w = *(const u32x4*)(xin16 + off);
            x0 = (f32x4){__builtin_bit_cast(float, w.x << 16), __builtin_bit_cast(float, w.x & 0xffff0000u), __builtin_bit_cast(float, w.y << 16), __builtin_bit_cast(float, w.y & 0xffff0000u)};
            x1 = (f32x4){__builtin_bit_cast(float, w.z << 16), __builtin_bit_cast(float, w.z & 0xffff0000u), __builtin_bit_cast(float, w.w << 16), __builtin_bit_cast(float, w.w & 0xffff0000u)};
          }
          const f32x4 v0 = x0 + g0 * acc[ai][bj][m][0], v1 = x1 + g1v * acc[ai][bj][m][1];
          u32x4 o; o.x = cvt_pk_bf16(v0[0], v0[1]); o.y = cvt_pk_bf16(v0[2], v0[3]); o.z = cvt_pk_bf16(v1[0], v1[1]); o.w = cvt_pk_bf16(v1[2], v1[3]);
          *(u32x4*)(X1 + off) = o;
        }
    }
  }
};
struct EpiUp {
  static constexpr bool PERM = true, AFTER_DRAIN = false;
  __amdgpu_buffer_rsrc_t act;
  const float* bup;
  __device__ __forceinline__ void operator()(const f32x4 (&acc)[2][2][4][2], const Unit& u, int wr, int wc, int fr, int fq) const {
    const int e = u.pn >> 3, j = u.pn & 7;
    const int row0 = u.pm * BM + wr * 64 + fr, col0 = j * 128 + wc * 32 + 8 * fq;
    const float* bg = bup + (size_t)e * 2048 + col0; const float* bl = bg + 1024;
    f32x4 bgv[2], blv[2];
#pragma unroll
    for (int n = 0; n < 2; ++n) { bgv[n] = *(const f32x4*)(bg + 4 * n); blv[n] = *(const f32x4*)(bl + 4 * n); }
#pragma unroll
    for (int ai = 0; ai < 2; ++ai)
#pragma unroll
      for (int m = 0; m < 4; ++m) {
        float o[8];
#pragma unroll
        for (int n = 0; n < 2; ++n) {
          const f32x4 gg = acc[ai][0][m][n] + bgv[n], ll = acc[ai][1][m][n] + blv[n];
#pragma unroll
          for (int c = 0; c < 4; ++c) {
            float g = fminf(gg[c], 7.f), lin = fminf(fmaxf(ll[c], -7.f), 7.f);
            float glu = g * __builtin_amdgcn_rcpf(1.f + __builtin_amdgcn_exp2f(-1.702f * 1.4426950408889634f * g));
            o[n * 4 + c] = (lin + 1.f) * glu;
          }
        }
        u32x4 w; w.x = cvt_pk_bf16(o[0], o[1]); w.y = cvt_pk_bf16(o[2], o[3]); w.z = cvt_pk_bf16(o[4], o[5]); w.w = cvt_pk_bf16(o[6], o[7]);
        __builtin_amdgcn_raw_buffer_store_b128(w, act, (unsigned)(((row0 + ai * HALF + m * 16) * 1024 + col0) * 2), 0,   16);
      }
  }
};
struct EpiDown {
  static constexpr bool PERM = true, AFTER_DRAIN = false;
  bf16_t* YS; const float* bdn;
  __device__ __forceinline__ void operator()(const f32x4 (&acc)[2][2][4][2], const Unit& u, int wr, int wc, int fr, int fq) const {
    const int e = u.pn >> 2, j = u.pn & 3;
    const int row0 = u.pm * BM + wr * 64 + fr, col0 = j * 256 + wc * 32 + 8 * fq;
    f32x4 bv[2][2];
#pragma unroll
    for (int bj = 0; bj < 2; ++bj)
#pragma unroll
      for (int n = 0; n < 2; ++n) bv[bj][n] = *(const f32x4*)(bdn + (size_t)e * 1024 + col0 + bj * HALF + 4 * n);
#pragma unroll
    for (int ai = 0; ai < 2; ++ai)
#pragma unroll
      for (int m = 0; m < 4; ++m) {
        bf16_t* rp = YS + (size_t)(row0 + ai * HALF + m * 16) * 1024 + col0;
#pragma unroll
        for (int bj = 0; bj < 2; ++bj) {
          const f32x4 v0 = acc[ai][bj][m][0] + bv[bj][0], v1 = acc[ai][bj][m][1] + bv[bj][1];
          u32x4 w; w.x = cvt_pk_bf16(v0[0], v0[1]); w.y = cvt_pk_bf16(v0[2], v0[3]); w.z = cvt_pk_bf16(v1[0], v1[1]); w.w = cvt_pk_bf16(v1[2], v1[3]);
          *(u32x4*)(rp + bj * HALF) = w;
        }
      }
  }
};
#ifndef MOE_ORDER
#define MOE_ORDER 0
#endif
template <int NJ> __device__ __forceinline__ void moe_build_units(const int* cnt, int G, int c, int* tab, int tid, bool rotate = false) {
  if (tid < 24) {
    int pm = -1, pn = -1, ex = 0, r0 = 0;
    {
      int cc = c;
      if (rotate) {
        int T = 0; for (int e = 0; e < 32; ++e) T += (cnt[e] + 255) >> 8;
        int r8 = 8 * T; while (r8 >= G) r8 -= G;
        cc = c - r8; if (cc < 0) cc += G;
      }
      const long L = (long)tid * G + cc; const int t = (int)(L / NJ);
      int acc = 0;
      for (int e = 0; e < 32; ++e) {
        const int ne = (cnt[e] + 255) >> 8;
        if (pm < 0 && t < acc + ne) { pm = t; pn = e * NJ + (int)(L % NJ); ex = e; r0 = (t - acc) << 8; }
        acc += ne;
      }
    }
    tab[4 * tid] = pm; tab[4 * tid + 1] = pn; tab[4 * tid + 2] = ex; tab[4 * tid + 3] = r0;
  }
  __syncthreads();
}
__device__ __forceinline__ void moe_build_rowoff(const int* elist, const int* cnt, const int* tab, unsigned* rowoff, int tid) {
  for (int i = tid; i < 13 * 256; i += 512) {
    const int u = i >> 8, pm = tab[4 * u];
    unsigned v = 0u;
    if (pm >= 0) { const int e = tab[4 * u + 2], r = tab[4 * u + 3] + (i & 255); if (r < cnt[e]) v = (unsigned)elist[e * 16384 + r] * 2048u; }
    rowoff[i] = v;
  }
  __syncthreads();
}
template <int NJ, int MODE = 0> struct MoeOrder {
  const int* tab;
  unsigned* rdy;
  __device__ __forceinline__ bool next(int i, Unit& u) const {
    if (i >= 24) return false;
    const int pm = tab[4 * i]; if (pm < 0) return false;
    u.pm = pm; u.pn = tab[4 * i + 1]; return true;
  }
  __device__ __forceinline__ void a_ready(const Unit& u) const {
    if constexpr (MODE == 2) {
      if (threadIdx.x < 64) {
        unsigned polls = 0;
        while ((unsigned)__builtin_amdgcn_readfirstlane(__hip_atomic_load(rdy + u.pm, __ATOMIC_RELAXED, __HIP_MEMORY_SCOPE_AGENT)) < 64u) {
          if (++polls > (1u << 22)) break;
          __builtin_amdgcn_s_sleep(2);
        }
        __builtin_amdgcn_fence(__ATOMIC_ACQUIRE, "agent");
        asm volatile("s_waitcnt vmcnt(0)" ::: "memory");
      }
      asm volatile("" ::: "memory"); __builtin_amdgcn_s_barrier(); asm volatile("" ::: "memory");
    }
  }
  __device__ __forceinline__ void done(const Unit& u) const {
    if constexpr (MODE == 1) {
      asm volatile("s_waitcnt vmcnt(0)" ::: "memory");
      if ((threadIdx.x & 63) == 0) __hip_atomic_fetch_add(rdy + u.pm, 1u, __ATOMIC_RELAXED, __HIP_MEMORY_SCOPE_AGENT);
    }
  }
};
}

#include <hip/hip_bf16.h>
#include <cmath>
namespace attn_body {
using bf16=__hip_bfloat16;
using bf16x8=__attribute__((ext_vector_type(8)))short;
using s16x4=__attribute__((ext_vector_type(4)))short;
using f32x16=__attribute__((ext_vector_type(16)))float;
using u32x4=__attribute__((ext_vector_type(4)))unsigned;
constexpr int BATCH=1,NHEAD=8,SEQ=16384,D=64,DM=NHEAD*D;
constexpr int NW=8,QBLK=32,QB=QBLK*NW,KVBLK=64,NQB=SEQ/QB;
constexpr int ATTN_PITCH=DM, ATTN_UNIT_ROWS=QB;
__device__ __forceinline__ int crow(int r,int hi){return (r&3)+8*(r>>2)+4*hi;}
#define SBAR() __builtin_amdgcn_sched_barrier(0)
__device__ __forceinline__ void cmask(f32x16&p0,f32x16&p1,int jb,int qrel,int hi){
  const float NEG=-INFINITY; int kb=64*jb+4*hi;
  #pragma unroll
  for(int r=0;r<16;++r){int kv=kb+(r&3)+8*(r>>2); if(kv>qrel)p0[r]=NEG; if(kv+32>qrel)p1[r]=NEG;}
}

constexpr int NSLOT=3, SLOTB=8192;
constexpr int LDS_K=0, LDS_V=NSLOT*SLOTB, LDS_WS=2*NSLOT*SLOTB, LDS_OST=LDS_WS+NW*64*4, LDS_BYTES=LDS_OST+NW*4096;
constexpr float C2=0.17677669529663687f*1.4426950408889634f;
__device__ __forceinline__ void glds16(const void*gsrc,unsigned lds_dst){unsigned keep;
  asm volatile("s_mov_b32 %0, m0\n\ts_mov_b32 m0, %2\n\ts_nop 0\n\tglobal_load_lds_dwordx4 %1, off\n\ts_mov_b32 m0, %0":"=&s"(keep):"v"(gsrc),"s"(lds_dst):"memory");}
__device__ __forceinline__ float max3f(float a,float b,float c){float r;asm("v_max3_f32 %0, %1, %2, %3":"=v"(r):"v"(a),"v"(b),"v"(c));return r;}
__device__ __forceinline__ float max2f(float a,float b){float r;asm("v_max_f32_e32 %0, %1, %2":"=v"(r):"v"(a),"v"(b));return r;}
__device__ __forceinline__ float fadd_s(float a,float b){float r;asm("v_add_f32_e32 %0, %1, %2":"=v"(r):"v"(a),"v"(b));return r;}
__device__ __forceinline__ float fsub_s(float a,float b){float r;asm("v_sub_f32_e32 %0, %1, %2":"=v"(r):"v"(a),"v"(b));return r;}
typedef float f32x2_t __attribute__((ext_vector_type(2))); typedef __bf16 bf16x2_t __attribute__((ext_vector_type(2)));
__device__ __forceinline__ unsigned cvtpk_s(float lo,float hi){f32x2_t v={lo,hi};bf16x2_t b=__builtin_convertvector(v,bf16x2_t);return __builtin_bit_cast(unsigned,b);}
#define WAIT_BAR(N) asm volatile("s_waitcnt vmcnt(" #N ") lgkmcnt(0)\n\ts_barrier":::"memory")

__device__ __forceinline__ void qkt(f32x16&p0,f32x16&p1,const char*Kslot,const bf16x8*qr,const f32x16&negm,int r32,int hi){
  const char*kb=Kslot+hi*1024+r32*16;
  #pragma unroll
  for(int d0=0;d0<2;++d0){
    const bf16x8 b0=*reinterpret_cast<const bf16x8*>(kb+d0*2048);
    const bf16x8 b1=*reinterpret_cast<const bf16x8*>(kb+d0*2048+512);
    if(d0==0){p0=__builtin_amdgcn_mfma_f32_32x32x16_bf16(b0,qr[0],negm,0,0,0);p1=__builtin_amdgcn_mfma_f32_32x32x16_bf16(b1,qr[0],negm,0,0,0);}
    else{p0=__builtin_amdgcn_mfma_f32_32x32x16_bf16(b0,qr[d0],p0,0,0,0);p1=__builtin_amdgcn_mfma_f32_32x32x16_bf16(b1,qr[d0],p1,0,0,0);}}
}
typedef __attribute__((address_space(3))) const char* lds_cptr;
typedef short v4i16_t __attribute__((ext_vector_type(4)));
__device__ __forceinline__ void kload8(bf16x8*kf,lds_cptr kp){
  kf[0]=*(const __attribute__((address_space(3))) bf16x8*)(kp);      kf[1]=*(const __attribute__((address_space(3))) bf16x8*)(kp+512);
  kf[2]=*(const __attribute__((address_space(3))) bf16x8*)(kp+2048); kf[3]=*(const __attribute__((address_space(3))) bf16x8*)(kp+2560);
  kf[4]=*(const __attribute__((address_space(3))) bf16x8*)(kp+4096); kf[5]=*(const __attribute__((address_space(3))) bf16x8*)(kp+4608);
  kf[6]=*(const __attribute__((address_space(3))) bf16x8*)(kp+6144); kf[7]=*(const __attribute__((address_space(3))) bf16x8*)(kp+6656);
}
__device__ __forceinline__ void kload2(bf16x8*kf,lds_cptr kp,int j){ kf[2*j]=*(const __attribute__((address_space(3))) bf16x8*)(kp+j*2048); kf[2*j+1]=*(const __attribute__((address_space(3))) bf16x8*)(kp+j*2048+512); }
__device__ __forceinline__ s16x4 vtr(lds_cptr p){ return __builtin_bit_cast(s16x4,__builtin_amdgcn_ds_read_tr16_b64_v4i16((__attribute__((address_space(3))) v4i16_t*)p)); }
__device__ __forceinline__ float rowmax(const f32x16&p0,const f32x16&p1){
  float a=max3f(p0[0],p0[1],p1[0]),b=max3f(p0[2],p0[3],p1[1]);a=max3f(a,p1[2],p1[3]);
  #pragma unroll
  for(int r=4;r<16;r+=4){a=max3f(a,p0[r],p0[r+1]);b=max3f(b,p0[r+2],p0[r+3]);a=max3f(a,p1[r],p1[r+1]);b=max3f(b,p1[r+2],p1[r+3]);}
  const float m=max2f(a,b);
  auto rr=__builtin_amdgcn_permlane32_swap(__float_as_uint(m),__float_as_uint(m),false,false);
  return max2f(__uint_as_float(rr[0]),__uint_as_float(rr[1]));
}
__device__ __forceinline__ void pv(f32x16*o,int vb,bf16x8 pa0,bf16x8 pa1,bf16x8 pa2,bf16x8 pa3){
  #pragma unroll
  for(int d0=0;d0<2;++d0){s16x4 lo[4],hi[4];
    #pragma unroll
    for(int ks=0;ks<4;++ks){
      asm volatile("ds_read_b64_tr_b16 %0,%1 offset:%c2":"=&v"(lo[ks]):"v"(vb),"i"(d0*4096+ks*1024):"memory");
      asm volatile("ds_read_b64_tr_b16 %0,%1 offset:%c2":"=&v"(hi[ks]):"v"(vb),"i"(d0*4096+ks*1024+512):"memory");}
    asm volatile("s_waitcnt lgkmcnt(0)":::"memory");SBAR();
    #define PK(k) (bf16x8){lo[k][0],lo[k][1],lo[k][2],lo[k][3],hi[k][0],hi[k][1],hi[k][2],hi[k][3]}
    o[d0]=__builtin_amdgcn_mfma_f32_32x32x16_bf16(pa0,PK(0),o[d0],0,0,0);
    o[d0]=__builtin_amdgcn_mfma_f32_32x32x16_bf16(pa1,PK(1),o[d0],0,0,0);
    o[d0]=__builtin_amdgcn_mfma_f32_32x32x16_bf16(pa2,PK(2),o[d0],0,0,0);
    o[d0]=__builtin_amdgcn_mfma_f32_32x32x16_bf16(pa3,PK(3),o[d0],0,0,0);
    #undef PK
  }
}

#ifndef ATTN_STORE16
#define ATTN_STORE16(p,v) (*(u32x4*)(p)=(v))
#endif
template<int THRL> __device__ __forceinline__ void attn_unit(int b,int h,int qb,const bf16*Q,const bf16*__restrict__ K,const bf16*__restrict__ V,bf16*O,char*shm,const bf16*ATTN_ZERO16){
  const int tid=tidx(),lane=tid&63,r32=lane&31,hi=lane>>5; const int wid=__builtin_amdgcn_readfirstlane(tid>>6);
  const long rowbase=(long)b*SEQ; const int q0=qb*QB;
  const bf16*Qw=Q+(rowbase+q0+wid*QBLK)*DM+h*D;
  constexpr int VP=DM/2;
  const bf16*Kh=K+rowbase*DM+h*D,*Vh=V+rowbase*VP+(h>>1)*D;
  const unsigned lds0=(unsigned)(uintptr_t)shm;
  float*wsf=(float*)(shm+LDS_WS)+wid*64;
  const bf16*ksrc=(wid<4)?Kh+(long)lane*DM+wid*8:ATTN_ZERO16; const long kstep_=(wid<4)?(long)KVBLK*DM:0L;
  const bf16*vsrc=Vh+(long)(16*(wid&3)+(lane>>2))*VP+(wid>>2)*32+(lane&3)*8;
  const unsigned kdst=lds0+LDS_K+wid*1024, vdst=lds0+LDS_V+wid*1024;
  #define DMA_K(t,slot) glds16(ksrc+(long)(t)*kstep_,(unsigned)__builtin_amdgcn_readfirstlane(kdst+(slot)))
  #define DMA_V(t,slot) glds16(vsrc+(long)(t)*KVBLK*VP,(unsigned)__builtin_amdgcn_readfirstlane(vdst+(slot)))
  const int vb0=(int)(lds0+LDS_V)+((lane>>4)&1)*32+(lane&3)*8+(4*hi+((lane&15)>>2))*64;
  const char*Kbase=shm+LDS_K; bf16x8 kf[8];
  const lds_cptr shm3=(lds_cptr)shm; const lds_cptr kp0=shm3+LDS_K+hi*1024+r32*16; const lds_cptr vp0=shm3+LDS_V+((lane>>4)&1)*32+(lane&3)*8+(4*hi+((lane&15)>>2))*64;
  const int NT=(q0+QB)/KVBLK;
  DMA_K(0,0);DMA_V(0,0);DMA_K(1,SLOTB);
  bf16x8 qr[4];
  #pragma unroll
  for(int d0=0;d0<4;++d0)qr[d0]=*reinterpret_cast<const bf16x8*>(&Qw[(long)r32*DM+d0*16+hi*8]);
  float mhat=0.f,l_reg=0.f;f32x16 o[2];o[0]=f32x16{};o[1]=f32x16{};f32x16 negm=f32x16{};asm volatile("":"+v"(negm));
  const int qrel=wid*QBLK+r32;
  #define CMASK(P0,P1,t) do{int jb_=(t)-(NT-4); if(jb_>=0)cmask(P0,P1,jb_,qrel,hi);}while(0)
  bool resc=false;
  #define START(P0,P1) do{ const float rm=rowmax(P0,P1); resc=false; \
    { const float dl=rm; mhat=fadd_s(mhat,dl); \
      _Pragma("unroll") for(int r=0;r<16;++r){P0[r]=fsub_s(P0[r],dl);P1[r]=fsub_s(P1[r],dl);} \
      _Pragma("unroll") for(int r=0;r<16;++r)negm[r]=-mhat; asm volatile("":"+v"(negm)); } \
    _Pragma("unroll") for(int r=0;r<16;++r)P0[r]=__builtin_amdgcn_exp2f(P0[r]); }while(0)
  #define RESC() do{ if(resc){ asm volatile("s_waitcnt lgkmcnt(0)":::"memory"); \
      _Pragma("unroll") for(int d_=0;d_<2;++d_) _Pragma("unroll") for(int r=0;r<16;++r)o[d_][r]*=wsf[crow(r,hi)]; } }while(0)
  f32x16 pA0,pA1,pB0,pB1;
  int sl_prev=0,sl_cur=0,sl_next=SLOTB;
  #define ROT() do{sl_prev=sl_cur;sl_cur=sl_next;sl_next=(sl_next==(NSLOT-1)*SLOTB)?0:sl_next+SLOTB;}while(0)
  DMA_K(2,2*SLOTB);
  WAIT_BAR(3);
  qkt(pA0,pA1,Kbase,qr,negm,r32,hi);asm volatile("s_nop 15\n\ts_nop 7":"+v"(pA0),"+v"(pA1));CMASK(pA0,pA1,0);
  START(pA0,pA1);
  _Pragma("unroll") for(int r=0;r<16;++r)pA1[r]=__builtin_amdgcn_exp2f(pA1[r]);
  WAIT_BAR(0);
  DMA_K(3,0);DMA_V(1,SLOTB);
  ROT();
  kload8(kf,kp0+sl_cur);
  WAIT_BAR(2);
  s16x4 vlo[8],vhi[8]; u32x4 pw0,pw1,pw2,pw3;
  #define PKW(P,B) cvtpk_s(P[B],P[B+1])
  #define PAF(k) __builtin_bit_cast(bf16x8,pw##k)
  #define VFR(i) (bf16x8){vlo[i][0],vlo[i][1],vlo[i][2],vlo[i][3],vhi[i][0],vhi[i][1],vhi[i][2],vhi[i][3]}
  #define PIN(x) asm volatile("":"+v"(x))
  #define MX3(a,b,c) __builtin_fmaxf(__builtin_fmaxf((a),(b)),(c))
  #define GAPA(MF,A0,A1,A2,A3,W0,W1,PW) do{ MF; sacc+=A0; sacc+=A1; sacc+=A2; sacc+=A3; PIN(sacc); W0; W1; PIN(PW); SBAR(); }while(0)
  #define EX(v) __builtin_amdgcn_exp2f(v)
  #define GAPB(MF,X,B) do{ MF; X[B]=EX(X[B]); X[B+1]=EX(X[B+1]); X[B+2]=EX(X[B+2]); X[B+3]=EX(X[B+3]); PIN(X); SBAR(); }while(0)
  #define VRD(i) do{ vlo[i]=vtr(vp_+(((i)>>2)*4096+((i)&3)*1024)); vhi[i]=vtr(vp_+(((i)>>2)*4096+((i)&3)*1024+512)); }while(0)
  #define KRD(G,j) do{ if(G){ kload2(kf,kp0+sl_next,j); SBAR(); } }while(0)
  #define STEP(C0,C1,P0,P1,t,GK,GV,GL) do{ SBAR(); \
    const lds_cptr vp_=vp0+sl_prev; \
    VRD(0); SBAR(); float sacc=(P0[0]+P0[1]); \
    GAPA(C0=__builtin_amdgcn_mfma_f32_32x32x16_bf16(kf[0],qr[0],negm,0,0,0), P0[2],P0[3],P0[4],P0[5],     pw0[0]=PKW(P0,0), pw0[1]=PKW(P0,2), pw0); \
    VRD(4); SBAR(); GAPA(C1=__builtin_amdgcn_mfma_f32_32x32x16_bf16(kf[1],qr[0],negm,0,0,0), P0[6],P0[7],P0[8],P0[9],     pw0[2]=PKW(P0,4), pw0[3]=PKW(P0,6), pw0); \
    VRD(1); SBAR(); GAPA(C0=__builtin_amdgcn_mfma_f32_32x32x16_bf16(kf[2],qr[1],C0,0,0,0),   P0[10],P0[11],P0[12],P0[13], pw1[0]=PKW(P0,8), pw1[1]=PKW(P0,10), pw1); \
    VRD(5); SBAR(); GAPA(C1=__builtin_amdgcn_mfma_f32_32x32x16_bf16(kf[3],qr[1],C1,0,0,0),   P0[14],P0[15],P1[0],P1[1],   pw1[2]=PKW(P0,12),pw1[3]=PKW(P0,14), pw1); \
    VRD(2); SBAR(); GAPA((void)0,   P1[2],P1[3],P1[4],P1[5],     pw2[0]=PKW(P1,0), pw2[1]=PKW(P1,2), pw2); \
    VRD(6); SBAR(); GAPA((void)0,   P1[6],P1[7],P1[8],P1[9],     pw2[2]=PKW(P1,4), pw2[3]=PKW(P1,6), pw2); \
    VRD(3); SBAR(); GAPA((void)0,   P1[10],P1[11],P1[12],P1[13], pw3[0]=PKW(P1,8), pw3[1]=PKW(P1,10), pw3); \
    VRD(7); SBAR(); GAPA((void)0,   P1[14],P1[15],0.f,0.f,       pw3[2]=PKW(P1,12),pw3[3]=PKW(P1,14), pw3); \
    l_reg+=sacc; \
    if(GK){DMA_K((t)+3,sl_cur);} if(GV){DMA_V((t)+1,sl_next);} \
    CMASK(C0,C1,t); \
    { float a=MX3(C0[0],C0[1],C1[0]),b=MX3(C0[2],C0[3],C1[1]); a=MX3(a,C1[2],C1[3]); \
      _Pragma("unroll") for(int r=4;r<16;r+=4){a=MX3(a,C0[r],C0[r+1]);b=MX3(b,C0[r+2],C0[r+3]);a=MX3(a,C1[r],C1[r+1]);b=MX3(b,C1[r+2],C1[r+3]);} \
      float rm=__builtin_fmaxf(a,b); { auto rr=__builtin_amdgcn_permlane32_swap(__float_as_uint(rm),__float_as_uint(rm),false,false); rm=__builtin_fmaxf(__uint_as_float(rr[0]),__uint_as_float(rr[1])); } \
      resc=false; \
      if(__builtin_expect(__any(rm>(float)THRL),0)){ const float dl=__builtin_fmaxf(rm,0.f); mhat+=dl; \
        _Pragma("unroll") for(int r=0;r<16;++r){C0[r]-=dl;C1[r]-=dl;} \
        _Pragma("unroll") for(int r=0;r<16;++r)negm[r]=-mhat; asm volatile("":"+v"(negm)); \
        const float f=__builtin_amdgcn_exp2f(-dl); l_reg*=f; if(hi==0)wsf[r32]=f; resc=true; } } \
    SBAR(); \
    GAPB(o[0]=__builtin_amdgcn_mfma_f32_32x32x16_bf16(PAF(0),VFR(0),o[0],0,0,0), C0,0); \
    GAPB(o[1]=__builtin_amdgcn_mfma_f32_32x32x16_bf16(PAF(0),VFR(4),o[1],0,0,0), C0,4); \
    KRD(GL,0); GAPB(o[0]=__builtin_amdgcn_mfma_f32_32x32x16_bf16(PAF(1),VFR(1),o[0],0,0,0), C0,8); \
    KRD(GL,1); GAPB(o[1]=__builtin_amdgcn_mfma_f32_32x32x16_bf16(PAF(1),VFR(5),o[1],0,0,0), C0,12); \
    KRD(GL,2); GAPB(o[0]=__builtin_amdgcn_mfma_f32_32x32x16_bf16(PAF(2),VFR(2),o[0],0,0,0), C1,0); \
    KRD(GL,3); GAPB(o[1]=__builtin_amdgcn_mfma_f32_32x32x16_bf16(PAF(2),VFR(6),o[1],0,0,0), C1,4); \
    GAPB(o[0]=__builtin_amdgcn_mfma_f32_32x32x16_bf16(PAF(3),VFR(3),o[0],0,0,0), C1,8); \
    GAPB(o[1]=__builtin_amdgcn_mfma_f32_32x32x16_bf16(PAF(3),VFR(7),o[1],0,0,0), C1,12); \
    }while(0)
  int t=1;
  #undef CMASK
  #define CMASK(P0,P1,t) do{}while(0)
  for(;t+5<NT;t+=2){
    STEP(pB0,pB1,pA0,pA1,t,true,true,true);     WAIT_BAR(2); RESC(); ROT();
    STEP(pA0,pA1,pB0,pB1,t+1,true,true,true);   WAIT_BAR(2); RESC(); ROT();
  }
  #undef CMASK
  #define CMASK(P0,P1,t) do{int jb_=(t)-(NT-4); if(jb_>=0)cmask(P0,P1,jb_,qrel,hi);}while(0)
  #define ENDW(tt) do{ if((tt)+3<NT){WAIT_BAR(2);} else if((tt)+2<NT){WAIT_BAR(1);} else {WAIT_BAR(0);} }while(0)
  for(;t+1<NT;t+=2){
    STEP(pB0,pB1,pA0,pA1,t,(t+3<NT),(t+1<NT),(t+1<NT));       ENDW(t);   RESC(); ROT();
    STEP(pA0,pA1,pB0,pB1,t+1,(t+4<NT),(t+2<NT),(t+2<NT));     ENDW(t+1); RESC(); ROT();
  }
  STEP(pB0,pB1,pA0,pA1,NT-1,false,false,false); RESC();
  { float sacc=pB0[0]+pB0[1]; _Pragma("unroll") for(int r=2;r<16;++r)sacc+=pB0[r]; _Pragma("unroll") for(int r=0;r<16;++r)sacc+=pB1[r]; l_reg+=sacc;
    pw0=(u32x4){PKW(pB0,0),PKW(pB0,2),PKW(pB0,4),PKW(pB0,6)};pw1=(u32x4){PKW(pB0,8),PKW(pB0,10),PKW(pB0,12),PKW(pB0,14)};pw2=(u32x4){PKW(pB1,0),PKW(pB1,2),PKW(pB1,4),PKW(pB1,6)};pw3=(u32x4){PKW(pB1,8),PKW(pB1,10),PKW(pB1,12),PKW(pB1,14)};
    SBAR(); pv(o,vb0+sl_cur,PAF(0),PAF(1),PAF(2),PAF(3)); }
  #undef PKW
  #undef PAF
  #undef VFR
  #undef PIN
  #undef MX3
  #undef GAPA
  #undef GAPB
  #undef EX
  #undef VRD
  #undef KRD
  #undef STEP
  #undef ENDW
  {auto rr=__builtin_amdgcn_permlane32_swap(__float_as_uint(l_reg),__float_as_uint(l_reg),false,false);l_reg=__uint_as_float(rr[0])+__uint_as_float(rr[1]);}
  if(hi==0)wsf[32+r32]=l_reg;asm volatile("s_waitcnt lgkmcnt(0)":::"memory");
  float rli[16];
  #pragma unroll
  for(int r=0;r<16;++r)rli[r]=__builtin_amdgcn_rcpf(wsf[32+crow(r,hi)]);
  bf16*Ow=O+(rowbase+q0+wid*QBLK)*DM+h*D;
  { bf16*stg=(bf16*)(shm+LDS_OST)+wid*2048;
    #pragma unroll
    for(int r=0;r<16;++r){const int orow=crow(r,hi);
      #pragma unroll
      for(int d0=0;d0<2;++d0)stg[orow*64+d0*32+r32]=__float2bfloat16(o[d0][r]*rli[r]);}
    asm volatile("s_waitcnt lgkmcnt(0)":::"memory");
    #pragma unroll
    for(int i=0;i<4;++i){const int row=i*8+(lane>>3),ch=lane&7; const u32x4 v=*(const u32x4*)(stg+row*64+ch*8); ATTN_STORE16(Ow+(long)row*DM+ch*8,v);} }
  asm volatile("s_waitcnt lgkmcnt(0)\n\ts_barrier":::"memory");
  #undef DMA_K
  #undef DMA_V
  #undef CMASK
  #undef START
  #undef RESC
  #undef ROT
}
constexpr int ATTN_LDS_BYTES=LDS_BYTES;
struct AttnTensors { const bf16* Q; const bf16* K; const bf16* V; bf16* O; const bf16* Z; };
struct AttnUnit { int bh; int qb; };
struct StaticOrder {
  int vcu,grid;
  __device__ __forceinline__ explicit StaticOrder(int grid_,int block):vcu((block%8)*(grid_/8)+block/8),grid(grid_){}
  __device__ __forceinline__ bool next(int i,AttnUnit&u)const{ const int L=(i>>1)*grid+vcu; if(L>=256)return false; const int s=L&31; u.bh=L>>5; u.qb=(i&1)?63-s:s; return true; }
  __device__ __forceinline__ void a_ready(const AttnUnit&)const{}
  __device__ __forceinline__ void done(const AttnUnit&)const{}
};
template<class Sched,int THRL=8> __device__ __forceinline__ void attn_phase(char*lds,const AttnTensors&T,const Sched&S){
  AttnUnit u;
  for(int i=0;S.next(i,u);++i){ S.a_ready(u); attn_unit<THRL>(u.bh/NHEAD,u.bh%NHEAD,u.qb,T.Q,T.K,T.V,T.O,lds,T.Z); S.done(u); }
}
#undef SBAR
#undef WAIT_BAR
}

__device__ __forceinline__ void transpose_item(const float* W, int N, int k0, int n0, bf16raw* WT, int drow0, float* scr, int lane, int hi_off = 32) {
  const int c4 = (lane & 15) * 4, r0 = lane >> 4;
  const bool inb = (n0 + c4) < N;
  float4 v[16];
  typedef float f32x4nt_ __attribute__((ext_vector_type(4)));
#pragma unroll
  for (int i = 0; i < 16; ++i) {
    if (inb) { const f32x4nt_ t = __builtin_nontemporal_load((const f32x4nt_*)(W + (size_t)(k0 + 4 * i + r0) * N + n0 + c4)); v[i] = make_float4(t[0], t[1], t[2], t[3]); }
    else v[i] = make_float4(0.f, 0.f, 0.f, 0.f);
  }
#pragma unroll
  for (int i = 0; i < 16; ++i) {
    float* sp = scr + (4 * i + r0) * 65 + c4;
    sp[0] = v[i].x; sp[1] = v[i].y; sp[2] = v[i].z; sp[3] = v[i].w;
  }
  __builtin_amdgcn_fence(__ATOMIC_RELEASE, "wavefront"); __builtin_amdgcn_wave_barrier(); __builtin_amdgcn_fence(__ATOMIC_ACQUIRE, "wavefront");
  const int c = lane & 7;
#pragma unroll
  for (int j = 0; j < 8; ++j) {
    const int n = (lane >> 3) + 8 * j;
    const float* sp = scr + (8 * c) * 65 + n;
    uint4 o;
    o.x = pk2(sp[0 * 65], sp[1 * 65]); o.y = pk2(sp[2 * 65], sp[3 * 65]); o.z = pk2(sp[4 * 65], sp[5 * 65]); o.w = pk2(sp[6 * 65], sp[7 * 65]);
    if (n0 + n < N) { typedef unsigned u32x4nt_ __attribute__((ext_vector_type(4))); const u32x4nt_ ov = {o.x, o.y, o.z, o.w}; __builtin_nontemporal_store(ov, (u32x4nt_*)(WT + (size_t)(drow0 + (n & 31) + (n >> 5) * hi_off) * 1024 + k0 + 8 * c)); }
  }
  __builtin_amdgcn_fence(__ATOMIC_RELEASE, "wavefront"); __builtin_amdgcn_wave_barrier(); __builtin_amdgcn_fence(__ATOMIC_ACQUIRE, "wavefront");
}
constexpr int CV_IN = 16 * 45, CV_OUT = 16 * 16, CV_UP = 32 * 16 * 32, CV_DN = 32 * 16 * 16;
__device__ __forceinline__ void convert_one(const Params& p, int l, int r, float* scr, int lane) {
  if (r < CV_IN) {
    const int kb = r / 45, nb = r % 45;
    const int n0 = nb * 64;
    int drow = n0, hio = 32;
    if (n0 >= 768 && n0 < 1280) { const int t = n0 - 768; drow = 768 + (t >> 8) * 256 + ((t >> 6) & 3) * 32; hio = 128; }
    transpose_item(p.in[6] + (size_t)l * 1024 * DIN, DIN, kb * 64, n0, (bf16raw*)(p.ws + WS_WIN) + (size_t)l * 3072 * 1024, drow, scr, lane, hio);
    return;
  }
  r -= CV_IN;
  if (r < CV_OUT) {
    const int kb = r / 16, nb = r % 16;
    transpose_item(p.in[7] + (size_t)l * 1024 * 1024, 1024, kb * 64, nb * 64, (bf16raw*)(p.ws + WS_WOUT) + (size_t)l * 1024 * 1024, nb * 64, scr, lane);
    return;
  }
  r -= CV_OUT;
  if (r < CV_UP) {
    const int e = r / (16 * 32), r2 = r % (16 * 32), kb = r2 / 32, nb = r2 % 32, n0 = nb * 64;
    const int drow = n0 < 1024 ? (n0 >> 7) * 256 + (n0 & 127) : ((n0 - 1024) >> 7) * 256 + 128 + ((n0 - 1024) & 127);
    transpose_item(p.in[29] + ((size_t)l * NE + e) * 1024 * 2048, 2048, kb * 64, n0, (bf16raw*)(p.ws + WS_WUP) + ((size_t)l * NE + e) * 2048 * 1024, drow, scr, lane);
    return;
  }
  r -= CV_UP;
  {
    const int e = r / (16 * 16), r2 = r % (16 * 16), kb = r2 / 16, nb = r2 % 16;
    transpose_item(p.in[31] + ((size_t)l * NE + e) * 1024 * 1024, 1024, kb * 64, nb * 64, (bf16raw*)(p.ws + WS_WDN) + ((size_t)l * NE + e) * 1024 * 1024, nb * 64, scr, lane);
  }
}
__device__ __forceinline__ void ph_convert(const Params& p, float* sm) {
  const int bid0_ = bidx();
  const int tid0_ = tidx();
  const int lane = tid0_ & 63, wave = tid0_ >> 6;
  float* scr = sm + wave * (64 * 65 + 16);
  const int gw = bid0_ * 8 + wave, NGW = gridDim.x * 8;
  for (int it = gw; it < 2 * CV_IN; it += NGW) convert_one(p, it / CV_IN, it % CV_IN, scr, lane);
  for (int i = bid0_ * NT + tid0_; i < 2 * 240 * 128; i += gridDim.x * NT) {
    const int l = i / (240 * 128), r = i % (240 * 128);
    *(uint4*)((bf16raw*)(p.ws + WS_WIN) + (size_t)l * 3072 * 1024 + (size_t)2832 * 1024 + (size_t)r * 8) = make_uint4(0u, 0u, 0u, 0u);
  }
}
__device__ __forceinline__ void convert_rest(const Params& p, float* sm, int l) {
  const int bid0_ = bidx();
  const int tid0_ = tidx();
  const int lane = tid0_ & 63, wave = tid0_ >> 6;
  float* scr = sm + wave * (64 * 65 + 16);
  const int gw = bid0_ * 8 + wave, NGW = gridDim.x * 8;
  for (int it = gw; it < CV_OUT + CV_UP + CV_DN; it += NGW) convert_one(p, l, CV_IN + it, scr, lane);
}

__device__ __forceinline__ void ph_mod(const Params& p, float* sm) {
  const int bid0_ = bidx();
  const int tid0_ = tidx();
  float* mod = (float*)(p.ws + WS_MOD);
  const float* c = p.in[1];
  if (bid0_ == 0 && tid0_ < 64) ((int*)(p.ws + WS_CNT))[tid0_] = 0;
  if (bid0_ == 0) ((int*)(p.ws + WS_LCNT))[tid0_] = 0;
  if (bid0_ == 0 && tid0_ < 16) ((int*)(p.ws + WS_ZERO))[tid0_] = 0;
  if (bid0_ == 0) for (int i = tid0_; i < 640; i += NT) ((unsigned*)(p.ws + WS_RDY))[i] = 0u;
  float* cs = sm;
  float* red = sm + 1024;
  for (int it = bid0_; it < 96; it += gridDim.x) {
    const int l = it / 48, col0 = (it % 48) * 128;
    __syncthreads();
    for (int i = tid0_; i < 1024; i += NT) { const float cv = c[i]; cs[i] = cv / (1.f + __expf(-cv)); }
    __syncthreads();
    const int cg4 = (tid0_ & 31) * 4, kc = tid0_ >> 5;
    const float* w = p.in[2] + (size_t)l * 1024 * 6144 + (size_t)(kc * 64) * 6144 + col0 + cg4;
    float4 acc = make_float4(0.f, 0.f, 0.f, 0.f);
#pragma unroll 16
    for (int i = 0; i < 64; ++i) {
      const float4 wv = *(const float4*)(w + (size_t)i * 6144);
      const float sv = cs[kc * 64 + i];
      acc.x += sv * wv.x; acc.y += sv * wv.y; acc.z += sv * wv.z; acc.w += sv * wv.w;
    }
    *(float4*)(red + kc * 128 + cg4) = acc;
    __syncthreads();
    if (tid0_ < 128) {
      float t = 0.f;
#pragma unroll
      for (int k = 0; k < 16; ++k) t += red[k * 128 + tid0_];
      mod[l * 6144 + col0 + tid0_] = t + p.in[3][l * 6144 + col0 + tid0_];
    }
  }
  __syncthreads();
}

__device__ __forceinline__ void ph_norm(const Params& p, int l, int which, float* sm) {
  const int bid0_ = bidx();
  const int tid0_ = tidx();
  const int lane = tid0_ & 63, wave = tid0_ >> 6;
  const float* mod = (const float*)(p.ws + WS_MOD) + l * 6144;
  const float* xin = which == 0 ? (l == 0 ? p.in[0] : (const float*)(p.ws + WS_XA)) : (const float*)(p.ws + WS_X1);
  const float* gain = (which == 0 ? p.in[4] : p.in[5]) + l * 1024;
  const float* sh = mod + (which == 0 ? 0 : 3) * 1024;
  const float* sc = mod + (which == 0 ? 1 : 4) * 1024;
  bf16raw* H = (bf16raw*)(p.ws + WS_H);
  const float* rw = p.in[27] + (size_t)l * 1024 * 32;
  const float* rb = p.in[28] + l * 32;
  int* cnt = (int*)(p.ws + WS_CNT) + l * 32;
  int* eidx = (int*)(p.ws + WS_EIDX);
  float* gatebuf = (float*)(p.ws + WS_GATE);
  for (int rbase = bid0_ * 8; rbase < S; rbase += gridDim.x * 8) {
    const int row = rbase + wave;
    const float4* xr = (const float4*)(xin + (size_t)row * 1024) + lane;
    float4 v[4];
    float ss = 0.f;
#pragma unroll
    for (int j = 0; j < 4; ++j) {
      v[j] = xr[64 * j];
      ss += v[j].x * v[j].x + v[j].y * v[j].y + v[j].z * v[j].z + v[j].w * v[j].w;
    }
    ss = wave_sum(ss);
    float r = rsqrtf(ss * (1.f / 1024.f) + 1e-6f);
    uint2* hr = (uint2*)(H + (size_t)row * 1024) + lane;
#pragma unroll
    for (int j = 0; j < 4; ++j) {
      int col = (lane + 64 * j) * 4;
      float4 g = *(const float4*)(gain + col), a = *(const float4*)(sc + col), b = *(const float4*)(sh + col);
      v[j].x = v[j].x * r * g.x * (1.f + a.x) + b.x;
      v[j].y = v[j].y * r * g.y * (1.f + a.y) + b.y;
      v[j].z = v[j].z * r * g.z * (1.f + a.z) + b.z;
      v[j].w = v[j].w * r * g.w * (1.f + a.w) + b.w;
      hr[64 * j] = make_uint2(pk2(v[j].x, v[j].y), pk2(v[j].z, v[j].w));
    }
  }
}

__device__ __forceinline__ void ph_norm2(const Params& p, int l, float* sm) {
  const int bid0_ = bidx();
  const int tid = tidx();
  const int lane = tid & 63, wave = tid >> 6;
  const float* mod = (const float*)(p.ws + WS_MOD) + l * 6144;
  const bf16raw* xin = (const bf16raw*)(p.ws + WS_X1);
  const float* gain = p.in[5] + l * 1024;
  const float* sh = mod + 3 * 1024; const float* sc = mod + 4 * 1024;
  bf16raw* H = (bf16raw*)(p.ws + WS_H);
  const float* rw = p.in[27] + (size_t)l * 1024 * 32;
  const float* rb = p.in[28] + l * 32;
  int* cnt = (int*)(p.ws + WS_CNT) + l * 32;
  int* eidx = (int*)(p.ws + WS_EIDX);
  int* elist = (int*)(p.ws + WS_ELIST);
  float* gatebuf = (float*)(p.ws + WS_GATE);
  float* hs = sm;
  float* wsm = sm + 64 * 132;
  float* rstd = wsm + 4096;
  int* lcnt = (int*)(rstd + 64);
  int* lbase = lcnt + 32;
  for (int rbase = bid0_ * 64; rbase < S; rbase += gridDim.x * 64) {
    __syncthreads();
    if (tid < 32) lcnt[tid] = 0;
#pragma unroll 2
    for (int ri = 0; ri < 8; ++ri) {
      const int row = rbase + wave * 8 + ri;
      const bf16raw* xr = xin + (size_t)row * 1024 + lane * 4;
      float4 v[4];
      float ss = 0.f;
#pragma unroll
      for (int j = 0; j < 4; ++j) { v[j] = ld4bf(xr + 256 * j); ss += v[j].x * v[j].x + v[j].y * v[j].y + v[j].z * v[j].z + v[j].w * v[j].w; }
      ss = wave_sum(ss);
      const float r = rsqrtf(ss * (1.f / 1024.f) + 1e-6f);
      if (lane == 0) rstd[wave * 8 + ri] = r;
      uint2* hr = (uint2*)(H + (size_t)row * 1024) + lane;
#pragma unroll
      for (int j = 0; j < 4; ++j) {
        const int col = (lane + 64 * j) * 4;
        const float4 g = *(const float4*)(gain + col), a = *(const float4*)(sc + col), b = *(const float4*)(sh + col);
        hr[64 * j] = make_uint2(pk2(v[j].x * r * g.x * (1.f + a.x) + b.x, v[j].y * r * g.y * (1.f + a.y) + b.y),
                                pk2(v[j].z * r * g.z * (1.f + a.z) + b.z, v[j].w * r * g.w * (1.f + a.w) + b.w));
      }
    }
    const int row_l = tid >> 3, eg = tid & 7;
    float acc[4] = {0.f, 0.f, 0.f, 0.f};
#pragma unroll 1
    for (int k0 = 0; k0 < 1024; k0 += 128) {
      __syncthreads();
#pragma unroll
      for (int u = 0; u < 4; ++u) {
        const int idx = tid + u * 512, rr = idx >> 5, c4 = (idx & 31) * 4;
        const float4 x = ld4bf(xin + (size_t)(rbase + rr) * 1024 + k0 + c4);
        const float4 g = *(const float4*)(gain + k0 + c4), a = *(const float4*)(sc + k0 + c4), b = *(const float4*)(sh + k0 + c4);
        const float r = rstd[rr];
        *(float4*)(hs + rr * 132 + c4) = make_float4(x.x * r * g.x * (1.f + a.x) + b.x, x.y * r * g.y * (1.f + a.y) + b.y, x.z * r * g.z * (1.f + a.z) + b.z,
                                                      x.w * r * g.w * (1.f + a.w) + b.w);
      }
#pragma unroll
      for (int u = 0; u < 2; ++u) { const int idx = tid + u * 512; *(float4*)(wsm + idx * 4) = *(const float4*)(rw + (size_t)k0 * 32 + idx * 4); }
      __syncthreads();
#pragma unroll 8
      for (int k4 = 0; k4 < 32; ++k4) {
        const float4 hv = *(const float4*)(hs + row_l * 132 + k4 * 4);
        const float4 w0 = *(const float4*)(wsm + (k4 * 4 + 0) * 32 + eg * 4), w1 = *(const float4*)(wsm + (k4 * 4 + 1) * 32 + eg * 4);
        const float4 w2 = *(const float4*)(wsm + (k4 * 4 + 2) * 32 + eg * 4), w3 = *(const float4*)(wsm + (k4 * 4 + 3) * 32 + eg * 4);
        acc[0] += hv.x * w0.x + hv.y * w1.x + hv.z * w2.x + hv.w * w3.x;
        acc[1] += hv.x * w0.y + hv.y * w1.y + hv.z * w2.y + hv.w * w3.y;
        acc[2] += hv.x * w0.z + hv.y * w1.z + hv.z * w2.z + hv.w * w3.z;
        acc[3] += hv.x * w0.w + hv.y * w1.w + hv.z * w2.w + hv.w * w3.w;
      }
    }
    {
      const float4 b4 = *(const float4*)(rb + eg * 4);
      acc[0] += b4.x; acc[1] += b4.y; acc[2] += b4.z; acc[3] += b4.w;
    }
    float tv[4]; int ti[4];
#pragma unroll
    for (int rd = 0; rd < 4; ++rd) {
      float bv = acc[0]; int bi = eg * 4;
#pragma unroll
      for (int c = 1; c < 4; ++c) if (acc[c] > bv) { bv = acc[c]; bi = eg * 4 + c; }
#pragma unroll
      for (int o = 1; o < 8; o <<= 1) {
        const float ov = __shfl_xor(bv, o); const int oi = __shfl_xor(bi, o);
        if (ov > bv || (ov == bv && oi < bi)) { bv = ov; bi = oi; }
      }
      tv[rd] = bv; ti[rd] = bi;
#pragma unroll
      for (int c = 0; c < 4; ++c) if (bi == eg * 4 + c) acc[c] = -INFINITY;
    }
    int rk[4] = {0, 0, 0, 0};
    if (eg == 0) {
#pragma unroll
      for (int k = 0; k < 4; ++k) rk[k] = atomicAdd(&lcnt[ti[k]], 1);
    }
    __syncthreads();
    if (tid < 32) { const int c = lcnt[tid]; lbase[tid] = c > 0 ? atomicAdd(&cnt[tid], c) : 0; }
    __syncthreads();
    if (eg == 0) {
      const int row = rbase + row_l;
      const float e1 = __expf(tv[1] - tv[0]), e2 = __expf(tv[2] - tv[0]), e3 = __expf(tv[3] - tv[0]);
      const float inv = 1.f / (1.f + e1 + e2 + e3);
      *(int4*)(eidx + row * 4) = make_int4(ti[0] | ((lbase[ti[0]] + rk[0]) << 8), ti[1] | ((lbase[ti[1]] + rk[1]) << 8), ti[2] | ((lbase[ti[2]] + rk[2]) << 8),
                                           ti[3] | ((lbase[ti[3]] + rk[3]) << 8));
      *(float4*)(gatebuf + row * 4) = make_float4(inv, e1 * inv, e2 * inv, e3 * inv);
#pragma unroll
      for (int k = 0; k < 4; ++k) elist[ti[k] * S + lbase[ti[k]] + rk[k]] = row;
    }
  }
}

__device__ __forceinline__ void ph_inproj(const Params& p, int l, float* sm) {
  const int bid0_ = bidx();
  pg8::Gemm g{(const pg8::bf16_t*)(p.ws + WS_H), (const pg8::bf16_t*)(p.ws + WS_WIN) + (size_t)l * 3072 * 1024, S, 3072, 1024};
  pg8::StaticOrder so; so.init(S, 3072, (int)gridDim.x, bid0_);
  pg8::EpiInproj E{(pg8::bf16_t*)(p.ws + WS_QA), (pg8::bf16_t*)(p.ws + WS_KA), (pg8::bf16_t*)(p.ws + WS_VA), (float*)(p.ws + WS_QB), (pg8::bf16_t*)(p.ws + WS_QBB), (pg8::bf16_t*)(p.ws + WS_KB),
                   (pg8::bf16_t*)(p.ws + WS_VB), (float*)(p.ws + WS_KMP), (pg8::bf16_t*)(p.ws + WS_PROJ), p.in[8] + l * 32, p.in[9] + l * 32, p.in[15] + l * 64, p.in[16] + l * 64, attn_body::C2};
  pg8::gemm_phase<pg8::EpiInproj, pg8::StaticOrder, true, true>((PG8_LAS unsigned char*)sm, g, so, E);
}

__device__ __forceinline__ void gla_local_item(const Params& p, int l, int c, float* sm) {
  const int tid = tidx();
  const bf16raw* P = (const bf16raw*)(p.ws + WS_PROJ);
  float* BC = (float*)(p.ws + WS_GA);
  float* SC = (float*)(p.ws + WS_SC); float* DEC = (float*)(p.ws + WS_DEC);
  const float* wg2 = p.in[17] + l * 16 * 128; const float* bg = p.in[18] + l * 128;
  float* gs = sm; float* ks = sm + 8192; float* vs = sm + 16384; float* part = sm + 32768;
  const size_t t0 = (size_t)c * 64;
  {
    const int t = tid >> 3, d0 = (tid & 7) * 16;
    float gl[16];
#pragma unroll
    for (int r4 = 0; r4 < 4; ++r4) { float4 x = ld4bf(P + (t0 + t) * PDIN + PC_CG + r4 * 4); gl[r4 * 4] = x.x; gl[r4 * 4 + 1] = x.y; gl[r4 * 4 + 2] = x.z; gl[r4 * 4 + 3] = x.w; }
#pragma unroll
    for (int d = 0; d < 16; ++d) {
      float z = bg[d0 + d];
#pragma unroll
      for (int r = 0; r < 16; ++r) z += gl[r] * wg2[r * 128 + d0 + d];
      gs[t * 128 + d0 + d] = logsigmoidf_(z) * (1.f / 16.f);
    }
#pragma unroll
    for (int u = 0; u < 4; ++u) { int idx = tid + u * 512, row = idx >> 5, c4 = (idx & 31) * 4; *(float4*)(ks + row * 128 + c4) = ld4bf(P + (t0 + row) * PDIN + PC_CK + c4); }
#pragma unroll
    for (int u = 0; u < 8; ++u) { int idx = tid + u * 512, row = idx >> 6, c4 = (idx & 63) * 4; *(float4*)(vs + row * 256 + c4) = ld4bf(P + (t0 + row) * PDIN + PC_CV + c4); }
  }
  __syncthreads();
  const int d = tid & 127, qtr = tid >> 7;
  {
    float run = 0.f;
#pragma unroll
    for (int i = 0; i < 16; ++i) { run += gs[(qtr * 16 + i) * 128 + d]; gs[(qtr * 16 + i) * 128 + d] = run; }
    part[qtr * 128 + d] = run;
  }
  __syncthreads();
  {
    float off = 0.f;
#pragma unroll
    for (int q = 0; q < 3; ++q) if (q < qtr) off += part[q * 128 + d];
#pragma unroll
    for (int i = 0; i < 16; ++i) { float v = gs[(qtr * 16 + i) * 128 + d] + off; gs[(qtr * 16 + i) * 128 + d] = v; BC[(t0 + qtr * 16 + i) * 128 + d] = v; }
  }
  __syncthreads();
  {
    const float bl = gs[63 * 128 + d];
#pragma unroll
    for (int i = 0; i < 16; ++i) { int t = qtr * 16 + i; ks[t * 128 + d] *= __expf(bl - gs[t * 128 + d]); }
  }
  __syncthreads();
  {
    const int h = tid >> 7, dd = (tid >> 2) & 31, e0 = (tid & 3) * 16;
    float acc[16];
#pragma unroll
    for (int i = 0; i < 16; ++i) acc[i] = 0.f;
    for (int t = 0; t < 64; ++t) {
      const float kv = ks[t * 128 + h * 32 + dd];
#pragma unroll
      for (int q = 0; q < 4; ++q) {
        float4 v4 = *(const float4*)(vs + t * 256 + h * 64 + e0 + q * 4);
        acc[q * 4] += kv * v4.x; acc[q * 4 + 1] += kv * v4.y; acc[q * 4 + 2] += kv * v4.z; acc[q * 4 + 3] += kv * v4.w;
      }
    }
    float* o = SC + (((size_t)c * 4 + h) * 32 + dd) * 64 + e0;
#pragma unroll
    for (int q = 0; q < 4; ++q) *(float4*)(o + q * 4) = make_float4(acc[q * 4], acc[q * 4 + 1], acc[q * 4 + 2], acc[q * 4 + 3]);
    if ((tid & 3) == 0) DEC[(size_t)c * 128 + h * 32 + dd] = __expf(gs[63 * 128 + h * 32 + dd]);
  }
  __syncthreads();
}

__device__ __forceinline__ void lru_local_item(const Params& p, int l, int c, float* sm) {
  const int tid = tidx();
  const bf16raw* P = (const bf16raw*)(p.ws + WS_PROJ);
  float* LA = (float*)(p.ws + WS_LA); float* LB = (float*)(p.ws + WS_LB);
  float* LTA = (float*)(p.ws + WS_LTA); float* LTH = (float*)(p.ws + WS_LTH);
  const float* cw = p.in[20] + l * 4 * 256; const float* cb = p.in[21] + l * 256;
  const float* wa = p.in[22] + (size_t)l * 4 * 64 * 64; const float* ba = p.in[23] + l * 256;
  const float* wx = p.in[24] + (size_t)l * 4 * 64 * 64; const float* bx = p.in[25] + l * 256;
  const float* lam = p.in[26] + l * 256;
  float* xcs = sm;
  const int t0 = c * 64;
  for (int i = tid; i < 64 * 256; i += NT) {
    int tt = i >> 8, ch = i & 255, t = t0 + tt;
    float acc = cb[ch];
#pragma unroll
    for (int w = 0; w < 4; ++w) { int ts = t + w - 3; if (ts >= 0) acc += cw[w * 256 + ch] * bf2f(P[(size_t)ts * PDIN + PC_DX + ch]); }
    xcs[tt * 256 + ch] = acc;
  }
  __syncthreads();
  {
    const int ch = tid & 255, half = tid >> 8, n = ch >> 6, e = ch & 63;
    const float ls = logsigmoidf_(lam[ch]), bav = ba[ch], bxv = bx[ch];
    float Hh = 0.f, Ac = 1.f;
    {
      const int tb = half * 32;
      float ar[32], ai[32];
#pragma unroll
      for (int i = 0; i < 32; ++i) { ar[i] = 0.f; ai[i] = 0.f; }
#pragma unroll 1
      for (int d4 = 0; d4 < 16; ++d4) {
        float w1[4], w2[4];
#pragma unroll
        for (int q = 0; q < 4; ++q) { w1[q] = wa[(n * 64 + d4 * 4 + q) * 64 + e]; w2[q] = wx[(n * 64 + d4 * 4 + q) * 64 + e]; }
#pragma unroll
        for (int i = 0; i < 32; ++i) {
          const float4 xv = *(const float4*)(xcs + (tb + i) * 256 + n * 64 + d4 * 4);
          ar[i] += xv.x * w1[0] + xv.y * w1[1] + xv.z * w1[2] + xv.w * w1[3];
          ai[i] += xv.x * w2[0] + xv.y * w2[1] + xv.z * w2[2] + xv.w * w2[3];
        }
      }
#pragma unroll
      for (int i = 0; i < 32; ++i) {
        const int t = t0 + tb + i;
        float rg = sigmoidf_(ar[i] + bav), ig = sigmoidf_(ai[i] + bxv);
        float la = 8.f * rg * ls;
        float a = __expf(la);
        float bt = sqrtf(fmaxf(1.f - a * a, 0.f)) * (ig * xcs[(tb + i) * 256 + ch]);
        Hh = a * Hh + bt; Ac *= a;
        LA[(size_t)t * 256 + ch] = Ac; LB[(size_t)t * 256 + ch] = Hh;
      }
    }
    LTA[(size_t)(c * 2 + half) * 256 + ch] = Ac; LTH[(size_t)(c * 2 + half) * 256 + ch] = Hh;
  }
  __syncthreads();
}

__device__ __forceinline__ void ph_prep(const Params& p, int l, float* sm) {
  const int bid0_ = bidx();
  const int tid0_ = tidx();
  const int lane = tid0_ & 63, wave = tid0_ >> 6;
  const bf16raw* P = (const bf16raw*)(p.ws + WS_PROJ);
  bf16raw* QAb = (bf16raw*)(p.ws + WS_QA); bf16raw* KAb = (bf16raw*)(p.ws + WS_KA); bf16raw* VAb = (bf16raw*)(p.ws + WS_VA);
  float* QB = (float*)(p.ws + WS_QB); bf16raw* KBb = (bf16raw*)(p.ws + WS_KB); bf16raw* QBb = (bf16raw*)(p.ws + WS_QBB);
  float* KMP = (float*)(p.ws + WS_KMP); bf16raw* VBt = (bf16raw*)(p.ws + WS_VBT);
  const float* aqg = p.in[8] + l * 32; const float* akg = p.in[9] + l * 32;
  const float* bqg = p.in[15] + l * 64; const float* bkg = p.in[16] + l * 64;
  const float* wg2 = p.in[17] + l * 16 * 128; const float* bg = p.in[18] + l * 128;
  bf16raw* vsl = (bf16raw*)sm;
  const bf16raw* VBn = (const bf16raw*)(p.ws + WS_VB);
  for (int tile = bid0_; tile < S / 64; tile += gridDim.x) {
    __syncthreads();
#pragma unroll
    for (int u = 0; u < 4; ++u) { const int idx = tid0_ + u * 512, r = idx >> 5, c8 = (idx & 31) * 8; *(uint4*)(vsl + r * 264 + c8) = *(const uint4*)(VBn + (size_t)(tile * 64 + r) * 256 + c8); }
    __syncthreads();
    {
      const int col = tid0_ & 255, half = tid0_ >> 8;
      unsigned w[16];
#pragma unroll
      for (int i = 0; i < 16; ++i) w[i] = (unsigned)vsl[(half * 32 + 2 * i) * 264 + col] | ((unsigned)vsl[(half * 32 + 2 * i + 1) * 264 + col] << 16);
      uint4* dst = (uint4*)(VBt + (size_t)col * S + tile * 64 + half * 32);
#pragma unroll
      for (int i = 0; i < 4; ++i) dst[i] = make_uint4(w[4 * i], w[4 * i + 1], w[4 * i + 2], w[4 * i + 3]);
    }
  }
  __syncthreads();
  for (int c = bid0_; c < S / 64; c += gridDim.x) gla_local_item(p, l, c, sm);
  for (int c = bid0_; c < S / 64; c += gridDim.x) lru_local_item(p, l, c, sm);
}

__device__ __forceinline__ void ph_scan(const Params& p, float* sm) {
  const int bid0_ = bidx();
  const int tid = tidx();
  const float* SC = (const float*)(p.ws + WS_SC); const float* DEC = (const float*)(p.ws + WS_DEC); float* STo = (float*)(p.ws + WS_ST);
  float* gA = sm; float* gH = sm + 512; float* gC = sm + 1024;
  for (int b = bid0_; b < 256; b += gridDim.x) {
    const int chain = tid & 31, grp = tid >> 5, gid = b * 32 + chain;
    float sv[16], dv[16];
#pragma unroll
    for (int i = 0; i < 16; ++i) { const int c = grp * 16 + i; sv[i] = SC[(size_t)c * 8192 + gid]; dv[i] = DEC[c * 128 + (gid >> 6)]; }
    float A = 1.f, H = 0.f;
#pragma unroll
    for (int i = 0; i < 16; ++i) { H = dv[i] * H + sv[i]; A *= dv[i]; }
    __syncthreads();
    gA[tid] = A; gH[tid] = H;
    __syncthreads();
    if (tid < 32) {
      float carry = 0.f;
#pragma unroll
      for (int g = 0; g < 16; ++g) { gC[g * 32 + tid] = carry; carry = gA[g * 32 + tid] * carry + gH[g * 32 + tid]; }
    }
    __syncthreads();
    float st = gC[tid];
#pragma unroll
    for (int i = 0; i < 16; ++i) { const int c = grp * 16 + i; STo[(size_t)c * 8192 + gid] = st; st = dv[i] * st + sv[i]; }
  }
}
__device__ __forceinline__ void ph_scan_lru(const Params& p, float* sm) {
  const int bid0_ = bidx();
  const int tid = tidx();
  const float* LTA = (const float*)(p.ws + WS_LTA); const float* LTH = (const float*)(p.ws + WS_LTH); float* LC = (float*)(p.ws + WS_LC);
  for (int b = bid0_; b < 48; b += gridDim.x) {
    if (b < 16) continue;
    const int ch = (b - 16) * 8 + (tid & 7), grp = tid >> 3;
    float a[8], h[8];
#pragma unroll
    for (int i = 0; i < 8; ++i) { a[i] = LTA[(grp * 8 + i) * 256 + ch]; h[i] = LTH[(grp * 8 + i) * 256 + ch]; }
    float A = 1.f, H = 0.f;
#pragma unroll
    for (int i = 0; i < 8; ++i) { H = a[i] * H + h[i]; A *= a[i]; }
    __syncthreads();
    sm[tid] = A; sm[512 + tid] = H;
    __syncthreads();
    if (tid < 8) {
      float carry = 0.f;
      for (int g = 0; g < 64; ++g) { const float ga = sm[g * 8 + tid], gh = sm[512 + g * 8 + tid]; sm[1024 + g * 8 + tid] = carry; carry = ga * carry + gh; }
    }
    __syncthreads();
    float carry = sm[1024 + tid];
#pragma unroll
    for (int i = 0; i < 8; ++i) { LC[(grp * 8 + i) * 256 + ch] = carry; carry = a[i] * carry + h[i]; }
  }
}

__device__ __forceinline__ void moba_gate_item(const Params& p, int l, int it, float* sm) {
  const int tid = tidx();
  const int h = it & 3, own = it >> 2, qi = own * 256 + (tid >> 1), half = tid & 1;
  const float* QB = (const float*)(p.ws + WS_QB); const float* KMP = (const float*)(p.ws + WS_KMP);
  int* LCNT = (int*)(p.ws + WS_LCNT) + l * 256; int* LIST = (int*)(p.ws + WS_MLIST); float2* ML = (float2*)(p.ws + WS_ML);
  float* km = sm;
  int* lcnt = (int*)(sm + 4096); int* lbase = lcnt + 64;
  __syncthreads();
  for (int idx = tid; idx < own * 64; idx += NT) {
    const int n = idx >> 6, c = idx & 63;
    const float* kp = KMP + (size_t)(4 * n) * 256 + h * 64 + c;
    km[idx] = (kp[0] + kp[256] + kp[512] + kp[768]) * (1.f / 256.f);
  }
  if (tid < 64) lcnt[tid] = 0;
  __syncthreads();
  float q[64];
  {
    const float4* qp = (const float4*)(QB + (size_t)qi * 256 + h * 64);
#pragma unroll
    for (int i = 0; i < 16; ++i) { float4 t = qp[i]; q[4 * i] = t.x; q[4 * i + 1] = t.y; q[4 * i + 2] = t.z; q[4 * i + 3] = t.w; }
  }
  int s0 = -1, s1 = -1, s2 = -1;
  float g0 = -INFINITY, g1 = -INFINITY, g2 = -INFINITY;
#pragma unroll 1
  for (int n = half; n < own; n += 2) {
    const float4* kmp = (const float4*)(km + n * 64);
    float a = 0.f;
#pragma unroll
    for (int i = 0; i < 16; ++i) { float4 t = kmp[i]; a += q[4 * i] * t.x + q[4 * i + 1] * t.y + q[4 * i + 2] * t.z + q[4 * i + 3] * t.w; }
    if (a > g0) { g2 = g1; s2 = s1; g1 = g0; s1 = s0; g0 = a; s0 = n; }
    else if (a > g1) { g2 = g1; s2 = s1; g1 = a; s1 = n; }
    else if (a > g2) { g2 = a; s2 = n; }
  }
  {
    const float pg0 = __shfl_xor(g0, 1), pg1 = __shfl_xor(g1, 1), pg2 = __shfl_xor(g2, 1);
    const int ps0 = __shfl_xor(s0, 1), ps1 = __shfl_xor(s1, 1), ps2 = __shfl_xor(s2, 1);
#define MOBA_INS(A, N) do { const float a_ = (A); const int n_ = (N); if (n_ >= 0) {                                                   \
      if (a_ > g0 || (a_ == g0 && n_ < s0) || s0 < 0) { g2 = g1; s2 = s1; g1 = g0; s1 = s0; g0 = a_; s0 = n_; }                         \
      else if (a_ > g1 || (a_ == g1 && n_ < s1) || s1 < 0) { g2 = g1; s2 = s1; g1 = a_; s1 = n_; }                                      \
      else if (a_ > g2 || (a_ == g2 && n_ < s2) || s2 < 0) { g2 = a_; s2 = n_; } } } while (0)
    MOBA_INS(pg0, ps0); MOBA_INS(pg1, ps1); MOBA_INS(pg2, ps2);
#undef MOBA_INS
  }
  int r0 = 0, r1 = 0, r2 = 0;
  if (half == 0) {
    if (s0 >= 0) r0 = atomicAdd(&lcnt[s0], 1);
    if (s1 >= 0) r1 = atomicAdd(&lcnt[s1], 1);
    if (s2 >= 0) r2 = atomicAdd(&lcnt[s2], 1);
  }
  __syncthreads();
  if (tid < 64) { const int c = lcnt[tid]; lbase[tid] = c > 0 ? atomicAdd(&LCNT[h * 64 + tid], c) : 0; }
  __syncthreads();
  if (half == 0) {
    const float2 dead = make_float2(-INFINITY, 0.f);
    const size_t sl = ((size_t)qi * 4 + h) * 4;
    if (s0 >= 0) LIST[(size_t)(h * 64 + s0) * 16384 + lbase[s0] + r0] = qi | (0 << 16); else ML[sl + 0] = dead;
    if (s1 >= 0) LIST[(size_t)(h * 64 + s1) * 16384 + lbase[s1] + r1] = qi | (1 << 16); else ML[sl + 1] = dead;
    if (s2 >= 0) LIST[(size_t)(h * 64 + s2) * 16384 + lbase[s2] + r2] = qi | (2 << 16); else ML[sl + 2] = dead;
  }
}

__device__ __forceinline__ void moba_attn_item(const Params& p, int h, int n, int chunk, int own, int len, float* sm) {
  typedef short bf16x8_t __attribute__((ext_vector_type(8)));
  typedef short bf16x4_t __attribute__((ext_vector_type(4)));
  typedef float f32x4_t __attribute__((ext_vector_type(4)));
  const int tid = tidx(), lane = tid & 63, wave = tid >> 6, qc = lane & 15, kg = lane >> 4;
  const bf16raw* KBb = (const bf16raw*)(p.ws + WS_KB); const bf16raw* QBb = (const bf16raw*)(p.ws + WS_QBB); const bf16raw* VBt = (const bf16raw*)(p.ws + WS_VBT);
  const int* LIST = (const int*)(p.ws + WS_MLIST); float2* ML = (float2*)(p.ws + WS_ML); bf16raw* PART = (bf16raw*)(p.ws + WS_PART);
  bf16raw* Ks = (bf16raw*)sm;
  bf16raw* Vt = (bf16raw*)sm + 256 * 72;
  __syncthreads();
#pragma unroll
  for (int u = 0; u < 4; ++u) {
    const int idx = tid + u * 512, key = idx >> 3, ch = idx & 7;
    *(uint4*)(Ks + key * 72 + ch * 8) = *(const uint4*)(KBb + (size_t)(n * 256 + key) * 256 + h * 64 + ch * 8);
    const int d = idx >> 5, c2 = idx & 31;
    *(uint4*)(Vt + d * 264 + c2 * 8) = *(const uint4*)(VBt + (size_t)(h * 64 + d) * S + n * 256 + c2 * 8);
  }
#pragma unroll 1
  for (int sub = 0; sub < 2; ++sub) {
  if (!own && chunk * 256 + sub * 128 >= len) break;
  const int slot_in = chunk * 256 + sub * 128 + wave * 16 + qc;
  int qi, src; bool valid = true;
  if (own) { qi = n * 256 + slot_in; src = 3; }
  else { valid = slot_in < len; const int e = LIST[(size_t)(h * 64 + n) * 16384 + (valid ? slot_in : 0)]; qi = e & 0xffff; src = e >> 16; }
  const bf16x8_t q0 = *(const bf16x8_t*)(QBb + (size_t)qi * 256 + h * 64 + kg * 8), q1 = *(const bf16x8_t*)(QBb + (size_t)qi * 256 + h * 64 + 32 + kg * 8);
  if (sub == 0) __syncthreads();
  const int nkeys = (own && sub == 0) ? 128 : 256;
  const int nkt = nkeys >> 4;
  f32x4_t sacc[16];
  float mx = -INFINITY;
  const int qpos = slot_in;
#pragma unroll
  for (int kt = 0; kt < 16; ++kt) {
    if (kt < nkt) {
      const bf16x8_t k0 = *(const bf16x8_t*)(Ks + (kt * 16 + qc) * 72 + kg * 8), k1 = *(const bf16x8_t*)(Ks + (kt * 16 + qc) * 72 + 32 + kg * 8);
      f32x4_t a = {0.f, 0.f, 0.f, 0.f};
      a = __builtin_amdgcn_mfma_f32_16x16x32_bf16(k0, q0, a, 0, 0, 0);
      a = __builtin_amdgcn_mfma_f32_16x16x32_bf16(k1, q1, a, 0, 0, 0);
      if (own) {
#pragma unroll
        for (int r = 0; r < 4; ++r) if (kt * 16 + kg * 4 + r > qpos) a[r] = -INFINITY;
      }
      sacc[kt] = a;
      mx = fmaxf(mx, fmaxf(fmaxf(a[0], a[1]), fmaxf(a[2], a[3])));
    } else sacc[kt] = (f32x4_t){-INFINITY, -INFINITY, -INFINITY, -INFINITY};
  }
  mx = fmaxf(mx, __shfl_xor(mx, 16)); mx = fmaxf(mx, __shfl_xor(mx, 32));
  float lsum = 0.f;
#pragma unroll
  for (int kt = 0; kt < 16; ++kt)
#pragma unroll
    for (int r = 0; r < 4; ++r) { const float pv = __builtin_amdgcn_exp2f(sacc[kt][r] - mx); sacc[kt][r] = pv; lsum += pv; }
  lsum += __shfl_xor(lsum, 16); lsum += __shfl_xor(lsum, 32);
  f32x4_t o[4];
#pragma unroll
  for (int dt = 0; dt < 4; ++dt) o[dt] = (f32x4_t){0.f, 0.f, 0.f, 0.f};
#pragma unroll
  for (int ks = 0; ks < 8; ++ks) {
    if (ks * 2 < nkt) {
      bf16x8_t pf;
      {
        const unsigned w0 = pk2(sacc[2 * ks][0], sacc[2 * ks][1]), w1 = pk2(sacc[2 * ks][2], sacc[2 * ks][3]);
        const unsigned w2 = pk2(sacc[2 * ks + 1][0], sacc[2 * ks + 1][1]), w3 = pk2(sacc[2 * ks + 1][2], sacc[2 * ks + 1][3]);
        const uint4 w = make_uint4(w0, w1, w2, w3);
        pf = __builtin_bit_cast(bf16x8_t, w);
      }
#pragma unroll
      for (int dt = 0; dt < 4; ++dt) {
        const bf16x4_t va = *(const bf16x4_t*)(Vt + (dt * 16 + qc) * 264 + ks * 32 + kg * 4), vb = *(const bf16x4_t*)(Vt + (dt * 16 + qc) * 264 + ks * 32 + 16 + kg * 4);
        const bf16x8_t vf = {va[0], va[1], va[2], va[3], vb[0], vb[1], vb[2], vb[3]};
        o[dt] = __builtin_amdgcn_mfma_f32_16x16x32_bf16(vf, pf, o[dt], 0, 0, 0);
      }
    }
  }
  if (valid) {
    const size_t sl = ((size_t)qi * 4 + h) * 4 + src;
    const float inv = 1.f / lsum;
#pragma unroll
    for (int dt = 0; dt < 4; ++dt) *(uint2*)(PART + sl * 64 + dt * 16 + kg * 4) = make_uint2(pk2(o[dt][0] * inv, o[dt][1] * inv), pk2(o[dt][2] * inv, o[dt][3] * inv));
    if (kg == 0) ML[sl] = make_float2(mx, lsum);
  }
  }
}

__device__ __forceinline__ void moba_attn(const Params& p, int l, float* sm) {
  const int bid0_ = bidx();
  const int tid = tidx();
  const int* LCNT = (const int*)(p.ws + WS_LCNT) + l * 256;
  int* pre = (int*)(sm + 36000);
  __syncthreads();
  if (tid < 64) {
    const int4 c4 = *(const int4*)(LCNT + tid * 4);
    const int n0 = (c4.x + 255) >> 8, n1 = (c4.y + 255) >> 8, n2 = (c4.z + 255) >> 8, n3 = (c4.w + 255) >> 8;
    const int tot = n0 + n1 + n2 + n3;
    int inc = tot;
#pragma unroll
    for (int o = 1; o < 64; o <<= 1) { const int t = __shfl_up(inc, o); if (tid >= o) inc += t; }
    const int ex = inc - tot;
    pre[tid * 4] = ex; pre[tid * 4 + 1] = ex + n0; pre[tid * 4 + 2] = ex + n0 + n1; pre[tid * 4 + 3] = ex + n0 + n1 + n2;
    if (tid == 63) pre[256] = inc;
  }
  __syncthreads();
  const int ng = pre[256];
  for (int it = bid0_; it < ng + 256; it += gridDim.x) {
    if (it < ng) {
      int lo = 0, hi = 255;
      while (lo < hi) { const int mid = (lo + hi + 1) >> 1; if (pre[mid] <= it) lo = mid; else hi = mid - 1; }
      moba_attn_item(p, lo >> 6, lo & 63, it - pre[lo], 0, LCNT[lo], sm);
    } else {
      const int w = it - ng;
      moba_attn_item(p, w & 3, w >> 2, 0, 1, 256, sm);
    }
  }
}

__device__ __forceinline__ void gla_out_item(const Params& p, int l, int it2, float* sm) {
  typedef short bf16x8_t __attribute__((ext_vector_type(8)));
  typedef short bf16x4_t __attribute__((ext_vector_type(4)));
  typedef float f32x4_t __attribute__((ext_vector_type(4)));
  const int tid = tidx(), lane = tid & 63, wave = tid >> 6, qc = lane & 15, kg = lane >> 4;
  const int c = it2 >> 1, hp = it2 & 1;
  const bf16raw* P = (const bf16raw*)(p.ws + WS_PROJ);
  const float* BC = (const float*)(p.ws + WS_GA);
  const float* ST = (const float*)(p.ws + WS_ST);
  bf16raw* Y = (bf16raw*)(p.ws + WS_Y);
  const float* cog = p.in[19] + l * 64;
  bf16raw* L = (bf16raw*)sm;
  const size_t t0 = (size_t)c * 64;
  __syncthreads();
  {
    const int hh = tid >> 8, h = hp * 2 + hh;
    bf16raw* Qs = L + hh * 12288; bf16raw* Ks = Qs + 2560; bf16raw* St = Ks + 2560; bf16raw* Vt = St + 2560;
    {
      const int t = (tid >> 2) & 63, d8 = (tid & 3) * 8;
      const bf16raw* qp = P + (t0 + t) * PDIN + PC_CQ + h * 32 + d8; const bf16raw* kp = P + (t0 + t) * PDIN + PC_CK + h * 32 + d8;
      const float4 qa = ld4bf(qp), qb = ld4bf(qp + 4), ka = ld4bf(kp), kb = ld4bf(kp + 4);
      const float4 ba = *(const float4*)(BC + (t0 + t) * 128 + h * 32 + d8), bb = *(const float4*)(BC + (t0 + t) * 128 + h * 32 + d8 + 4);
      const float sc = 0.17677669529663687f;
      *(uint4*)(Qs + t * 40 + d8) = make_uint4(pk2(qa.x * sc * __expf(ba.x), qa.y * sc * __expf(ba.y)), pk2(qa.z * sc * __expf(ba.z), qa.w * sc * __expf(ba.w)),
                                               pk2(qb.x * sc * __expf(bb.x), qb.y * sc * __expf(bb.y)), pk2(qb.z * sc * __expf(bb.z), qb.w * sc * __expf(bb.w)));
      *(uint4*)(Ks + t * 40 + d8) = make_uint4(pk2(ka.x * __expf(-ba.x), ka.y * __expf(-ba.y)), pk2(ka.z * __expf(-ba.z), ka.w * __expf(-ba.w)),
                                               pk2(kb.x * __expf(-bb.x), kb.y * __expf(-bb.y)), pk2(kb.z * __expf(-bb.z), kb.w * __expf(-bb.w)));
    }
    {
      const int j = (tid >> 2) & 63, e0 = (tid & 3) * 16;
      const bf16raw* vp = P + (t0 + j) * PDIN + PC_CV + h * 64 + e0;
      const uint4 va = *(const uint4*)vp, vb = *(const uint4*)(vp + 8);
      const unsigned w[8] = {va.x, va.y, va.z, va.w, vb.x, vb.y, vb.z, vb.w};
#pragma unroll
      for (int q = 0; q < 8; ++q) { Vt[(e0 + 2 * q) * 72 + j] = (bf16raw)(w[q] & 0xffff); Vt[(e0 + 2 * q + 1) * 72 + j] = (bf16raw)(w[q] >> 16); }
    }
    {
      const int d = (tid >> 3) & 31, e0 = (tid & 7) * 8;
      const float* sp = ST + ((size_t)c * 4 + h) * 2048 + d * 64 + e0;
      const float4 sa = *(const float4*)sp, sb = *(const float4*)(sp + 4);
      const float v[8] = {sa.x, sa.y, sa.z, sa.w, sb.x, sb.y, sb.z, sb.w};
#pragma unroll
      for (int q = 0; q < 8; ++q) St[(e0 + q) * 40 + d] = (bf16raw)(pk2(v[q], 0.f) & 0xffff);
    }
  }
  __syncthreads();
  {
    const int hh = wave >> 2, itile = wave & 3, h = hp * 2 + hh;
    const bf16raw* Qs = L + hh * 12288; const bf16raw* Ks = Qs + 2560; const bf16raw* St = Ks + 2560; const bf16raw* Vt = St + 2560;
    const bf16x8_t qf = *(const bf16x8_t*)(Qs + (itile * 16 + qc) * 40 + kg * 8);
    f32x4_t att[4];
#pragma unroll
    for (int jt = 0; jt < 4; ++jt) {
      f32x4_t a = {0.f, 0.f, 0.f, 0.f};
      if (jt <= itile) {
        const bf16x8_t kf = *(const bf16x8_t*)(Ks + (jt * 16 + qc) * 40 + kg * 8);
        a = __builtin_amdgcn_mfma_f32_16x16x32_bf16(kf, qf, a, 0, 0, 0);
        if (jt == itile) {
#pragma unroll
          for (int r = 0; r < 4; ++r) if (kg * 4 + r > qc) a[r] = 0.f;
        }
      }
      att[jt] = a;
    }
    bf16x8_t pf[2];
#pragma unroll
    for (int s2 = 0; s2 < 2; ++s2) {
      const uint4 w = make_uint4(pk2(att[2 * s2][0], att[2 * s2][1]), pk2(att[2 * s2][2], att[2 * s2][3]), pk2(att[2 * s2 + 1][0], att[2 * s2 + 1][1]),
                                 pk2(att[2 * s2 + 1][2], att[2 * s2 + 1][3]));
      pf[s2] = __builtin_bit_cast(bf16x8_t, w);
    }
    f32x4_t o[4];
    float ss = 0.f;
#pragma unroll
    for (int et = 0; et < 4; ++et) {
      f32x4_t acc = {0.f, 0.f, 0.f, 0.f};
      const bf16x8_t sf = *(const bf16x8_t*)(St + (et * 16 + qc) * 40 + kg * 8);
      acc = __builtin_amdgcn_mfma_f32_16x16x32_bf16(sf, qf, acc, 0, 0, 0);
#pragma unroll
      for (int s2 = 0; s2 < 2; ++s2) {
        if (2 * s2 <= itile) {
          const bf16x4_t va = *(const bf16x4_t*)(Vt + (et * 16 + qc) * 72 + s2 * 32 + kg * 4), vb = *(const bf16x4_t*)(Vt + (et * 16 + qc) * 72 + s2 * 32 + 16 + kg * 4);
          const bf16x8_t vf = {va[0], va[1], va[2], va[3], vb[0], vb[1], vb[2], vb[3]};
          acc = __builtin_amdgcn_mfma_f32_16x16x32_bf16(vf, pf[s2], acc, 0, 0, 0);
        }
      }
      o[et] = acc;
      ss += acc[0] * acc[0] + acc[1] * acc[1] + acc[2] * acc[2] + acc[3] * acc[3];
    }
    ss += __shfl_xor(ss, 16); ss += __shfl_xor(ss, 32);
    const float r = rsqrtf(ss * (1.f / 64.f) + 1e-6f);
    const size_t t = t0 + itile * 16 + qc;
#pragma unroll
    for (int et = 0; et < 4; ++et) {
      const int e = et * 16 + kg * 4;
      const float4 rr = ld4bf(P + t * PDIN + PC_CR + h * 64 + e), g = *(const float4*)(cog + e);
      *(uint2*)(Y + t * 1024 + 512 + h * 64 + e) = make_uint2(pk2(o[et][0] * r * g.x * rr.x * sigmoidf_(rr.x), o[et][1] * r * g.y * rr.y * sigmoidf_(rr.y)),
                                                             pk2(o[et][2] * r * g.z * rr.z * sigmoidf_(rr.z), o[et][3] * r * g.w * rr.w * sigmoidf_(rr.w)));
    }
  }
}

__device__ __forceinline__ void lru_out(const Params& p) {
  const int bid0_ = bidx();
  const int tid = tidx();
  const float* LA = (const float*)(p.ws + WS_LA); const float* LB = (const float*)(p.ws + WS_LB); const float* LC = (const float*)(p.ws + WS_LC);
  const bf16raw* P = (const bf16raw*)(p.ws + WS_PROJ);
  bf16raw* Y = (bf16raw*)(p.ws + WS_Y);
  for (int idx = bid0_ * NT + tid; idx < S * 64; idx += gridDim.x * NT) {
    const int t = idx >> 6, c4 = (idx & 63) * 4;
    const float4 a = *(const float4*)(LA + (size_t)t * 256 + c4), b = *(const float4*)(LB + (size_t)t * 256 + c4);
    const float4 cr = *(const float4*)(LC + (size_t)(t >> 5) * 256 + c4), g = ld4bf(P + (size_t)t * PDIN + PC_DG + c4);
    *(uint2*)(Y + (size_t)t * 1024 + 768 + c4) = make_uint2(pk2((b.x + a.x * cr.x) * gelu_tanh(g.x), (b.y + a.y * cr.y) * gelu_tanh(g.y)),
                                                          pk2((b.z + a.z * cr.z) * gelu_tanh(g.z), (b.w + a.w * cr.w) * gelu_tanh(g.w)));
  }
}

__device__ __forceinline__ void ph_mix(const Params& p, int l, float* sm) {
  const int bid0_ = bidx();
  const int grp = bid0_ % 3;
  if (grp == 0) { __syncthreads(); convert_rest(p, sm, l); __syncthreads(); }
  moba_attn(p, l, sm);
  for (int it = bid0_; it < 512; it += gridDim.x) gla_out_item(p, l, it, sm);
  lru_out(p);
  __syncthreads();
  if (grp == 1) { convert_rest(p, sm, l); __syncthreads(); }
  {
    const attn_body::AttnTensors AT{(const attn_body::bf16*)(p.ws + WS_QA), (const attn_body::bf16*)(p.ws + WS_KA), (const attn_body::bf16*)(p.ws + WS_VA),
                                    (attn_body::bf16*)(p.ws + WS_OA), (const attn_body::bf16*)(p.ws + WS_ZERO)};
    const attn_body::StaticOrder so((int)gridDim.x, bid0_);
    attn_body::attn_phase<attn_body::StaticOrder>((char*)sm, AT, so);
  }
  if (grp == 2) { __syncthreads(); convert_rest(p, sm, l); }
}

__device__ __forceinline__ void ph_fin(const Params& p, int l) {
  const int bid0_ = bidx();
  const int tid0_ = tidx();
  const int lane = tid0_ & 63, wave = tid0_ >> 6;
  const bf16raw* OA = (const bf16raw*)(p.ws + WS_OA);
  const bf16raw* P = (const bf16raw*)(p.ws + WS_PROJ);
  bf16raw* Y = (bf16raw*)(p.ws + WS_Y);
  const float lam = lam_of(p, l), li = lam_init_of(l);
  const float2* ML = (const float2*)(p.ws + WS_ML); const bf16raw* PART = (const bf16raw*)(p.ws + WS_PART);
  const float* aog = p.in[14] + l * 64; const float* cog = p.in[19] + l * 64;
#pragma unroll 2
  for (int row = bid0_ * 8 + wave; row < S; row += gridDim.x * 8) {
    int h = lane >> 4, c = (lane & 15) * 4;
    {
      const uint2 u1 = *(const uint2*)(OA + ((size_t)row * 8 + h * 2) * 64 + c), u2 = *(const uint2*)(OA + ((size_t)row * 8 + h * 2 + 1) * 64 + c);
      const float4 o1 = make_float4(bf2f(u1.x & 0xffff), bf2f(u1.x >> 16), bf2f(u1.y & 0xffff), bf2f(u1.y >> 16));
      const float4 o2 = make_float4(bf2f(u2.x & 0xffff), bf2f(u2.x >> 16), bf2f(u2.y & 0xffff), bf2f(u2.y >> 16));
      float4 o = make_float4(o1.x - lam * o2.x, o1.y - lam * o2.y, o1.z - lam * o2.z, o1.w - lam * o2.w);
      float ss = o.x * o.x + o.y * o.y + o.z * o.z + o.w * o.w;
#pragma unroll
      for (int k = 1; k < 16; k <<= 1) ss += __shfl_xor(ss, k);
      float r = rsqrtf(ss * (1.f / 64.f) + 1e-6f) * (1.f - li);
      float4 g = *(const float4*)(aog + c);
      *(uint2*)(Y + (size_t)row * 1024 + h * 64 + c) = make_uint2(pk2(o.x * r * g.x, o.y * r * g.y), pk2(o.z * r * g.z, o.w * r * g.w));
    }
    {
      const size_t sl = ((size_t)row * 4 + h) * 4;
      const float2 m0 = ML[sl], m1 = ML[sl + 1], m2 = ML[sl + 2], m3 = ML[sl + 3];
      const float M = fmaxf(fmaxf(m0.x, m1.x), fmaxf(m2.x, m3.x));
      const float w0 = m0.y * __builtin_amdgcn_exp2f(m0.x - M), w1 = m1.y * __builtin_amdgcn_exp2f(m1.x - M), w2 = m2.y * __builtin_amdgcn_exp2f(m2.x - M),
                  w3 = m3.y * __builtin_amdgcn_exp2f(m3.x - M);
      const float inv = 1.f / (w0 + w1 + w2 + w3);
      float4 o = make_float4(0.f, 0.f, 0.f, 0.f);
      if (w0 > 0.f) { const float4 t = ld4bf(PART + (sl + 0) * 64 + c); o.x += w0 * t.x; o.y += w0 * t.y; o.z += w0 * t.z; o.w += w0 * t.w; }
      if (w1 > 0.f) { const float4 t = ld4bf(PART + (sl + 1) * 64 + c); o.x += w1 * t.x; o.y += w1 * t.y; o.z += w1 * t.z; o.w += w1 * t.w; }
      if (w2 > 0.f) { const float4 t = ld4bf(PART + (sl + 2) * 64 + c); o.x += w2 * t.x; o.y += w2 * t.y; o.z += w2 * t.z; o.w += w2 * t.w; }
      { const float4 t = ld4bf(PART + (sl + 3) * 64 + c); o.x += w3 * t.x; o.y += w3 * t.y; o.z += w3 * t.z; o.w += w3 * t.w; }
      *(uint2*)(Y + (size_t)row * 1024 + 256 + h * 64 + c) = make_uint2(pk2(o.x * inv, o.y * inv), pk2(o.z * inv, o.w * inv));
    }
  }
}

__device__ __forceinline__ void ph_outproj(const Params& p, int l, float* sm) {
  const int bid0_ = bidx();
  pg8::Gemm g{(const pg8::bf16_t*)(p.ws + WS_Y), (const pg8::bf16_t*)(p.ws + WS_WOUT) + (size_t)l * 1024 * 1024, S, 1024, 1024};
  pg8::StaticOrder so; so.init(S, 1024, (int)gridDim.x, bid0_);
  pg8::EpiOutproj E{l == 0 ? p.in[0] : (const float*)nullptr, (const pg8::bf16_t*)(p.ws + WS_XA), (const float*)(p.ws + WS_MOD) + l * 6144 + 2 * 1024, (pg8::bf16_t*)(p.ws + WS_X1)};
  pg8::gemm_phase<pg8::EpiOutproj, pg8::StaticOrder, true, true>((PG8_LAS unsigned char*)sm, g, so, E);
}

__device__ __forceinline__ void ph_gather(const Params& p, int l, float* sm) {
  const int bid0_ = bidx();
  const int tid0_ = tidx();
  const int* cnt = (const int*)(p.ws + WS_CNT) + l * 32;
  int* ps = (int*)sm;
  __syncthreads();
  int* cl = ps + 64;
  if (tid0_ < 32) cl[tid0_] = (cnt[tid0_] + 255) & ~255;
  __syncthreads();
  if (tid0_ < 33) { int a = 0; for (int e = 0; e < tid0_; ++e) a += cl[e]; ps[tid0_] = a; }
  __syncthreads();
  int* srow = (int*)(p.ws + WS_SROW);
  if (bid0_ == 0) {
    int* texp = (int*)(p.ws + WS_TEXP);
    const int nt = ps[32] >> 8;
    if (tid0_ == 0) texp[0] = nt;
    if (tid0_ < 32) { texp[352 + tid0_] = ps[tid0_] >> 8; texp[384 + tid0_] = cl[tid0_] >> 8; }
    if (tid0_ < 320) {
      int e = 0;
      for (int k = 0; k < 32; ++k) if (tid0_ * 256 >= ps[k + 1]) e = k + 1;
      texp[1 + tid0_] = e < 32 ? e : 31;
    }
  }
  for (int e = bid0_; e < 32; e += gridDim.x)
    for (int i = cnt[e] + tid0_; i < cl[e]; i += NT) srow[ps[e] + i] = 0;
  const int* eidx = (const int*)(p.ws + WS_EIDX);
  int* rpos = (int*)(p.ws + WS_RPOS);
  for (int r = bid0_ * NT + tid0_; r < S * 4; r += gridDim.x * NT) {
    const int ei = eidx[r], e = ei & 255, rank = ei >> 8;
    const int dest = ps[e] + rank;
    srow[dest] = r >> 2;
    rpos[r] = dest;
  }
}

__device__ __forceinline__ void ph_up(const Params& p, int l, float* sm) {
  const int bid0_ = bidx();
  pg8::Gemm g{(const pg8::bf16_t*)(p.ws + WS_H), (const pg8::bf16_t*)(p.ws + WS_WUP) + (size_t)l * NE * 2048 * 1024, MOE_ROWS, 2048, 1024};
  int* tab = (int*)(sm + 33000);
  unsigned* rowoff = (unsigned*)(sm + 33104);
  const int t_ = tidx();
  const int* cnt = (const int*)(p.ws + WS_CNT) + l * 32;
  pg8::moe_build_units<8>(cnt, (int)gridDim.x, bid0_, tab, t_);
  pg8::moe_build_rowoff((const int*)(p.ws + WS_ELIST), cnt, tab, rowoff, t_);
  pg8::MoeOrder<8, 1> so{tab, (unsigned*)(p.ws + WS_RDY) + l * 320};
  pg8::EpiUp E{__builtin_amdgcn_make_buffer_rsrc((void*)(p.ws + WS_ACT), 0, (int)((size_t)MOE_ROWS * 1024 * 2), 0x00020000), p.in[30] + (size_t)l * NE * 2048};
  pg8::gemm_phase<pg8::EpiUp, pg8::MoeOrder<8, 1>, true, true, true>((PG8_LAS unsigned char*)sm, g, so, E, rowoff);
}

__device__ __forceinline__ void ph_down(const Params& p, int l, float* sm) {
  const int bid0_ = bidx();
  pg8::Gemm g{(const pg8::bf16_t*)(p.ws + WS_ACT), (const pg8::bf16_t*)(p.ws + WS_WDN) + (size_t)l * NE * 1024 * 1024, MOE_ROWS, 1024, 1024};
  int* tab = (int*)(sm + 33000);
  pg8::moe_build_units<4>((const int*)(p.ws + WS_CNT) + l * 32, (int)gridDim.x, bid0_, tab, tidx(), true);
  pg8::MoeOrder<4, 2> so{tab, (unsigned*)(p.ws + WS_RDY) + l * 320};
  pg8::EpiDown E{(pg8::bf16_t*)(p.ws + WS_YS), p.in[32] + (size_t)l * NE * 1024};
  pg8::gemm_phase<pg8::EpiDown, pg8::MoeOrder<4, 2>, true, true>((PG8_LAS unsigned char*)sm, g, so, E);
}

__device__ __forceinline__ void ph_combine(const Params& p, int l, float* sm) {
  const int bid0_ = bidx();
  const int tid0_ = tidx();
  const int lane = tid0_ & 63, wave = tid0_ >> 6;
  const bf16raw* X1 = (const bf16raw*)(p.ws + WS_X1); const bf16raw* YS = (const bf16raw*)(p.ws + WS_YS);
  const float* gatebuf = (const float*)(p.ws + WS_GATE);
  const int* eidx = (const int*)(p.ws + WS_EIDX);
  const int* cnt = (const int*)(p.ws + WS_CNT) + l * 32;
  const float* g2 = (const float*)(p.ws + WS_MOD) + l * 6144 + 5 * 1024;
  bf16raw* xa = (bf16raw*)(p.ws + WS_XA);
  const float* modn = (const float*)(p.ws + WS_MOD) + 6144;
  const float* gain = p.in[4] + 1024;
  bf16raw* H = (bf16raw*)(p.ws + WS_H);
  int* ps = (int*)sm;
  __syncthreads();
  if (tid0_ < 33) { int a = 0; for (int e = 0; e < tid0_; ++e) a += (cnt[e] + 255) & ~255; ps[tid0_] = a; }
  __syncthreads();
#pragma unroll 2
  for (int row = bid0_ * 8 + wave; row < S; row += gridDim.x * 8) {
    const float4 gt = *(const float4*)(gatebuf + row * 4);
    const int4 ei = *(const int4*)(eidx + row * 4);
    const int4 rp = make_int4(ps[ei.x & 255] + (ei.x >> 8), ps[ei.y & 255] + (ei.y >> 8), ps[ei.z & 255] + (ei.z >> 8), ps[ei.w & 255] + (ei.w >> 8));
    float4 v[4];
    float ss = 0.f;
#pragma unroll
    for (int j = 0; j < 4; ++j) {
      const int c = (lane + 64 * j) * 4;
      const uint2 y0 = *(const uint2*)(YS + (size_t)rp.x * 1024 + c), y1 = *(const uint2*)(YS + (size_t)rp.y * 1024 + c);
      const uint2 y2 = *(const uint2*)(YS + (size_t)rp.z * 1024 + c), y3 = *(const uint2*)(YS + (size_t)rp.w * 1024 + c);
      float4 a;
      a.x = gt.x * bf2f(y0.x & 0xffff) + gt.y * bf2f(y1.x & 0xffff) + gt.z * bf2f(y2.x & 0xffff) + gt.w * bf2f(y3.x & 0xffff);
      a.y = gt.x * bf2f(y0.x >> 16) + gt.y * bf2f(y1.x >> 16) + gt.z * bf2f(y2.x >> 16) + gt.w * bf2f(y3.x >> 16);
      a.z = gt.x * bf2f(y0.y & 0xffff) + gt.y * bf2f(y1.y & 0xffff) + gt.z * bf2f(y2.y & 0xffff) + gt.w * bf2f(y3.y & 0xffff);
      a.w = gt.x * bf2f(y0.y >> 16) + gt.y * bf2f(y1.y >> 16) + gt.z * bf2f(y2.y >> 16) + gt.w * bf2f(y3.y >> 16);
      const float4 x = ld4bf(X1 + (size_t)row * 1024 + c), g = *(const float4*)(g2 + c);
      v[j] = make_float4(x.x + g.x * a.x, x.y + g.y * a.y, x.z + g.z * a.z, x.w + g.w * a.w);
      if (l == 0) *(uint2*)(xa + (size_t)row * 1024 + c) = make_uint2(pk2(v[j].x, v[j].y), pk2(v[j].z, v[j].w)); else *(float4*)(p.out + (size_t)row * 1024 + c) = v[j];
      ss += v[j].x * v[j].x + v[j].y * v[j].y + v[j].z * v[j].z + v[j].w * v[j].w;
    }
    if (l == 0) {
      ss = wave_sum(ss);
      const float r = rsqrtf(ss * (1.f / 1024.f) + 1e-6f);
      uint2* hr = (uint2*)(H + (size_t)row * 1024) + lane;
#pragma unroll
      for (int j = 0; j < 4; ++j) {
        const int c = (lane + 64 * j) * 4;
        const float4 g = *(const float4*)(gain + c), a = *(const float4*)(modn + 1024 + c), b = *(const float4*)(modn + c);
        hr[64 * j] = make_uint2(pk2(v[j].x * r * g.x * (1.f + a.x) + b.x, v[j].y * r * g.y * (1.f + a.y) + b.y),
                                pk2(v[j].z * r * g.z * (1.f + a.z) + b.z, v[j].w * r * g.w * (1.f + a.w) + b.w));
      }
    }
  }
}

#define LAS __attribute__((address_space(3)))
#define XB_TMO      128
#define XB_XCNT(j)  (256  + 64 * (j))
#define XB_XSUB(j)  (1280 + 64 * (j))
#define XB_XGEN(j)  (2304 + 64 * (j))
#define XB_TOP      3328
#define XB_TOPGEN   3392
#define XCD_BAR_WORDS 3456
#define XB_SPIN_CAP (1u << 18)

__device__ __forceinline__ unsigned xb_ld(unsigned* p)              { return __hip_atomic_load(p, __ATOMIC_RELAXED, __HIP_MEMORY_SCOPE_AGENT); }
__device__ __forceinline__ unsigned xb_add(unsigned* p, unsigned v) { return __hip_atomic_fetch_add(p, v, __ATOMIC_RELAXED, __HIP_MEMORY_SCOPE_AGENT); }
__device__ __forceinline__ unsigned xb_xcc_id() { return (unsigned)__builtin_amdgcn_s_getreg((3 << 11) | 20) & 0xFu; }
#define XB_SPIN(cond, bar) do { unsigned _sp = 0; while (cond) { __builtin_amdgcn_s_sleep(1); \
    if ((++_sp & 255u) == 0u) { if (xb_ld(&(bar)[XB_TMO])) break; if (_sp > XB_SPIN_CAP) { atomicAdd(&(bar)[XB_TMO], 1u); break; } } } } while (0)

struct XcdBarrier {
    unsigned* bar; unsigned x;
    volatile LAS unsigned* st;
};

__device__ __forceinline__ XcdBarrier xcd_barrier_post(unsigned* bar, volatile LAS unsigned* st) {
    XcdBarrier b; b.bar = bar; b.x = xb_xcc_id(); b.st = st;
    if (threadIdx.x == 0) (void)xb_add(&bar[XB_XCNT(b.x)], 1u);
    return b;
}
__device__ __forceinline__ void xcd_barrier_complete(unsigned* bar, unsigned x, unsigned& nloc, unsigned& nx) {
    const unsigned G = gridDim.x * gridDim.y * gridDim.z;
    unsigned sum, cnt, mine, sp = 0u;
    for (;;) {
        sum = 0u; cnt = 0u; mine = 0u;
#pragma unroll
        for (unsigned j = 0; j < 16; ++j) { const unsigned c = xb_ld(&bar[XB_XCNT(j)]); sum += c; cnt += (c > 0u) ? 1u : 0u; mine = (j == x) ? c : mine; }
        if (sum == G) break;
        __builtin_amdgcn_s_sleep(1);
        if ((++sp & 255u) == 0u) { if (xb_ld(&bar[XB_TMO])) break; if (sp > XB_SPIN_CAP) { atomicAdd(&bar[XB_TMO], 1u); break; } }
    }
    nloc = mine > 0u ? mine : 1u; nx = cnt > 0u ? cnt : 1u;
}

__device__ __forceinline__ void xcd_barrier(const XcdBarrier& b) {
    asm volatile("s_waitcnt vmcnt(0)" ::: "memory");
    __syncthreads();
    if (threadIdx.x == 0) {
        unsigned* bar = b.bar; asm volatile("" : "+s"(bar));
        const unsigned bx_ = xb_xcc_id();
        __builtin_amdgcn_s_waitcnt(0);
        unsigned nloc = b.st[0], nx = b.st[1];
        if (nloc == 0u) { xcd_barrier_complete(bar, bx_, nloc, nx); b.st[0] = nloc; b.st[1] = nx; }
        const unsigned old = xb_add(&bar[XB_XSUB(bx_)], 1u);
        const unsigned gen = old / nloc;
        if (old + 1u == (gen + 1u) * nloc) {
            __builtin_amdgcn_fence(__ATOMIC_RELEASE, "agent");
            asm volatile("s_waitcnt vmcnt(0)" ::: "memory");
            const unsigned og = xb_add(&bar[XB_TOP], 1u);
            const unsigned tg = og / nx;
            if (og + 1u == (tg + 1u) * nx) xb_add(&bar[XB_TOPGEN], 1u);
            else XB_SPIN(xb_ld(&bar[XB_TOPGEN]) == tg, bar);
            __builtin_amdgcn_fence(__ATOMIC_ACQUIRE, "agent");
            xb_add(&bar[XB_XGEN(bx_)], 1u);
            asm volatile("s_waitcnt vmcnt(0)" ::: "memory");
        } else {
            XB_SPIN(xb_ld(&bar[XB_XGEN(bx_)]) == gen, bar);
            __builtin_amdgcn_fence(__ATOMIC_ACQUIRE, "agent");
            asm volatile("s_waitcnt vmcnt(0)" ::: "memory");
        }
    }
    __syncthreads();
}

template <int SUB>
__device__ __forceinline__ void run_sub(const Params& p, int l, float* sm) {
  const int bid0_ = bidx();
  asm volatile("" : "+s"(l));
  if (SUB == 0) ph_norm(p, l, 0, sm);
  else if (SUB == 1) ph_inproj(p, l, sm);
  else if (SUB == 2) ph_prep(p, l, sm);
  else if (SUB == 3) { ph_scan(p, sm); ph_scan_lru(p, sm); for (int it = bid0_; it < 256; it += gridDim.x) moba_gate_item(p, l, (it - 16) & 255, sm); }
  else if (SUB == 4) ph_mix(p, l, sm);
  else if (SUB == 5) ph_fin(p, l);
  else if (SUB == 6) ph_outproj(p, l, sm);
  else if (SUB == 7) ph_norm2(p, l, sm);
  else if (SUB == 8) ph_gather(p, l, sm);
  else if (SUB == 9) ph_up(p, l, sm);
  else if (SUB == 10) ph_down(p, l, sm);
  else if (SUB == 11) ph_combine(p, l, sm);
}

#if MK_SINGLE
__global__ void __launch_bounds__(NT, 2) mega(Params p) {
  extern __shared__ __attribute__((aligned(16))) unsigned char lds_raw[];
  float* sm = (float*)lds_raw;
  cg::grid_group grid = cg::this_grid();
  unsigned* barw = (unsigned*)(p.ws + WS_BAR);
  volatile LAS unsigned* bst = (volatile LAS unsigned*)((LAS unsigned char*)lds_raw + (LDS_BYTES - 64));
  if (threadIdx.x < 2) bst[threadIdx.x] = 0u;
  if (blockIdx.x == 0) for (int i = threadIdx.x; i < XCD_BAR_WORDS; i += NT) barw[i] = 0u;
  ph_mod(p, sm);
  ph_convert(p, sm);
  grid.sync();
  const XcdBarrier gb = xcd_barrier_post(barw, bst);
#define GSYNC() xcd_barrier(gb)
  run_sub<0>(p, 0, sm); GSYNC();
#pragma unroll 1
  for (int l = 0; l < 2; ++l) {
    run_sub<1>(p, l, sm); GSYNC();
    run_sub<2>(p, l, sm); GSYNC();
    run_sub<3>(p, l, sm); GSYNC();
    run_sub<4>(p, l, sm); GSYNC();
    run_sub<5>(p, l, sm); GSYNC();
    run_sub<6>(p, l, sm); GSYNC();
    run_sub<7>(p, l, sm); GSYNC();
    run_sub<9>(p, l, sm);
    run_sub<10>(p, l, sm); GSYNC();
    run_sub<11>(p, l, sm);
    if (l == 0) GSYNC();
  }
#undef GSYNC
}
#else
template <int SUB>
__global__ void __launch_bounds__(NT, 2) phk(Params p, int l) {
  extern __shared__ __attribute__((aligned(16))) unsigned char lds_raw[];
  float* sm = (float*)lds_raw;
  if (SUB < 0) { ph_mod(p, sm); ph_convert(p, sm); }
  else run_sub<(SUB < 0 ? 0 : SUB)>(p, l, sm);
}
template <int SUB> static void launch_ph(const Params& p, int l, hipStream_t stream) {
  static bool attr = false;
  if (!attr) { (void)hipFuncSetAttribute((const void*)phk<SUB>, hipFuncAttributeMaxDynamicSharedMemorySize, LDS_BYTES); attr = true; }
  hipLaunchKernelGGL(phk<SUB>, dim3(256), dim3(NT), LDS_BYTES, stream, p, l);
}
#endif

extern "C" void kernel_launch(void* const* d_in, const int* in_sizes, int n_in, void* d_out, int out_size, void* d_ws, size_t ws_size,
                              hipStream_t stream) {
  Params p{};
  for (int i = 0; i < 33; ++i) p.in[i] = (const float*)d_in[i];
  p.out = (float*)d_out;
  p.ws = (char*)d_ws;
#if MK_SINGLE
  static int grid_blocks = 0;
  if (!grid_blocks) {
    int dev = 0, cus = 0, per_cu = 0;
    (void)hipGetDevice(&dev);
    (void)hipDeviceGetAttribute(&cus, hipDeviceAttributeMultiprocessorCount, dev);
    (void)hipFuncSetAttribute((const void*)mega, hipFuncAttributeMaxDynamicSharedMemorySize, LDS_BYTES);
    (void)hipOccupancyMaxActiveBlocksPerMultiprocessor(&per_cu, mega, NT, LDS_BYTES);
    if (per_cu < 1) per_cu = 1;
    if (per_cu > 1) per_cu = 1;
    grid_blocks = cus * per_cu;
  }
  void* args[] = {&p};
  hipError_t e = hipLaunchCooperativeKernel((void*)mega, dim3(grid_blocks), dim3(NT), args, LDS_BYTES, stream);
  if (e != hipSuccess) fprintf(stderr, "cooperative launch failed: %s (grid %d)\n", hipGetErrorString(e), grid_blocks);
#else
  launch_ph<-1>(p, 0, stream);
  for (int l = 0; l < 2; ++l) {
    if (l == 0) launch_ph<0>(p, l, stream);
    launch_ph<1>(p, l, stream); launch_ph<2>(p, l, stream); launch_ph<3>(p, l, stream);
    launch_ph<4>(p, l, stream); launch_ph<5>(p, l, stream); launch_ph<6>(p, l, stream); launch_ph<7>(p, l, stream);
    launch_ph<9>(p, l, stream); launch_ph<10>(p, l, stream); launch_ph<11>(p, l, stream);
  }
#endif
}
```

```cpp
#include <hip/hip_runtime.h>
#include <hip/hip_cooperative_groups.h>
#include <cstdio>
#include <cstdint>
namespace cg = cooperative_groups;

#ifndef MK_SINGLE
#define MK_SINGLE 1
#endif
#ifndef PROBE
#define PROBE 0
#endif

constexpr int S = 16384, D = 1024, DIN = 2832, NE = 32;
constexpr int NT = 512;
constexpr size_t MiB = 1u << 20;
constexpr size_t WS_MOD = 0;
constexpr size_t WS_CNT = 64 * 1024;
constexpr size_t WS_TEXP = 128 * 1024;
constexpr size_t WS_KMP = 1 * MiB;
constexpr size_t WS_BAR = 256 * 1024;
constexpr size_t WS_SROW = 320 * 1024;
constexpr size_t WS_RDY = 216 * 1024;
constexpr size_t WS_ZERO = 224 * 1024;
constexpr size_t WS_LCNT = 192 * 1024;
constexpr size_t WS_EIDX = 2 * MiB;
constexpr size_t WS_RPOS = 2 * MiB + 512 * 1024;
constexpr size_t WS_GATE = 3 * MiB;
constexpr size_t WS_H = 8 * MiB;
constexpr size_t WS_VBT = 40 * MiB;
constexpr size_t WS_ELIST = 66 * MiB;
constexpr size_t WS_MLIST = 48 * MiB;
constexpr size_t WS_ML = 64 * MiB;
constexpr size_t WS_PROJ = 72 * MiB;
constexpr size_t WS_Y = 250 * MiB;
constexpr size_t WS_X1 = 314 * MiB;
constexpr size_t WS_XA = 378 * MiB;
constexpr size_t WS_QA = 442 * MiB;
constexpr size_t WS_KA = 458 * MiB;
constexpr size_t WS_QB = 474 * MiB;
constexpr size_t WS_KB = 490 * MiB;
constexpr size_t WS_QBB = 498 * MiB;
constexpr size_t WS_GA = 506 * MiB;
constexpr size_t WS_LA = 514 * MiB;
constexpr size_t WS_LB = 530 * MiB;
constexpr size_t WS_OA = 546 * MiB;
constexpr size_t WS_VA = 562 * MiB;
constexpr size_t WS_SC = 578 * MiB;
constexpr size_t WS_DEC = 586 * MiB;
constexpr size_t WS_LTA = 587 * MiB;
constexpr size_t WS_LTH = 588 * MiB;
constexpr size_t WS_LC = 589 * MiB;
constexpr int MOE_ROWS = 73728;
constexpr size_t WS_ST = 1490 * MiB;
constexpr size_t WS_PART = 1426 * MiB;
constexpr size_t WS_VB = 594 * MiB;
constexpr size_t WS_XS = 602 * MiB;
constexpr size_t WS_ACT = 738 * MiB;
constexpr size_t WS_YS = 882 * MiB;
constexpr size_t WS_WIN = 1026 * MiB;
constexpr size_t WS_WOUT = 1038 * MiB;
constexpr size_t WS_WUP = 1042 * MiB;
constexpr size_t WS_WDN = 1298 * MiB;
constexpr int LDS_BYTES = 147456;

struct Params {
  const float* in[33];
  float* out;
  char* ws;
};

constexpr int PDIN = 1296;
constexpr int PC_CQ = 0, PC_CK = 128, PC_CV = 256, PC_CG = 512, PC_CR = 528, PC_DX = 784, PC_DG = 1040;

__device__ __forceinline__ int bidx() { int b = blockIdx.x; asm volatile("" : "+s"(b)); return b; }
__device__ __forceinline__ int tidx() { int t = threadIdx.x; asm volatile("" : "+v"(t)); return t; }
__device__ __forceinline__ float wave_sum(float v) {
#pragma unroll
  for (int o = 1; o < 64; o <<= 1) v += __shfl_xor(v, o);
  return v;
}
__device__ __forceinline__ float sigmoidf_(float x) { return __builtin_amdgcn_rcpf(1.f + __builtin_amdgcn_exp2f(-1.4426950408889634f * x)); }
__device__ __forceinline__ float logsigmoidf_(float z) { return fminf(z, 0.f) - log1pf(__expf(-fabsf(z))); }
__device__ __forceinline__ float gelu_tanh(float x) {
  float u = 0.7978845608028654f * (x + 0.044715f * x * x * x);
  float t = 1.f - 2.f * __builtin_amdgcn_rcpf(__expf(2.f * u) + 1.f);
  return 0.5f * x * (1.f + t);
}
__device__ __forceinline__ float lam_init_of(int l) { return l == 0 ? 0.2f : (0.8f - 0.6f * 0.7408182206817179f); }
__device__ __forceinline__ float lam_of(const Params& p, int l) {
  float s1 = 0.f, s2 = 0.f;
  for (int i = 0; i < 32; ++i) {
    s1 += p.in[10][l * 32 + i] * p.in[11][l * 32 + i];
    s2 += p.in[12][l * 32 + i] * p.in[13][l * 32 + i];
  }
  return __expf(s1) - __expf(s2) + lam_init_of(l);
}

typedef unsigned short bf16raw;
__device__ __forceinline__ unsigned f2bf(float f) { unsigned u = __builtin_bit_cast(unsigned, f); return (u + 0x7fffu + ((u >> 16) & 1u)) >> 16; }
typedef float f32x2v_ __attribute__((ext_vector_type(2))); typedef __bf16 bf16x2v_ __attribute__((ext_vector_type(2)));
__device__ __forceinline__ unsigned pk2(float lo, float hi) { f32x2v_ v = {lo, hi}; bf16x2v_ b = __builtin_convertvector(v, bf16x2v_); return __builtin_bit_cast(unsigned, b); }
__device__ __forceinline__ float4 ld4bf(const unsigned short* p) { const uint2 u = *(const uint2*)p; return make_float4(__builtin_bit_cast(float, u.x << 16), __builtin_bit_cast(float, u.x & 0xffff0000u), __builtin_bit_cast(float, u.y << 16), __builtin_bit_cast(float, u.y & 0xffff0000u)); }
__device__ __forceinline__ float bf2f(unsigned short h) { return __builtin_bit_cast(float, (unsigned)h << 16); }

namespace pg8 {
#define PG8_LAS __attribute__((address_space(3)))
typedef unsigned short bf16_t;
typedef short bf16x8 __attribute__((ext_vector_type(8)));
typedef float f32x4 __attribute__((ext_vector_type(4)));
typedef unsigned u32x4 __attribute__((ext_vector_type(4)));
constexpr int BM = 256, BK = 64, HALF = 128, HTB = HALF * BK * 2  , STAGE_BYTES = 8 * HTB, NXCD = 8, WGM = 8;

__host__ __device__ __forceinline__ int lds_byte(int r, int c) { const int st = (r >> 4) * 2 + (c >> 5), rr = r & 15, cc = c & 31, ob = rr * 64 + cc * 2; return st * 1024 + (ob ^ (((ob >> 9) & 1) << 5)); }
__host__ __device__ __forceinline__ void stage_rc(int b, int& R, int& C) {
  const int bid0_ = bidx(); const int st = b / 1024, sb = b % 1024, swz = sb ^ (((sb >> 9) & 1) << 5); R = (st >> 1) * 16 + swz / 64; C = (st & 1) * 32 + (swz % 64) / 2; }
__host__ __device__ __forceinline__ int perm32(int rho) { const int n = rho >> 4, i = rho & 15; return 8 * (i >> 2) + 4 * n + (i & 3); }

struct Unit { int pm, pn; };
struct Gemm { const bf16_t* A; const bf16_t* Bt; int M, N, K; };

struct StaticOrder {
    int nM, nN, nwg, G, c;
    __host__ __device__ void init(int M, int N, int G_, int c_) { nM = M / BM; nN = N / BM; nwg = nM * nN; G = G_; c = c_; }
    __host__ __device__ bool next(int i, Unit& u) const {
        const long L = (long)i * G + c; if (L >= nwg) return false;
        int wgid = (int)L; { const int q = nwg / NXCD, r = nwg % NXCD, xcd = wgid % NXCD, off = wgid / NXCD; wgid = (xcd < r ? xcd * (q + 1) : r * (q + 1) + (xcd - r) * q) + off; }
        const int nig = WGM * nN, gid = wgid / nig, fm = gid * WGM, gsz = (nM - fm) < WGM ? (nM - fm) : WGM;
        u.pm = fm + ((wgid % nig) % gsz); u.pn = (wgid % nig) / gsz; return true;
    }
    __device__ __forceinline__ void a_ready(const Unit&) const {}
    __device__ __forceinline__ void done(const Unit&) const {}
};

__device__ __forceinline__ unsigned cvt_pk_bf16(float lo, float hi) { unsigned r; asm volatile("v_cvt_pk_bf16_f32 %0, %1, %2" : "=v"(r) : "v"(lo), "v"(hi)); return r; }
typedef float f32x2 __attribute__((ext_vector_type(2)));
template <class Epi, class Sched, bool ALIGN_EPI = false, bool SP2 = false, bool GATHER = false>
__device__ __forceinline__ void gemm_phase(PG8_LAS unsigned char* lds, const Gemm g, const Sched& S, const Epi& E, const unsigned* rowoff = nullptr) {
    static_assert(!GATHER || SP2, "row gather is wired into the SP2 loop only");
    const int tid = tidx(), wid = __builtin_amdgcn_readfirstlane(tid >> 6), lane = tid & 63, wr = wid >> 2, wc = wid & 3, fr = lane & 15, fq = lane >> 4;
    const int K = g.K, nt = K / BK;
    unsigned voffA[2], voffB[2]; int RA[2], CA[2];
#pragma unroll
    for (int i = 0; i < 2; ++i) { int R, C; stage_rc(tid * 16 + i * 8192, R, C); const int Rb = Epi::PERM ? ((R & ~31) + perm32(R & 31)) : R;
        voffA[i] = (unsigned)(R * K + C) * 2u; voffB[i] = (unsigned)(Rb * K + C) * 2u; RA[i] = R; CA[i] = C; }
    const size_t kstep = (size_t)(BK * 2);
    const size_t hstep = (size_t)HALF * K * 2;
    const size_t tstep = 2 * hstep;
    const unsigned ldsw = (unsigned)wid * 1024u;
    const int aoff = lds_byte(wr * 64 + fr, fq * 8), boff = lds_byte(wc * 32 + fr, fq * 8);
#define PG8_SA(b, h) (((b) * 2 + (h)) * HTB)
#define PG8_SB(b, h) ((4 + (b) * 2 + (h)) * HTB)
#define PG8_STAGE(bufoff, gbase, voff) do { _Pragma("unroll") for (int _i = 0; _i < 2; ++_i) \
        __builtin_amdgcn_global_load_lds((const unsigned*)((const char*)(gbase) + (voff)[_i]), (PG8_LAS unsigned*)(lds + (bufoff) + ldsw + _i * 8192), 16, 0, 0); } while (0)
#define PG8_STAGE2(bufoff, gbase, o0, o1) do { \
        __builtin_amdgcn_global_load_lds((const unsigned*)((const char*)(gbase) + (o0)), (PG8_LAS unsigned*)(lds + (bufoff) + ldsw), 16, 0, 0); \
        __builtin_amdgcn_global_load_lds((const unsigned*)((const char*)(gbase) + (o1)), (PG8_LAS unsigned*)(lds + (bufoff) + ldsw + 8192), 16, 0, 0); } while (0)
#define PG8_GOFF(dst, pm_) do { _Pragma("unroll") for (int _h = 0; _h < 2; ++_h) _Pragma("unroll") for (int _i = 0; _i < 2; ++_i) \
        dst[_h][_i] = rowoff[(pm_) * BM + _h * HALF + RA[_i]] + (unsigned)CA[_i] * 2u; } while (0)
#define PG8_LDA(dst, b, h) do { _Pragma("unroll") for (int m = 0; m < 4; ++m) _Pragma("unroll") for (int k = 0; k < 2; ++k) dst[m][k] = *(const PG8_LAS bf16x8*)(lds + PG8_SA(b, h) + aoff + m * 2048 + k * 1024); } while (0)
#define PG8_LDB(dst, b, h) do { _Pragma("unroll") for (int n = 0; n < 2; ++n) _Pragma("unroll") for (int k = 0; k < 2; ++k) dst[n][k] = *(const PG8_LAS bf16x8*)(lds + PG8_SB(b, h) + boff + n * 2048 + k * 1024); } while (0)
#define PG8_MMA(ai, bj, At, Bt) do { __builtin_amdgcn_s_setprio(1); _Pragma("unroll") for (int m = 0; m < 4; ++m) _Pragma("unroll") for (int n = 0; n < 2; ++n) _Pragma("unroll") for (int k = 0; k < 2; ++k) \
        acc[ai][bj][m][n] = __builtin_amdgcn_mfma_f32_16x16x32_bf16(Bt[n][k], At[m][k], acc[ai][bj][m][n], 0, 0, 0); __builtin_amdgcn_s_setprio(0); } while (0)
#define PG8_WAIT_V(n) asm volatile("s_waitcnt vmcnt(" #n ")" ::: "memory")
#define PG8_WAIT_L(n) asm volatile("s_waitcnt lgkmcnt(" #n ")" ::: "memory")
#define PG8_BAR __builtin_amdgcn_s_barrier()
#define PG8_SCHED __builtin_amdgcn_sched_barrier(0)
    Unit cur, nxt; int ui = 0;
    if (!S.next(0, cur)) return;
    f32x4 acc[2][2][4][2];
#pragma unroll
    for (int a = 0; a < 2; ++a)
#pragma unroll
        for (int b = 0; b < 2; ++b)
#pragma unroll
            for (int m = 0; m < 4; ++m)
#pragma unroll
                for (int n = 0; n < 2; ++n) acc[a][b][m][n] = (f32x4){0.f, 0.f, 0.f, 0.f};
    bf16x8 At[4][2], B0[2][2], B1[2][2];
    const char* cA = GATHER ? (const char*)g.A : (const char*)g.A + (size_t)cur.pm * tstep; const char* cB = (const char*)g.Bt + (size_t)cur.pn * tstep;
    unsigned vA[2][2], vN[2][2];
    if constexpr (GATHER) { PG8_GOFF(vA, 0); _Pragma("unroll") for (int _h = 0; _h < 2; ++_h) _Pragma("unroll") for (int _i = 0; _i < 2; ++_i) vN[_h][_i] = vA[_h][_i]; }
#define PG8_STA(bufoff, ptr, h, nx) do { if constexpr (GATHER) { PG8_STAGE2(bufoff, ptr, (nx) ? vN[h][0] : vA[h][0], (nx) ? vN[h][1] : vA[h][1]); } else { PG8_STAGE(bufoff, (ptr) + (h) * hstep, voffA); } } while (0)
    S.a_ready(cur);
    if constexpr (SP2) {
        PG8_STAGE(PG8_SB(0, 0), cB, voffB); PG8_STAGE(PG8_SB(0, 1), cB + hstep, voffB); PG8_STA(PG8_SA(0, 0), cA, 0, false); PG8_STA(PG8_SA(0, 1), cA, 1, false);
        if (wr == 1) PG8_BAR;
        PG8_WAIT_V(2); PG8_BAR;
        PG8_STAGE(PG8_SB(1, 0), cB + kstep, voffB); PG8_STA(PG8_SA(1, 0), cA + kstep, 0, false); PG8_STAGE(PG8_SB(1, 1), cB + hstep + kstep, voffB);
        PG8_WAIT_V(6); PG8_BAR;
    } else {
        PG8_STAGE(PG8_SB(0, 0), cB, voffB); PG8_STAGE(PG8_SA(0, 0), cA, voffA); PG8_STAGE(PG8_SB(0, 1), cB + hstep, voffB); PG8_STAGE(PG8_SA(0, 1), cA + hstep, voffA);
        if (wr == 1) PG8_BAR;
        PG8_WAIT_V(4); PG8_BAR;
        PG8_STAGE(PG8_SB(1, 0), cB + kstep, voffB); PG8_STA(PG8_SA(1, 0), cA + kstep, 0, false); PG8_STAGE(PG8_SB(1, 1), cB + hstep + kstep, voffB);
        PG8_WAIT_V(6); PG8_BAR;
    }
    for (;;) {
        const bool has_next = S.next(ui + 1, nxt);
        const char* nA = GATHER ? cA : (has_next ? (const char*)g.A + (size_t)nxt.pm * tstep : cA); const char* nB = has_next ? (const char*)g.Bt + (size_t)nxt.pn * tstep : cB;
        if constexpr (GATHER) { if (has_next) { PG8_GOFF(vN, ui + 1); } }
        for (int t = 0; t < nt; t += 2) {
            const bool last = (t == nt - 2);
            const char* a1 = cA + (size_t)(t + 1) * kstep;
            const char* a2 = last ? nA : cA + (size_t)(t + 2) * kstep; const bool nx_ = GATHER && last; const char* b2 = last ? nB : cB + (size_t)(t + 2) * kstep;
            const char* a3 = a2 + kstep; const char* b3 = b2 + kstep;
            if (last && has_next) S.a_ready(nxt);
            if constexpr (SP2) {
            PG8_LDB(B0, 0, 0); PG8_LDB(B1, 0, 1); PG8_SCHED; PG8_LDA(At, 0, 0); PG8_STA(PG8_SA(1, 1), a1, 1, false);
            PG8_WAIT_V(8); PG8_WAIT_L(0); PG8_BAR; PG8_MMA(0, 0, At, B0); PG8_MMA(0, 1, At, B1); PG8_BAR; PG8_SCHED;
            PG8_LDA(At, 0, 1); PG8_STAGE(PG8_SB(0, 0), b2, voffB); PG8_STAGE(PG8_SB(0, 1), b2 + hstep, voffB); PG8_STA(PG8_SA(0, 0), a2, 0, nx_);
            PG8_WAIT_V(8); PG8_WAIT_L(0); PG8_BAR; PG8_MMA(1, 0, At, B0); PG8_MMA(1, 1, At, B1); PG8_BAR; PG8_SCHED;
            PG8_LDB(B0, 1, 0); PG8_LDB(B1, 1, 1); PG8_SCHED; PG8_LDA(At, 1, 0); PG8_STA(PG8_SA(0, 1), a2, 1, nx_);
            PG8_WAIT_V(8); PG8_WAIT_L(0); PG8_BAR; PG8_MMA(0, 0, At, B0); PG8_MMA(0, 1, At, B1); PG8_BAR; PG8_SCHED;
            PG8_LDA(At, 1, 1); PG8_STAGE(PG8_SB(1, 0), b3, voffB); PG8_STAGE(PG8_SB(1, 1), b3 + hstep, voffB); PG8_STA(PG8_SA(1, 0), a3, 0, nx_);
            PG8_WAIT_V(8); PG8_WAIT_L(0); PG8_BAR; PG8_MMA(1, 0, At, B0); PG8_MMA(1, 1, At, B1); PG8_BAR; PG8_SCHED;
            } else {
            PG8_LDB(B0, 0, 0); PG8_SCHED; PG8_LDA(At, 0, 0); PG8_STA(PG8_SA(1, 1), a1, 1, false);
            PG8_WAIT_L(8); PG8_BAR; PG8_WAIT_L(0); PG8_MMA(0, 0, At, B0); PG8_BAR; PG8_SCHED;
            PG8_LDB(B1, 0, 1); PG8_STAGE(PG8_SB(0, 0), b2, voffB);
            PG8_BAR; PG8_WAIT_L(0); PG8_MMA(0, 1, At, B1); PG8_BAR;
            PG8_LDA(At, 0, 1); PG8_STA(PG8_SA(0, 0), a2, 0, nx_);
            PG8_BAR; PG8_WAIT_L(0); PG8_MMA(1, 0, At, B0); PG8_BAR; PG8_SCHED;
            PG8_STAGE(PG8_SB(0, 1), b2 + hstep, voffB);
            PG8_WAIT_V(6); PG8_BAR; PG8_MMA(1, 1, At, B1); PG8_BAR;
            PG8_LDB(B0, 1, 0); PG8_SCHED; PG8_LDA(At, 1, 0); PG8_STA(PG8_SA(0, 1), a2, 1, nx_);
            PG8_WAIT_L(8); PG8_BAR; PG8_WAIT_L(0); PG8_MMA(0, 0, At, B0); PG8_BAR; PG8_SCHED;
            PG8_LDB(B1, 1, 1); PG8_STAGE(PG8_SB(1, 0), b3, voffB);
            PG8_BAR; PG8_WAIT_L(0); PG8_MMA(0, 1, At, B1); PG8_BAR;
            PG8_LDA(At, 1, 1); PG8_STA(PG8_SA(1, 0), a3, 0, nx_);
            PG8_BAR; PG8_WAIT_L(0); PG8_MMA(1, 0, At, B0); PG8_BAR; PG8_SCHED;
            PG8_STAGE(PG8_SB(1, 1), b3 + hstep, voffB);
            PG8_WAIT_V(6); PG8_BAR; PG8_MMA(1, 1, At, B1); PG8_BAR;
            }
        }
        if constexpr (ALIGN_EPI) { if (wr == 0) PG8_BAR; }
        if constexpr (!Epi::AFTER_DRAIN) { E(acc, cur, wr, wc, fr, fq); S.done(cur); }
        if (!has_next) break;
#pragma unroll
        for (int a = 0; a < 2; ++a)
#pragma unroll
            for (int b = 0; b < 2; ++b)
#pragma unroll
                for (int m = 0; m < 4; ++m)
#pragma unroll
                    for (int n = 0; n < 2; ++n) acc[a][b][m][n] = (f32x4){0.f, 0.f, 0.f, 0.f};
        cur = nxt; cA = nA; cB = nB; ++ui;
        if constexpr (GATHER) { _Pragma("unroll") for (int _h = 0; _h < 2; ++_h) _Pragma("unroll") for (int _i = 0; _i < 2; ++_i) vA[_h][_i] = vN[_h][_i]; }
        if constexpr (ALIGN_EPI) { if (wr == 1) PG8_BAR; }
    }
    PG8_WAIT_V(0);
    if constexpr (!ALIGN_EPI) { if (wr == 0) PG8_BAR; }
    PG8_BAR;
    if constexpr (Epi::AFTER_DRAIN) { E.fused(acc, cur, wr, wc, fr, fq, lds, wid, lane); S.done(cur); }
#undef PG8_SA
#undef PG8_SB
#undef PG8_STAGE
#undef PG8_STAGE2
#undef PG8_GOFF
#undef PG8_STA
#undef PG8_LDA
#undef PG8_LDB
#undef PG8_MMA
#undef PG8_WAIT_V
#undef PG8_WAIT_L
#undef PG8_BAR
#undef PG8_SCHED
}
}

namespace pg8 {
struct EpiInproj {
  static constexpr bool PERM = true, AFTER_DRAIN = false;
  bf16_t* QAb; bf16_t* KAb; bf16_t* VAb;
  float* QB; bf16_t* QBb; bf16_t* KBb; bf16_t* VB; float* KMP;
  bf16_t* P2;
  const float* aqg; const float* akg; const float* bqg; const float* bkg; float c2;
  __device__ __forceinline__ static u32x4 pk8(const f32x4& a, const f32x4& b) { u32x4 w; w.x = cvt_pk_bf16(a[0], a[1]); w.y = cvt_pk_bf16(a[2], a[3]); w.z = cvt_pk_bf16(b[0], b[1]); w.w = cvt_pk_bf16(b[2], b[3]); return w; }
  __device__ __forceinline__ void operator()(const f32x4 (&acc)[2][2][4][2], const Unit& u, int wr, int wc, int fr, int fq) const {
    const int row0 = u.pm * BM + wr * 64 + fr, t = u.pn;
    if (t >= 6) {
      const int col0 = (t - 6) * BM + wc * 32 + 8 * fq;
#pragma unroll
      for (int ai = 0; ai < 2; ++ai)
#pragma unroll
        for (int m = 0; m < 4; ++m) {
          bf16_t* rp = P2 + (size_t)(row0 + ai * HALF + m * 16) * 1296;
#pragma unroll
          for (int bj = 0; bj < 2; ++bj) { const int col = col0 + bj * HALF; if (col < 1296) *(u32x4*)(rp + col) = pk8(acc[ai][bj][m][0], acc[ai][bj][m][1]); }
        }
    } else if (t <= 1) {
      const float* gp = (t == 0 ? aqg : akg) + 8 * fq;
      const f32x4 g0 = *(const f32x4*)gp, g1 = *(const f32x4*)(gp + 4);
      bf16_t* dst = t == 0 ? QAb : KAb;
      const float sc = t == 0 ? c2 : 1.f;
#pragma unroll
      for (int ai = 0; ai < 2; ++ai)
#pragma unroll
        for (int m = 0; m < 4; ++m)
#pragma unroll
          for (int bj = 0; bj < 2; ++bj) {
            const f32x4 v0 = acc[ai][bj][m][0], v1 = acc[ai][bj][m][1];
            float ss = (v0[0] * v0[0] + v0[1] * v0[1]) + (v0[2] * v0[2] + v0[3] * v0[3]) + (v1[0] * v1[0] + v1[1] * v1[1]) + (v1[2] * v1[2] + v1[3] * v1[3]);
            ss += __shfl_xor(ss, 16); ss += __shfl_xor(ss, 32);
            const float r = rsqrtf(ss * (1.f / 32.f) + 1e-6f) * sc;
            bf16_t* o = dst + (size_t)(row0 + ai * HALF + m * 16) * 512 + (bj * 4 + wc) * 64 + 8 * fq;
            *(u32x4*)o = pk8(v0 * g0 * r, v1 * g1 * r);
          }
    } else if (t == 2) {
#pragma unroll
      for (int ai = 0; ai < 2; ++ai)
#pragma unroll
        for (int m = 0; m < 4; ++m)
#pragma unroll
          for (int bj = 0; bj < 2; ++bj) {
            const u32x4 w = pk8(acc[ai][bj][m][0], acc[ai][bj][m][1]);
            *(u32x4*)(VAb + (size_t)(row0 + ai * HALF + m * 16) * 256 + bj * HALF + wc * 32 + 8 * fq) = w;
          }
    } else if (t == 5) {
#pragma unroll
      for (int ai = 0; ai < 2; ++ai)
#pragma unroll
        for (int m = 0; m < 4; ++m)
#pragma unroll
          for (int bj = 0; bj < 2; ++bj)
            *(u32x4*)(VB + (size_t)(row0 + ai * HALF + m * 16) * 256 + bj * HALF + wc * 32 + 8 * fq) = pk8(acc[ai][bj][m][0], acc[ai][bj][m][1]);
    } else {
      const float* gp = (t == 3 ? bqg : bkg) + 8 * fq;
      f32x4 g[2][2];
#pragma unroll
      for (int bj = 0; bj < 2; ++bj) { g[bj][0] = *(const f32x4*)(gp + 32 * bj); g[bj][1] = *(const f32x4*)(gp + 32 * bj + 4); }
#pragma unroll
      for (int ai = 0; ai < 2; ++ai) {
        f32x4 cs[2][2];
#pragma unroll
        for (int bj = 0; bj < 2; ++bj) { cs[bj][0] = (f32x4){0.f, 0.f, 0.f, 0.f}; cs[bj][1] = (f32x4){0.f, 0.f, 0.f, 0.f}; }
#pragma unroll
        for (int m = 0; m < 4; ++m) {
          float ss = 0.f;
#pragma unroll
          for (int bj = 0; bj < 2; ++bj)
#pragma unroll
            for (int n = 0; n < 2; ++n) { const f32x4 v = acc[ai][bj][m][n]; ss += (v[0] * v[0] + v[1] * v[1]) + (v[2] * v[2] + v[3] * v[3]); }
          ss += __shfl_xor(ss, 16); ss += __shfl_xor(ss, 32);
          const float r = rsqrtf(ss * (1.f / 64.f) + 1e-6f);
          const size_t ro = (size_t)(row0 + ai * HALF + m * 16) * 256 + wc * 64 + 8 * fq;
#pragma unroll
          for (int bj = 0; bj < 2; ++bj) {
            const f32x4 n0 = acc[ai][bj][m][0] * g[bj][0] * r, n1 = acc[ai][bj][m][1] * g[bj][1] * r;
            if (t == 3) {
              *(f32x4*)(QB + ro + 32 * bj) = n0; *(f32x4*)(QB + ro + 32 * bj + 4) = n1;
              const float qs = 0.125f * 1.4426950408889634f;
              *(u32x4*)(QBb + ro + 32 * bj) = pk8(n0 * qs, n1 * qs);
            } else {
              *(u32x4*)(KBb + ro + 32 * bj) = pk8(n0, n1);
              cs[bj][0] += n0; cs[bj][1] += n1;
            }
          }
        }
        if (t == 4) {
#pragma unroll
          for (int bj = 0; bj < 2; ++bj)
#pragma unroll
            for (int n = 0; n < 2; ++n)
#pragma unroll
              for (int j = 0; j < 4; ++j) { float v = cs[bj][n][j]; v += __shfl_xor(v, 1); v += __shfl_xor(v, 2); v += __shfl_xor(v, 4); v += __shfl_xor(v, 8); cs[bj][n][j] = v; }
          if (fr == 0) {
            float* kp = KMP + (size_t)(u.pm * 4 + ai * 2 + wr) * 256 + wc * 64 + 8 * fq;
#pragma unroll
            for (int bj = 0; bj < 2; ++bj) { *(f32x4*)(kp + 32 * bj) = cs[bj][0]; *(f32x4*)(kp + 32 * bj + 4) = cs[bj][1]; }
          }
        }
      }
    }
  }
};
struct EpiOutproj {
  static constexpr bool PERM = true, AFTER_DRAIN = false;
  const float* xin32; const bf16_t* xin16; const float* g1; bf16_t* X1;
  __device__ __forceinline__ void operator()(const f32x4 (&acc)[2][2][4][2], const Unit& u, int wr, int wc, int fr, int fq) const {
    const int row0 = u.pm * BM + wr * 64 + fr, col0 = u.pn * BM + wc * 32 + 8 * fq;
#pragma unroll
    for (int bj = 0; bj < 2; ++bj) {
      const int col = col0 + bj * HALF;
      const f32x4 g0 = *(const f32x4*)(g1 + col), g1v = *(const f32x4*)(g1 + col + 4);
#pragma unroll
      for (int ai = 0; ai < 2; ++ai)
#pragma unroll
        for (int m = 0; m < 4; ++m) {
          const size_t off = (size_t)(row0 + ai * HALF + m * 16) * 1024 + col;
          f32x4 x0, x1;
          if (xin32) { x0 = *(const f32x4*)(xin32 + off); x1 = *(const f32x4*)(xin32 + off + 4); }
          else {
            const u32x4 w = *(const u32x4*)(xin16 + off);
            x0 = (f32x4){__builtin_bit_cast(float, w.x << 16), __builtin_bit_cast(float, w.x & 0xffff0000u), __builtin_bit_cast(float, w.y << 16), __builtin_bit_cast(float, w.y & 0xffff0000u)};
            x1 = (f32x4){__builtin_bit_cast(float, w.z << 16), __builtin_bit_cast(float, w.z & 0xffff0000u), __builtin_bit_cast(float, w.w << 16), __builtin_bit_cast(float, w.w & 0xffff0000u)};
          }
          const f32x4 v0 = x0 + g0 * acc[ai][bj][m][0], v1 = x1 + g1v * acc[ai][bj][m][1];
          u32x4 o; o.x = cvt_pk_bf16(v0[0], v0[1]); o.y = cvt_pk_bf16(v0[2], v0[3]); o.z = cvt_pk_bf16(v1[0], v1[1]); o.w = cvt_pk_bf16(v1[2], v1[3]);
          *(u32x4*)(X1 + off) = o;
        }
    }
  }
};
struct EpiUp {
  static constexpr bool PERM = true, AFTER_DRAIN = false;
  __amdgpu_buffer_rsrc_t act;
  const float* bup;
  __device__ __forceinline__ void operator()(const f32x4 (&acc)[2][2][4][2], const Unit& u, int wr, int wc, int fr, int fq) const {
    const int e = u.pn >> 3, j = u.pn & 7;
    const int row0 = u.pm * BM + wr * 64 + fr, col0 = j * 128 + wc * 32 + 8 * fq;
    const float* bg = bup + (size_t)e * 2048 + col0; const float* bl = bg + 1024;
    f32x4 bgv[2], blv[2];
#pragma unroll
    for (int n = 0; n < 2; ++n) { bgv[n] = *(const f32x4*)(bg + 4 * n); blv[n] = *(const f32x4*)(bl + 4 * n); }
#pragma unroll
    for (int ai = 0; ai < 2; ++ai)
#pragma unroll
      for (int m = 0; m < 4; ++m) {
        float o[8];
#pragma unroll
        for (int n = 0; n < 2; ++n) {
          const f32x4 gg = acc[ai][0][m][n] + bgv[n], ll = acc[ai][1][m][n] + blv[n];
#pragma unroll
          for (int c = 0; c < 4; ++c) {
            float g = fminf(gg[c], 7.f), lin = fminf(fmaxf(ll[c], -7.f), 7.f);
            float glu = g * __builtin_amdgcn_rcpf(1.f + __builtin_amdgcn_exp2f(-1.702f * 1.4426950408889634f * g));
            o[n * 4 + c] = (lin + 1.f) * glu;
          }
        }
        u32x4 w; w.x = cvt_pk_bf16(o[0], o[1]); w.y = cvt_pk_bf16(o[2], o[3]); w.z = cvt_pk_bf16(o[4], o[5]); w.w = cvt_pk_bf16(o[6], o[7]);
        __builtin_amdgcn_raw_buffer_store_b128(w, act, (unsigned)(((row0 + ai * HALF + m * 16) * 1024 + col0) * 2), 0,   16);
      }
  }
};
struct EpiDown {
  static constexpr bool PERM = true, AFTER_DRAIN = false;
  bf16_t* YS; const float* bdn;
  __device__ __forceinline__ void operator()(const f32x4 (&acc)[2][2][4][2], const Unit& u, int wr, int wc, int fr, int fq) const {
    const int e = u.pn >> 2, j = u.pn & 3;
    const int row0 = u.pm * BM + wr * 64 + fr, col0 = j * 256 + wc * 32 + 8 * fq;
    f32x4 bv[2][2];
#pragma unroll
    for (int bj = 0; bj < 2; ++bj)
#pragma unroll
      for (int n = 0; n < 2; ++n) bv[bj][n] = *(const f32x4*)(bdn + (size_t)e * 1024 + col0 + bj * HALF + 4 * n);
#pragma unroll
    for (int ai = 0; ai < 2; ++ai)
#pragma unroll
      for (int m = 0; m < 4; ++m) {
        bf16_t* rp = YS + (size_t)(row0 + ai * HALF + m * 16) * 1024 + col0;
#pragma unroll
        for (int bj = 0; bj < 2; ++bj) {
          const f32x4 v0 = acc[ai][bj][m][0] + bv[bj][0], v1 = acc[ai][bj][m][1] + bv[bj][1];
          u32x4 w; w.x = cvt_pk_bf16(v0[0], v0[1]); w.y = cvt_pk_bf16(v0[2], v0[3]); w.z = cvt_pk_bf16(v1[0], v1[1]); w.w = cvt_pk_bf16(v1[2], v1[3]);
          *(u32x4*)(rp + bj * HALF) = w;
        }
      }
  }
};
#ifndef MOE_ORDER
#define MOE_ORDER 0
#endif
template <int NJ> __device__ __forceinline__ void moe_build_units(const int* cnt, int G, int c, int* tab, int tid, bool rotate = false) {
  if (tid < 24) {
    int pm = -1, pn = -1, ex = 0, r0 = 0;
    {
      int cc = c;
      if (rotate) {
        int T = 0; for (int e = 0; e < 32; ++e) T += (cnt[e] + 255) >> 8;
        int r8 = 8 * T; while (r8 >= G) r8 -= G;
        cc = c - r8; if (cc < 0) cc += G;
      }
      const long L = (long)tid * G + cc; const int t = (int)(L / NJ);
      int acc = 0;
      for (int e = 0; e < 32; ++e) {
        const int ne = (cnt[e] + 255) >> 8;
        if (pm < 0 && t < acc + ne) { pm = t; pn = e * NJ + (int)(L % NJ); ex = e; r0 = (t - acc) << 8; }
        acc += ne;
      }
    }
    tab[4 * tid] = pm; tab[4 * tid + 1] = pn; tab[4 * tid + 2] = ex; tab[4 * tid + 3] = r0;
  }
  __syncthreads();
}
__device__ __forceinline__ void moe_build_rowoff(const int* elist, const int* cnt, const int* tab, unsigned* rowoff, int tid) {
  for (int i = tid; i < 13 * 256; i += 512) {
    const int u = i >> 8, pm = tab[4 * u];
    unsigned v = 0u;
    if (pm >= 0) { const int e = tab[4 * u + 2], r = tab[4 * u + 3] + (i & 255); if (r < cnt[e]) v = (unsigned)elist[e * 16384 + r] * 2048u; }
    rowoff[i] = v;
  }
  __syncthreads();
}
template <int NJ, int MODE = 0> struct MoeOrder {
  const int* tab;
  unsigned* rdy;
  __device__ __forceinline__ bool next(int i, Unit& u) const {
    if (i >= 24) return false;
    const int pm = tab[4 * i]; if (pm < 0) return false;
    u.pm = pm; u.pn = tab[4 * i + 1]; return true;
  }
  __device__ __forceinline__ void a_ready(const Unit& u) const {
    if constexpr (MODE == 2) {
      if (threadIdx.x < 64) {
        unsigned polls = 0;
        while ((unsigned)__builtin_amdgcn_readfirstlane(__hip_atomic_load(rdy + u.pm, __ATOMIC_RELAXED, __HIP_MEMORY_SCOPE_AGENT)) < 64u) {
          if (++polls > (1u << 22)) break;
          __builtin_amdgcn_s_sleep(2);
        }
        __builtin_amdgcn_fence(__ATOMIC_ACQUIRE, "agent");
        asm volatile("s_waitcnt vmcnt(0)" ::: "memory");
      }
      asm volatile("" ::: "memory"); __builtin_amdgcn_s_barrier(); asm volatile("" ::: "memory");
    }
  }
  __device__ __forceinline__ void done(const Unit& u) const {
    if constexpr (MODE == 1) {
      asm volatile("s_waitcnt vmcnt(0)" ::: "memory");
      if ((threadIdx.x & 63) == 0) __hip_atomic_fetch_add(rdy + u.pm, 1u, __ATOMIC_RELAXED, __HIP_MEMORY_SCOPE_AGENT);
    }
  }
};
}

#include <hip/hip_bf16.h>
#include <cmath>
namespace attn_body {
using bf16=__hip_bfloat16;
using bf16x8=__attribute__((ext_vector_type(8)))short;
using s16x4=__attribute__((ext_vector_type(4)))short;
using f32x16=__attribute__((ext_vector_type(16)))float;
using u32x4=__attribute__((ext_vector_type(4)))unsigned;
constexpr int BATCH=1,NHEAD=8,SEQ=16384,D=64,DM=NHEAD*D;
constexpr int NW=8,QBLK=32,QB=QBLK*NW,KVBLK=64,NQB=SEQ/QB;
constexpr int ATTN_PITCH=DM, ATTN_UNIT_ROWS=QB;
__device__ __forceinline__ int crow(int r,int hi){return (r&3)+8*(r>>2)+4*hi;}
#define SBAR() __builtin_amdgcn_sched_barrier(0)
__device__ __forceinline__ void cmask(f32x16&p0,f32x16&p1,int jb,int qrel,int hi){
  const float NEG=-INFINITY; int kb=64*jb+4*hi;
  #pragma unroll
  for(int r=0;r<16;++r){int kv=kb+(r&3)+8*(r>>2); if(kv>qrel)p0[r]=NEG; if(kv+32>qrel)p1[r]=NEG;}
}

constexpr int NSLOT=3, SLOTB=8192;
constexpr int LDS_K=0, LDS_V=NSLOT*SLOTB, LDS_WS=2*NSLOT*SLOTB, LDS_OST=LDS_WS+NW*64*4, LDS_BYTES=LDS_OST+NW*4096;
constexpr float C2=0.17677669529663687f*1.4426950408889634f;
__device__ __forceinline__ void glds16(const void*gsrc,unsigned lds_dst){unsigned keep;
  asm volatile("s_mov_b32 %0, m0\n\ts_mov_b32 m0, %2\n\ts_nop 0\n\tglobal_load_lds_dwordx4 %1, off\n\ts_mov_b32 m0, %0":"=&s"(keep):"v"(gsrc),"s"(lds_dst):"memory");}
__device__ __forceinline__ float max3f(float a,float b,float c){float r;asm("v_max3_f32 %0, %1, %2, %3":"=v"(r):"v"(a),"v"(b),"v"(c));return r;}
__device__ __forceinline__ float max2f(float a,float b){float r;asm("v_max_f32_e32 %0, %1, %2":"=v"(r):"v"(a),"v"(b));return r;}
__device__ __forceinline__ float fadd_s(float a,float b){float r;asm("v_add_f32_e32 %0, %1, %2":"=v"(r):"v"(a),"v"(b));return r;}
__device__ __forceinline__ float fsub_s(float a,float b){float r;asm("v_sub_f32_e32 %0, %1, %2":"=v"(r):"v"(a),"v"(b));return r;}
typedef float f32x2_t __attribute__((ext_vector_type(2))); typedef __bf16 bf16x2_t __attribute__((ext_vector_type(2)));
__device__ __forceinline__ unsigned cvtpk_s(float lo,float hi){f32x2_t v={lo,hi};bf16x2_t b=__builtin_convertvector(v,bf16x2_t);return __builtin_bit_cast(unsigned,b);}
#define WAIT_BAR(N) asm volatile("s_waitcnt vmcnt(" #N ") lgkmcnt(0)\n\ts_barrier":::"memory")

__device__ __forceinline__ void qkt(f32x16&p0,f32x16&p1,const char*Kslot,const bf16x8*qr,const f32x16&negm,int r32,int hi){
  const char*kb=Kslot+hi*1024+r32*16;
  #pragma unroll
  for(int d0=0;d0<2;++d0){
    const bf16x8 b0=*reinterpret_cast<const bf16x8*>(kb+d0*2048);
    const bf16x8 b1=*reinterpret_cast<const bf16x8*>(kb+d0*2048+512);
    if(d0==0){p0=__builtin_amdgcn_mfma_f32_32x32x16_bf16(b0,qr[0],negm,0,0,0);p1=__builtin_amdgcn_mfma_f32_32x32x16_bf16(b1,qr[0],negm,0,0,0);}
    else{p0=__builtin_amdgcn_mfma_f32_32x32x16_bf16(b0,qr[d0],p0,0,0,0);p1=__builtin_amdgcn_mfma_f32_32x32x16_bf16(b1,qr[d0],p1,0,0,0);}}
}
typedef __attribute__((address_space(3))) const char* lds_cptr;
typedef short v4i16_t __attribute__((ext_vector_type(4)));
__device__ __forceinline__ void kload8(bf16x8*kf,lds_cptr kp){
  kf[0]=*(const __attribute__((address_space(3))) bf16x8*)(kp);      kf[1]=*(const __attribute__((address_space(3))) bf16x8*)(kp+512);
  kf[2]=*(const __attribute__((address_space(3))) bf16x8*)(kp+2048); kf[3]=*(const __attribute__((address_space(3))) bf16x8*)(kp+2560);
  kf[4]=*(const __attribute__((address_space(3))) bf16x8*)(kp+4096); kf[5]=*(const __attribute__((address_space(3))) bf16x8*)(kp+4608);
  kf[6]=*(const __attribute__((address_space(3))) bf16x8*)(kp+6144); kf[7]=*(const __attribute__((address_space(3))) bf16x8*)(kp+6656);
}
__device__ __forceinline__ void kload2(bf16x8*kf,lds_cptr kp,int j){ kf[2*j]=*(const __attribute__((address_space(3))) bf16x8*)(kp+j*2048); kf[2*j+1]=*(const __attribute__((address_space(3))) bf16x8*)(kp+j*2048+512); }
__device__ __forceinline__ s16x4 vtr(lds_cptr p){ return __builtin_bit_cast(s16x4,__builtin_amdgcn_ds_read_tr16_b64_v4i16((__attribute__((address_space(3))) v4i16_t*)p)); }
__device__ __forceinline__ float rowmax(const f32x16&p0,const f32x16&p1){
  float a=max3f(p0[0],p0[1],p1[0]),b=max3f(p0[2],p0[3],p1[1]);a=max3f(a,p1[2],p1[3]);
  #pragma unroll
  for(int r=4;r<16;r+=4){a=max3f(a,p0[r],p0[r+1]);b=max3f(b,p0[r+2],p0[r+3]);a=max3f(a,p1[r],p1[r+1]);b=max3f(b,p1[r+2],p1[r+3]);}
  const float m=max2f(a,b);
  auto rr=__builtin_amdgcn_permlane32_swap(__float_as_uint(m),__float_as_uint(m),false,false);
  return max2f(__uint_as_float(rr[0]),__uint_as_float(rr[1]));
}
__device__ __forceinline__ void pv(f32x16*o,int vb,bf16x8 pa0,bf16x8 pa1,bf16x8 pa2,bf16x8 pa3){
  #pragma unroll
  for(int d0=0;d0<2;++d0){s16x4 lo[4],hi[4];
    #pragma unroll
    for(int ks=0;ks<4;++ks){
      asm volatile("ds_read_b64_tr_b16 %0,%1 offset:%c2":"=&v"(lo[ks]):"v"(vb),"i"(d0*4096+ks*1024):"memory");
      asm volatile("ds_read_b64_tr_b16 %0,%1 offset:%c2":"=&v"(hi[ks]):"v"(vb),"i"(d0*4096+ks*1024+512):"memory");}
    asm volatile("s_waitcnt lgkmcnt(0)":::"memory");SBAR();
    #define PK(k) (bf16x8){lo[k][0],lo[k][1],lo[k][2],lo[k][3],hi[k][0],hi[k][1],hi[k][2],hi[k][3]}
    o[d0]=__builtin_amdgcn_mfma_f32_32x32x16_bf16(pa0,PK(0),o[d0],0,0,0);
    o[d0]=__builtin_amdgcn_mfma_f32_32x32x16_bf16(pa1,PK(1),o[d0],0,0,0);
    o[d0]=__builtin_amdgcn_mfma_f32_32x32x16_bf16(pa2,PK(2),o[d0],0,0,0);
    o[d0]=__builtin_amdgcn_mfma_f32_32x32x16_bf16(pa3,PK(3),o[d0],0,0,0);
    #undef PK
  }
}

#ifndef ATTN_STORE16
#define ATTN_STORE16(p,v) (*(u32x4*)(p)=(v))
#endif
template<int THRL> __device__ __forceinline__ void attn_unit(int b,int h,int qb,const bf16*Q,const bf16*__restrict__ K,const bf16*__restrict__ V,bf16*O,char*shm,const bf16*ATTN_ZERO16){
  const int tid=tidx(),lane=tid&63,r32=lane&31,hi=lane>>5; const int wid=__builtin_amdgcn_readfirstlane(tid>>6);
  const long rowbase=(long)b*SEQ; const int q0=qb*QB;
  const bf16*Qw=Q+(rowbase+q0+wid*QBLK)*DM+h*D;
  constexpr int VP=DM/2;
  const bf16*Kh=K+rowbase*DM+h*D,*Vh=V+rowbase*VP+(h>>1)*D;
  const unsigned lds0=(unsigned)(uintptr_t)shm;
  float*wsf=(float*)(shm+LDS_WS)+wid*64;
  const bf16*ksrc=(wid<4)?Kh+(long)lane*DM+wid*8:ATTN_ZERO16; const long kstep_=(wid<4)?(long)KVBLK*DM:0L;
  const bf16*vsrc=Vh+(long)(16*(wid&3)+(lane>>2))*VP+(wid>>2)*32+(lane&3)*8;
  const unsigned kdst=lds0+LDS_K+wid*1024, vdst=lds0+LDS_V+wid*1024;
  #define DMA_K(t,slot) glds16(ksrc+(long)(t)*kstep_,(unsigned)__builtin_amdgcn_readfirstlane(kdst+(slot)))
  #define DMA_V(t,slot) glds16(vsrc+(long)(t)*KVBLK*VP,(unsigned)__builtin_amdgcn_readfirstlane(vdst+(slot)))
  const int vb0=(int)(lds0+LDS_V)+((lane>>4)&1)*32+(lane&3)*8+(4*hi+((lane&15)>>2))*64;
  const char*Kbase=shm+LDS_K; bf16x8 kf[8];
  const lds_cptr shm3=(lds_cptr)shm; const lds_cptr kp0=shm3+LDS_K+hi*1024+r32*16; const lds_cptr vp0=shm3+LDS_V+((lane>>4)&1)*32+(lane&3)*8+(4*hi+((lane&15)>>2))*64;
  const int NT=(q0+QB)/KVBLK;
  DMA_K(0,0);DMA_V(0,0);DMA_K(1,SLOTB);
  bf16x8 qr[4];
  #pragma unroll
  for(int d0=0;d0<4;++d0)qr[d0]=*reinterpret_cast<const bf16x8*>(&Qw[(long)r32*DM+d0*16+hi*8]);
  float mhat=0.f,l_reg=0.f;f32x16 o[2];o[0]=f32x16{};o[1]=f32x16{};f32x16 negm=f32x16{};asm volatile("":"+v"(negm));
  const int qrel=wid*QBLK+r32;
  #define CMASK(P0,P1,t) do{int jb_=(t)-(NT-4); if(jb_>=0)cmask(P0,P1,jb_,qrel,hi);}while(0)
  bool resc=false;
  #define START(P0,P1) do{ const float rm=rowmax(P0,P1); resc=false; \
    { const float dl=rm; mhat=fadd_s(mhat,dl); \
      _Pragma("unroll") for(int r=0;r<16;++r){P0[r]=fsub_s(P0[r],dl);P1[r]=fsub_s(P1[r],dl);} \
      _Pragma("unroll") for(int r=0;r<16;++r)negm[r]=-mhat; asm volatile("":"+v"(negm)); } \
    _Pragma("unroll") for(int r=0;r<16;++r)P0[r]=__builtin_amdgcn_exp2f(P0[r]); }while(0)
  #define RESC() do{ if(resc){ asm volatile("s_waitcnt lgkmcnt(0)":::"memory"); \
      _Pragma("unroll") for(int d_=0;d_<2;++d_) _Pragma("unroll") for(int r=0;r<16;++r)o[d_][r]*=wsf[crow(r,hi)]; } }while(0)
  f32x16 pA0,pA1,pB0,pB1;
  int sl_prev=0,sl_cur=0,sl_next=SLOTB;
  #define ROT() do{sl_prev=sl_cur;sl_cur=sl_next;sl_next=(sl_next==(NSLOT-1)*SLOTB)?0:sl_next+SLOTB;}while(0)
  DMA_K(2,2*SLOTB);
  WAIT_BAR(3);
  qkt(pA0,pA1,Kbase,qr,negm,r32,hi);asm volatile("s_nop 15\n\ts_nop 7":"+v"(pA0),"+v"(pA1));CMASK(pA0,pA1,0);
  START(pA0,pA1);
  _Pragma("unroll") for(int r=0;r<16;++r)pA1[r]=__builtin_amdgcn_exp2f(pA1[r]);
  WAIT_BAR(0);
  DMA_K(3,0);DMA_V(1,SLOTB);
  ROT();
  kload8(kf,kp0+sl_cur);
  WAIT_BAR(2);
  s16x4 vlo[8],vhi[8]; u32x4 pw0,pw1,pw2,pw3;
  #define PKW(P,B) cvtpk_s(P[B],P[B+1])
  #define PAF(k) __builtin_bit_cast(bf16x8,pw##k)
  #define VFR(i) (bf16x8){vlo[i][0],vlo[i][1],vlo[i][2],vlo[i][3],vhi[i][0],vhi[i][1],vhi[i][2],vhi[i][3]}
  #define PIN(x) asm volatile("":"+v"(x))
  #define MX3(a,b,c) __builtin_fmaxf(__builtin_fmaxf((a),(b)),(c))
  #define GAPA(MF,A0,A1,A2,A3,W0,W1,PW) do{ MF; sacc+=A0; sacc+=A1; sacc+=A2; sacc+=A3; PIN(sacc); W0; W1; PIN(PW); SBAR(); }while(0)
  #define EX(v) __builtin_amdgcn_exp2f(v)
  #define GAPB(MF,X,B) do{ MF; X[B]=EX(X[B]); X[B+1]=EX(X[B+1]); X[B+2]=EX(X[B+2]); X[B+3]=EX(X[B+3]); PIN(X); SBAR(); }while(0)
  #define VRD(i) do{ vlo[i]=vtr(vp_+(((i)>>2)*4096+((i)&3)*1024)); vhi[i]=vtr(vp_+(((i)>>2)*4096+((i)&3)*1024+512)); }while(0)
  #define KRD(G,j) do{ if(G){ kload2(kf,kp0+sl_next,j); SBAR(); } }while(0)
  #define STEP(C0,C1,P0,P1,t,GK,GV,GL) do{ SBAR(); \
    const lds_cptr vp_=vp0+sl_prev; \
    VRD(0); SBAR(); float sacc=(P0[0]+P0[1]); \
    GAPA(C0=__builtin_amdgcn_mfma_f32_32x32x16_bf16(kf[0],qr[0],negm,0,0,0), P0[2],P0[3],P0[4],P0[5],     pw0[0]=PKW(P0,0), pw0[1]=PKW(P0,2), pw0); \
    VRD(4); SBAR(); GAPA(C1=__builtin_amdgcn_mfma_f32_32x32x16_bf16(kf[1],qr[0],negm,0,0,0), P0[6],P0[7],P0[8],P0[9],     pw0[2]=PKW(P0,4), pw0[3]=PKW(P0,6), pw0); \
    VRD(1); SBAR(); GAPA(C0=__builtin_amdgcn_mfma_f32_32x32x16_bf16(kf[2],qr[1],C0,0,0,0),   P0[10],P0[11],P0[12],P0[13], pw1[0]=PKW(P0,8), pw1[1]=PKW(P0,10), pw1); \
    VRD(5); SBAR(); GAPA(C1=__builtin_amdgcn_mfma_f32_32x32x16_bf16(kf[3],qr[1],C1,0,0,0),   P0[14],P0[15],P1[0],P1[1],   pw1[2]=PKW(P0,12),pw1[3]=PKW(P0,14), pw1); \
    VRD(2); SBAR(); GAPA((void)0,   P1[2],P1[3],P1[4],P1[5],     pw2[0]=PKW(P1,0), pw2[1]=PKW(P1,2), pw2); \
    VRD(6); SBAR(); GAPA((void)0,   P1[6],P1[7],P1[8],P1[9],     pw2[2]=PKW(P1,4), pw2[3]=PKW(P1,6), pw2); \
    VRD(3); SBAR(); GAPA((void)0,   P1[10],P1[11],P1[12],P1[13], pw3[0]=PKW(P1,8), pw3[1]=PKW(P1,10), pw3); \
    VRD(7); SBAR(); GAPA((void)0,   P1[14],P1[15],0.f,0.f,       pw3[2]=PKW(P1,12),pw3[3]=PKW(P1,14), pw3); \
    l_reg+=sacc; \
    if(GK){DMA_K((t)+3,sl_cur);} if(GV){DMA_V((t)+1,sl_next);} \
    CMASK(C0,C1,t); \
    { float a=MX3(C0[0],C0[1],C1[0]),b=MX3(C0[2],C0[3],C1[1]); a=MX3(a,C1[2],C1[3]); \
      _Pragma("unroll") for(int r=4;r<16;r+=4){a=MX3(a,C0[r],C0[r+1]);b=MX3(b,C0[r+2],C0[r+3]);a=MX3(a,C1[r],C1[r+1]);b=MX3(b,C1[r+2],C1[r+3]);} \
      float rm=__builtin_fmaxf(a,b); { auto rr=__builtin_amdgcn_permlane32_swap(__float_as_uint(rm),__float_as_uint(rm),false,false); rm=__builtin_fmaxf(__uint_as_float(rr[0]),__uint_as_float(rr[1])); } \
      resc=false; \
      if(__builtin_expect(__any(rm>(float)THRL),0)){ const float dl=__builtin_fmaxf(rm,0.f); mhat+=dl; \
        _Pragma("unroll") for(int r=0;r<16;++r){C0[r]-=dl;C1[r]-=dl;} \
        _Pragma("unroll") for(int r=0;r<16;++r)negm[r]=-mhat; asm volatile("":"+v"(negm)); \
        const float f=__builtin_amdgcn_exp2f(-dl); l_reg*=f; if(hi==0)wsf[r32]=f; resc=true; } } \
    SBAR(); \
    GAPB(o[0]=__builtin_amdgcn_mfma_f32_32x32x16_bf16(PAF(0),VFR(0),o[0],0,0,0), C0,0); \
    GAPB(o[1]=__builtin_amdgcn_mfma_f32_32x32x16_bf16(PAF(0),VFR(4),o[1],0,0,0), C0,4); \
    KRD(GL,0); GAPB(o[0]=__builtin_amdgcn_mfma_f32_32x32x16_bf16(PAF(1),VFR(1),o[0],0,0,0), C0,8); \
    KRD(GL,1); GAPB(o[1]=__builtin_amdgcn_mfma_f32_32x32x16_bf16(PAF(1),VFR(5),o[1],0,0,0), C0,12); \
    KRD(GL,2); GAPB(o[0]=__builtin_amdgcn_mfma_f32_32x32x16_bf16(PAF(2),VFR(2),o[0],0,0,0), C1,0); \
    KRD(GL,3); GAPB(o[1]=__builtin_amdgcn_mfma_f32_32x32x16_bf16(PAF(2),VFR(6),o[1],0,0,0), C1,4); \
    GAPB(o[0]=__builtin_amdgcn_mfma_f32_32x32x16_bf16(PAF(3),VFR(3),o[0],0,0,0), C1,8); \
    GAPB(o[1]=__builtin_amdgcn_mfma_f32_32x32x16_bf16(PAF(3),VFR(7),o[1],0,0,0), C1,12); \
    }while(0)
  int t=1;
  #undef CMASK
  #define CMASK(P0,P1,t) do{}while(0)
  for(;t+5<NT;t+=2){
    STEP(pB0,pB1,pA0,pA1,t,true,true,true);     WAIT_BAR(2); RESC(); ROT();
    STEP(pA0,pA1,pB0,pB1,t+1,true,true,true);   WAIT_BAR(2); RESC(); ROT();
  }
  #undef CMASK
  #define CMASK(P0,P1,t) do{int jb_=(t)-(NT-4); if(jb_>=0)cmask(P0,P1,jb_,qrel,hi);}while(0)
  #define ENDW(tt) do{ if((tt)+3<NT){WAIT_BAR(2);} else if((tt)+2<NT){WAIT_BAR(1);} else {WAIT_BAR(0);} }while(0)
  for(;t+1<NT;t+=2){
    STEP(pB0,pB1,pA0,pA1,t,(t+3<NT),(t+1<NT),(t+1<NT));       ENDW(t);   RESC(); ROT();
    STEP(pA0,pA1,pB0,pB1,t+1,(t+4<NT),(t+2<NT),(t+2<NT));     ENDW(t+1); RESC(); ROT();
  }
  STEP(pB0,pB1,pA0,pA1,NT-1,false,false,false); RESC();
  { float sacc=pB0[0]+pB0[1]; _Pragma("unroll") for(int r=2;r<16;++r)sacc+=pB0[r]; _Pragma("unroll") for(int r=0;r<16;++r)sacc+=pB1[r]; l_reg+=sacc;
    pw0=(u32x4){PKW(pB0,0),PKW(pB0,2),PKW(pB0,4),PKW(pB0,6)};pw1=(u32x4){PKW(pB0,8),PKW(pB0,10),PKW(pB0,12),PKW(pB0,14)};pw2=(u32x4){PKW(pB1,0),PKW(pB1,2),PKW(pB1,4),PKW(pB1,6)};pw3=(u32x4){PKW(pB1,8),PKW(pB1,10),PKW(pB1,12),PKW(pB1,14)};
    SBAR(); pv(o,vb0+sl_cur,PAF(0),PAF(1),PAF(2),PAF(3)); }
  #undef PKW
  #undef PAF
  #undef VFR
  #undef PIN
  #undef MX3
  #undef GAPA
  #undef GAPB
  #undef EX
  #undef VRD
  #undef KRD
  #undef STEP
  #undef ENDW
  {auto rr=__builtin_amdgcn_permlane32_swap(__float_as_uint(l_reg),__float_as_uint(l_reg),false,false);l_reg=__uint_as_float(rr[0])+__uint_as_float(rr[1]);}
  if(hi==0)wsf[32+r32]=l_reg;asm volatile("s_waitcnt lgkmcnt(0)":::"memory");
  float rli[16];
  #pragma unroll
  for(int r=0;r<16;++r)rli[r]=__builtin_amdgcn_rcpf(wsf[32+crow(r,hi)]);
  bf16*Ow=O+(rowbase+q0+wid*QBLK)*DM+h*D;
  { bf16*stg=(bf16*)(shm+LDS_OST)+wid*2048;
    #pragma unroll
    for(int r=0;r<16;++r){const int orow=crow(r,hi);
      #pragma unroll
      for(int d0=0;d0<2;++d0)stg[orow*64+d0*32+r32]=__float2bfloat16(o[d0][r]*rli[r]);}
    asm volatile("s_waitcnt lgkmcnt(0)":::"memory");
    #pragma unroll
    for(int i=0;i<4;++i){const int row=i*8+(lane>>3),ch=lane&7; const u32x4 v=*(const u32x4*)(stg+row*64+ch*8); ATTN_STORE16(Ow+(long)row*DM+ch*8,v);} }
  asm volatile("s_waitcnt lgkmcnt(0)\n\ts_barrier":::"memory");
  #undef DMA_K
  #undef DMA_V
  #undef CMASK
  #undef START
  #undef RESC
  #undef ROT
}
constexpr int ATTN_LDS_BYTES=LDS_BYTES;
struct AttnTensors { const bf16* Q; const bf16* K; const bf16* V; bf16* O; const bf16* Z; };
struct AttnUnit { int bh; int qb; };
struct StaticOrder {
  int vcu,grid;
  __device__ __forceinline__ explicit StaticOrder(int grid_,int block):vcu((block%8)*(grid_/8)+block/8),grid(grid_){}
  __device__ __forceinline__ bool next(int i,AttnUnit&u)const{ const int L=(i>>1)*grid+vcu; if(L>=256)return false; const int s=L&31; u.bh=L>>5; u.qb=(i&1)?63-s:s; return true; }
  __device__ __forceinline__ void a_ready(const AttnUnit&)const{}
  __device__ __forceinline__ void done(const AttnUnit&)const{}
};
template<class Sched,int THRL=8> __device__ __forceinline__ void attn_phase(char*lds,const AttnTensors&T,const Sched&S){
  AttnUnit u;
  for(int i=0;S.next(i,u);++i){ S.a_ready(u); attn_unit<THRL>(u.bh/NHEAD,u.bh%NHEAD,u.qb,T.Q,T.K,T.V,T.O,lds,T.Z); S.done(u); }
}
#undef SBAR
#undef WAIT_BAR
}

__device__ __forceinline__ void transpose_item(const float* W, int N, int k0, int n0, bf16raw* WT, int drow0, float* scr, int lane, int hi_off = 32) {
  const int c4 = (lane & 15) * 4, r0 = lane >> 4;
  const bool inb = (n0 + c4) < N;
  float4 v[16];
  typedef float f32x4nt_ __attribute__((ext_vector_type(4)));
#pragma unroll
  for (int i = 0; i < 16; ++i) {
    if (inb) { const f32x4nt_ t = __builtin_nontemporal_load((const f32x4nt_*)(W + (size_t)(k0 + 4 * i + r0) * N + n0 + c4)); v[i] = make_float4(t[0], t[1], t[2], t[3]); }
    else v[i] = make_float4(0.f, 0.f, 0.f, 0.f);
  }
#pragma unroll
  for (int i = 0; i < 16; ++i) {
    float* sp = scr + (4 * i + r0) * 65 + c4;
    sp[0] = v[i].x; sp[1] = v[i].y; sp[2] = v[i].z; sp[3] = v[i].w;
  }
  __builtin_amdgcn_fence(__ATOMIC_RELEASE, "wavefront"); __builtin_amdgcn_wave_barrier(); __builtin_amdgcn_fence(__ATOMIC_ACQUIRE, "wavefront");
  const int c = lane & 7;
#pragma unroll
  for (int j = 0; j < 8; ++j) {
    const int n = (lane >> 3) + 8 * j;
    const float* sp = scr + (8 * c) * 65 + n;
    uint4 o;
    o.x = pk2(sp[0 * 65], sp[1 * 65]); o.y = pk2(sp[2 * 65], sp[3 * 65]); o.z = pk2(sp[4 * 65], sp[5 * 65]); o.w = pk2(sp[6 * 65], sp[7 * 65]);
    if (n0 + n < N) { typedef unsigned u32x4nt_ __attribute__((ext_vector_type(4))); const u32x4nt_ ov = {o.x, o.y, o.z, o.w}; __builtin_nontemporal_store(ov, (u32x4nt_*)(WT + (size_t)(drow0 + (n & 31) + (n >> 5) * hi_off) * 1024 + k0 + 8 * c)); }
  }
  __builtin_amdgcn_fence(__ATOMIC_RELEASE, "wavefront"); __builtin_amdgcn_wave_barrier(); __builtin_amdgcn_fence(__ATOMIC_ACQUIRE, "wavefront");
}
constexpr int CV_IN = 16 * 45, CV_OUT = 16 * 16, CV_UP = 32 * 16 * 32, CV_DN = 32 * 16 * 16;
__device__ __forceinline__ void convert_one(const Params& p, int l, int r, float* scr, int lane) {
  if (r < CV_IN) {
    const int kb = r / 45, nb = r % 45;
    const int n0 = nb * 64;
    int drow = n0, hio = 32;
    if (n0 >= 768 && n0 < 1280) { const int t = n0 - 768; drow = 768 + (t >> 8) * 256 + ((t >> 6) & 3) * 32; hio = 128; }
    transpose_item(p.in[6] + (size_t)l * 1024 * DIN, DIN, kb * 64, n0, (bf16raw*)(p.ws + WS_WIN) + (size_t)l * 3072 * 1024, drow, scr, lane, hio);
    return;
  }
  r -= CV_IN;
  if (r < CV_OUT) {
    const int kb = r / 16, nb = r % 16;
    transpose_item(p.in[7] + (size_t)l * 1024 * 1024, 1024, kb * 64, nb * 64, (bf16raw*)(p.ws + WS_WOUT) + (size_t)l * 1024 * 1024, nb * 64, scr, lane);
    return;
  }
  r -= CV_OUT;
  if (r < CV_UP) {
    const int e = r / (16 * 32), r2 = r % (16 * 32), kb = r2 / 32, nb = r2 % 32, n0 = nb * 64;
    const int drow = n0 < 1024 ? (n0 >> 7) * 256 + (n0 & 127) : ((n0 - 1024) >> 7) * 256 + 128 + ((n0 - 1024) & 127);
    transpose_item(p.in[29] + ((size_t)l * NE + e) * 1024 * 2048, 2048, kb * 64, n0, (bf16raw*)(p.ws + WS_WUP) + ((size_t)l * NE + e) * 2048 * 1024, drow, scr, lane);
    return;
  }
  r -= CV_UP;
  {
    const int e = r / (16 * 16), r2 = r % (16 * 16), kb = r2 / 16, nb = r2 % 16;
    transpose_item(p.in[31] + ((size_t)l * NE + e) * 1024 * 1024, 1024, kb * 64, nb * 64, (bf16raw*)(p.ws + WS_WDN) + ((size_t)l * NE + e) * 1024 * 1024, nb * 64, scr, lane);
  }
}
__device__ __forceinline__ void ph_convert(const Params& p, float* sm) {
  const int bid0_ = bidx();
  const int tid0_ = tidx();
  const int lane = tid0_ & 63, wave = tid0_ >> 6;
  float* scr = sm + wave * (64 * 65 + 16);
  const int gw = bid0_ * 8 + wave, NGW = gridDim.x * 8;
  for (int it = gw; it < 2 * CV_IN; it += NGW) convert_one(p, it / CV_IN, it % CV_IN, scr, lane);
  for (int i = bid0_ * NT + tid0_; i < 2 * 240 * 128; i += gridDim.x * NT) {
    const int l = i / (240 * 128), r = i % (240 * 128);
    *(uint4*)((bf16raw*)(p.ws + WS_WIN) + (size_t)l * 3072 * 1024 + (size_t)2832 * 1024 + (size_t)r * 8) = make_uint4(0u, 0u, 0u, 0u);
  }
}
__device__ __forceinline__ void convert_rest(const Params& p, float* sm, int l) {
  const int bid0_ = bidx();
  const int tid0_ = tidx();
  const int lane = tid0_ & 63, wave = tid0_ >> 6;
  float* scr = sm + wave * (64 * 65 + 16);
  const int gw = bid0_ * 8 + wave, NGW = gridDim.x * 8;
  for (int it = gw; it < CV_OUT + CV_UP + CV_DN; it += NGW) convert_one(p, l, CV_IN + it, scr, lane);
}

__device__ __forceinline__ void ph_mod(const Params& p, float* sm) {
  const int bid0_ = bidx();
  const int tid0_ = tidx();
  float* mod = (float*)(p.ws + WS_MOD);
  const float* c = p.in[1];
  if (bid0_ == 0 && tid0_ < 64) ((int*)(p.ws + WS_CNT))[tid0_] = 0;
  if (bid0_ == 0) ((int*)(p.ws + WS_LCNT))[tid0_] = 0;
  if (bid0_ == 0 && tid0_ < 16) ((int*)(p.ws + WS_ZERO))[tid0_] = 0;
  if (bid0_ == 0) for (int i = tid0_; i < 640; i += NT) ((unsigned*)(p.ws + WS_RDY))[i] = 0u;
  float* cs = sm;
  float* red = sm + 1024;
  for (int it = bid0_; it < 96; it += gridDim.x) {
    const int l = it / 48, col0 = (it % 48) * 128;
    __syncthreads();
    for (int i = tid0_; i < 1024; i += NT) { const float cv = c[i]; cs[i] = cv / (1.f + __expf(-cv)); }
    __syncthreads();
    const int cg4 = (tid0_ & 31) * 4, kc = tid0_ >> 5;
    const float* w = p.in[2] + (size_t)l * 1024 * 6144 + (size_t)(kc * 64) * 6144 + col0 + cg4;
    float4 acc = make_float4(0.f, 0.f, 0.f, 0.f);
#pragma unroll 16
    for (int i = 0; i < 64; ++i) {
      const float4 wv = *(const float4*)(w + (size_t)i * 6144);
      const float sv = cs[kc * 64 + i];
      acc.x += sv * wv.x; acc.y += sv * wv.y; acc.z += sv * wv.z; acc.w += sv * wv.w;
    }
    *(float4*)(red + kc * 128 + cg4) = acc;
    __syncthreads();
    if (tid0_ < 128) {
      float t = 0.f;
#pragma unroll
      for (int k = 0; k < 16; ++k) t += red[k * 128 + tid0_];
      mod[l * 6144 + col0 + tid0_] = t + p.in[3][l * 6144 + col0 + tid0_];
    }
  }
  __syncthreads();
}

__device__ __forceinline__ void ph_norm(const Params& p, int l, int which, float* sm) {
  const int bid0_ = bidx();
  const int tid0_ = tidx();
  const int lane = tid0_ & 63, wave = tid0_ >> 6;
  const float* mod = (const float*)(p.ws + WS_MOD) + l * 6144;
  const float* xin = which == 0 ? (l == 0 ? p.in[0] : (const float*)(p.ws + WS_XA)) : (const float*)(p.ws + WS_X1);
  const float* gain = (which == 0 ? p.in[4] : p.in[5]) + l * 1024;
  const float* sh = mod + (which == 0 ? 0 : 3) * 1024;
  const float* sc = mod + (which == 0 ? 1 : 4) * 1024;
  bf16raw* H = (bf16raw*)(p.ws + WS_H);
  const float* rw = p.in[27] + (size_t)l * 1024 * 32;
  const float* rb = p.in[28] + l * 32;
  int* cnt = (int*)(p.ws + WS_CNT) + l * 32;
  int* eidx = (int*)(p.ws + WS_EIDX);
  float* gatebuf = (float*)(p.ws + WS_GATE);
  for (int rbase = bid0_ * 8; rbase < S; rbase += gridDim.x * 8) {
    const int row = rbase + wave;
    const float4* xr = (const float4*)(xin + (size_t)row * 1024) + lane;
    float4 v[4];
    float ss = 0.f;
#pragma unroll
    for (int j = 0; j < 4; ++j) {
      v[j] = xr[64 * j];
      ss += v[j].x * v[j].x + v[j].y * v[j].y + v[j].z * v[j].z + v[j].w * v[j].w;
    }
    ss = wave_sum(ss);
    float r = rsqrtf(ss * (1.f / 1024.f) + 1e-6f);
    uint2* hr = (uint2*)(H + (size_t)row * 1024) + lane;
#pragma unroll
    for (int j = 0; j < 4; ++j) {
      int col = (lane + 64 * j) * 4;
      float4 g = *(const float4*)(gain + col), a = *(const float4*)(sc + col), b = *(const float4*)(sh + col);
      v[j].x = v[j].x * r * g.x * (1.f + a.x) + b.x;
      v[j].y = v[j].y * r * g.y * (1.f + a.y) + b.y;
      v[j].z = v[j].z * r * g.z * (1.f + a.z) + b.z;
      v[j].w = v[j].w * r * g.w * (1.f + a.w) + b.w;
      hr[64 * j] = make_uint2(pk2(v[j].x, v[j].y), pk2(v[j].z, v[j].w));
    }
  }
}

__device__ __forceinline__ void ph_norm2(const Params& p, int l, float* sm) {
  const int bid0_ = bidx();
  const int tid = tidx();
  const int lane = tid & 63, wave = tid >> 6;
  const float* mod = (const float*)(p.ws + WS_MOD) + l * 6144;
  const bf16raw* xin = (const bf16raw*)(p.ws + WS_X1);
  const float* gain = p.in[5] + l * 1024;
  const float* sh = mod + 3 * 1024; const float* sc = mod + 4 * 1024;
  bf16raw* H = (bf16raw*)(p.ws + WS_H);
  const float* rw = p.in[27] + (size_t)l * 1024 * 32;
  const float* rb = p.in[28] + l * 32;
  int* cnt = (int*)(p.ws + WS_CNT) + l * 32;
  int* eidx = (int*)(p.ws + WS_EIDX);
  int* elist = (int*)(p.ws + WS_ELIST);
  float* gatebuf = (float*)(p.ws + WS_GATE);
  unsigned short* whi = (unsigned short*)sm;
  unsigned short* wlo = whi + 32 * 1032;
  float* fl = sm + 33024;
  float* gab = fl;
  float* lgp = fl;
  float* cpart = fl + 2048;
  float* cexp = fl + 2560;
  float* rr = fl + 2592;
  int* lcnt = (int*)(fl + 2656);
  int* lbase = lcnt + 32;
  __syncthreads();
  for (int k = tid; k < 1024; k += 512) { gab[k] = gain[k] * (1.f + sc[k]); gab[1024 + k] = sh[k]; }
  __syncthreads();
  {
    const int e = tid & 31, kg = tid >> 5;
    float cacc = 0.f;
#pragma unroll 2
    for (int k8 = 0; k8 < 8; ++k8) {
      const int k0 = kg * 64 + k8 * 8;
      float w[8];
#pragma unroll
      for (int i = 0; i < 8; ++i) w[i] = rw[(size_t)(k0 + i) * 32 + e];
      const float4 g0 = *(const float4*)(gab + k0), g1 = *(const float4*)(gab + k0 + 4);
      const float4 s0 = *(const float4*)(gab + 1024 + k0), s1 = *(const float4*)(gab + 1024 + k0 + 4);
      cacc += s0.x * w[0] + s0.y * w[1] + s0.z * w[2] + s0.w * w[3] + s1.x * w[4] + s1.y * w[5] + s1.z * w[6] + s1.w * w[7];
      w[0] *= g0.x; w[1] *= g0.y; w[2] *= g0.z; w[3] *= g0.w; w[4] *= g1.x; w[5] *= g1.y; w[6] *= g1.z; w[7] *= g1.w;
      unsigned hi[4], lo[4];
#pragma unroll
      for (int i = 0; i < 4; ++i) {
        hi[i] = pk2(w[2 * i], w[2 * i + 1]);
        lo[i] = pk2(w[2 * i] - __builtin_bit_cast(float, hi[i] << 16), w[2 * i + 1] - __builtin_bit_cast(float, hi[i] & 0xffff0000u));
      }
      *(uint4*)(whi + e * 1032 + k0) = make_uint4(hi[0], hi[1], hi[2], hi[3]);
      *(uint4*)(wlo + e * 1032 + k0) = make_uint4(lo[0], lo[1], lo[2], lo[3]);
    }
    cpart[kg * 32 + e] = cacc;
  }
  float4 ga[4], gb[4];
#pragma unroll
  for (int j = 0; j < 4; ++j) { ga[j] = *(const float4*)(gab + (lane + 64 * j) * 4); gb[j] = *(const float4*)(gab + 1024 + (lane + 64 * j) * 4); }
  for (int rbase = bid0_ * 64; rbase < S; rbase += gridDim.x * 64) {
    if (tid < 32) lcnt[tid] = 0;
#pragma unroll 2
    for (int ri = 0; ri < 8; ++ri) {
      const int rl = wave * 8 + ri, row = rbase + rl;
      const bf16raw* xr = xin + (size_t)row * 1024 + lane * 4;
      float4 v[4];
      float ss = 0.f;
#pragma unroll
      for (int j = 0; j < 4; ++j) { v[j] = ld4bf(xr + 256 * j); ss += v[j].x * v[j].x + v[j].y * v[j].y + v[j].z * v[j].z + v[j].w * v[j].w; }
      ss = wave_sum(ss);
      const float r = rsqrtf(ss * (1.f / 1024.f) + 1e-6f);
      if (lane == 0) rr[rl] = r;
      uint2* hr = (uint2*)(H + (size_t)row * 1024) + lane;
#pragma unroll
      for (int j = 0; j < 4; ++j) {
        const float4 g = ga[j], b = gb[j];
        hr[64 * j] = make_uint2(pk2(v[j].x * r * g.x + b.x, v[j].y * r * g.y + b.y), pk2(v[j].z * r * g.z + b.z, v[j].w * r * g.w + b.w));
      }
    }
    typedef short bf16x8 __attribute__((ext_vector_type(8)));
    typedef float f32x4 __attribute__((ext_vector_type(4)));
    const int rt = wave & 3, kh = wave >> 2, fr = lane & 15, fq = lane >> 4;
    bf16x8 xf[16];
    {
      const bf16raw* xp = xin + (size_t)(rbase + rt * 16 + fr) * 1024 + kh * 512 + fq * 8;
#pragma unroll
      for (int ks = 0; ks < 16; ++ks) xf[ks] = *(const bf16x8*)(xp + ks * 32);
    }
    __syncthreads();
    if (tid < 32) {
      float c = rb[tid];
#pragma unroll
      for (int g = 0; g < 16; ++g) c += cpart[g * 32 + tid];
      cexp[tid] = c;
    }
    f32x4 d0 = {0.f, 0.f, 0.f, 0.f}, d1 = {0.f, 0.f, 0.f, 0.f};
    {
      const unsigned short* wh = whi + fr * 1032 + kh * 512 + fq * 8;
      const unsigned short* wl = wlo + fr * 1032 + kh * 512 + fq * 8;
#pragma unroll
      for (int ks = 0; ks < 16; ++ks) {
        const bf16x8 h0 = *(const bf16x8*)(wh + ks * 32), l0 = *(const bf16x8*)(wl + ks * 32);
        const bf16x8 h1 = *(const bf16x8*)(wh + 16 * 1032 + ks * 32), l1 = *(const bf16x8*)(wl + 16 * 1032 + ks * 32);
        d0 = __builtin_amdgcn_mfma_f32_16x16x32_bf16(xf[ks], h0, d0, 0, 0, 0);
        d1 = __builtin_amdgcn_mfma_f32_16x16x32_bf16(xf[ks], h1, d1, 0, 0, 0);
        d0 = __builtin_amdgcn_mfma_f32_16x16x32_bf16(xf[ks], l0, d0, 0, 0, 0);
        d1 = __builtin_amdgcn_mfma_f32_16x16x32_bf16(xf[ks], l1, d1, 0, 0, 0);
      }
    }
    if (kh == 1) {
#pragma unroll
      for (int j = 0; j < 4; ++j) { lgp[(rt * 16 + fq * 4 + j) * 32 + fr] = d0[j]; lgp[(rt * 16 + fq * 4 + j) * 32 + 16 + fr] = d1[j]; }
    }
    __syncthreads();
    if (kh == 0) {
#pragma unroll
      for (int j = 0; j < 4; ++j) { lgp[(rt * 16 + fq * 4 + j) * 32 + fr] += d0[j]; lgp[(rt * 16 + fq * 4 + j) * 32 + 16 + fr] += d1[j]; }
    }
    __syncthreads();
    const int row_l = tid >> 3, eg = tid & 7;
    float acc[4];
    {
      const float4 t = *(const float4*)(lgp + row_l * 32 + eg * 4), c4 = *(const float4*)(cexp + eg * 4);
      const float r = rr[row_l];
      acc[0] = t.x * r + c4.x; acc[1] = t.y * r + c4.y; acc[2] = t.z * r + c4.z; acc[3] = t.w * r + c4.w;
    }
    float tv[4]; int ti[4];
#pragma unroll
    for (int rd = 0; rd < 4; ++rd) {
      float bv = acc[0]; int bi = eg * 4;
#pragma unroll
      for (int c = 1; c < 4; ++c) if (acc[c] > bv) { bv = acc[c]; bi = eg * 4 + c; }
#pragma unroll
      for (int o = 1; o < 8; o <<= 1) {
        const float ov = __shfl_xor(bv, o); const int oi = __shfl_xor(bi, o);
        if (ov > bv || (ov == bv && oi < bi)) { bv = ov; bi = oi; }
      }
      tv[rd] = bv; ti[rd] = bi;
#pragma unroll
      for (int c = 0; c < 4; ++c) if (bi == eg * 4 + c) acc[c] = -INFINITY;
    }
    int rk[4] = {0, 0, 0, 0};
    if (eg == 0) {
#pragma unroll
      for (int k = 0; k < 4; ++k) rk[k] = atomicAdd(&lcnt[ti[k]], 1);
    }
    __syncthreads();
    if (tid < 32) { const int c = lcnt[tid]; lbase[tid] = c > 0 ? atomicAdd(&cnt[tid], c) : 0; }
    __syncthreads();
    if (eg == 0) {
      const int row = rbase + row_l;
      const float e1 = __expf(tv[1] - tv[0]), e2 = __expf(tv[2] - tv[0]), e3 = __expf(tv[3] - tv[0]);
      const float inv = 1.f / (1.f + e1 + e2 + e3);
      *(int4*)(eidx + row * 4) = make_int4(ti[0] | ((lbase[ti[0]] + rk[0]) << 8), ti[1] | ((lbase[ti[1]] + rk[1]) << 8), ti[2] | ((lbase[ti[2]] + rk[2]) << 8),
                                           ti[3] | ((lbase[ti[3]] + rk[3]) << 8));
      *(float4*)(gatebuf + row * 4) = make_float4(inv, e1 * inv, e2 * inv, e3 * inv);
#pragma unroll
      for (int k = 0; k < 4; ++k) elist[ti[k] * S + lbase[ti[k]] + rk[k]] = row;
    }
  }
}

__device__ __forceinline__ void ph_inproj(const Params& p, int l, float* sm) {
  const int bid0_ = bidx();
  pg8::Gemm g{(const pg8::bf16_t*)(p.ws + WS_H), (const pg8::bf16_t*)(p.ws + WS_WIN) + (size_t)l * 3072 * 1024, S, 3072, 1024};
  pg8::StaticOrder so; so.init(S, 3072, (int)gridDim.x, bid0_);
  pg8::EpiInproj E{(pg8::bf16_t*)(p.ws + WS_QA), (pg8::bf16_t*)(p.ws + WS_KA), (pg8::bf16_t*)(p.ws + WS_VA), (float*)(p.ws + WS_QB), (pg8::bf16_t*)(p.ws + WS_QBB), (pg8::bf16_t*)(p.ws + WS_KB),
                   (pg8::bf16_t*)(p.ws + WS_VB), (float*)(p.ws + WS_KMP), (pg8::bf16_t*)(p.ws + WS_PROJ), p.in[8] + l * 32, p.in[9] + l * 32, p.in[15] + l * 64, p.in[16] + l * 64, attn_body::C2};
  pg8::gemm_phase<pg8::EpiInproj, pg8::StaticOrder, true, true>((PG8_LAS unsigned char*)sm, g, so, E);
}

__device__ __forceinline__ void gla_local_item(const Params& p, int l, int c, float* sm) {
  const int tid = tidx();
  const bf16raw* P = (const bf16raw*)(p.ws + WS_PROJ);
  float* BC = (float*)(p.ws + WS_GA);
  float* SC = (float*)(p.ws + WS_SC); float* DEC = (float*)(p.ws + WS_DEC);
  const float* wg2 = p.in[17] + l * 16 * 128; const float* bg = p.in[18] + l * 128;
  float* gs = sm; float* ks = sm + 8192; float* vs = sm + 16384; float* part = sm + 32768;
  const size_t t0 = (size_t)c * 64;
  {
    const int t = tid >> 3, d0 = (tid & 7) * 16;
    float gl[16];
#pragma unroll
    for (int r4 = 0; r4 < 4; ++r4) { float4 x = ld4bf(P + (t0 + t) * PDIN + PC_CG + r4 * 4); gl[r4 * 4] = x.x; gl[r4 * 4 + 1] = x.y; gl[r4 * 4 + 2] = x.z; gl[r4 * 4 + 3] = x.w; }
#pragma unroll
    for (int d = 0; d < 16; ++d) {
      float z = bg[d0 + d];
#pragma unroll
      for (int r = 0; r < 16; ++r) z += gl[r] * wg2[r * 128 + d0 + d];
      gs[t * 128 + d0 + d] = logsigmoidf_(z) * (1.f / 16.f);
    }
#pragma unroll
    for (int u = 0; u < 2; ++u) { int idx = tid + u * 512, row = idx >> 4, c8 = (idx & 15) * 8; const uint4 w = *(const uint4*)(P + (t0 + row) * PDIN + PC_CK + c8);
      *(float4*)(ks + row * 128 + c8) = make_float4(__builtin_bit_cast(float, w.x << 16), __builtin_bit_cast(float, w.x & 0xffff0000u), __builtin_bit_cast(float, w.y << 16), __builtin_bit_cast(float, w.y & 0xffff0000u));
      *(float4*)(ks + row * 128 + c8 + 4) = make_float4(__builtin_bit_cast(float, w.z << 16), __builtin_bit_cast(float, w.z & 0xffff0000u), __builtin_bit_cast(float, w.w << 16), __builtin_bit_cast(float, w.w & 0xffff0000u)); }
#pragma unroll
    for (int u = 0; u < 4; ++u) { int idx = tid + u * 512, row = idx >> 5, c8 = (idx & 31) * 8; const uint4 w = *(const uint4*)(P + (t0 + row) * PDIN + PC_CV + c8);
      *(float4*)(vs + row * 256 + c8) = make_float4(__builtin_bit_cast(float, w.x << 16), __builtin_bit_cast(float, w.x & 0xffff0000u), __builtin_bit_cast(float, w.y << 16), __builtin_bit_cast(float, w.y & 0xffff0000u));
      *(float4*)(vs + row * 256 + c8 + 4) = make_float4(__builtin_bit_cast(float, w.z << 16), __builtin_bit_cast(float, w.z & 0xffff0000u), __builtin_bit_cast(float, w.w << 16), __builtin_bit_cast(float, w.w & 0xffff0000u)); }
  }
  __syncthreads();
  const int d = tid & 127, qtr = tid >> 7;
  {
    float run = 0.f;
#pragma unroll
    for (int i = 0; i < 16; ++i) { run += gs[(qtr * 16 + i) * 128 + d]; gs[(qtr * 16 + i) * 128 + d] = run; }
    part[qtr * 128 + d] = run;
  }
  __syncthreads();
  {
    float off = 0.f;
#pragma unroll
    for (int q = 0; q < 3; ++q) if (q < qtr) off += part[q * 128 + d];
#pragma unroll
    for (int i = 0; i < 16; ++i) { float v = gs[(qtr * 16 + i) * 128 + d] + off; gs[(qtr * 16 + i) * 128 + d] = v; BC[(t0 + qtr * 16 + i) * 128 + d] = v; }
  }
  __syncthreads();
  {
    const float bl = gs[63 * 128 + d];
#pragma unroll
    for (int i = 0; i < 16; ++i) { int t = qtr * 16 + i; ks[t * 128 + d] *= __expf(bl - gs[t * 128 + d]); }
  }
  __syncthreads();
  {
    const int h = tid >> 7, dd = (tid >> 2) & 31, e0 = (tid & 3) * 16;
    float acc[16];
#pragma unroll
    for (int i = 0; i < 16; ++i) acc[i] = 0.f;
    for (int t = 0; t < 64; ++t) {
      const float kv = ks[t * 128 + h * 32 + dd];
#pragma unroll
      for (int q = 0; q < 4; ++q) {
        float4 v4 = *(const float4*)(vs + t * 256 + h * 64 + e0 + q * 4);
        acc[q * 4] += kv * v4.x; acc[q * 4 + 1] += kv * v4.y; acc[q * 4 + 2] += kv * v4.z; acc[q * 4 + 3] += kv * v4.w;
      }
    }
    float* o = SC + (((size_t)c * 4 + h) * 32 + dd) * 64 + e0;
#pragma unroll
    for (int q = 0; q < 4; ++q) *(float4*)(o + q * 4) = make_float4(acc[q * 4], acc[q * 4 + 1], acc[q * 4 + 2], acc[q * 4 + 3]);
    if ((tid & 3) == 0) DEC[(size_t)c * 128 + h * 32 + dd] = __expf(gs[63 * 128 + h * 32 + dd]);
  }
  __syncthreads();
}

__device__ __forceinline__ void lru_local_item(const Params& p, int l, int c, float* sm) {
  const int tid = tidx();
  const bf16raw* P = (const bf16raw*)(p.ws + WS_PROJ);
  float* LA = (float*)(p.ws + WS_LA); float* LB = (float*)(p.ws + WS_LB);
  float* LTA = (float*)(p.ws + WS_LTA); float* LTH = (float*)(p.ws + WS_LTH);
  const float* cw = p.in[20] + l * 4 * 256; const float* cb = p.in[21] + l * 256;
  const float* wa = p.in[22] + (size_t)l * 4 * 64 * 64; const float* ba = p.in[23] + l * 256;
  const float* wx = p.in[24] + (size_t)l * 4 * 64 * 64; const float* bx = p.in[25] + l * 256;
  const float* lam = p.in[26] + l * 256;
  float* xcs = sm;
  const int t0 = c * 64;
  bf16raw* dxs = (bf16raw*)(sm + 16384);
  for (int i = tid; i < 67 * 32; i += NT) {
    const int r = i >> 5, c8 = (i & 31) * 8, ts = t0 - 3 + r;
    *(uint4*)(dxs + r * 256 + c8) = ts >= 0 ? *(const uint4*)(P + (size_t)ts * PDIN + PC_DX + c8) : make_uint4(0u, 0u, 0u, 0u);
  }
  __syncthreads();
  {
    const int ch = tid & 255;
    const float w0 = cw[ch], w1 = cw[256 + ch], w2 = cw[512 + ch], w3 = cw[768 + ch], bb = cb[ch];
#pragma unroll 4
    for (int tt = tid >> 8; tt < 64; tt += 2)
      xcs[tt * 256 + ch] = bb + w0 * bf2f(dxs[tt * 256 + ch]) + w1 * bf2f(dxs[(tt + 1) * 256 + ch]) + w2 * bf2f(dxs[(tt + 2) * 256 + ch]) + w3 * bf2f(dxs[(tt + 3) * 256 + ch]);
  }
  __syncthreads();
  {
    const int ch = tid & 255, half = tid >> 8, n = ch >> 6, e = ch & 63;
    const float ls = logsigmoidf_(lam[ch]), bav = ba[ch], bxv = bx[ch];
    float Hh = 0.f, Ac = 1.f;
    {
      const int tb = half * 32;
      float ar[32], ai[32];
#pragma unroll
      for (int i = 0; i < 32; ++i) { ar[i] = 0.f; ai[i] = 0.f; }
#pragma unroll 1
      for (int d4 = 0; d4 < 16; ++d4) {
        float w1[4], w2[4];
#pragma unroll
        for (int q = 0; q < 4; ++q) { w1[q] = wa[(n * 64 + d4 * 4 + q) * 64 + e]; w2[q] = wx[(n * 64 + d4 * 4 + q) * 64 + e]; }
#pragma unroll
        for (int i = 0; i < 32; ++i) {
          const float4 xv = *(const float4*)(xcs + (tb + i) * 256 + n * 64 + d4 * 4);
          ar[i] += xv.x * w1[0] + xv.y * w1[1] + xv.z * w1[2] + xv.w * w1[3];
          ai[i] += xv.x * w2[0] + xv.y * w2[1] + xv.z * w2[2] + xv.w * w2[3];
        }
      }
#pragma unroll
      for (int i = 0; i < 32; ++i) {
        const int t = t0 + tb + i;
        float rg = sigmoidf_(ar[i] + bav), ig = sigmoidf_(ai[i] + bxv);
        float la = 8.f * rg * ls;
        float a = __expf(la);
        float bt = sqrtf(fmaxf(1.f - a * a, 0.f)) * (ig * xcs[(tb + i) * 256 + ch]);
        Hh = a * Hh + bt; Ac *= a;
        LA[(size_t)t * 256 + ch] = Ac; LB[(size_t)t * 256 + ch] = Hh;
      }
    }
    LTA[(size_t)(c * 2 + half) * 256 + ch] = Ac; LTH[(size_t)(c * 2 + half) * 256 + ch] = Hh;
  }
  __syncthreads();
}

__device__ __forceinline__ void ph_prep(const Params& p, int l, float* sm) {
  const int bid0_ = bidx();
  const int tid0_ = tidx();
  const int lane = tid0_ & 63, wave = tid0_ >> 6;
  const bf16raw* P = (const bf16raw*)(p.ws + WS_PROJ);
  bf16raw* QAb = (bf16raw*)(p.ws + WS_QA); bf16raw* KAb = (bf16raw*)(p.ws + WS_KA); bf16raw* VAb = (bf16raw*)(p.ws + WS_VA);
  float* QB = (float*)(p.ws + WS_QB); bf16raw* KBb = (bf16raw*)(p.ws + WS_KB); bf16raw* QBb = (bf16raw*)(p.ws + WS_QBB);
  float* KMP = (float*)(p.ws + WS_KMP); bf16raw* VBt = (bf16raw*)(p.ws + WS_VBT);
  const float* aqg = p.in[8] + l * 32; const float* akg = p.in[9] + l * 32;
  const float* bqg = p.in[15] + l * 64; const float* bkg = p.in[16] + l * 64;
  const float* wg2 = p.in[17] + l * 16 * 128; const float* bg = p.in[18] + l * 128;
  bf16raw* vsl = (bf16raw*)sm;
  const bf16raw* VBn = (const bf16raw*)(p.ws + WS_VB);
  for (int tile = bid0_; tile < S / 64; tile += gridDim.x) {
    __syncthreads();
#pragma unroll
    for (int u = 0; u < 4; ++u) { const int idx = tid0_ + u * 512, r = idx >> 5, c8 = (idx & 31) * 8; *(uint4*)(vsl + r * 264 + c8) = *(const uint4*)(VBn + (size_t)(tile * 64 + r) * 256 + c8); }
    __syncthreads();
    {
      const int col = tid0_ & 255, half = tid0_ >> 8;
      unsigned w[16];
#pragma unroll
      for (int i = 0; i < 16; ++i) w[i] = (unsigned)vsl[(half * 32 + 2 * i) * 264 + col] | ((unsigned)vsl[(half * 32 + 2 * i + 1) * 264 + col] << 16);
      uint4* dst = (uint4*)(VBt + (size_t)col * S + tile * 64 + half * 32);
#pragma unroll
      for (int i = 0; i < 4; ++i) dst[i] = make_uint4(w[4 * i], w[4 * i + 1], w[4 * i + 2], w[4 * i + 3]);
    }
  }
  __syncthreads();
  for (int c = bid0_; c < S / 64; c += gridDim.x) gla_local_item(p, l, c, sm);
  for (int c = bid0_; c < S / 64; c += gridDim.x) lru_local_item(p, l, c, sm);
}

__device__ __forceinline__ void ph_scan(const Params& p, float* sm) {
  const int bid0_ = bidx();
  const int tid = tidx();
  const float* SC = (const float*)(p.ws + WS_SC); const float* DEC = (const float*)(p.ws + WS_DEC); float* STo = (float*)(p.ws + WS_ST);
  float* gA = sm; float* gH = sm + 512; float* gC = sm + 1024;
  for (int b = bid0_; b < 256; b += gridDim.x) {
    const int chain = tid & 31, grp = tid >> 5, gid = b * 32 + chain;
    float sv[16], dv[16];
#pragma unroll
    for (int i = 0; i < 16; ++i) { const int c = grp * 16 + i; sv[i] = SC[(size_t)c * 8192 + gid]; dv[i] = DEC[c * 128 + (gid >> 6)]; }
    float A = 1.f, H = 0.f;
#pragma unroll
    for (int i = 0; i < 16; ++i) { H = dv[i] * H + sv[i]; A *= dv[i]; }
    __syncthreads();
    gA[tid] = A; gH[tid] = H;
    __syncthreads();
    if (tid < 32) {
      float carry = 0.f;
#pragma unroll
      for (int g = 0; g < 16; ++g) { gC[g * 32 + tid] = carry; carry = gA[g * 32 + tid] * carry + gH[g * 32 + tid]; }
    }
    __syncthreads();
    float st = gC[tid];
#pragma unroll
    for (int i = 0; i < 16; ++i) { const int c = grp * 16 + i; STo[(size_t)c * 8192 + gid] = st; st = dv[i] * st + sv[i]; }
  }
}
__device__ __forceinline__ void ph_scan_lru(const Params& p, float* sm) {
  const int bid0_ = bidx();
  const int tid = tidx();
  const float* LTA = (const float*)(p.ws + WS_LTA); const float* LTH = (const float*)(p.ws + WS_LTH); float* LC = (float*)(p.ws + WS_LC);
  for (int b = bid0_; b < 48; b += gridDim.x) {
    if (b < 16) continue;
    const int ch = (b - 16) * 8 + (tid & 7), grp = tid >> 3;
    float a[8], h[8];
#pragma unroll
    for (int i = 0; i < 8; ++i) { a[i] = LTA[(grp * 8 + i) * 256 + ch]; h[i] = LTH[(grp * 8 + i) * 256 + ch]; }
    float A = 1.f, H = 0.f;
#pragma unroll
    for (int i = 0; i < 8; ++i) { H = a[i] * H + h[i]; A *= a[i]; }
    __syncthreads();
    sm[tid] = A; sm[512 + tid] = H;
    __syncthreads();
    if (tid < 8) {
      float carry = 0.f;
      for (int g = 0; g < 64; ++g) { const float ga = sm[g * 8 + tid], gh = sm[512 + g * 8 + tid]; sm[1024 + g * 8 + tid] = carry; carry = ga * carry + gh; }
    }
    __syncthreads();
    float carry = sm[1024 + tid];
#pragma unroll
    for (int i = 0; i < 8; ++i) { LC[(grp * 8 + i) * 256 + ch] = carry; carry = a[i] * carry + h[i]; }
  }
}

__device__ __forceinline__ void moba_gate_item(const Params& p, int l, int it, float* sm) {
  const int tid = tidx();
  const int h = it & 3, own = it >> 2, qi = own * 256 + (tid >> 1), half = tid & 1;
  const float* QB = (const float*)(p.ws + WS_QB); const float* KMP = (const float*)(p.ws + WS_KMP);
  int* LCNT = (int*)(p.ws + WS_LCNT) + l * 256; int* LIST = (int*)(p.ws + WS_MLIST); float2* ML = (float2*)(p.ws + WS_ML);
  float* km = sm;
  int* lcnt = (int*)(sm + 4096); int* lbase = lcnt + 64;
  __syncthreads();
  for (int idx = tid; idx < own * 64; idx += NT) {
    const int n = idx >> 6, c = idx & 63;
    const float* kp = KMP + (size_t)(4 * n) * 256 + h * 64 + c;
    km[idx] = (kp[0] + kp[256] + kp[512] + kp[768]) * (1.f / 256.f);
  }
  if (tid < 64) lcnt[tid] = 0;
  __syncthreads();
  float q[64];
  {
    const float4* qp = (const float4*)(QB + (size_t)qi * 256 + h * 64);
#pragma unroll
    for (int i = 0; i < 16; ++i) { float4 t = qp[i]; q[4 * i] = t.x; q[4 * i + 1] = t.y; q[4 * i + 2] = t.z; q[4 * i + 3] = t.w; }
  }
  int s0 = -1, s1 = -1, s2 = -1;
  float g0 = -INFINITY, g1 = -INFINITY, g2 = -INFINITY;
#pragma unroll 1
  for (int n = half; n < own; n += 2) {
    const float4* kmp = (const float4*)(km + n * 64);
    float a = 0.f;
#pragma unroll
    for (int i = 0; i < 16; ++i) { float4 t = kmp[i]; a += q[4 * i] * t.x + q[4 * i + 1] * t.y + q[4 * i + 2] * t.z + q[4 * i + 3] * t.w; }
    if (a > g0) { g2 = g1; s2 = s1; g1 = g0; s1 = s0; g0 = a; s0 = n; }
    else if (a > g1) { g2 = g1; s2 = s1; g1 = a; s1 = n; }
    else if (a > g2) { g2 = a; s2 = n; }
  }
  {
    const float pg0 = __shfl_xor(g0, 1), pg1 = __shfl_xor(g1, 1), pg2 = __shfl_xor(g2, 1);
    const int ps0 = __shfl_xor(s0, 1), ps1 = __shfl_xor(s1, 1), ps2 = __shfl_xor(s2, 1);
#define MOBA_INS(A, N) do { const float a_ = (A); const int n_ = (N); if (n_ >= 0) {                                                   \
      if (a_ > g0 || (a_ == g0 && n_ < s0) || s0 < 0) { g2 = g1; s2 = s1; g1 = g0; s1 = s0; g0 = a_; s0 = n_; }                         \
      else if (a_ > g1 || (a_ == g1 && n_ < s1) || s1 < 0) { g2 = g1; s2 = s1; g1 = a_; s1 = n_; }                                      \
      else if (a_ > g2 || (a_ == g2 && n_ < s2) || s2 < 0) { g2 = a_; s2 = n_; } } } while (0)
    MOBA_INS(pg0, ps0); MOBA_INS(pg1, ps1); MOBA_INS(pg2, ps2);
#undef MOBA_INS
  }
  int r0 = 0, r1 = 0, r2 = 0;
  if (half == 0) {
    if (s0 >= 0) r0 = atomicAdd(&lcnt[s0], 1);
    if (s1 >= 0) r1 = atomicAdd(&lcnt[s1], 1);
    if (s2 >= 0) r2 = atomicAdd(&lcnt[s2], 1);
  }
  __syncthreads();
  if (tid < 64) { const int c = lcnt[tid]; lbase[tid] = c > 0 ? atomicAdd(&LCNT[h * 64 + tid], c) : 0; }
  __syncthreads();
  if (half == 0) {
    const float2 dead = make_float2(-INFINITY, 0.f);
    const size_t sl = ((size_t)qi * 4 + h) * 4;
    if (s0 >= 0) LIST[(size_t)(h * 64 + s0) * 16384 + lbase[s0] + r0] = qi | (0 << 16); else ML[sl + 0] = dead;
    if (s1 >= 0) LIST[(size_t)(h * 64 + s1) * 16384 + lbase[s1] + r1] = qi | (1 << 16); else ML[sl + 1] = dead;
    if (s2 >= 0) LIST[(size_t)(h * 64 + s2) * 16384 + lbase[s2] + r2] = qi | (2 << 16); else ML[sl + 2] = dead;
  }
}

__device__ __forceinline__ void moba_attn_item(const Params& p, int h, int n, int chunk, int own, int len, float* sm) {
  typedef short bf16x8_t __attribute__((ext_vector_type(8)));
  typedef short bf16x4_t __attribute__((ext_vector_type(4)));
  typedef float f32x4_t __attribute__((ext_vector_type(4)));
  const int tid = tidx(), lane = tid & 63, wave = tid >> 6, qc = lane & 15, kg = lane >> 4;
  const bf16raw* KBb = (const bf16raw*)(p.ws + WS_KB); const bf16raw* QBb = (const bf16raw*)(p.ws + WS_QBB); const bf16raw* VBt = (const bf16raw*)(p.ws + WS_VBT);
  const int* LIST = (const int*)(p.ws + WS_MLIST); float2* ML = (float2*)(p.ws + WS_ML); bf16raw* PART = (bf16raw*)(p.ws + WS_PART);
  bf16raw* Ks = (bf16raw*)sm;
  bf16raw* Vt = (bf16raw*)sm + 256 * 72;
  __syncthreads();
#pragma unroll
  for (int u = 0; u < 4; ++u) {
    const int idx = tid + u * 512, key = idx >> 3, ch = idx & 7;
    *(uint4*)(Ks + key * 72 + ch * 8) = *(const uint4*)(KBb + (size_t)(n * 256 + key) * 256 + h * 64 + ch * 8);
    const int d = idx >> 5, c2 = idx & 31;
    *(uint4*)(Vt + d * 264 + c2 * 8) = *(const uint4*)(VBt + (size_t)(h * 64 + d) * S + n * 256 + c2 * 8);
  }
#pragma unroll 1
  for (int sub = 0; sub < 2; ++sub) {
  if (!own && chunk * 256 + sub * 128 >= len) break;
  const int slot_in = chunk * 256 + sub * 128 + wave * 16 + qc;
  int qi, src; bool valid = true;
  if (own) { qi = n * 256 + slot_in; src = 3; }
  else { valid = slot_in < len; const int e = LIST[(size_t)(h * 64 + n) * 16384 + (valid ? slot_in : 0)]; qi = e & 0xffff; src = e >> 16; }
  const bf16x8_t q0 = *(const bf16x8_t*)(QBb + (size_t)qi * 256 + h * 64 + kg * 8), q1 = *(const bf16x8_t*)(QBb + (size_t)qi * 256 + h * 64 + 32 + kg * 8);
  if (sub == 0) __syncthreads();
  const int nkeys = (own && sub == 0) ? 128 : 256;
  const int nkt = nkeys >> 4;
  f32x4_t sacc[16];
  float mx = -INFINITY;
  const int qpos = slot_in;
#pragma unroll
  for (int kt = 0; kt < 16; ++kt) {
    if (kt < nkt) {
      const bf16x8_t k0 = *(const bf16x8_t*)(Ks + (kt * 16 + qc) * 72 + kg * 8), k1 = *(const bf16x8_t*)(Ks + (kt * 16 + qc) * 72 + 32 + kg * 8);
      f32x4_t a = {0.f, 0.f, 0.f, 0.f};
      a = __builtin_amdgcn_mfma_f32_16x16x32_bf16(k0, q0, a, 0, 0, 0);
      a = __builtin_amdgcn_mfma_f32_16x16x32_bf16(k1, q1, a, 0, 0, 0);
      if (own) {
#pragma unroll
        for (int r = 0; r < 4; ++r) if (kt * 16 + kg * 4 + r > qpos) a[r] = -INFINITY;
      }
      sacc[kt] = a;
      mx = fmaxf(mx, fmaxf(fmaxf(a[0], a[1]), fmaxf(a[2], a[3])));
    } else sacc[kt] = (f32x4_t){-INFINITY, -INFINITY, -INFINITY, -INFINITY};
  }
  mx = fmaxf(mx, __shfl_xor(mx, 16)); mx = fmaxf(mx, __shfl_xor(mx, 32));
  float lsum = 0.f;
#pragma unroll
  for (int kt = 0; kt < 16; ++kt)
#pragma unroll
    for (int r = 0; r < 4; ++r) { const float pv = __builtin_amdgcn_exp2f(sacc[kt][r] - mx); sacc[kt][r] = pv; lsum += pv; }
  lsum += __shfl_xor(lsum, 16); lsum += __shfl_xor(lsum, 32);
  f32x4_t o[4];
#pragma unroll
  for (int dt = 0; dt < 4; ++dt) o[dt] = (f32x4_t){0.f, 0.f, 0.f, 0.f};
#pragma unroll
  for (int ks = 0; ks < 8; ++ks) {
    if (ks * 2 < nkt) {
      bf16x8_t pf;
      {
        const unsigned w0 = pk2(sacc[2 * ks][0], sacc[2 * ks][1]), w1 = pk2(sacc[2 * ks][2], sacc[2 * ks][3]);
        const unsigned w2 = pk2(sacc[2 * ks + 1][0], sacc[2 * ks + 1][1]), w3 = pk2(sacc[2 * ks + 1][2], sacc[2 * ks + 1][3]);
        const uint4 w = make_uint4(w0, w1, w2, w3);
        pf = __builtin_bit_cast(bf16x8_t, w);
      }
#pragma unroll
      for (int dt = 0; dt < 4; ++dt) {
        const bf16x4_t va = *(const bf16x4_t*)(Vt + (dt * 16 + qc) * 264 + ks * 32 + kg * 4), vb = *(const bf16x4_t*)(Vt + (dt * 16 + qc) * 264 + ks * 32 + 16 + kg * 4);
        const bf16x8_t vf = {va[0], va[1], va[2], va[3], vb[0], vb[1], vb[2], vb[3]};
        o[dt] = __builtin_amdgcn_mfma_f32_16x16x32_bf16(vf, pf, o[dt], 0, 0, 0);
      }
    }
  }
  if (valid) {
    const size_t sl = ((size_t)qi * 4 + h) * 4 + src;
    const float inv = 1.f / lsum;
#pragma unroll
    for (int dt = 0; dt < 4; ++dt) *(uint2*)(PART + sl * 64 + dt * 16 + kg * 4) = make_uint2(pk2(o[dt][0] * inv, o[dt][1] * inv), pk2(o[dt][2] * inv, o[dt][3] * inv));
    if (kg == 0) ML[sl] = make_float2(mx, lsum);
  }
  }
}

__device__ __forceinline__ void moba_attn(const Params& p, int l, float* sm) {
  const int bid0_ = bidx();
  const int tid = tidx();
  const int* LCNT = (const int*)(p.ws + WS_LCNT) + l * 256;
  int* pre = (int*)(sm + 36000);
  __syncthreads();
  if (tid < 64) {
    const int4 c4 = *(const int4*)(LCNT + tid * 4);
    const int n0 = (c4.x + 255) >> 8, n1 = (c4.y + 255) >> 8, n2 = (c4.z + 255) >> 8, n3 = (c4.w + 255) >> 8;
    const int tot = n0 + n1 + n2 + n3;
    int inc = tot;
#pragma unroll
    for (int o = 1; o < 64; o <<= 1) { const int t = __shfl_up(inc, o); if (tid >= o) inc += t; }
    const int ex = inc - tot;
    pre[tid * 4] = ex; pre[tid * 4 + 1] = ex + n0; pre[tid * 4 + 2] = ex + n0 + n1; pre[tid * 4 + 3] = ex + n0 + n1 + n2;
    if (tid == 63) pre[256] = inc;
  }
  __syncthreads();
  const int ng = pre[256];
  for (int it = bid0_; it < ng + 256; it += gridDim.x) {
    if (it < ng) {
      int lo = 0, hi = 255;
      while (lo < hi) { const int mid = (lo + hi + 1) >> 1; if (pre[mid] <= it) lo = mid; else hi = mid - 1; }
      moba_attn_item(p, lo >> 6, lo & 63, it - pre[lo], 0, LCNT[lo], sm);
    } else {
      const int w = it - ng;
      moba_attn_item(p, w & 3, w >> 2, 0, 1, 256, sm);
    }
  }
}

__device__ __forceinline__ void gla_out_item(const Params& p, int l, int it2, float* sm) {
  typedef short bf16x8_t __attribute__((ext_vector_type(8)));
  typedef short bf16x4_t __attribute__((ext_vector_type(4)));
  typedef float f32x4_t __attribute__((ext_vector_type(4)));
  const int tid = tidx(), lane = tid & 63, wave = tid >> 6, qc = lane & 15, kg = lane >> 4;
  const int c = it2 >> 1, hp = it2 & 1;
  const bf16raw* P = (const bf16raw*)(p.ws + WS_PROJ);
  const float* BC = (const float*)(p.ws + WS_GA);
  const float* ST = (const float*)(p.ws + WS_ST);
  bf16raw* Y = (bf16raw*)(p.ws + WS_Y);
  const float* cog = p.in[19] + l * 64;
  bf16raw* L = (bf16raw*)sm;
  const size_t t0 = (size_t)c * 64;
  __syncthreads();
  {
    const int hh = tid >> 8, h = hp * 2 + hh;
    bf16raw* Qs = L + hh * 12288; bf16raw* Ks = Qs + 2560; bf16raw* St = Ks + 2560; bf16raw* Vt = St + 2560;
    {
      const int t = (tid >> 2) & 63, d8 = (tid & 3) * 8;
      const bf16raw* qp = P + (t0 + t) * PDIN + PC_CQ + h * 32 + d8; const bf16raw* kp = P + (t0 + t) * PDIN + PC_CK + h * 32 + d8;
      const float4 qa = ld4bf(qp), qb = ld4bf(qp + 4), ka = ld4bf(kp), kb = ld4bf(kp + 4);
      const float4 ba = *(const float4*)(BC + (t0 + t) * 128 + h * 32 + d8), bb = *(const float4*)(BC + (t0 + t) * 128 + h * 32 + d8 + 4);
      const float sc = 0.17677669529663687f;
      *(uint4*)(Qs + t * 40 + d8) = make_uint4(pk2(qa.x * sc * __expf(ba.x), qa.y * sc * __expf(ba.y)), pk2(qa.z * sc * __expf(ba.z), qa.w * sc * __expf(ba.w)),
                                               pk2(qb.x * sc * __expf(bb.x), qb.y * sc * __expf(bb.y)), pk2(qb.z * sc * __expf(bb.z), qb.w * sc * __expf(bb.w)));
      *(uint4*)(Ks + t * 40 + d8) = make_uint4(pk2(ka.x * __expf(-ba.x), ka.y * __expf(-ba.y)), pk2(ka.z * __expf(-ba.z), ka.w * __expf(-ba.w)),
                                               pk2(kb.x * __expf(-bb.x), kb.y * __expf(-bb.y)), pk2(kb.z * __expf(-bb.z), kb.w * __expf(-bb.w)));
    }
    {
      const int j = (tid >> 2) & 63, e0 = (tid & 3) * 16;
      const bf16raw* vp = P + (t0 + j) * PDIN + PC_CV + h * 64 + e0;
      const uint4 va = *(const uint4*)vp, vb = *(const uint4*)(vp + 8);
      const unsigned w[8] = {va.x, va.y, va.z, va.w, vb.x, vb.y, vb.z, vb.w};
#pragma unroll
      for (int q = 0; q < 8; ++q) { Vt[(e0 + 2 * q) * 72 + j] = (bf16raw)(w[q] & 0xffff); Vt[(e0 + 2 * q + 1) * 72 + j] = (bf16raw)(w[q] >> 16); }
    }
    {
      const int d = (tid >> 3) & 31, e0 = (tid & 7) * 8;
      const float* sp = ST + ((size_t)c * 4 + h) * 2048 + d * 64 + e0;
      const float4 sa = *(const float4*)sp, sb = *(const float4*)(sp + 4);
      const float v[8] = {sa.x, sa.y, sa.z, sa.w, sb.x, sb.y, sb.z, sb.w};
#pragma unroll
      for (int q = 0; q < 8; ++q) St[(e0 + q) * 40 + d] = (bf16raw)(pk2(v[q], 0.f) & 0xffff);
    }
  }
  __syncthreads();
  {
    const int hh = wave >> 2, itile = wave & 3, h = hp * 2 + hh;
    const bf16raw* Qs = L + hh * 12288; const bf16raw* Ks = Qs + 2560; const bf16raw* St = Ks + 2560; const bf16raw* Vt = St + 2560;
    const bf16x8_t qf = *(const bf16x8_t*)(Qs + (itile * 16 + qc) * 40 + kg * 8);
    f32x4_t att[4];
#pragma unroll
    for (int jt = 0; jt < 4; ++jt) {
      f32x4_t a = {0.f, 0.f, 0.f, 0.f};
      if (jt <= itile) {
        const bf16x8_t kf = *(const bf16x8_t*)(Ks + (jt * 16 + qc) * 40 + kg * 8);
        a = __builtin_amdgcn_mfma_f32_16x16x32_bf16(kf, qf, a, 0, 0, 0);
        if (jt == itile) {
#pragma unroll
          for (int r = 0; r < 4; ++r) if (kg * 4 + r > qc) a[r] = 0.f;
        }
      }
      att[jt] = a;
    }
    bf16x8_t pf[2];
#pragma unroll
    for (int s2 = 0; s2 < 2; ++s2) {
      const uint4 w = make_uint4(pk2(att[2 * s2][0], att[2 * s2][1]), pk2(att[2 * s2][2], att[2 * s2][3]), pk2(att[2 * s2 + 1][0], att[2 * s2 + 1][1]),
                                 pk2(att[2 * s2 + 1][2], att[2 * s2 + 1][3]));
      pf[s2] = __builtin_bit_cast(bf16x8_t, w);
    }
    f32x4_t o[4];
    float ss = 0.f;
#pragma unroll
    for (int et = 0; et < 4; ++et) {
      f32x4_t acc = {0.f, 0.f, 0.f, 0.f};
      const bf16x8_t sf = *(const bf16x8_t*)(St + (et * 16 + qc) * 40 + kg * 8);
      acc = __builtin_amdgcn_mfma_f32_16x16x32_bf16(sf, qf, acc, 0, 0, 0);
#pragma unroll
      for (int s2 = 0; s2 < 2; ++s2) {
        if (2 * s2 <= itile) {
          const bf16x4_t va = *(const bf16x4_t*)(Vt + (et * 16 + qc) * 72 + s2 * 32 + kg * 4), vb = *(const bf16x4_t*)(Vt + (et * 16 + qc) * 72 + s2 * 32 + 16 + kg * 4);
          const bf16x8_t vf = {va[0], va[1], va[2], va[3], vb[0], vb[1], vb[2], vb[3]};
          acc = __builtin_amdgcn_mfma_f32_16x16x32_bf16(vf, pf[s2], acc, 0, 0, 0);
        }
      }
      o[et] = acc;
      ss += acc[0] * acc[0] + acc[1] * acc[1] + acc[2] * acc[2] + acc[3] * acc[3];
    }
    ss += __shfl_xor(ss, 16); ss += __shfl_xor(ss, 32);
    const float r = rsqrtf(ss * (1.f / 64.f) + 1e-6f);
    const size_t t = t0 + itile * 16 + qc;
#pragma unroll
    for (int et = 0; et < 4; ++et) {
      const int e = et * 16 + kg * 4;
      const float4 rr = ld4bf(P + t * PDIN + PC_CR + h * 64 + e), g = *(const float4*)(cog + e);
      *(uint2*)(Y + t * 1024 + 512 + h * 64 + e) = make_uint2(pk2(o[et][0] * r * g.x * rr.x * sigmoidf_(rr.x), o[et][1] * r * g.y * rr.y * sigmoidf_(rr.y)),
                                                             pk2(o[et][2] * r * g.z * rr.z * sigmoidf_(rr.z), o[et][3] * r * g.w * rr.w * sigmoidf_(rr.w)));
    }
  }
}

__device__ __forceinline__ void lru_out(const Params& p) {
  const int bid0_ = bidx();
  const int tid = tidx();
  const float* LA = (const float*)(p.ws + WS_LA); const float* LB = (const float*)(p.ws + WS_LB); const float* LC = (const float*)(p.ws + WS_LC);
  const bf16raw* P = (const bf16raw*)(p.ws + WS_PROJ);
  bf16raw* Y = (bf16raw*)(p.ws + WS_Y);
  for (int idx = bid0_ * NT + tid; idx < S * 64; idx += gridDim.x * NT) {
    const int t = idx >> 6, c4 = (idx & 63) * 4;
    const float4 a = *(const float4*)(LA + (size_t)t * 256 + c4), b = *(const float4*)(LB + (size_t)t * 256 + c4);
    const float4 cr = *(const float4*)(LC + (size_t)(t >> 5) * 256 + c4), g = ld4bf(P + (size_t)t * PDIN + PC_DG + c4);
    *(uint2*)(Y + (size_t)t * 1024 + 768 + c4) = make_uint2(pk2((b.x + a.x * cr.x) * gelu_tanh(g.x), (b.y + a.y * cr.y) * gelu_tanh(g.y)),
                                                          pk2((b.z + a.z * cr.z) * gelu_tanh(g.z), (b.w + a.w * cr.w) * gelu_tanh(g.w)));
  }
}

__device__ __forceinline__ void ph_mix(const Params& p, int l, float* sm) {
  const int bid0_ = bidx();
  const int grp = bid0_ % 3;
  if (grp == 0) { __syncthreads(); convert_rest(p, sm, l); __syncthreads(); }
  moba_attn(p, l, sm);
  for (int it = bid0_; it < 512; it += gridDim.x) gla_out_item(p, l, it, sm);
  lru_out(p);
  __syncthreads();
  if (grp == 1) { convert_rest(p, sm, l); __syncthreads(); }
  {
    const attn_body::AttnTensors AT{(const attn_body::bf16*)(p.ws + WS_QA), (const attn_body::bf16*)(p.ws + WS_KA), (const attn_body::bf16*)(p.ws + WS_VA),
                                    (attn_body::bf16*)(p.ws + WS_OA), (const attn_body::bf16*)(p.ws + WS_ZERO)};
    const attn_body::StaticOrder so((int)gridDim.x, bid0_);
    attn_body::attn_phase<attn_body::StaticOrder>((char*)sm, AT, so);
  }
  if (grp == 2) { __syncthreads(); convert_rest(p, sm, l); }
}

__device__ __forceinline__ void ph_fin(const Params& p, int l) {
  const int bid0_ = bidx();
  const int tid0_ = tidx();
  const int lane = tid0_ & 63, wave = tid0_ >> 6;
  const bf16raw* OA = (const bf16raw*)(p.ws + WS_OA);
  const bf16raw* P = (const bf16raw*)(p.ws + WS_PROJ);
  bf16raw* Y = (bf16raw*)(p.ws + WS_Y);
  const float lam = lam_of(p, l), li = lam_init_of(l);
  const float2* ML = (const float2*)(p.ws + WS_ML); const bf16raw* PART = (const bf16raw*)(p.ws + WS_PART);
  const float* aog = p.in[14] + l * 64; const float* cog = p.in[19] + l * 64;
#pragma unroll 2
  for (int row = bid0_ * 8 + wave; row < S; row += gridDim.x * 8) {
    int h = lane >> 4, c = (lane & 15) * 4;
    {
      const uint2 u1 = *(const uint2*)(OA + ((size_t)row * 8 + h * 2) * 64 + c), u2 = *(const uint2*)(OA + ((size_t)row * 8 + h * 2 + 1) * 64 + c);
      const float4 o1 = make_float4(bf2f(u1.x & 0xffff), bf2f(u1.x >> 16), bf2f(u1.y & 0xffff), bf2f(u1.y >> 16));
      const float4 o2 = make_float4(bf2f(u2.x & 0xffff), bf2f(u2.x >> 16), bf2f(u2.y & 0xffff), bf2f(u2.y >> 16));
      float4 o = make_float4(o1.x - lam * o2.x, o1.y - lam * o2.y, o1.z - lam * o2.z, o1.w - lam * o2.w);
      float ss = o.x * o.x + o.y * o.y + o.z * o.z + o.w * o.w;
#pragma unroll
      for (int k = 1; k < 16; k <<= 1) ss += __shfl_xor(ss, k);
      float r = rsqrtf(ss * (1.f / 64.f) + 1e-6f) * (1.f - li);
      float4 g = *(const float4*)(aog + c);
      *(uint2*)(Y + (size_t)row * 1024 + h * 64 + c) = make_uint2(pk2(o.x * r * g.x, o.y * r * g.y), pk2(o.z * r * g.z, o.w * r * g.w));
    }
    {
      const size_t sl = ((size_t)row * 4 + h) * 4;
      const float2 m0 = ML[sl], m1 = ML[sl + 1], m2 = ML[sl + 2], m3 = ML[sl + 3];
      const float M = fmaxf(fmaxf(m0.x, m1.x), fmaxf(m2.x, m3.x));
      const float w0 = m0.y * __builtin_amdgcn_exp2f(m0.x - M), w1 = m1.y * __builtin_amdgcn_exp2f(m1.x - M), w2 = m2.y * __builtin_amdgcn_exp2f(m2.x - M),
                  w3 = m3.y * __builtin_amdgcn_exp2f(m3.x - M);
      const float inv = 1.f / (w0 + w1 + w2 + w3);
      float4 o = make_float4(0.f, 0.f, 0.f, 0.f);
      if (w0 > 0.f) { const float4 t = ld4bf(PART + (sl + 0) * 64 + c); o.x += w0 * t.x; o.y += w0 * t.y; o.z += w0 * t.z; o.w += w0 * t.w; }
      if (w1 > 0.f) { const float4 t = ld4bf(PART + (sl + 1) * 64 + c); o.x += w1 * t.x; o.y += w1 * t.y; o.z += w1 * t.z; o.w += w1 * t.w; }
      if (w2 > 0.f) { const float4 t = ld4bf(PART + (sl + 2) * 64 + c); o.x += w2 * t.x; o.y += w2 * t.y; o.z += w2 * t.z; o.w += w2 * t.w; }
      { const float4 t = ld4bf(PART + (sl + 3) * 64 + c); o.x += w3 * t.x; o.y += w3 * t.y; o.z += w3 * t.z; o.w += w3 * t.w; }
      *(uint2*)(Y + (size_t)row * 1024 + 256 + h * 64 + c) = make_uint2(pk2(o.x * inv, o.y * inv), pk2(o.z * inv, o.w * inv));
    }
  }
}

__device__ __forceinline__ void ph_outproj(const Params& p, int l, float* sm) {
  const int bid0_ = bidx();
  pg8::Gemm g{(const pg8::bf16_t*)(p.ws + WS_Y), (const pg8::bf16_t*)(p.ws + WS_WOUT) + (size_t)l * 1024 * 1024, S, 1024, 1024};
  pg8::StaticOrder so; so.init(S, 1024, (int)gridDim.x, bid0_);
  pg8::EpiOutproj E{l == 0 ? p.in[0] : (const float*)nullptr, (const pg8::bf16_t*)(p.ws + WS_XA), (const float*)(p.ws + WS_MOD) + l * 6144 + 2 * 1024, (pg8::bf16_t*)(p.ws + WS_X1)};
  pg8::gemm_phase<pg8::EpiOutproj, pg8::StaticOrder, true, true>((PG8_LAS unsigned char*)sm, g, so, E);
}

__device__ __forceinline__ void ph_gather(const Params& p, int l, float* sm) {
  const int bid0_ = bidx();
  const int tid0_ = tidx();
  const int* cnt = (const int*)(p.ws + WS_CNT) + l * 32;
  int* ps = (int*)sm;
  __syncthreads();
  int* cl = ps + 64;
  if (tid0_ < 32) cl[tid0_] = (cnt[tid0_] + 255) & ~255;
  __syncthreads();
  if (tid0_ < 33) { int a = 0; for (int e = 0; e < tid0_; ++e) a += cl[e]; ps[tid0_] = a; }
  __syncthreads();
  int* srow = (int*)(p.ws + WS_SROW);
  if (bid0_ == 0) {
    int* texp = (int*)(p.ws + WS_TEXP);
    const int nt = ps[32] >> 8;
    if (tid0_ == 0) texp[0] = nt;
    if (tid0_ < 32) { texp[352 + tid0_] = ps[tid0_] >> 8; texp[384 + tid0_] = cl[tid0_] >> 8; }
    if (tid0_ < 320) {
      int e = 0;
      for (int k = 0; k < 32; ++k) if (tid0_ * 256 >= ps[k + 1]) e = k + 1;
      texp[1 + tid0_] = e < 32 ? e : 31;
    }
  }
  for (int e = bid0_; e < 32; e += gridDim.x)
    for (int i = cnt[e] + tid0_; i < cl[e]; i += NT) srow[ps[e] + i] = 0;
  const int* eidx = (const int*)(p.ws + WS_EIDX);
  int* rpos = (int*)(p.ws + WS_RPOS);
  for (int r = bid0_ * NT + tid0_; r < S * 4; r += gridDim.x * NT) {
    const int ei = eidx[r], e = ei & 255, rank = ei >> 8;
    const int dest = ps[e] + rank;
    srow[dest] = r >> 2;
    rpos[r] = dest;
  }
}

__device__ __forceinline__ void ph_up(const Params& p, int l, float* sm) {
  const int bid0_ = bidx();
  pg8::Gemm g{(const pg8::bf16_t*)(p.ws + WS_H), (const pg8::bf16_t*)(p.ws + WS_WUP) + (size_t)l * NE * 2048 * 1024, MOE_ROWS, 2048, 1024};
  int* tab = (int*)(sm + 33000);
  unsigned* rowoff = (unsigned*)(sm + 33104);
  const int t_ = tidx();
  const int* cnt = (const int*)(p.ws + WS_CNT) + l * 32;
  pg8::moe_build_units<8>(cnt, (int)gridDim.x, bid0_, tab, t_);
  pg8::moe_build_rowoff((const int*)(p.ws + WS_ELIST), cnt, tab, rowoff, t_);
  pg8::MoeOrder<8, 1> so{tab, (unsigned*)(p.ws + WS_RDY) + l * 320};
  pg8::EpiUp E{__builtin_amdgcn_make_buffer_rsrc((void*)(p.ws + WS_ACT), 0, (int)((size_t)MOE_ROWS * 1024 * 2), 0x00020000), p.in[30] + (size_t)l * NE * 2048};
  pg8::gemm_phase<pg8::EpiUp, pg8::MoeOrder<8, 1>, true, true, true>((PG8_LAS unsigned char*)sm, g, so, E, rowoff);
}

__device__ __forceinline__ void ph_down(const Params& p, int l, float* sm) {
  const int bid0_ = bidx();
  pg8::Gemm g{(const pg8::bf16_t*)(p.ws + WS_ACT), (const pg8::bf16_t*)(p.ws + WS_WDN) + (size_t)l * NE * 1024 * 1024, MOE_ROWS, 1024, 1024};
  int* tab = (int*)(sm + 33000);
  pg8::moe_build_units<4>((const int*)(p.ws + WS_CNT) + l * 32, (int)gridDim.x, bid0_, tab, tidx(), true);
  pg8::MoeOrder<4, 2> so{tab, (unsigned*)(p.ws + WS_RDY) + l * 320};
  pg8::EpiDown E{(pg8::bf16_t*)(p.ws + WS_YS), p.in[32] + (size_t)l * NE * 1024};
  pg8::gemm_phase<pg8::EpiDown, pg8::MoeOrder<4, 2>, true, true>((PG8_LAS unsigned char*)sm, g, so, E);
}

__device__ __forceinline__ void ph_combine(const Params& p, int l, float* sm) {
  const int bid0_ = bidx();
  const int tid0_ = tidx();
  const int lane = tid0_ & 63, wave = tid0_ >> 6;
  const bf16raw* X1 = (const bf16raw*)(p.ws + WS_X1); const bf16raw* YS = (const bf16raw*)(p.ws + WS_YS);
  const float* gatebuf = (const float*)(p.ws + WS_GATE);
  const int* eidx = (const int*)(p.ws + WS_EIDX);
  const int* cnt = (const int*)(p.ws + WS_CNT) + l * 32;
  const float* g2 = (const float*)(p.ws + WS_MOD) + l * 6144 + 5 * 1024;
  bf16raw* xa = (bf16raw*)(p.ws + WS_XA);
  const float* modn = (const float*)(p.ws + WS_MOD) + 6144;
  const float* gain = p.in[4] + 1024;
  bf16raw* H = (bf16raw*)(p.ws + WS_H);
  int* ps = (int*)sm;
  __syncthreads();
  if (tid0_ < 33) { int a = 0; for (int e = 0; e < tid0_; ++e) a += (cnt[e] + 255) & ~255; ps[tid0_] = a; }
  __syncthreads();
#pragma unroll 2
  for (int row = bid0_ * 8 + wave; row < S; row += gridDim.x * 8) {
    const float4 gt = *(const float4*)(gatebuf + row * 4);
    const int4 ei = *(const int4*)(eidx + row * 4);
    const int4 rp = make_int4(ps[ei.x & 255] + (ei.x >> 8), ps[ei.y & 255] + (ei.y >> 8), ps[ei.z & 255] + (ei.z >> 8), ps[ei.w & 255] + (ei.w >> 8));
    float4 v[4];
    float ss = 0.f;
#pragma unroll
    for (int j = 0; j < 4; ++j) {
      const int c = (lane + 64 * j) * 4;
      const uint2 y0 = *(const uint2*)(YS + (size_t)rp.x * 1024 + c), y1 = *(const uint2*)(YS + (size_t)rp.y * 1024 + c);
      const uint2 y2 = *(const uint2*)(YS + (size_t)rp.z * 1024 + c), y3 = *(const uint2*)(YS + (size_t)rp.w * 1024 + c);
      float4 a;
      a.x = gt.x * bf2f(y0.x & 0xffff) + gt.y * bf2f(y1.x & 0xffff) + gt.z * bf2f(y2.x & 0xffff) + gt.w * bf2f(y3.x & 0xffff);
      a.y = gt.x * bf2f(y0.x >> 16) + gt.y * bf2f(y1.x >> 16) + gt.z * bf2f(y2.x >> 16) + gt.w * bf2f(y3.x >> 16);
      a.z = gt.x * bf2f(y0.y & 0xffff) + gt.y * bf2f(y1.y & 0xffff) + gt.z * bf2f(y2.y & 0xffff) + gt.w * bf2f(y3.y & 0xffff);
      a.w = gt.x * bf2f(y0.y >> 16) + gt.y * bf2f(y1.y >> 16) + gt.z * bf2f(y2.y >> 16) + gt.w * bf2f(y3.y >> 16);
      const float4 x = ld4bf(X1 + (size_t)row * 1024 + c), g = *(const float4*)(g2 + c);
      v[j] = make_float4(x.x + g.x * a.x, x.y + g.y * a.y, x.z + g.z * a.z, x.w + g.w * a.w);
      if (l == 0) *(uint2*)(xa + (size_t)row * 1024 + c) = make_uint2(pk2(v[j].x, v[j].y), pk2(v[j].z, v[j].w)); else *(float4*)(p.out + (size_t)row * 1024 + c) = v[j];
      ss += v[j].x * v[j].x + v[j].y * v[j].y + v[j].z * v[j].z + v[j].w * v[j].w;
    }
    if (l == 0) {
      ss = wave_sum(ss);
      const float r = rsqrtf(ss * (1.f / 1024.f) + 1e-6f);
      uint2* hr = (uint2*)(H + (size_t)row * 1024) + lane;
#pragma unroll
      for (int j = 0; j < 4; ++j) {
        const int c = (lane + 64 * j) * 4;
        const float4 g = *(const float4*)(gain + c), a = *(const float4*)(modn + 1024 + c), b = *(const float4*)(modn + c);
        hr[64 * j] = make_uint2(pk2(v[j].x * r * g.x * (1.f + a.x) + b.x, v[j].y * r * g.y * (1.f + a.y) + b.y),
                                pk2(v[j].z * r * g.z * (1.f + a.z) + b.z, v[j].w * r * g.w * (1.f + a.w) + b.w));
      }
    }
  }
}

#define LAS __attribute__((address_space(3)))
#define XB_TMO      128
#define XB_XCNT(j)  (256  + 64 * (j))
#define XB_XSUB(j)  (1280 + 64 * (j))
#define XB_XGEN(j)  (2304 + 64 * (j))
#define XB_TOP      3328
#define XB_TOPGEN   3392
#define XCD_BAR_WORDS 3456
#define XB_SPIN_CAP (1u << 18)

__device__ __forceinline__ unsigned xb_ld(unsigned* p)              { return __hip_atomic_load(p, __ATOMIC_RELAXED, __HIP_MEMORY_SCOPE_AGENT); }
__device__ __forceinline__ unsigned xb_add(unsigned* p, unsigned v) { return __hip_atomic_fetch_add(p, v, __ATOMIC_RELAXED, __HIP_MEMORY_SCOPE_AGENT); }
__device__ __forceinline__ unsigned xb_xcc_id() { return (unsigned)__builtin_amdgcn_s_getreg((3 << 11) | 20) & 0xFu; }
#define XB_SPIN(cond, bar) do { unsigned _sp = 0; while (cond) { __builtin_amdgcn_s_sleep(1); \
    if ((++_sp & 255u) == 0u) { if (xb_ld(&(bar)[XB_TMO])) break; if (_sp > XB_SPIN_CAP) { atomicAdd(&(bar)[XB_TMO], 1u); break; } } } } while (0)

struct XcdBarrier {
    unsigned* bar; unsigned x;
    volatile LAS unsigned* st;
};

__device__ __forceinline__ XcdBarrier xcd_barrier_post(unsigned* bar, volatile LAS unsigned* st) {
    XcdBarrier b; b.bar = bar; b.x = xb_xcc_id(); b.st = st;
    if (threadIdx.x == 0) (void)xb_add(&bar[XB_XCNT(b.x)], 1u);
    return b;
}
__device__ __forceinline__ void xcd_barrier_complete(unsigned* bar, unsigned x, unsigned& nloc, unsigned& nx) {
    const unsigned G = gridDim.x * gridDim.y * gridDim.z;
    unsigned sum, cnt, mine, sp = 0u;
    for (;;) {
        sum = 0u; cnt = 0u; mine = 0u;
#pragma unroll
        for (unsigned j = 0; j < 16; ++j) { const unsigned c = xb_ld(&bar[XB_XCNT(j)]); sum += c; cnt += (c > 0u) ? 1u : 0u; mine = (j == x) ? c : mine; }
        if (sum == G) break;
        __builtin_amdgcn_s_sleep(1);
        if ((++sp & 255u) == 0u) { if (xb_ld(&bar[XB_TMO])) break; if (sp > XB_SPIN_CAP) { atomicAdd(&bar[XB_TMO], 1u); break; } }
    }
    nloc = mine > 0u ? mine : 1u; nx = cnt > 0u ? cnt : 1u;
}

__device__ __forceinline__ void xcd_barrier(const XcdBarrier& b) {
    asm volatile("s_waitcnt vmcnt(0)" ::: "memory");
    __syncthreads();
    if (threadIdx.x == 0) {
        unsigned* bar = b.bar; asm volatile("" : "+s"(bar));
        const unsigned bx_ = xb_xcc_id();
        __builtin_amdgcn_s_waitcnt(0);
        unsigned nloc = b.st[0], nx = b.st[1];
        if (nloc == 0u) { xcd_barrier_complete(bar, bx_, nloc, nx); b.st[0] = nloc; b.st[1] = nx; }
        const unsigned old = xb_add(&bar[XB_XSUB(bx_)], 1u);
        const unsigned gen = old / nloc;
        if (old + 1u == (gen + 1u) * nloc) {
            __builtin_amdgcn_fence(__ATOMIC_RELEASE, "agent");
            asm volatile("s_waitcnt vmcnt(0)" ::: "memory");
            const unsigned og = xb_add(&bar[XB_TOP], 1u);
            const unsigned tg = og / nx;
            if (og + 1u == (tg + 1u) * nx) xb_add(&bar[XB_TOPGEN], 1u);
            else XB_SPIN(xb_ld(&bar[XB_TOPGEN]) == tg, bar);
            __builtin_amdgcn_fence(__ATOMIC_ACQUIRE, "agent");
            xb_add(&bar[XB_XGEN(bx_)], 1u);
            asm volatile("s_waitcnt vmcnt(0)" ::: "memory");
        } else {
            XB_SPIN(xb_ld(&bar[XB_XGEN(bx_)]) == gen, bar);
            __builtin_amdgcn_fence(__ATOMIC_ACQUIRE, "agent");
            asm volatile("s_waitcnt vmcnt(0)" ::: "memory");
        }
    }
    __syncthreads();
}

template <int SUB>
__device__ __forceinline__ void run_sub(const Params& p, int l, float* sm) {
  const int bid0_ = bidx();
  asm volatile("" : "+s"(l));
  if (SUB == 0) ph_norm(p, l, 0, sm);
  else if (SUB == 1) ph_inproj(p, l, sm);
  else if (SUB == 2) ph_prep(p, l, sm);
  else if (SUB == 3) { ph_scan(p, sm); ph_scan_lru(p, sm); for (int it = bid0_; it < 256; it += gridDim.x) moba_gate_item(p, l, (it - 16) & 255, sm); }
  else if (SUB == 4) ph_mix(p, l, sm);
  else if (SUB == 5) ph_fin(p, l);
  else if (SUB == 6) ph_outproj(p, l, sm);
  else if (SUB == 7) ph_norm2(p, l, sm);
  else if (SUB == 8) ph_gather(p, l, sm);
  else if (SUB == 9) ph_up(p, l, sm);
  else if (SUB == 10) ph_down(p, l, sm);
  else if (SUB == 11) ph_combine(p, l, sm);
}

#if MK_SINGLE
__global__ void __launch_bounds__(NT, 2) mega(Params p) {
  extern __shared__ __attribute__((aligned(16))) unsigned char lds_raw[];
  float* sm = (float*)lds_raw;
  cg::grid_group grid = cg::this_grid();
  unsigned* barw = (unsigned*)(p.ws + WS_BAR);
  volatile LAS unsigned* bst = (volatile LAS unsigned*)((LAS unsigned char*)lds_raw + (LDS_BYTES - 64));
  if (threadIdx.x < 2) bst[threadIdx.x] = 0u;
  if (blockIdx.x == 0) for (int i = threadIdx.x; i < XCD_BAR_WORDS; i += NT) barw[i] = 0u;
  ph_mod(p, sm);
  ph_convert(p, sm);
  grid.sync();
  const XcdBarrier gb = xcd_barrier_post(barw, bst);
#define GSYNC() xcd_barrier(gb)
  run_sub<0>(p, 0, sm); GSYNC();
#pragma unroll 1
  for (int l = 0; l < 2; ++l) {
    run_sub<1>(p, l, sm); GSYNC();
    run_sub<2>(p, l, sm); GSYNC();
    run_sub<3>(p, l, sm); GSYNC();
    run_sub<4>(p, l, sm); GSYNC();
    run_sub<5>(p, l, sm); GSYNC();
    run_sub<6>(p, l, sm); GSYNC();
    run_sub<7>(p, l, sm); GSYNC();
    run_sub<9>(p, l, sm);
    run_sub<10>(p, l, sm); GSYNC();
    run_sub<11>(p, l, sm);
    if (l == 0) GSYNC();
  }
#undef GSYNC
}
#else
template <int SUB>
__global__ void __launch_bounds__(NT, 2) phk(Params p, int l) {
  extern __shared__ __attribute__((aligned(16))) unsigned char lds_raw[];
  float* sm = (float*)lds_raw;
  if (SUB < 0) { ph_mod(p, sm); ph_convert(p, sm); }
  else run_sub<(SUB < 0 ? 0 : SUB)>(p, l, sm);
}
template <int SUB> static void launch_ph(const Params& p, int l, hipStream_t stream) {
  static bool attr = false;
  if (!attr) { (void)hipFuncSetAttribute((const void*)phk<SUB>, hipFuncAttributeMaxDynamicSharedMemorySize, LDS_BYTES); attr = true; }
  hipLaunchKernelGGL(phk<SUB>, dim3(256), dim3(NT), LDS_BYTES, stream, p, l);
}
#endif

extern "C" void kernel_launch(void* const* d_in, const int* in_sizes, int n_in, void* d_out, int out_size, void* d_ws, size_t ws_size,
                              hipStream_t stream) {
  Params p{};
  for (int i = 0; i < 33; ++i) p.in[i] = (const float*)d_in[i];
  p.out = (float*)d_out;
  p.ws = (char*)d_ws;
#if MK_SINGLE
  static int grid_blocks = 0;
  if (!grid_blocks) {
    int dev = 0, cus = 0, per_cu = 0;
    (void)hipGetDevice(&dev);
    (void)hipDeviceGetAttribute(&cus, hipDeviceAttributeMultiprocessorCount, dev);
    (void)hipFuncSetAttribute((const void*)mega, hipFuncAttributeMaxDynamicSharedMemorySize, LDS_BYTES);
    (void)hipOccupancyMaxActiveBlocksPerMultiprocessor(&per_cu, mega, NT, LDS_BYTES);
    if (per_cu < 1) per_cu = 1;
    if (per_cu > 1) per_cu = 1;
    grid_blocks = cus * per_cu;
  }
  void* args[] = {&p};
  hipError_t e = hipLaunchCooperativeKernel((void*)mega, dim3(grid_blocks), dim3(NT), args, LDS_BYTES, stream);
  if (e != hipSuccess) fprintf(stderr, "cooperative launch failed: %s (grid %d)\n", hipGetErrorString(e), grid_blocks);
#else
  launch_ph<-1>(p, 0, stream);
  for (int l = 0; l < 2; ++l) {
    if (l == 0) launch_ph<0>(p, l, stream);
    launch_ph<1>(p, l, stream); launch_ph<2>(p, l, stream); launch_ph<3>(p, l, stream);
    launch_ph<4>(p, l, stream); launch_ph<5>(p, l, stream); launch_ph<6>(p, l, stream); launch_ph<7>(p, l, stream);
    launch_ph<9>(p, l, stream); launch_ph<10>(p, l, stream); launch_ph<11>(p, l, stream);
  }
#endif
}
```

```cpp
#include <hip/hip_runtime.h>
#include <hip/hip_cooperative_groups.h>
#include <cstdio>
#include <cstdint>
namespace cg = cooperative_groups;

#ifndef MK_SINGLE
#define MK_SINGLE 1
#endif
#ifndef PROBE
#define PROBE 0
#endif

constexpr int S = 16384, D = 1024, DIN = 2832, NE = 32;
constexpr int NT = 512;
constexpr size_t MiB = 1u << 20;
constexpr size_t WS_MOD = 0;
constexpr size_t WS_CNT = 64 * 1024;
constexpr size_t WS_TEXP = 128 * 1024;
constexpr size_t WS_KMP = 1 * MiB;
constexpr size_t WS_BAR = 256 * 1024;
constexpr size_t WS_SROW = 320 * 1024;
constexpr size_t WS_RDY = 216 * 1024;
constexpr size_t WS_ZERO = 224 * 1024;
constexpr size_t WS_LCNT = 192 * 1024;
constexpr size_t WS_EIDX = 2 * MiB;
constexpr size_t WS_RPOS = 2 * MiB + 512 * 1024;
constexpr size_t WS_GATE = 3 * MiB;
constexpr size_t WS_H = 8 * MiB;
constexpr size_t WS_VBT = 40 * MiB;
constexpr size_t WS_ELIST = 66 * MiB;
constexpr size_t WS_MLIST = 48 * MiB;
constexpr size_t WS_ML = 64 * MiB;
constexpr size_t WS_PROJ = 72 * MiB;
constexpr size_t WS_Y = 250 * MiB;
constexpr size_t WS_X1 = 314 * MiB;
constexpr size_t WS_XA = 378 * MiB;
constexpr size_t WS_QA = 442 * MiB;
constexpr size_t WS_KA = 458 * MiB;
constexpr size_t WS_QB = 474 * MiB;
constexpr size_t WS_KB = 490 * MiB;
constexpr size_t WS_QBB = 498 * MiB;
constexpr size_t WS_GA = 506 * MiB;
constexpr size_t WS_LA = 514 * MiB;
constexpr size_t WS_LB = 530 * MiB;
constexpr size_t WS_OA = 546 * MiB;
constexpr size_t WS_VA = 562 * MiB;
constexpr size_t WS_SC = 578 * MiB;
constexpr size_t WS_DEC = 586 * MiB;
constexpr size_t WS_LTA = 587 * MiB;
constexpr size_t WS_LTH = 588 * MiB;
constexpr size_t WS_LC = 589 * MiB;
constexpr int MOE_ROWS = 73728;
constexpr size_t WS_ST = 1490 * MiB;
constexpr size_t WS_PART = 1426 * MiB;
constexpr size_t WS_VB = 594 * MiB;
constexpr size_t WS_XS = 602 * MiB;
constexpr size_t WS_ACT = 738 * MiB;
constexpr size_t WS_YS = 882 * MiB;
constexpr size_t WS_WIN = 1026 * MiB;
constexpr size_t WS_WOUT = 1038 * MiB;
constexpr size_t WS_WUP = 1042 * MiB;
constexpr size_t WS_WDN = 1298 * MiB;
constexpr int LDS_BYTES = 147456;

struct Params {
  const float* in[33];
  float* out;
  char* ws;
};

constexpr int PDIN = 1296;
constexpr int PC_CQ = 0, PC_CK = 128, PC_CV = 256, PC_CG = 512, PC_CR = 528, PC_DX = 784, PC_DG = 1040;

__device__ __forceinline__ int bidx() { int b = blockIdx.x; asm volatile("" : "+s"(b)); return b; }
__device__ __forceinline__ int tidx() { int t = threadIdx.x; asm volatile("" : "+v"(t)); return t; }
__device__ __forceinline__ float wave_sum(float v) {
#pragma unroll
  for (int o = 1; o < 64; o <<= 1) v += __shfl_xor(v, o);
  return v;
}
__device__ __forceinline__ float sigmoidf_(float x) { return __builtin_amdgcn_rcpf(1.f + __builtin_amdgcn_exp2f(-1.4426950408889634f * x)); }
__device__ __forceinline__ float logsigmoidf_(float z) { return fminf(z, 0.f) - log1pf(__expf(-fabsf(z))); }
__device__ __forceinline__ float gelu_tanh(float x) {
  float u = 0.7978845608028654f * (x + 0.044715f * x * x * x);
  float t = 1.f - 2.f * __builtin_amdgcn_rcpf(__expf(2.f * u) + 1.f);
  return 0.5f * x * (1.f + t);
}
__device__ __forceinline__ float lam_init_of(int l) { return l == 0 ? 0.2f : (0.8f - 0.6f * 0.7408182206817179f); }
__device__ __forceinline__ float lam_of(const Params& p, int l) {
  float s1 = 0.f, s2 = 0.f;
  for (int i = 0; i < 32; ++i) {
    s1 += p.in[10][l * 32 + i] * p.in[11][l * 32 + i];
    s2 += p.in[12][l * 32 + i] * p.in[13][l * 32 + i];
  }
  return __expf(s1) - __expf(s2) + lam_init_of(l);
}

typedef unsigned short bf16raw;
__device__ __forceinline__ unsigned f2bf(float f) { unsigned u = __builtin_bit_cast(unsigned, f); return (u + 0x7fffu + ((u >> 16) & 1u)) >> 16; }
typedef float f32x2v_ __attribute__((ext_vector_type(2))); typedef __bf16 bf16x2v_ __attribute__((ext_vector_type(2)));
__device__ __forceinline__ unsigned pk2(float lo, float hi) { f32x2v_ v = {lo, hi}; bf16x2v_ b = __builtin_convertvector(v, bf16x2v_); return __builtin_bit_cast(unsigned, b); }
__device__ __forceinline__ float4 ld4bf(const unsigned short* p) { const uint2 u = *(const uint2*)p; return make_float4(__builtin_bit_cast(float, u.x << 16), __builtin_bit_cast(float, u.x & 0xffff0000u), __builtin_bit_cast(float, u.y << 16), __builtin_bit_cast(float, u.y & 0xffff0000u)); }
__device__ __forceinline__ float bf2f(unsigned short h) { return __builtin_bit_cast(float, (unsigned)h << 16); }

namespace pg8 {
#define PG8_LAS __attribute__((address_space(3)))
typedef unsigned short bf16_t;
typedef short bf16x8 __attribute__((ext_vector_type(8)));
typedef float f32x4 __attribute__((ext_vector_type(4)));
typedef unsigned u32x4 __attribute__((ext_vector_type(4)));
constexpr int BM = 256, BK = 64, HALF = 128, HTB = HALF * BK * 2  , STAGE_BYTES = 8 * HTB, NXCD = 8, WGM = 8;

__host__ __device__ __forceinline__ int lds_byte(int r, int c) { const int st = (r >> 4) * 2 + (c >> 5), rr = r & 15, cc = c & 31, ob = rr * 64 + cc * 2; return st * 1024 + (ob ^ (((ob >> 9) & 1) << 5)); }
__host__ __device__ __forceinline__ void stage_rc(int b, int& R, int& C) {
  const int bid0_ = bidx(); const int st = b / 1024, sb = b % 1024, swz = sb ^ (((sb >> 9) & 1) << 5); R = (st >> 1) * 16 + swz / 64; C = (st & 1) * 32 + (swz % 64) / 2; }
__host__ __device__ __forceinline__ int perm32(int rho) { const int n = rho >> 4, i = rho & 15; return 8 * (i >> 2) + 4 * n + (i & 3); }

struct Unit { int pm, pn; };
struct Gemm { const bf16_t* A; const bf16_t* Bt; int M, N, K; };

struct StaticOrder {
    int nM, nN, nwg, G, c;
    __host__ __device__ void init(int M, int N, int G_, int c_) { nM = M / BM; nN = N / BM; nwg = nM * nN; G = G_; c = c_; }
    __host__ __device__ bool next(int i, Unit& u) const {
        const long L = (long)i * G + c; if (L >= nwg) return false;
        int wgid = (int)L; { const int q = nwg / NXCD, r = nwg % NXCD, xcd = wgid % NXCD, off = wgid / NXCD; wgid = (xcd < r ? xcd * (q + 1) : r * (q + 1) + (xcd - r) * q) + off; }
        const int nig = WGM * nN, gid = wgid / nig, fm = gid * WGM, gsz = (nM - fm) < WGM ? (nM - fm) : WGM;
        u.pm = fm + ((wgid % nig) % gsz); u.pn = (wgid % nig) / gsz; return true;
    }
    __device__ __forceinline__ void a_ready(const Unit&) const {}
    __device__ __forceinline__ void done(const Unit&) const {}
};

__device__ __forceinline__ unsigned cvt_pk_bf16(float lo, float hi) { unsigned r; asm volatile("v_cvt_pk_bf16_f32 %0, %1, %2" : "=v"(r) : "v"(lo), "v"(hi)); return r; }
typedef float f32x2 __attribute__((ext_vector_type(2)));
template <class Epi, class Sched, bool ALIGN_EPI = false, bool SP2 = false, bool GATHER = false>
__device__ __forceinline__ void gemm_phase(PG8_LAS unsigned char* lds, const Gemm g, const Sched& S, const Epi& E, const unsigned* rowoff = nullptr) {
    static_assert(!GATHER || SP2, "row gather is wired into the SP2 loop only");
    const int tid = tidx(), wid = __builtin_amdgcn_readfirstlane(tid >> 6), lane = tid & 63, wr = wid >> 2, wc = wid & 3, fr = lane & 15, fq = lane >> 4;
    const int K = g.K, nt = K / BK;
    unsigned voffA[2], voffB[2]; int RA[2], CA[2];
#pragma unroll
    for (int i = 0; i < 2; ++i) { int R, C; stage_rc(tid * 16 + i * 8192, R, C); const int Rb = Epi::PERM ? ((R & ~31) + perm32(R & 31)) : R;
        voffA[i] = (unsigned)(R * K + C) * 2u; voffB[i] = (unsigned)(Rb * K + C) * 2u; RA[i] = R; CA[i] = C; }
    const size_t kstep = (size_t)(BK * 2);
    const size_t hstep = (size_t)HALF * K * 2;
    const size_t tstep = 2 * hstep;
    const unsigned ldsw = (unsigned)wid * 1024u;
    const int aoff = lds_byte(wr * 64 + fr, fq * 8), boff = lds_byte(wc * 32 + fr, fq * 8);
#define PG8_SA(b, h) (((b) * 2 + (h)) * HTB)
#define PG8_SB(b, h) ((4 + (b) * 2 + (h)) * HTB)
#define PG8_STAGE(bufoff, gbase, voff) do { _Pragma("unroll") for (int _i = 0; _i < 2; ++_i) \
        __builtin_amdgcn_global_load_lds((const unsigned*)((const char*)(gbase) + (voff)[_i]), (PG8_LAS unsigned*)(lds + (bufoff) + ldsw + _i * 8192), 16, 0, 0); } while (0)
#define PG8_STAGE2(bufoff, gbase, o0, o1) do { \
        __builtin_amdgcn_global_load_lds((const unsigned*)((const char*)(gbase) + (o0)), (PG8_LAS unsigned*)(lds + (bufoff) + ldsw), 16, 0, 0); \
        __builtin_amdgcn_global_load_lds((const unsigned*)((const char*)(gbase) + (o1)), (PG8_LAS unsigned*)(lds + (bufoff) + ldsw + 8192), 16, 0, 0); } while (0)
#define PG8_GOFF(dst, pm_) do { _Pragma("unroll") for (int _h = 0; _h < 2; ++_h) _Pragma("unroll") for (int _i = 0; _i < 2; ++_i) \
        dst[_h][_i] = rowoff[(pm_) * BM + _h * HALF + RA[_i]] + (unsigned)CA[_i] * 2u; } while (0)
#define PG8_LDA(dst, b, h) do { _Pragma("unroll") for (int m = 0; m < 4; ++m) _Pragma("unroll") for (int k = 0; k < 2; ++k) dst[m][k] = *(const PG8_LAS bf16x8*)(lds + PG8_SA(b, h) + aoff + m * 2048 + k * 1024); } while (0)
#define PG8_LDB(dst, b, h) do { _Pragma("unroll") for (int n = 0; n < 2; ++n) _Pragma("unroll") for (int k = 0; k < 2; ++k) dst[n][k] = *(const PG8_LAS bf16x8*)(lds + PG8_SB(b, h) + boff + n * 2048 + k * 1024); } while (0)
#define PG8_MMA(ai, bj, At, Bt) do { __builtin_amdgcn_s_setprio(1); _Pragma("unroll") for (int m = 0; m < 4; ++m) _Pragma("unroll") for (int n = 0; n < 2; ++n) _Pragma("unroll") for (int k = 0; k < 2; ++k) \
        acc[ai][bj][m][n] = __builtin_amdgcn_mfma_f32_16x16x32_bf16(Bt[n][k], At[m][k], acc[ai][bj][m][n], 0, 0, 0); __builtin_amdgcn_s_setprio(0); } while (0)
#define PG8_WAIT_V(n) asm volatile("s_waitcnt vmcnt(" #n ")" ::: "memory")
#define PG8_WAIT_L(n) asm volatile("s_waitcnt lgkmcnt(" #n ")" ::: "memory")
#define PG8_BAR __builtin_amdgcn_s_barrier()
#define PG8_SCHED __builtin_amdgcn_sched_barrier(0)
    Unit cur, nxt; int ui = 0;
    if (!S.next(0, cur)) return;
    f32x4 acc[2][2][4][2];
#pragma unroll
    for (int a = 0; a < 2; ++a)
#pragma unroll
        for (int b = 0; b < 2; ++b)
#pragma unroll
            for (int m = 0; m < 4; ++m)
#pragma unroll
                for (int n = 0; n < 2; ++n) acc[a][b][m][n] = (f32x4){0.f, 0.f, 0.f, 0.f};
    bf16x8 At[4][2], B0[2][2], B1[2][2];
    const char* cA = GATHER ? (const char*)g.A : (const char*)g.A + (size_t)cur.pm * tstep; const char* cB = (const char*)g.Bt + (size_t)cur.pn * tstep;
    unsigned vA[2][2], vN[2][2];
    if constexpr (GATHER) { PG8_GOFF(vA, 0); _Pragma("unroll") for (int _h = 0; _h < 2; ++_h) _Pragma("unroll") for (int _i = 0; _i < 2; ++_i) vN[_h][_i] = vA[_h][_i]; }
#define PG8_STA(bufoff, ptr, h, nx) do { if constexpr (GATHER) { PG8_STAGE2(bufoff, ptr, (nx) ? vN[h][0] : vA[h][0], (nx) ? vN[h][1] : vA[h][1]); } else { PG8_STAGE(bufoff, (ptr) + (h) * hstep, voffA); } } while (0)
    S.a_ready(cur);
    if constexpr (SP2) {
        PG8_STAGE(PG8_SB(0, 0), cB, voffB); PG8_STAGE(PG8_SB(0, 1), cB + hstep, voffB); PG8_STA(PG8_SA(0, 0), cA, 0, false); PG8_STA(PG8_SA(0, 1), cA, 1, false);
        if (wr == 1) PG8_BAR;
        PG8_WAIT_V(2); PG8_BAR;
        PG8_STAGE(PG8_SB(1, 0), cB + kstep, voffB); PG8_STA(PG8_SA(1, 0), cA + kstep, 0, false); PG8_STAGE(PG8_SB(1, 1), cB + hstep + kstep, voffB);
        PG8_WAIT_V(6); PG8_BAR;
    } else {
        PG8_STAGE(PG8_SB(0, 0), cB, voffB); PG8_STAGE(PG8_SA(0, 0), cA, voffA); PG8_STAGE(PG8_SB(0, 1), cB + hstep, voffB); PG8_STAGE(PG8_SA(0, 1), cA + hstep, voffA);
        if (wr == 1) PG8_BAR;
        PG8_WAIT_V(4); PG8_BAR;
        PG8_STAGE(PG8_SB(1, 0), cB + kstep, voffB); PG8_STA(PG8_SA(1, 0), cA + kstep, 0, false); PG8_STAGE(PG8_SB(1, 1), cB + hstep + kstep, voffB);
        PG8_WAIT_V(6); PG8_BAR;
    }
    for (;;) {
        const bool has_next = S.next(ui + 1, nxt);
        const char* nA = GATHER ? cA : (has_next ? (const char*)g.A + (size_t)nxt.pm * tstep : cA); const char* nB = has_next ? (const char*)g.Bt + (size_t)nxt.pn * tstep : cB;
        if constexpr (GATHER) { if (has_next) { PG8_GOFF(vN, ui + 1); } }
        for (int t = 0; t < nt; t += 2) {
            const bool last = (t == nt - 2);
            const char* a1 = cA + (size_t)(t + 1) * kstep;
            const char* a2 = last ? nA : cA + (size_t)(t + 2) * kstep; const bool nx_ = GATHER && last; const char* b2 = last ? nB : cB + (size_t)(t + 2) * kstep;
            const char* a3 = a2 + kstep; const char* b3 = b2 + kstep;
            if (last && has_next) S.a_ready(nxt);
            if constexpr (SP2) {
            PG8_LDB(B0, 0, 0); PG8_LDB(B1, 0, 1); PG8_SCHED; PG8_LDA(At, 0, 0); PG8_STA(PG8_SA(1, 1), a1, 1, false);
            PG8_WAIT_V(8); PG8_WAIT_L(0); PG8_BAR; PG8_MMA(0, 0, At, B0); PG8_MMA(0, 1, At, B1); PG8_BAR; PG8_SCHED;
            PG8_LDA(At, 0, 1); PG8_STAGE(PG8_SB(0, 0), b2, voffB); PG8_STAGE(PG8_SB(0, 1), b2 + hstep, voffB); PG8_STA(PG8_SA(0, 0), a2, 0, nx_);
            PG8_WAIT_V(8); PG8_WAIT_L(0); PG8_BAR; PG8_MMA(1, 0, At, B0); PG8_MMA(1, 1, At, B1); PG8_BAR; PG8_SCHED;
            PG8_LDB(B0, 1, 0); PG8_LDB(B1, 1, 1); PG8_SCHED; PG8_LDA(At, 1, 0); PG8_STA(PG8_SA(0, 1), a2, 1, nx_);
            PG8_WAIT_V(8); PG8_WAIT_L(0); PG8_BAR; PG8_MMA(0, 0, At, B0); PG8_MMA(0, 1, At, B1); PG8_BAR; PG8_SCHED;
            PG8_LDA(At, 1, 1); PG8_STAGE(PG8_SB(1, 0), b3, voffB); PG8_STAGE(PG8_SB(1, 1), b3 + hstep, voffB); PG8_STA(PG8_SA(1, 0), a3, 0, nx_);
            PG8_WAIT_V(8); PG8_WAIT_L(0); PG8_BAR; PG8_MMA(1, 0, At, B0); PG8_MMA(1, 1, At, B1); PG8_BAR; PG8_SCHED;
            } else {
            PG8_LDB(B0, 0, 0); PG8_SCHED; PG8_LDA(At, 0, 0); PG8_STA(PG8_SA(1, 1), a1, 1, false);
            PG8_WAIT_L(8); PG8_BAR; PG8_WAIT_L(0); PG8_MMA(0, 0, At, B0); PG8_BAR; PG8_SCHED;
            PG8_LDB(B1, 0, 1); PG8_STAGE(PG8_SB(0, 0), b2, voffB);
            PG8_BAR; PG8_WAIT_L(0); PG8_MMA(0, 1, At, B1); PG8_BAR;
            PG8_LDA(At, 0, 1); PG8_STA(PG8_SA(0, 0), a2, 0, nx_);
            PG8_BAR; PG8_WAIT_L(0); PG8_MMA(1, 0, At, B0); PG8_BAR; PG8_SCHED;
            PG8_STAGE(PG8_SB(0, 1), b2 + hstep, voffB);
            PG8_WAIT_V(6); PG8_BAR; PG8_MMA(1, 1, At, B1); PG8_BAR;
            PG8_LDB(B0, 1, 0); PG8_SCHED; PG8_LDA(At, 1, 0); PG8_STA(PG8_SA(0, 1), a2, 1, nx_);
            PG8_WAIT_L(8); PG8_BAR; PG8_WAIT_L(0); PG8_MMA(0, 0, At, B0); PG8_BAR; PG8_SCHED;
            PG8_LDB(B1, 1, 1); PG8_STAGE(PG8_SB(1, 0), b3, voffB);
            PG8_BAR; PG8_WAIT_L(0); PG8_MMA(0, 1, At, B1); PG8_BAR;
            PG8_LDA(At, 1, 1); PG8_STA(PG8_SA(1, 0), a3, 0, nx_);
            PG8_BAR; PG8_WAIT_L(0); PG8_MMA(1, 0, At, B0); PG8_BAR; PG8_SCHED;
            PG8_STAGE(PG8_SB(1, 1), b3 + hstep, voffB);
            PG8_WAIT_V(6); PG8_BAR; PG8_MMA(1, 1, At, B1); PG8_BAR;
            }
        }
        if constexpr (ALIGN_EPI) { if (wr == 0) PG8_BAR; }
        if constexpr (!Epi::AFTER_DRAIN) { E(acc, cur, wr, wc, fr, fq); S.done(cur); }
        if (!has_next) break;
#pragma unroll
        for (int a = 0; a < 2; ++a)
#pragma unroll
            for (int b = 0; b < 2; ++b)
#pragma unroll
                for (int m = 0; m < 4; ++m)
#pragma unroll
                    for (int n = 0; n < 2; ++n) acc[a][b][m][n] = (f32x4){0.f, 0.f, 0.f, 0.f};
        cur = nxt; cA = nA; cB = nB; ++ui;
        if constexpr (GATHER) { _Pragma("unroll") for (int _h = 0; _h < 2; ++_h) _Pragma("unroll") for (int _i = 0; _i < 2; ++_i) vA[_h][_i] = vN[_h][_i]; }
        if constexpr (ALIGN_EPI) { if (wr == 1) PG8_BAR; }
    }
    PG8_WAIT_V(0);
    if constexpr (!ALIGN_EPI) { if (wr == 0) PG8_BAR; }
    PG8_BAR;
    if constexpr (Epi::AFTER_DRAIN) { E.fused(acc, cur, wr, wc, fr, fq, lds, wid, lane); S.done(cur); }
#undef PG8_SA
#undef PG8_SB
#undef PG8_STAGE
#undef PG8_STAGE2
#undef PG8_GOFF
#undef PG8_STA
#undef PG8_LDA
#undef PG8_LDB
#undef PG8_MMA
#undef PG8_WAIT_V
#undef PG8_WAIT_L
#undef PG8_BAR
#undef PG8_SCHED
}
}

namespace pg8 {
struct EpiInproj {
  static constexpr bool PERM = true, AFTER_DRAIN = false;
  bf16_t* QAb; bf16_t* KAb; bf16_t* VAb;
  float* QB; bf16_t* QBb; bf16_t* KBb; bf16_t* VB; float* KMP;
  bf16_t* P2;
  const float* aqg; const float* akg; const float* bqg; const float* bkg; float c2;
  __device__ __forceinline__ static u32x4 pk8(const f32x4& a, const f32x4& b) { u32x4 w; w.x = cvt_pk_bf16(a[0], a[1]); w.y = cvt_pk_bf16(a[2], a[3]); w.z = cvt_pk_bf16(b[0], b[1]); w.w = cvt_pk_bf16(b[2], b[3]); return w; }
  __device__ __forceinline__ void operator()(const f32x4 (&acc)[2][2][4][2], const Unit& u, int wr, int wc, int fr, int fq) const {
    const int row0 = u.pm * BM + wr * 64 + fr, t = u.pn;
    if (t >= 6) {
      const int col0 = (t - 6) * BM + wc * 32 + 8 * fq;
#pragma unroll
      for (int ai = 0; ai < 2; ++ai)
#pragma unroll
        for (int m = 0; m < 4; ++m) {
          bf16_t* rp = P2 + (size_t)(row0 + ai * HALF + m * 16) * 1296;
#pragma unroll
          for (int bj = 0; bj < 2; ++bj) { const int col = col0 + bj * HALF; if (col < 1296) *(u32x4*)(rp + col) = pk8(acc[ai][bj][m][0], acc[ai][bj][m][1]); }
        }
    } else if (t <= 1) {
      const float* gp = (t == 0 ? aqg : akg) + 8 * fq;
      const f32x4 g0 = *(const f32x4*)gp, g1 = *(const f32x4*)(gp + 4);
      bf16_t* dst = t == 0 ? QAb : KAb;
      const float sc = t == 0 ? c2 : 1.f;
#pragma unroll
      for (int ai = 0; ai < 2; ++ai)
#pragma unroll
        for (int m = 0; m < 4; ++m)
#pragma unroll
          for (int bj = 0; bj < 2; ++bj) {
            const f32x4 v0 = acc[ai][bj][m][0], v1 = acc[ai][bj][m][1];
            float ss = (v0[0] * v0[0] + v0[1] * v0[1]) + (v0[2] * v0[2] + v0[3] * v0[3]) + (v1[0] * v1[0] + v1[1] * v1[1]) + (v1[2] * v1[2] + v1[3] * v1[3]);
            ss += __shfl_xor(ss, 16); ss += __shfl_xor(ss, 32);
            const float r = rsqrtf(ss * (1.f / 32.f) + 1e-6f) * sc;
            bf16_t* o = dst + (size_t)(row0 + ai * HALF + m * 16) * 512 + (bj * 4 + wc) * 64 + 8 * fq;
            *(u32x4*)o = pk8(v0 * g0 * r, v1 * g1 * r);
          }
    } else if (t == 2) {
#pragma unroll
      for (int ai = 0; ai < 2; ++ai)
#pragma unroll
        for (int m = 0; m < 4; ++m)
#pragma unroll
          for (int bj = 0; bj < 2; ++bj) {
            const u32x4 w = pk8(acc[ai][bj][m][0], acc[ai][bj][m][1]);
            *(u32x4*)(VAb + (size_t)(row0 + ai * HALF + m * 16) * 256 + bj * HALF + wc * 32 + 8 * fq) = w;
          }
    } else if (t == 5) {
#pragma unroll
      for (int ai = 0; ai < 2; ++ai)
#pragma unroll
        for (int m = 0; m < 4; ++m)
#pragma unroll
          for (int bj = 0; bj < 2; ++bj)
            *(u32x4*)(VB + (size_t)(row0 + ai * HALF + m * 16) * 256 + bj * HALF + wc * 32 + 8 * fq) = pk8(acc[ai][bj][m][0], acc[ai][bj][m][1]);
    } else {
      const float* gp = (t == 3 ? bqg : bkg) + 8 * fq;
      f32x4 g[2][2];
#pragma unroll
      for (int bj = 0; bj < 2; ++bj) { g[bj][0] = *(const f32x4*)(gp + 32 * bj); g[bj][1] = *(const f32x4*)(gp + 32 * bj + 4); }
#pragma unroll
      for (int ai = 0; ai < 2; ++ai) {
        f32x4 cs[2][2];
#pragma unroll
        for (int bj = 0; bj < 2; ++bj) { cs[bj][0] = (f32x4){0.f, 0.f, 0.f, 0.f}; cs[bj][1] = (f32x4){0.f, 0.f, 0.f, 0.f}; }
#pragma unroll
        for (int m = 0; m < 4; ++m) {
          float ss = 0.f;
#pragma unroll
          for (int bj = 0; bj < 2; ++bj)
#pragma unroll
            for (int n = 0; n < 2; ++n) { const f32x4 v = acc[ai][bj][m][n]; ss += (v[0] * v[0] + v[1] * v[1]) + (v[2] * v[2] + v[3] * v[3]); }
          ss += __shfl_xor(ss, 16); ss += __shfl_xor(ss, 32);
          const float r = rsqrtf(ss * (1.f / 64.f) + 1e-6f);
          const size_t ro = (size_t)(row0 + ai * HALF + m * 16) * 256 + wc * 64 + 8 * fq;
#pragma unroll
          for (int bj = 0; bj < 2; ++bj) {
            const f32x4 n0 = acc[ai][bj][m][0] * g[bj][0] * r, n1 = acc[ai][bj][m][1] * g[bj][1] * r;
            if (t == 3) {
              *(f32x4*)(QB + ro + 32 * bj) = n0; *(f32x4*)(QB + ro + 32 * bj + 4) = n1;
              const float qs = 0.125f * 1.4426950408889634f;
              *(u32x4*)(QBb + ro + 32 * bj) = pk8(n0 * qs, n1 * qs);
            } else {
              *(u32x4*)(KBb + ro + 32 * bj) = pk8(n0, n1);
              cs[bj][0] += n0; cs[bj][1] += n1;
            }
          }
        }
        if (t == 4) {
#pragma unroll
          for (int bj = 0; bj < 2; ++bj)
#pragma unroll
            for (int n = 0; n < 2; ++n)
#pragma unroll
              for (int j = 0; j < 4; ++j) { float v = cs[bj][n][j]; v += __shfl_xor(v, 1); v += __shfl_xor(v, 2); v += __shfl_xor(v, 4); v += __shfl_xor(v, 8); cs[bj][n][j] = v; }
          if (fr == 0) {
            float* kp = KMP + (size_t)(u.pm * 4 + ai * 2 + wr) * 256 + wc * 64 + 8 * fq;
#pragma unroll
            for (int bj = 0; bj < 2; ++bj) { *(f32x4*)(kp + 32 * bj) = cs[bj][0]; *(f32x4*)(kp + 32 * bj + 4) = cs[bj][1]; }
          }
        }
      }
    }
  }
};
struct EpiOutproj {
  static constexpr bool PERM = true, AFTER_DRAIN = false;
  const float* xin32; const bf16_t* xin16; const float* g1; bf16_t* X1;
  __device__ __forceinline__ void operator()(const f32x4 (&acc)[2][2][4][2], const Unit& u, int wr, int wc, int fr, int fq) const {
    const int row0 = u.pm * BM + wr * 64 + fr, col0 = u.pn * BM + wc * 32 + 8 * fq;
#pragma unroll
    for (int bj = 0; bj < 2; ++bj) {
      const int col = col0 + bj * HALF;
      const f32x4 g0 = *(const f32x4*)(g1 + col), g1v = *(const f32x4*)(g1 + col + 4);
#pragma unroll
      for (int ai = 0; ai < 2; ++ai)
#pragma unroll
        for (int m = 0; m < 4; ++m) {
          const size_t off = (size_t)(row0 + ai * HALF + m * 16) * 1024 + col;
          f32x4 x0, x1;
          if (xin32) { x0 = *(const f32x4*)(xin32 + off); x1 = *(const f32x4*)(xin32 + off + 4); }
          else {
            const u32x4 w = *(const u32x4*)(xin16 + off);
            x0 = (f32x4){__builtin_bit_cast(float, w.x << 16), __builtin_bit_cast(float, w.x & 0xffff0000u), __builtin_bit_cast(float, w.y << 16), __builtin_bit_cast(float, w.y & 0xffff0000u)};
            x1 = (f32x4){__builtin_bit_cast(float, w.z << 16), __builtin_bit_cast(float, w.z & 0xffff0000u), __builtin_bit_cast(float, w.w << 16), __builtin_bit_cast(float, w.w & 0xffff0000u)};
          }
          const f32x4 v0 = x0 + g0 * acc[ai][bj][m][0], v1 = x1 + g1v * acc[ai][bj][m][1];
          u32x4 o; o.x = cvt_pk_bf16(v0[0], v0[1]); o.y = cvt_pk_bf16(v0[2], v0[3]); o.z = cvt_pk_bf16(v1[0], v1[1]); o.w = cvt_pk_bf16(v1[2], v1[3]);
          *(u32x4*)(X1 + off) = o;
        }
    }
  }
};
struct EpiUp {
  static constexpr bool PERM = true, AFTER_DRAIN = false;
  __amdgpu_buffer_rsrc_t act;
  const float* bup;
  __device__ __forceinline__ void operator()(const f32x4 (&acc)[2][2][4][2], const Unit& u, int wr, int wc, int fr, int fq) const {
    const int e = u.pn >> 3, j = u.pn & 7;
    const int row0 = u.pm * BM + wr * 64 + fr, col0 = j * 128 + wc * 32 + 8 * fq;
    const float* bg = bup + (size_t)e * 2048 + col0; const float* bl = bg + 1024;
    f32x4 bgv[2], blv[2];
#pragma unroll
    for (int n = 0; n < 2; ++n) { bgv[n] = *(const f32x4*)(bg + 4 * n); blv[n] = *(const f32x4*)(bl + 4 * n); }
#pragma unroll
    for (int ai = 0; ai < 2; ++ai)
#pragma unroll
      for (int m = 0; m < 4; ++m) {
        float o[8];
#pragma unroll
        for (int n = 0; n < 2; ++n) {
          const f32x4 gg = acc[ai][0][m][n] + bgv[n], ll = acc[ai][1][m][n] + blv[n];
#pragma unroll
          for (int c = 0; c < 4; ++c) {
            float g = fminf(gg[c], 7.f), lin = fminf(fmaxf(ll[c], -7.f), 7.f);
            float glu = g * __builtin_amdgcn_rcpf(1.f + __builtin_amdgcn_exp2f(-1.702f * 1.4426950408889634f * g));
            o[n * 4 + c] = (lin + 1.f) * glu;
          }
        }
        u32x4 w; w.x = cvt_pk_bf16(o[0], o[1]); w.y = cvt_pk_bf16(o[2], o[3]); w.z = cvt_pk_bf16(o[4], o[5]); w.w = cvt_pk_bf16(o[6], o[7]);
        __builtin_amdgcn_raw_buffer_store_b128(w, act, (unsigned)(((row0 + ai * HALF + m * 16) * 1024 + col0) * 2), 0,   16);
      }
  }
};
struct EpiDown {
  static constexpr bool PERM = true, AFTER_DRAIN = false;
  bf16_t* YS; const float* bdn;
  __device__ __forceinline__ void operator()(const f32x4 (&acc)[2][2][4][2], const Unit& u, int wr, int wc, int fr, int fq) const {
    const int e = u.pn >> 2, j = u.pn & 3;
    const int row0 = u.pm * BM + wr * 64 + fr, col0 = j * 256 + wc * 32 + 8 * fq;
    f32x4 bv[2][2];
#pragma unroll
    for (int bj = 0; bj < 2; ++bj)
#pragma unroll
      for (int n = 0; n < 2; ++n) bv[bj][n] = *(const f32x4*)(bdn + (size_t)e * 1024 + col0 + bj * HALF + 4 * n);
#pragma unroll
    for (int ai = 0; ai < 2; ++ai)
#pragma unroll
      for (int m = 0; m < 4; ++m) {
        bf16_t* rp = YS + (size_t)(row0 + ai * HALF + m * 16) * 1024 + col0;
#pragma unroll
        for (int bj = 0; bj < 2; ++bj) {
          const f32x4 v0 = acc[ai][bj][m][0] + bv[bj][0], v1 = acc[ai][bj][m][1] + bv[bj][1];
          u32x4 w; w.x = cvt_pk_bf16(v0[0], v0[1]); w.y = cvt_pk_bf16(v0[2], v0[3]); w.z = cvt_pk_bf16(v1[0], v1[1]); w.w = cvt_pk_bf16(v1[2], v1[3]);
          *(u32x4*)(rp + bj * HALF) = w;
        }
      }
  }
};
#ifndef MOE_ORDER
#define MOE_ORDER 0
#endif
template <int NJ> __device__ __forceinline__ void moe_build_units(const int* cnt, int G, int c, int* tab, int tid, bool rotate = false) {
  if (tid < 24) {
    int pm = -1, pn = -1, ex = 0, r0 = 0;
    {
      int cc = c;
      if (rotate) {
        int T = 0; for (int e = 0; e < 32; ++e) T += (cnt[e] + 255) >> 8;
        int r8 = 8 * T; while (r8 >= G) r8 -= G;
        cc = c - r8; if (cc < 0) cc += G;
      }
      const long L = (long)tid * G + cc; const int t = (int)(L / NJ);
      int acc = 0;
      for (int e = 0; e < 32; ++e) {
        const int ne = (cnt[e] + 255) >> 8;
        if (pm < 0 && t < acc + ne) { pm = t; pn = e * NJ + (int)(L % NJ); ex = e; r0 = (t - acc) << 8; }
        acc += ne;
      }
    }
    tab[4 * tid] = pm; tab[4 * tid + 1] = pn; tab[4 * tid + 2] = ex; tab[4 * tid + 3] = r0;
  }
  __syncthreads();
}
__device__ __forceinline__ void moe_build_rowoff(const int* elist, const int* cnt, const int* tab, unsigned* rowoff, int tid) {
  for (int i = tid; i < 13 * 256; i += 512) {
    const int u = i >> 8, pm = tab[4 * u];
    unsigned v = 0u;
    if (pm >= 0) { const int e = tab[4 * u + 2], r = tab[4 * u + 3] + (i & 255); if (r < cnt[e]) v = (unsigned)elist[e * 16384 + r] * 2048u; }
    rowoff[i] = v;
  }
  __syncthreads();
}
template <int NJ, int MODE = 0> struct MoeOrder {
  const int* tab;
  unsigned* rdy;
  __device__ __forceinline__ bool next(int i, Unit& u) const {
    if (i >= 24) return false;
    const int pm = tab[4 * i]; if (pm < 0) return false;
    u.pm = pm; u.pn = tab[4 * i + 1]; return true;
  }
  __device__ __forceinline__ void a_ready(const Unit& u) const {
    if constexpr (MODE == 2) {
      if (threadIdx.x < 64) {
        unsigned polls = 0;
        while ((unsigned)__builtin_amdgcn_readfirstlane(__hip_atomic_load(rdy + u.pm, __ATOMIC_RELAXED, __HIP_MEMORY_SCOPE_AGENT)) < 64u) {
          if (++polls > (1u << 22)) break;
          __builtin_amdgcn_s_sleep(2);
        }
        __builtin_amdgcn_fence(__ATOMIC_ACQUIRE, "agent");
        asm volatile("s_waitcnt vmcnt(0)" ::: "memory");
      }
      asm volatile("" ::: "memory"); __builtin_amdgcn_s_barrier(); asm volatile("" ::: "memory");
    }
  }
  __device__ __forceinline__ void done(const Unit& u) const {
    if constexpr (MODE == 1) {
      asm volatile("s_waitcnt vmcnt(0)" ::: "memory");
      if ((threadIdx.x & 63) == 0) __hip_atomic_fetch_add(rdy + u.pm, 1u, __ATOMIC_RELAXED, __HIP_MEMORY_SCOPE_AGENT);
    }
  }
};
}

#include <hip/hip_bf16.h>
#include <cmath>
namespace attn_body {
using bf16=__hip_bfloat16;
using bf16x8=__attribute__((ext_vector_type(8)))short;
using s16x4=__attribute__((ext_vector_type(4)))short;
using f32x16=__attribute__((ext_vector_type(16)))float;
using u32x4=__attribute__((ext_vector_type(4)))unsigned;
constexpr int BATCH=1,NHEAD=8,SEQ=16384,D=64,DM=NHEAD*D;
constexpr int NW=8,QBLK=32,QB=QBLK*NW,KVBLK=64,NQB=SEQ/QB;
constexpr int ATTN_PITCH=DM, ATTN_UNIT_ROWS=QB;
__device__ __forceinline__ int crow(int r,int hi){return (r&3)+8*(r>>2)+4*hi;}
#define SBAR() __builtin_amdgcn_sched_barrier(0)
__device__ __forceinline__ void cmask(f32x16&p0,f32x16&p1,int jb,int qrel,int hi){
  const float NEG=-INFINITY; int kb=64*jb+4*hi;
  #pragma unroll
  for(int r=0;r<16;++r){int kv=kb+(r&3)+8*(r>>2); if(kv>qrel)p0[r]=NEG; if(kv+32>qrel)p1[r]=NEG;}
}

constexpr int NSLOT=3, SLOTB=8192;
constexpr int LDS_K=0, LDS_V=NSLOT*SLOTB, LDS_WS=2*NSLOT*SLOTB, LDS_OST=LDS_WS+NW*64*4, LDS_BYTES=LDS_OST+NW*4096;
constexpr float C2=0.17677669529663687f*1.4426950408889634f;
__device__ __forceinline__ void glds16(const void*gsrc,unsigned lds_dst){unsigned keep;
  asm volatile("s_mov_b32 %0, m0\n\ts_mov_b32 m0, %2\n\ts_nop 0\n\tglobal_load_lds_dwordx4 %1, off\n\ts_mov_b32 m0, %0":"=&s"(keep):"v"(gsrc),"s"(lds_dst):"memory");}
__device__ __forceinline__ float max3f(float a,float b,float c){float r;asm("v_max3_f32 %0, %1, %2, %3":"=v"(r):"v"(a),"v"(b),"v"(c));return r;}
__device__ __forceinline__ float max2f(float a,float b){float r;asm("v_max_f32_e32 %0, %1, %2":"=v"(r):"v"(a),"v"(b));return r;}
__device__ __forceinline__ float fadd_s(float a,float b){float r;asm("v_add_f32_e32 %0, %1, %2":"=v"(r):"v"(a),"v"(b));return r;}
__device__ __forceinline__ float fsub_s(float a,float b){float r;asm("v_sub_f32_e32 %0, %1, %2":"=v"(r):"v"(a),"v"(b));return r;}
typedef float f32x2_t __attribute__((ext_vector_type(2))); typedef __bf16 bf16x2_t __attribute__((ext_vector_type(2)));
__device__ __forceinline__ unsigned cvtpk_s(float lo,float hi){f32x2_t v={lo,hi};bf16x2_t b=__builtin_convertvector(v,bf16x2_t);return __builtin_bit_cast(unsigned,b);}
#define WAIT_BAR(N) asm volatile("s_waitcnt vmcnt(" #N ") lgkmcnt(0)\n\ts_barrier":::"memory")

__device__ __forceinline__ void qkt(f32x16&p0,f32x16&p1,const char*Kslot,const bf16x8*qr,const f32x16&negm,int r32,int hi){
  const char*kb=Kslot+hi*1024+r32*16;
  #pragma unroll
  for(int d0=0;d0<2;++d0){
    const bf16x8 b0=*reinterpret_cast<const bf16x8*>(kb+d0*2048);
    const bf16x8 b1=*reinterpret_cast<const bf16x8*>(kb+d0*2048+512);
    if(d0==0){p0=__builtin_amdgcn_mfma_f32_32x32x16_bf16(b0,qr[0],negm,0,0,0);p1=__builtin_amdgcn_mfma_f32_32x32x16_bf16(b1,qr[0],negm,0,0,0);}
    else{p0=__builtin_amdgcn_mfma_f32_32x32x16_bf16(b0,qr[d0],p0,0,0,0);p1=__builtin_amdgcn_mfma_f32_32x32x16_bf16(b1,qr[d0],p1,0,0,0);}}
}
typedef __attribute__((address_space(3))) const char* lds_cptr;
typedef short v4i16_t __attribute__((ext_vector_type(4)));
__device__ __forceinline__ void kload8(bf16x8*kf,lds_cptr kp){
  kf[0]=*(const __attribute__((address_space(3))) bf16x8*)(kp);      kf[1]=*(const __attribute__((address_space(3))) bf16x8*)(kp+512);
  kf[2]=*(const __attribute__((address_space(3))) bf16x8*)(kp+2048); kf[3]=*(const __attribute__((address_space(3))) bf16x8*)(kp+2560);
  kf[4]=*(const __attribute__((address_space(3))) bf16x8*)(kp+4096); kf[5]=*(const __attribute__((address_space(3))) bf16x8*)(kp+4608);
  kf[6]=*(const __attribute__((address_space(3))) bf16x8*)(kp+6144); kf[7]=*(const __attribute__((address_space(3))) bf16x8*)(kp+6656);
}
__device__ __forceinline__ void kload2(bf16x8*kf,lds_cptr kp,int j){ kf[2*j]=*(const __attribute__((address_space(3))) bf16x8*)(kp+j*2048); kf[2*j+1]=*(const __attribute__((address_space(3))) bf16x8*)(kp+j*2048+512); }
__device__ __forceinline__ s16x4 vtr(lds_cptr p){ return __builtin_bit_cast(s16x4,__builtin_amdgcn_ds_read_tr16_b64_v4i16((__attribute__((address_space(3))) v4i16_t*)p)); }
__device__ __forceinline__ float rowmax(const f32x16&p0,const f32x16&p1){
  float a=max3f(p0[0],p0[1],p1[0]),b=max3f(p0[2],p0[3],p1[1]);a=max3f(a,p1[2],p1[3]);
  #pragma unroll
  for(int r=4;r<16;r+=4){a=max3f(a,p0[r],p0[r+1]);b=max3f(b,p0[r+2],p0[r+3]);a=max3f(a,p1[r],p1[r+1]);b=max3f(b,p1[r+2],p1[r+3]);}
  const float m=max2f(a,b);
  auto rr=__builtin_amdgcn_permlane32_swap(__float_as_uint(m),__float_as_uint(m),false,false);
  return max2f(__uint_as_float(rr[0]),__uint_as_float(rr[1]));
}
__device__ __forceinline__ void pv(f32x16*o,int vb,bf16x8 pa0,bf16x8 pa1,bf16x8 pa2,bf16x8 pa3){
  #pragma unroll
  for(int d0=0;d0<2;++d0){s16x4 lo[4],hi[4];
    #pragma unroll
    for(int ks=0;ks<4;++ks){
      asm volatile("ds_read_b64_tr_b16 %0,%1 offset:%c2":"=&v"(lo[ks]):"v"(vb),"i"(d0*4096+ks*1024):"memory");
      asm volatile("ds_read_b64_tr_b16 %0,%1 offset:%c2":"=&v"(hi[ks]):"v"(vb),"i"(d0*4096+ks*1024+512):"memory");}
    asm volatile("s_waitcnt lgkmcnt(0)":::"memory");SBAR();
    #define PK(k) (bf16x8){lo[k][0],lo[k][1],lo[k][2],lo[k][3],hi[k][0],hi[k][1],hi[k][2],hi[k][3]}
    o[d0]=__builtin_amdgcn_mfma_f32_32x32x16_bf16(pa0,PK(0),o[d0],0,0,0);
    o[d0]=__builtin_amdgcn_mfma_f32_32x32x16_bf16(pa1,PK(1),o[d0],0,0,0);
    o[d0]=__builtin_amdgcn_mfma_f32_32x32x16_bf16(pa2,PK(2),o[d0],0,0,0);
    o[d0]=__builtin_amdgcn_mfma_f32_32x32x16_bf16(pa3,PK(3),o[d0],0,0,0);
    #undef PK
  }
}

#ifndef ATTN_STORE16
#define ATTN_STORE16(p,v) (*(u32x4*)(p)=(v))
#endif
template<int THRL> __device__ __forceinline__ void attn_unit(int b,int h,int qb,const bf16*Q,const bf16*__restrict__ K,const bf16*__restrict__ V,bf16*O,char*shm,const bf16*ATTN_ZERO16){
  const int tid=tidx(),lane=tid&63,r32=lane&31,hi=lane>>5; const int wid=__builtin_amdgcn_readfirstlane(tid>>6);
  const long rowbase=(long)b*SEQ; const int q0=qb*QB;
  const bf16*Qw=Q+(rowbase+q0+wid*QBLK)*DM+h*D;
  constexpr int VP=DM/2;
  const bf16*Kh=K+rowbase*DM+h*D,*Vh=V+rowbase*VP+(h>>1)*D;
  const unsigned lds0=(unsigned)(uintptr_t)shm;
  float*wsf=(float*)(shm+LDS_WS)+wid*64;
  const bf16*ksrc=(wid<4)?Kh+(long)lane*DM+wid*8:ATTN_ZERO16; const long kstep_=(wid<4)?(long)KVBLK*DM:0L;
  const bf16*vsrc=Vh+(long)(16*(wid&3)+(lane>>2))*VP+(wid>>2)*32+(lane&3)*8;
  const unsigned kdst=lds0+LDS_K+wid*1024, vdst=lds0+LDS_V+wid*1024;
  #define DMA_K(t,slot) glds16(ksrc+(long)(t)*kstep_,(unsigned)__builtin_amdgcn_readfirstlane(kdst+(slot)))
  #define DMA_V(t,slot) glds16(vsrc+(long)(t)*KVBLK*VP,(unsigned)__builtin_amdgcn_readfirstlane(vdst+(slot)))
  const int vb0=(int)(lds0+LDS_V)+((lane>>4)&1)*32+(lane&3)*8+(4*hi+((lane&15)>>2))*64;
  const char*Kbase=shm+LDS_K; bf16x8 kf[8];
  const lds_cptr shm3=(lds_cptr)shm; const lds_cptr kp0=shm3+LDS_K+hi*1024+r32*16; const lds_cptr vp0=shm3+LDS_V+((lane>>4)&1)*32+(lane&3)*8+(4*hi+((lane&15)>>2))*64;
  const int NT=(q0+QB)/KVBLK;
  DMA_K(0,0);DMA_V(0,0);DMA_K(1,SLOTB);
  bf16x8 qr[4];
  #pragma unroll
  for(int d0=0;d0<4;++d0)qr[d0]=*reinterpret_cast<const bf16x8*>(&Qw[(long)r32*DM+d0*16+hi*8]);
  float mhat=0.f,l_reg=0.f;f32x16 o[2];o[0]=f32x16{};o[1]=f32x16{};f32x16 negm=f32x16{};asm volatile("":"+v"(negm));
  const int qrel=wid*QBLK+r32;
  #define CMASK(P0,P1,t) do{int jb_=(t)-(NT-4); if(jb_>=0)cmask(P0,P1,jb_,qrel,hi);}while(0)
  bool resc=false;
  #define START(P0,P1) do{ const float rm=rowmax(P0,P1); resc=false; \
    { const float dl=rm; mhat=fadd_s(mhat,dl); \
      _Pragma("unroll") for(int r=0;r<16;++r){P0[r]=fsub_s(P0[r],dl);P1[r]=fsub_s(P1[r],dl);} \
      _Pragma("unroll") for(int r=0;r<16;++r)negm[r]=-mhat; asm volatile("":"+v"(negm)); } \
    _Pragma("unroll") for(int r=0;r<16;++r)P0[r]=__builtin_amdgcn_exp2f(P0[r]); }while(0)
  #define RESC() do{ if(resc){ asm volatile("s_waitcnt lgkmcnt(0)":::"memory"); \
      _Pragma("unroll") for(int d_=0;d_<2;++d_) _Pragma("unroll") for(int r=0;r<16;++r)o[d_][r]*=wsf[crow(r,hi)]; } }while(0)
  f32x16 pA0,pA1,pB0,pB1;
  int sl_prev=0,sl_cur=0,sl_next=SLOTB;
  #define ROT() do{sl_prev=sl_cur;sl_cur=sl_next;sl_next=(sl_next==(NSLOT-1)*SLOTB)?0:sl_next+SLOTB;}while(0)
  DMA_K(2,2*SLOTB);
  WAIT_BAR(3);
  qkt(pA0,pA1,Kbase,qr,negm,r32,hi);asm volatile("s_nop 15\n\ts_nop 7":"+v"(pA0),"+v"(pA1));CMASK(pA0,pA1,0);
  START(pA0,pA1);
  _Pragma("unroll") for(int r=0;r<16;++r)pA1[r]=__builtin_amdgcn_exp2f(pA1[r]);
  WAIT_BAR(0);
  DMA_K(3,0);DMA_V(1,SLOTB);
  ROT();
  kload8(kf,kp0+sl_cur);
  WAIT_BAR(2);
  s16x4 vlo[8],vhi[8]; u32x4 pw0,pw1,pw2,pw3;
  #define PKW(P,B) cvtpk_s(P[B],P[B+1])
  #define PAF(k) __builtin_bit_cast(bf16x8,pw##k)
  #define VFR(i) (bf16x8){vlo[i][0],vlo[i][1],vlo[i][2],vlo[i][3],vhi[i][0],vhi[i][1],vhi[i][2],vhi[i][3]}
  #define PIN(x) asm volatile("":"+v"(x))
  #define MX3(a,b,c) __builtin_fmaxf(__builtin_fmaxf((a),(b)),(c))
  #define GAPA(MF,A0,A1,A2,A3,W0,W1,PW) do{ MF; sacc+=A0; sacc+=A1; sacc+=A2; sacc+=A3; PIN(sacc); W0; W1; PIN(PW); SBAR(); }while(0)
  #define EX(v) __builtin_amdgcn_exp2f(v)
  #define GAPB(MF,X,B) do{ MF; X[B]=EX(X[B]); X[B+1]=EX(X[B+1]); X[B+2]=EX(X[B+2]); X[B+3]=EX(X[B+3]); PIN(X); SBAR(); }while(0)
  #define VRD(i) do{ vlo[i]=vtr(vp_+(((i)>>2)*4096+((i)&3)*1024)); vhi[i]=vtr(vp_+(((i)>>2)*4096+((i)&3)*1024+512)); }while(0)
  #define KRD(G,j) do{ if(G){ kload2(kf,kp0+sl_next,j); SBAR(); } }while(0)
  #define STEP(C0,C1,P0,P1,t,GK,GV,GL) do{ SBAR(); \
    const lds_cptr vp_=vp0+sl_prev; \
    VRD(0); SBAR(); float sacc=(P0[0]+P0[1]); \
    GAPA(C0=__builtin_amdgcn_mfma_f32_32x32x16_bf16(kf[0],qr[0],negm,0,0,0), P0[2],P0[3],P0[4],P0[5],     pw0[0]=PKW(P0,0), pw0[1]=PKW(P0,2), pw0); \
    VRD(4); SBAR(); GAPA(C1=__builtin_amdgcn_mfma_f32_32x32x16_bf16(kf[1],qr[0],negm,0,0,0), P0[6],P0[7],P0[8],P0[9],     pw0[2]=PKW(P0,4), pw0[3]=PKW(P0,6), pw0); \
    VRD(1); SBAR(); GAPA(C0=__builtin_amdgcn_mfma_f32_32x32x16_bf16(kf[2],qr[1],C0,0,0,0),   P0[10],P0[11],P0[12],P0[13], pw1[0]=PKW(P0,8), pw1[1]=PKW(P0,10), pw1); \
    VRD(5); SBAR(); GAPA(C1=__builtin_amdgcn_mfma_f32_32x32x16_bf16(kf[3],qr[1],C1,0,0,0),   P0[14],P0[15],P1[0],P1[1],   pw1[2]=PKW(P0,12),pw1[3]=PKW(P0,14), pw1); \
    VRD(2); SBAR(); GAPA((void)0,   P1[2],P1[3],P1[4],P1[5],     pw2[0]=PKW(P1,0), pw2[1]=PKW(P1,2), pw2); \
    VRD(6); SBAR(); GAPA((void)0,   P1[6],P1[7],P1[8],P1[9],     pw2[2]=PKW(P1,4), pw2[3]=PKW(P1,6), pw2); \
    VRD(3); SBAR(); GAPA((void)0,   P1[10],P1[11],P1[12],P1[13], pw3[0]=PKW(P1,8), pw3[1]=PKW(P1,10), pw3); \
    VRD(7); SBAR(); GAPA((void)0,   P1[14],P1[15],0.f,0.f,       pw3[2]=PKW(P1,12),pw3[3]=PKW(P1,14), pw3); \
    l_reg+=sacc; \
    if(GK){DMA_K((t)+3,sl_cur);} if(GV){DMA_V((t)+1,sl_next);} \
    CMASK(C0,C1,t); \
    { float a=MX3(C0[0],C0[1],C1[0]),b=MX3(C0[2],C0[3],C1[1]); a=MX3(a,C1[2],C1[3]); \
      _Pragma("unroll") for(int r=4;r<16;r+=4){a=MX3(a,C0[r],C0[r+1]);b=MX3(b,C0[r+2],C0[r+3]);a=MX3(a,C1[r],C1[r+1]);b=MX3(b,C1[r+2],C1[r+3]);} \
      float rm=__builtin_fmaxf(a,b); { auto rr=__builtin_amdgcn_permlane32_swap(__float_as_uint(rm),__float_as_uint(rm),false,false); rm=__builtin_fmaxf(__uint_as_float(rr[0]),__uint_as_float(rr[1])); } \
      resc=false; \
      if(__builtin_expect(__any(rm>(float)THRL),0)){ const float dl=__builtin_fmaxf(rm,0.f); mhat+=dl; \
        _Pragma("unroll") for(int r=0;r<16;++r){C0[r]-=dl;C1[r]-=dl;} \
        _Pragma("unroll") for(int r=0;r<16;++r)negm[r]=-mhat; asm volatile("":"+v"(negm)); \
        const float f=__builtin_amdgcn_exp2f(-dl); l_reg*=f; if(hi==0)wsf[r32]=f; resc=true; } } \
    SBAR(); \
    GAPB(o[0]=__builtin_amdgcn_mfma_f32_32x32x16_bf16(PAF(0),VFR(0),o[0],0,0,0), C0,0); \
    GAPB(o[1]=__builtin_amdgcn_mfma_f32_32x32x16_bf16(PAF(0),VFR(4),o[1],0,0,0), C0,4); \
    KRD(GL,0); GAPB(o[0]=__builtin_amdgcn_mfma_f32_32x32x16_bf16(PAF(1),VFR(1),o[0],0,0,0), C0,8); \
    KRD(GL,1); GAPB(o[1]=__builtin_amdgcn_mfma_f32_32x32x16_bf16(PAF(1),VFR(5),o[1],0,0,0), C0,12); \
    KRD(GL,2); GAPB(o[0]=__builtin_amdgcn_mfma_f32_32x32x16_bf16(PAF(2),VFR(2),o[0],0,0,0), C1,0); \
    KRD(GL,3); GAPB(o[1]=__builtin_amdgcn_mfma_f32_32x32x16_bf16(PAF(2),VFR(6),o[1],0,0,0), C1,4); \
    GAPB(o[0]=__builtin_amdgcn_mfma_f32_32x32x16_bf16(PAF(3),VFR(3),o[0],0,0,0), C1,8); \
    GAPB(o[1]=__builtin_amdgcn_mfma_f32_32x32x16_bf16(PAF(3),VFR(7),o[1],0,0,0), C1,12); \
    }while(0)
  int t=1;
  #undef CMASK
  #define CMASK(P0,P1,t) do{}while(0)
  for(;t+5<NT;t+=2){
    STEP(pB0,pB1,pA0,pA1,t,true,true,true);     WAIT_BAR(2); RESC(); ROT();
    STEP(pA0,pA1,pB0,pB1,t+1,true,true,true);   WAIT_BAR(2); RESC(); ROT();
  }
  #undef CMASK
  #define CMASK(P0,P1,t) do{int jb_=(t)-(NT-4); if(jb_>=0)cmask(P0,P1,jb_,qrel,hi);}while(0)
  #define ENDW(tt) do{ if((tt)+3<NT){WAIT_BAR(2);} else if((tt)+2<NT){WAIT_BAR(1);} else {WAIT_BAR(0);} }while(0)
  for(;t+1<NT;t+=2){
    STEP(pB0,pB1,pA0,pA1,t,(t+3<NT),(t+1<NT),(t+1<NT));       ENDW(t);   RESC(); ROT();
    STEP(pA0,pA1,pB0,pB1,t+1,(t+4<NT),(t+2<NT),(t+2<NT));     ENDW(t+1); RESC(); ROT();
  }
  STEP(pB0,pB1,pA0,pA1,NT-1,false,false,false); RESC();
  { float sacc=pB0[0]+pB0[1]; _Pragma("unroll") for(int r=2;r<16;++r)sacc+=pB0[r]; _Pragma("unroll") for(int r=0;r<16;++r)sacc+=pB1[r]; l_reg+=sacc;
    pw0=(u32x4){PKW(pB0,0),PKW(pB0,2),PKW(pB0,4),PKW(pB0,6)};pw1=(u32x4){PKW(pB0,8),PKW(pB0,10),PKW(pB0,12),PKW(pB0,14)};pw2=(u32x4){PKW(pB1,0),PKW(pB1,2),PKW(pB1,4),PKW(pB1,6)};pw3=(u32x4){PKW(pB1,8),PKW(pB1,10),PKW(pB1,12),PKW(pB1,14)};
    SBAR(); pv(o,vb0+sl_cur,PAF(0),PAF(1),PAF(2),PAF(3)); }
  #undef PKW
  #undef PAF
  #undef VFR
  #undef PIN
  #undef MX3
  #undef GAPA
  #undef GAPB
  #undef EX
  #undef VRD
  #undef KRD
  #undef STEP
  #undef ENDW
  {auto rr=__builtin_amdgcn_permlane32_swap(__float_as_uint(l_reg),__float_as_uint(l_reg),false,false);l_reg=__uint_as_float(rr[0])+__uint_as_float(rr[1]);}
  if(hi==0)wsf[32+r32]=l_reg;asm volatile("s_waitcnt lgkmcnt(0)":::"memory");
  float rli[16];
  #pragma unroll
  for(int r=0;r<16;++r)rli[r]=__builtin_amdgcn_rcpf(wsf[32+crow(r,hi)]);
  bf16*Ow=O+(rowbase+q0+wid*QBLK)*DM+h*D;
  { bf16*stg=(bf16*)(shm+LDS_OST)+wid*2048;
    #pragma unroll
    for(int r=0;r<16;++r){const int orow=crow(r,hi);
      #pragma unroll
      for(int d0=0;d0<2;++d0)stg[orow*64+d0*32+r32]=__float2bfloat16(o[d0][r]*rli[r]);}
    asm volatile("s_waitcnt lgkmcnt(0)":::"memory");
    #pragma unroll
    for(int i=0;i<4;++i){const int row=i*8+(lane>>3),ch=lane&7; const u32x4 v=*(const u32x4*)(stg+row*64+ch*8); ATTN_STORE16(Ow+(long)row*DM+ch*8,v);} }
  asm volatile("s_waitcnt lgkmcnt(0)\n\ts_barrier":::"memory");
  #undef DMA_K
  #undef DMA_V
  #undef CMASK
  #undef START
  #undef RESC
  #undef ROT
}
constexpr int ATTN_LDS_BYTES=LDS_BYTES;
struct AttnTensors { const bf16* Q; const bf16* K; const bf16* V; bf16* O; const bf16* Z; };
struct AttnUnit { int bh; int qb; };
struct StaticOrder {
  int vcu,grid;
  __device__ __forceinline__ explicit StaticOrder(int grid_,int block):vcu((block%8)*(grid_/8)+block/8),grid(grid_){}
  __device__ __forceinline__ bool next(int i,AttnUnit&u)const{ const int L=(i>>1)*grid+vcu; if(L>=256)return false; const int s=L&31; u.bh=L>>5; u.qb=(i&1)?63-s:s; return true; }
  __device__ __forceinline__ void a_ready(const AttnUnit&)const{}
  __device__ __forceinline__ void done(const AttnUnit&)const{}
};
template<class Sched,int THRL=8> __device__ __forceinline__ void attn_phase(char*lds,const AttnTensors&T,const Sched&S){
  AttnUnit u;
  for(int i=0;S.next(i,u);++i){ S.a_ready(u); attn_unit<THRL>(u.bh/NHEAD,u.bh%NHEAD,u.qb,T.Q,T.K,T.V,T.O,lds,T.Z); S.done(u); }
}
#undef SBAR
#undef WAIT_BAR
}

__device__ __forceinline__ void transpose_item(const float* W, int N, int k0, int n0, bf16raw* WT, int drow0, float* scr, int lane, int hi_off = 32) {
  const int c4 = (lane & 15) * 4, r0 = lane >> 4;
  const bool inb = (n0 + c4) < N;
  float4 v[16];
  typedef float f32x4nt_ __attribute__((ext_vector_type(4)));
#pragma unroll
  for (int i = 0; i < 16; ++i) {
    if (inb) { const f32x4nt_ t = __builtin_nontemporal_load((const f32x4nt_*)(W + (size_t)(k0 + 4 * i + r0) * N + n0 + c4)); v[i] = make_float4(t[0], t[1], t[2], t[3]); }
    else v[i] = make_float4(0.f, 0.f, 0.f, 0.f);
  }
#pragma unroll
  for (int i = 0; i < 16; ++i) {
    float* sp = scr + (4 * i + r0) * 65 + c4;
    sp[0] = v[i].x; sp[1] = v[i].y; sp[2] = v[i].z; sp[3] = v[i].w;
  }
  __builtin_amdgcn_fence(__ATOMIC_RELEASE, "wavefront"); __builtin_amdgcn_wave_barrier(); __builtin_amdgcn_fence(__ATOMIC_ACQUIRE, "wavefront");
  const int c = lane & 7;
#pragma unroll
  for (int j = 0; j < 8; ++j) {
    const int n = (lane >> 3) + 8 * j;
    const float* sp = scr + (8 * c) * 65 + n;
    uint4 o;
    o.x = pk2(sp[0 * 65], sp[1 * 65]); o.y = pk2(sp[2 * 65], sp[3 * 65]); o.z = pk2(sp[4 * 65], sp[5 * 65]); o.w = pk2(sp[6 * 65], sp[7 * 65]);
    if (n0 + n < N) { typedef unsigned u32x4nt_ __attribute__((ext_vector_type(4))); const u32x4nt_ ov = {o.x, o.y, o.z, o.w}; __builtin_nontemporal_store(ov, (u32x4nt_*)(WT + (size_t)(drow0 + (n & 31) + (n >> 5) * hi_off) * 1024 + k0 + 8 * c)); }
  }
  __builtin_amdgcn_fence(__ATOMIC_RELEASE, "wavefront"); __builtin_amdgcn_wave_barrier(); __builtin_amdgcn_fence(__ATOMIC_ACQUIRE, "wavefront");
}
constexpr int CV_IN = 16 * 45, CV_OUT = 16 * 16, CV_UP = 32 * 16 * 32, CV_DN = 32 * 16 * 16;
__device__ __forceinline__ void convert_one(const Params& p, int l, int r, float* scr, int lane) {
  if (r < CV_IN) {
    const int kb = r / 45, nb = r % 45;
    const int n0 = nb * 64;
    int drow = n0, hio = 32;
    if (n0 >= 768 && n0 < 1280) { const int t = n0 - 768; drow = 768 + (t >> 8) * 256 + ((t >> 6) & 3) * 32; hio = 128; }
    transpose_item(p.in[6] + (size_t)l * 1024 * DIN, DIN, kb * 64, n0, (bf16raw*)(p.ws + WS_WIN) + (size_t)l * 3072 * 1024, drow, scr, lane, hio);
    return;
  }
  r -= CV_IN;
  if (r < CV_OUT) {
    const int kb = r / 16, nb = r % 16;
    transpose_item(p.in[7] + (size_t)l * 1024 * 1024, 1024, kb * 64, nb * 64, (bf16raw*)(p.ws + WS_WOUT) + (size_t)l * 1024 * 1024, nb * 64, scr, lane);
    return;
  }
  r -= CV_OUT;
  if (r < CV_UP) {
    const int e = r / (16 * 32), r2 = r % (16 * 32), kb = r2 / 32, nb = r2 % 32, n0 = nb * 64;
    const int drow = n0 < 1024 ? (n0 >> 7) * 256 + (n0 & 127) : ((n0 - 1024) >> 7) * 256 + 128 + ((n0 - 1024) & 127);
    transpose_item(p.in[29] + ((size_t)l * NE + e) * 1024 * 2048, 2048, kb * 64, n0, (bf16raw*)(p.ws + WS_WUP) + ((size_t)l * NE + e) * 2048 * 1024, drow, scr, lane);
    return;
  }
  r -= CV_UP;
  {
    const int e = r / (16 * 16), r2 = r % (16 * 16), kb = r2 / 16, nb = r2 % 16;
    transpose_item(p.in[31] + ((size_t)l * NE + e) * 1024 * 1024, 1024, kb * 64, nb * 64, (bf16raw*)(p.ws + WS_WDN) + ((size_t)l * NE + e) * 1024 * 1024, nb * 64, scr, lane);
  }
}
__device__ __forceinline__ void ph_convert(const Params& p, float* sm) {
  const int bid0_ = bidx();
  const int tid0_ = tidx();
  const int lane = tid0_ & 63, wave = tid0_ >> 6;
  float* scr = sm + wave * (64 * 65 + 16);
  const int gw = bid0_ * 8 + wave, NGW = gridDim.x * 8;
  for (int it = gw; it < 2 * CV_IN; it += NGW) convert_one(p, it / CV_IN, it % CV_IN, scr, lane);
  for (int i = bid0_ * NT + tid0_; i < 2 * 240 * 128; i += gridDim.x * NT) {
    const int l = i / (240 * 128), r = i % (240 * 128);
    *(uint4*)((bf16raw*)(p.ws + WS_WIN) + (size_t)l * 3072 * 1024 + (size_t)2832 * 1024 + (size_t)r * 8) = make_uint4(0u, 0u, 0u, 0u);
  }
}
__device__ __forceinline__ void convert_rest(const Params& p, float* sm, int l) {
  const int bid0_ = bidx();
  const int tid0_ = tidx();
  const int lane = tid0_ & 63, wave = tid0_ >> 6;
  float* scr = sm + wave * (64 * 65 + 16);
  const int gw = bid0_ * 8 + wave, NGW = gridDim.x * 8;
  for (int it = gw; it < CV_OUT + CV_UP + CV_DN; it += NGW) convert_one(p, l, CV_IN + it, scr, lane);
}

__device__ __forceinline__ void ph_mod(const Params& p, float* sm) {
  const int bid0_ = bidx();
  const int tid0_ = tidx();
  float* mod = (float*)(p.ws + WS_MOD);
  const float* c = p.in[1];
  if (bid0_ == 0 && tid0_ < 64) ((int*)(p.ws + WS_CNT))[tid0_] = 0;
  if (bid0_ == 0) ((int*)(p.ws + WS_LCNT))[tid0_] = 0;
  if (bid0_ == 0 && tid0_ < 16) ((int*)(p.ws + WS_ZERO))[tid0_] = 0;
  if (bid0_ == 0) for (int i = tid0_; i < 640; i += NT) ((unsigned*)(p.ws + WS_RDY))[i] = 0u;
  float* cs = sm;
  float* red = sm + 1024;
  for (int it = bid0_; it < 96; it += gridDim.x) {
    const int l = it / 48, col0 = (it % 48) * 128;
    __syncthreads();
    for (int i = tid0_; i < 1024; i += NT) { const float cv = c[i]; cs[i] = cv / (1.f + __expf(-cv)); }
    __syncthreads();
    const int cg4 = (tid0_ & 31) * 4, kc = tid0_ >> 5;
    const float* w = p.in[2] + (size_t)l * 1024 * 6144 + (size_t)(kc * 64) * 6144 + col0 + cg4;
    float4 acc = make_float4(0.f, 0.f, 0.f, 0.f);
#pragma unroll 16
    for (int i = 0; i < 64; ++i) {
      const float4 wv = *(const float4*)(w + (size_t)i * 6144);
      const float sv = cs[kc * 64 + i];
      acc.x += sv * wv.x; acc.y += sv * wv.y; acc.z += sv * wv.z; acc.w += sv * wv.w;
    }
    *(float4*)(red + kc * 128 + cg4) = acc;
    __syncthreads();
    if (tid0_ < 128) {
      float t = 0.f;
#pragma unroll
      for (int k = 0; k < 16; ++k) t += red[k * 128 + tid0_];
      mod[l * 6144 + col0 + tid0_] = t + p.in[3][l * 6144 + col0 + tid0_];
    }
  }
  __syncthreads();
}

__device__ __forceinline__ void ph_norm(const Params& p, int l, int which, float* sm) {
  const int bid0_ = bidx();
  const int tid0_ = tidx();
  const int lane = tid0_ & 63, wave = tid0_ >> 6;
  const float* mod = (const float*)(p.ws + WS_MOD) + l * 6144;
  const float* xin = which == 0 ? (l == 0 ? p.in[0] : (const float*)(p.ws + WS_XA)) : (const float*)(p.ws + WS_X1);
  const float* gain = (which == 0 ? p.in[4] : p.in[5]) + l * 1024;
  const float* sh = mod + (which == 0 ? 0 : 3) * 1024;
  const float* sc = mod + (which == 0 ? 1 : 4) * 1024;
  bf16raw* H = (bf16raw*)(p.ws + WS_H);
  const float* rw = p.in[27] + (size_t)l * 1024 * 32;
  const float* rb = p.in[28] + l * 32;
  int* cnt = (int*)(p.ws + WS_CNT) + l * 32;
  int* eidx = (int*)(p.ws + WS_EIDX);
  float* gatebuf = (float*)(p.ws + WS_GATE);
  for (int rbase = bid0_ * 8; rbase < S; rbase += gridDim.x * 8) {
    const int row = rbase + wave;
    const float4* xr = (const float4*)(xin + (size_t)row * 1024) + lane;
    float4 v[4];
    float ss = 0.f;
#pragma unroll
    for (int j = 0; j < 4; ++j) {
      v[j] = xr[64 * j];
      ss += v[j].x * v[j].x + v[j].y * v[j].y + v[j].z * v[j].z + v[j].w * v[j].w;
    }
    ss = wave_sum(ss);
    float r = rsqrtf(ss * (1.f / 1024.f) + 1e-6f);
    uint2* hr = (uint2*)(H + (size_t)row * 1024) + lane;
#pragma unroll
    for (int j = 0; j < 4; ++j) {
      int col = (lane + 64 * j) * 4;
      float4 g = *(const float4*)(gain + col), a = *(const float4*)(sc + col), b = *(const float4*)(sh + col);
      v[j].x = v[j].x * r * g.x * (1.f + a.x) + b.x;
      v[j].y = v[j].y * r * g.y * (1.f + a.y) + b.y;
      v[j].z = v[j].z * r * g.z * (1.f + a.z) + b.z;
      v[j].w = v[j].w * r * g.w * (1.f + a.w) + b.w;
      hr[64 * j] = make_uint2(pk2(v[j].x, v[j].y), pk2(v[j].z, v[j].w));
    }
  }
}

__device__ __forceinline__ void ph_norm2(const Params& p, int l, float* sm) {
  const int bid0_ = bidx();
  const int tid = tidx();
  const int lane = tid & 63, wave = tid >> 6;
  const float* mod = (const float*)(p.ws + WS_MOD) + l * 6144;
  const bf16raw* xin = (const bf16raw*)(p.ws + WS_X1);
  const float* gain = p.in[5] + l * 1024;
  const float* sh = mod + 3 * 1024; const float* sc = mod + 4 * 1024;
  bf16raw* H = (bf16raw*)(p.ws + WS_H);
  const float* rw = p.in[27] + (size_t)l * 1024 * 32;
  const float* rb = p.in[28] + l * 32;
  int* cnt = (int*)(p.ws + WS_CNT) + l * 32;
  int* eidx = (int*)(p.ws + WS_EIDX);
  int* elist = (int*)(p.ws + WS_ELIST);
  float* gatebuf = (float*)(p.ws + WS_GATE);
  unsigned short* whi = (unsigned short*)sm;
  unsigned short* wlo = whi + 32 * 1032;
  float* fl = sm + 33024;
  float* gab = fl;
  float* lgp = fl;
  float* cpart = fl + 2048;
  float* cexp = fl + 2560;
  float* rr = fl + 2592;
  int* lcnt = (int*)(fl + 2656);
  int* lbase = lcnt + 32;
  __syncthreads();
  for (int k = tid; k < 1024; k += 512) { gab[k] = gain[k] * (1.f + sc[k]); gab[1024 + k] = sh[k]; }
  __syncthreads();
  {
    const int e = tid & 31, kg = tid >> 5;
    float cacc = 0.f;
#pragma unroll 2
    for (int k8 = 0; k8 < 8; ++k8) {
      const int k0 = kg * 64 + k8 * 8;
      float w[8];
#pragma unroll
      for (int i = 0; i < 8; ++i) w[i] = rw[(size_t)(k0 + i) * 32 + e];
      const float4 g0 = *(const float4*)(gab + k0), g1 = *(const float4*)(gab + k0 + 4);
      const float4 s0 = *(const float4*)(gab + 1024 + k0), s1 = *(const float4*)(gab + 1024 + k0 + 4);
      cacc += s0.x * w[0] + s0.y * w[1] + s0.z * w[2] + s0.w * w[3] + s1.x * w[4] + s1.y * w[5] + s1.z * w[6] + s1.w * w[7];
      w[0] *= g0.x; w[1] *= g0.y; w[2] *= g0.z; w[3] *= g0.w; w[4] *= g1.x; w[5] *= g1.y; w[6] *= g1.z; w[7] *= g1.w;
      unsigned hi[4], lo[4];
#pragma unroll
      for (int i = 0; i < 4; ++i) {
        hi[i] = pk2(w[2 * i], w[2 * i + 1]);
        lo[i] = pk2(w[2 * i] - __builtin_bit_cast(float, hi[i] << 16), w[2 * i + 1] - __builtin_bit_cast(float, hi[i] & 0xffff0000u));
      }
      *(uint4*)(whi + e * 1032 + k0) = make_uint4(hi[0], hi[1], hi[2], hi[3]);
      *(uint4*)(wlo + e * 1032 + k0) = make_uint4(lo[0], lo[1], lo[2], lo[3]);
    }
    cpart[kg * 32 + e] = cacc;
  }
  float4 ga[4], gb[4];
#pragma unroll
  for (int j = 0; j < 4; ++j) { ga[j] = *(const float4*)(gab + (lane + 64 * j) * 4); gb[j] = *(const float4*)(gab + 1024 + (lane + 64 * j) * 4); }
  for (int rbase = bid0_ * 64; rbase < S; rbase += gridDim.x * 64) {
    if (tid < 32) lcnt[tid] = 0;
#pragma unroll 2
    for (int ri = 0; ri < 8; ++ri) {
      const int rl = wave * 8 + ri, row = rbase + rl;
      const bf16raw* xr = xin + (size_t)row * 1024 + lane * 4;
      float4 v[4];
      float ss = 0.f;
#pragma unroll
      for (int j = 0; j < 4; ++j) { v[j] = ld4bf(xr + 256 * j); ss += v[j].x * v[j].x + v[j].y * v[j].y + v[j].z * v[j].z + v[j].w * v[j].w; }
      ss = wave_sum(ss);
      const float r = rsqrtf(ss * (1.f / 1024.f) + 1e-6f);
      if (lane == 0) rr[rl] = r;
      uint2* hr = (uint2*)(H + (size_t)row * 1024) + lane;
#pragma unroll
      for (int j = 0; j < 4; ++j) {
        const float4 g = ga[j], b = gb[j];
        hr[64 * j] = make_uint2(pk2(v[j].x * r * g.x + b.x, v[j].y * r * g.y + b.y), pk2(v[j].z * r * g.z + b.z, v[j].w * r * g.w + b.w));
      }
    }
    typedef short bf16x8 __attribute__((ext_vector_type(8)));
    typedef float f32x4 __attribute__((ext_vector_type(4)));
    const int rt = wave & 3, kh = wave >> 2, fr = lane & 15, fq = lane >> 4;
    bf16x8 xf[16];
    {
      const bf16raw* xp = xin + (size_t)(rbase + rt * 16 + fr) * 1024 + kh * 512 + fq * 8;
#pragma unroll
      for (int ks = 0; ks < 16; ++ks) xf[ks] = *(const bf16x8*)(xp + ks * 32);
    }
    __syncthreads();
    if (tid < 32) {
      float c = rb[tid];
#pragma unroll
      for (int g = 0; g < 16; ++g) c += cpart[g * 32 + tid];
      cexp[tid] = c;
    }
    f32x4 d0 = {0.f, 0.f, 0.f, 0.f}, d1 = {0.f, 0.f, 0.f, 0.f};
    {
      const unsigned short* wh = whi + fr * 1032 + kh * 512 + fq * 8;
      const unsigned short* wl = wlo + fr * 1032 + kh * 512 + fq * 8;
#pragma unroll
      for (int ks = 0; ks < 16; ++ks) {
        const bf16x8 h0 = *(const bf16x8*)(wh + ks * 32), l0 = *(const bf16x8*)(wl + ks * 32);
        const bf16x8 h1 = *(const bf16x8*)(wh + 16 * 1032 + ks * 32), l1 = *(const bf16x8*)(wl + 16 * 1032 + ks * 32);
        d0 = __builtin_amdgcn_mfma_f32_16x16x32_bf16(xf[ks], h0, d0, 0, 0, 0);
        d1 = __builtin_amdgcn_mfma_f32_16x16x32_bf16(xf[ks], h1, d1, 0, 0, 0);
        d0 = __builtin_amdgcn_mfma_f32_16x16x32_bf16(xf[ks], l0, d0, 0, 0, 0);
        d1 = __builtin_amdgcn_mfma_f32_16x16x32_bf16(xf[ks], l1, d1, 0, 0, 0);
      }
    }
    if (kh == 1) {
#pragma unroll
      for (int j = 0; j < 4; ++j) { lgp[(rt * 16 + fq * 4 + j) * 32 + fr] = d0[j]; lgp[(rt * 16 + fq * 4 + j) * 32 + 16 + fr] = d1[j]; }
    }
    __syncthreads();
    if (kh == 0) {
#pragma unroll
      for (int j = 0; j < 4; ++j) { lgp[(rt * 16 + fq * 4 + j) * 32 + fr] += d0[j]; lgp[(rt * 16 + fq * 4 + j) * 32 + 16 + fr] += d1[j]; }
    }
    __syncthreads();
    const int row_l = tid >> 3, eg = tid & 7;
    float acc[4];
    {
      const float4 t = *(const float4*)(lgp + row_l * 32 + eg * 4), c4 = *(const float4*)(cexp + eg * 4);
      const float r = rr[row_l];
      acc[0] = t.x * r + c4.x; acc[1] = t.y * r + c4.y; acc[2] = t.z * r + c4.z; acc[3] = t.w * r + c4.w;
    }
    float tv[4]; int ti[4];
#pragma unroll
    for (int rd = 0; rd < 4; ++rd) {
      float bv = acc[0]; int bi = eg * 4;
#pragma unroll
      for (int c = 1; c < 4; ++c) if (acc[c] > bv) { bv = acc[c]; bi = eg * 4 + c; }
#pragma unroll
      for (int o = 1; o < 8; o <<= 1) {
        const float ov = __shfl_xor(bv, o); const int oi = __shfl_xor(bi, o);
        if (ov > bv || (ov == bv && oi < bi)) { bv = ov; bi = oi; }
      }
      tv[rd] = bv; ti[rd] = bi;
#pragma unroll
      for (int c = 0; c < 4; ++c) if (bi == eg * 4 + c) acc[c] = -INFINITY;
    }
    int rk[4] = {0, 0, 0, 0};
    if (eg == 0) {
#pragma unroll
      for (int k = 0; k < 4; ++k) rk[k] = atomicAdd(&lcnt[ti[k]], 1);
    }
    __syncthreads();
    if (tid < 32) { const int c = lcnt[tid]; lbase[tid] = c > 0 ? atomicAdd(&cnt[tid], c) : 0; }
    __syncthreads();
    if (eg == 0) {
      const int row = rbase + row_l;
      const float e1 = __expf(tv[1] - tv[0]), e2 = __expf(tv[2] - tv[0]), e3 = __expf(tv[3] - tv[0]);
      const float inv = 1.f / (1.f + e1 + e2 + e3);
      *(int4*)(eidx + row * 4) = make_int4(ti[0] | ((lbase[ti[0]] + rk[0]) << 8), ti[1] | ((lbase[ti[1]] + rk[1]) << 8), ti[2] | ((lbase[ti[2]] + rk[2]) << 8),
                                           ti[3] | ((lbase[ti[3]] + rk[3]) << 8));
      *(float4*)(gatebuf + row * 4) = make_float4(inv, e1 * inv, e2 * inv, e3 * inv);
#pragma unroll
      for (int k = 0; k < 4; ++k) elist[ti[k] * S + lbase[ti[k]] + rk[k]] = row;
    }
  }
}

__device__ __forceinline__ void ph_inproj(const Params& p, int l, float* sm) {
  const int bid0_ = bidx();
  pg8::Gemm g{(const pg8::bf16_t*)(p.ws + WS_H), (const pg8::bf16_t*)(p.ws + WS_WIN) + (size_t)l * 3072 * 1024, S, 3072, 1024};
  pg8::StaticOrder so; so.init(S, 3072, (int)gridDim.x, bid0_);
  pg8::EpiInproj E{(pg8::bf16_t*)(p.ws + WS_QA), (pg8::bf16_t*)(p.ws + WS_KA), (pg8::bf16_t*)(p.ws + WS_VA), (float*)(p.ws + WS_QB), (pg8::bf16_t*)(p.ws + WS_QBB), (pg8::bf16_t*)(p.ws + WS_KB),
                   (pg8::bf16_t*)(p.ws + WS_VB), (float*)(p.ws + WS_KMP), (pg8::bf16_t*)(p.ws + WS_PROJ), p.in[8] + l * 32, p.in[9] + l * 32, p.in[15] + l * 64, p.in[16] + l * 64, attn_body::C2};
  pg8::gemm_phase<pg8::EpiInproj, pg8::StaticOrder, true, true>((PG8_LAS unsigned char*)sm, g, so, E);
}

__device__ __forceinline__ void gla_local_item(const Params& p, int l, int c, float* sm) {
  const int tid = tidx();
  const bf16raw* P = (const bf16raw*)(p.ws + WS_PROJ);
  float* BC = (float*)(p.ws + WS_GA);
  float* SC = (float*)(p.ws + WS_SC); float* DEC = (float*)(p.ws + WS_DEC);
  const float* wg2 = p.in[17] + l * 16 * 128; const float* bg = p.in[18] + l * 128;
  typedef short bf16x8 __attribute__((ext_vector_type(8)));
  typedef float f32x4 __attribute__((ext_vector_type(4)));
  typedef unsigned u32x4 __attribute__((ext_vector_type(4)));
  float* gs = sm; float* ks = sm + 8192;
  bf16raw* vsb = (bf16raw*)(sm + 16384);
  bf16raw* kth = (bf16raw*)(sm + 16384 + 8320); bf16raw* ktl = kth + 128 * 72;
  float* part = sm + 33920; float* gls = sm + 34432;
  const size_t t0 = (size_t)c * 64;
  const int d = tid & 127, qtr = tid >> 7;
  float wcol[16];
#pragma unroll
  for (int r = 0; r < 16; ++r) wcol[r] = wg2[r * 128 + d];
  const float bias = bg[d];
  {
    if (tid < 128) {
      const int t = tid >> 1, hf = tid & 1;
      const uint4 w = *(const uint4*)(P + (t0 + t) * PDIN + PC_CG + hf * 8);
      *(float4*)(gls + t * 16 + hf * 8) = make_float4(__builtin_bit_cast(float, w.x << 16), __builtin_bit_cast(float, w.x & 0xffff0000u), __builtin_bit_cast(float, w.y << 16), __builtin_bit_cast(float, w.y & 0xffff0000u));
      *(float4*)(gls + t * 16 + hf * 8 + 4) = make_float4(__builtin_bit_cast(float, w.z << 16), __builtin_bit_cast(float, w.z & 0xffff0000u), __builtin_bit_cast(float, w.w << 16), __builtin_bit_cast(float, w.w & 0xffff0000u));
    }
#pragma unroll
    for (int u = 0; u < 2; ++u) { int idx = tid + u * 512, row = idx >> 4, c8 = (idx & 15) * 8; const uint4 w = *(const uint4*)(P + (t0 + row) * PDIN + PC_CK + c8);
      *(float4*)(ks + row * 128 + c8) = make_float4(__builtin_bit_cast(float, w.x << 16), __builtin_bit_cast(float, w.x & 0xffff0000u), __builtin_bit_cast(float, w.y << 16), __builtin_bit_cast(float, w.y & 0xffff0000u));
      *(float4*)(ks + row * 128 + c8 + 4) = make_float4(__builtin_bit_cast(float, w.z << 16), __builtin_bit_cast(float, w.z & 0xffff0000u), __builtin_bit_cast(float, w.w << 16), __builtin_bit_cast(float, w.w & 0xffff0000u)); }
#pragma unroll
    for (int u = 0; u < 4; ++u) { int idx = tid + u * 512, row = idx >> 5, c8 = (idx & 31) * 8; const uint4 w = *(const uint4*)(P + (t0 + row) * PDIN + PC_CV + c8);
      *(uint2*)(vsb + row * 260 + c8) = make_uint2(w.x, w.y); *(uint2*)(vsb + row * 260 + c8 + 4) = make_uint2(w.z, w.w); }
  }
  __syncthreads();
  float gv[16];
  {
    float run = 0.f;
#pragma unroll
    for (int i = 0; i < 16; ++i) {
      const float* gp = gls + (qtr * 16 + i) * 16;
      const float4 x0 = *(const float4*)gp, x1 = *(const float4*)(gp + 4), x2 = *(const float4*)(gp + 8), x3 = *(const float4*)(gp + 12);
      const float z = bias + x0.x * wcol[0] + x0.y * wcol[1] + x0.z * wcol[2] + x0.w * wcol[3] + x1.x * wcol[4] + x1.y * wcol[5] + x1.z * wcol[6] + x1.w * wcol[7]
                    + x2.x * wcol[8] + x2.y * wcol[9] + x2.z * wcol[10] + x2.w * wcol[11] + x3.x * wcol[12] + x3.y * wcol[13] + x3.z * wcol[14] + x3.w * wcol[15];
      run += logsigmoidf_(z) * (1.f / 16.f);
      gv[i] = run;
    }
    part[qtr * 128 + d] = run;
  }
  __syncthreads();
  {
    float off = 0.f;
#pragma unroll
    for (int q = 0; q < 3; ++q) if (q < qtr) off += part[q * 128 + d];
#pragma unroll
    for (int i = 0; i < 16; ++i) { gv[i] += off; BC[(t0 + qtr * 16 + i) * 128 + d] = gv[i]; }
    if (qtr == 3) gs[63 * 128 + d] = gv[15];
  }
  __syncthreads();
  {
    const float bl = gs[63 * 128 + d];
    if (qtr == 0) DEC[(size_t)c * 128 + d] = __expf(bl);
    float kp[16];
#pragma unroll
    for (int i = 0; i < 16; ++i) kp[i] = ks[(qtr * 16 + i) * 128 + d] * __expf(bl - gv[i]);
    unsigned hi[8], lo[8];
#pragma unroll
    for (int i = 0; i < 8; ++i) {
      hi[i] = pk2(kp[2 * i], kp[2 * i + 1]);
      lo[i] = pk2(kp[2 * i] - __builtin_bit_cast(float, hi[i] << 16), kp[2 * i + 1] - __builtin_bit_cast(float, hi[i] & 0xffff0000u));
    }
    *(uint4*)(kth + d * 72 + qtr * 16) = make_uint4(hi[0], hi[1], hi[2], hi[3]); *(uint4*)(kth + d * 72 + qtr * 16 + 8) = make_uint4(hi[4], hi[5], hi[6], hi[7]);
    *(uint4*)(ktl + d * 72 + qtr * 16) = make_uint4(lo[0], lo[1], lo[2], lo[3]); *(uint4*)(ktl + d * 72 + qtr * 16 + 8) = make_uint4(lo[4], lo[5], lo[6], lo[7]);
  }
  __syncthreads();
  {
    const int lane = tid & 63, wave = tid >> 6, fr = lane & 15, fq = lane >> 4, h = wave >> 1, ddt = wave & 1;
    f32x4 acc[4];
#pragma unroll
    for (int et = 0; et < 4; ++et) acc[et] = (f32x4){0.f, 0.f, 0.f, 0.f};
#pragma unroll
    for (int ksx = 0; ksx < 2; ++ksx) {
      const bf16x8 ah = *(const bf16x8*)(kth + (h * 32 + ddt * 16 + fr) * 72 + ksx * 32 + fq * 8);
      const bf16x8 al = *(const bf16x8*)(ktl + (h * 32 + ddt * 16 + fr) * 72 + ksx * 32 + fq * 8);
#pragma unroll
      for (int et = 0; et < 4; ++et) {
        const bf16raw* vp = vsb + (ksx * 32 + fq * 8) * 260 + h * 64 + et * 16 + fr;
        u32x4 w;
#pragma unroll
        for (int i = 0; i < 4; ++i) w[i] = (unsigned)vp[(2 * i) * 260] | ((unsigned)vp[(2 * i + 1) * 260] << 16);
        const bf16x8 bv = __builtin_bit_cast(bf16x8, w);
        acc[et] = __builtin_amdgcn_mfma_f32_16x16x32_bf16(ah, bv, acc[et], 0, 0, 0);
        acc[et] = __builtin_amdgcn_mfma_f32_16x16x32_bf16(al, bv, acc[et], 0, 0, 0);
      }
    }
    float* o = SC + (((size_t)c * 4 + h) * 32 + ddt * 16 + fq * 4) * 64 + fr;
#pragma unroll
    for (int et = 0; et < 4; ++et)
#pragma unroll
      for (int j = 0; j < 4; ++j) o[j * 64 + et * 16] = acc[et][j];
  }
  __syncthreads();
}

__device__ __forceinline__ void lru_local_item(const Params& p, int l, int c, float* sm) {
  typedef short bf16x8 __attribute__((ext_vector_type(8)));
  typedef float f32x4 __attribute__((ext_vector_type(4)));
  typedef unsigned u32x4 __attribute__((ext_vector_type(4)));
  const int tid = tidx();
  const int lane = tid & 63, wave = tid >> 6, fr = lane & 15, fq = lane >> 4;
  const bf16raw* P = (const bf16raw*)(p.ws + WS_PROJ);
  float* LA = (float*)(p.ws + WS_LA); float* LB = (float*)(p.ws + WS_LB);
  float* LTA = (float*)(p.ws + WS_LTA); float* LTH = (float*)(p.ws + WS_LTH);
  const float* cw = p.in[20] + l * 4 * 256; const float* cb = p.in[21] + l * 256;
  const float* wa = p.in[22] + (size_t)l * 4 * 64 * 64; const float* ba = p.in[23] + l * 256;
  const float* wx = p.in[24] + (size_t)l * 4 * 64 * 64; const float* bx = p.in[25] + l * 256;
  const float* lam = p.in[26] + l * 256;
  constexpr int PX = 260;
  float* xcs = sm;
  float* As = sm + 64 * PX;
  const int t0 = c * 64;
  bf16raw* dxs = (bf16raw*)(sm + 64 * PX);
  const int n = wave >> 1, eh = wave & 1;
  bf16x8 wh[2][2][2], wl[2][2][2];
#pragma unroll
  for (int g = 0; g < 2; ++g)
#pragma unroll
    for (int et = 0; et < 2; ++et)
#pragma unroll
      for (int ks = 0; ks < 2; ++ks) {
        const float* wp = (g == 0 ? wa : wx) + (size_t)(n * 64 + ks * 32 + fq * 8) * 64 + eh * 32 + et * 16 + fr;
        float w[8];
#pragma unroll
        for (int i = 0; i < 8; ++i) w[i] = wp[i * 64];
        u32x4 hi, lo;
#pragma unroll
        for (int i = 0; i < 4; ++i) {
          hi[i] = pk2(w[2 * i], w[2 * i + 1]);
          lo[i] = pk2(w[2 * i] - __builtin_bit_cast(float, hi[i] << 16), w[2 * i + 1] - __builtin_bit_cast(float, hi[i] & 0xffff0000u));
        }
        wh[g][et][ks] = __builtin_bit_cast(bf16x8, hi); wl[g][et][ks] = __builtin_bit_cast(bf16x8, lo);
      }
  float lsv[2], bav[2], bxv[2];
#pragma unroll
  for (int et = 0; et < 2; ++et) { const int ch = n * 64 + eh * 32 + et * 16 + fr; lsv[et] = 8.f * logsigmoidf_(lam[ch]); bav[et] = ba[ch]; bxv[et] = bx[ch]; }
  for (int i = tid; i < 67 * 32; i += NT) {
    const int r = i >> 5, c8 = (i & 31) * 8, ts = t0 - 3 + r;
    *(uint4*)(dxs + r * 256 + c8) = ts >= 0 ? *(const uint4*)(P + (size_t)ts * PDIN + PC_DX + c8) : make_uint4(0u, 0u, 0u, 0u);
  }
  __syncthreads();
  {
    const int ch = tid & 255;
    const float w0 = cw[ch], w1 = cw[256 + ch], w2 = cw[512 + ch], w3 = cw[768 + ch], bb = cb[ch];
#pragma unroll 4
    for (int tt = tid >> 8; tt < 64; tt += 2)
      xcs[tt * PX + ch] = bb + w0 * bf2f(dxs[tt * 256 + ch]) + w1 * bf2f(dxs[(tt + 1) * 256 + ch]) + w2 * bf2f(dxs[(tt + 2) * 256 + ch]) + w3 * bf2f(dxs[(tt + 3) * 256 + ch]);
  }
  __syncthreads();
#pragma unroll 1
  for (int tt = 0; tt < 4; ++tt) {
    bf16x8 xh[2], xl[2];
#pragma unroll
    for (int ks = 0; ks < 2; ++ks) {
      const float* xp = xcs + (tt * 16 + fr) * PX + n * 64 + ks * 32 + fq * 8;
      const float4 v0 = *(const float4*)xp, v1 = *(const float4*)(xp + 4);
      const float f[8] = {v0.x, v0.y, v0.z, v0.w, v1.x, v1.y, v1.z, v1.w};
      u32x4 hi, lo;
#pragma unroll
      for (int i = 0; i < 4; ++i) {
        hi[i] = pk2(f[2 * i], f[2 * i + 1]);
        lo[i] = pk2(f[2 * i] - __builtin_bit_cast(float, hi[i] << 16), f[2 * i + 1] - __builtin_bit_cast(float, hi[i] & 0xffff0000u));
      }
      xh[ks] = __builtin_bit_cast(bf16x8, hi); xl[ks] = __builtin_bit_cast(bf16x8, lo);
    }
    float xo[2][4];
#pragma unroll
    for (int et = 0; et < 2; ++et)
#pragma unroll
      for (int j = 0; j < 4; ++j) xo[et][j] = xcs[(tt * 16 + fq * 4 + j) * PX + n * 64 + eh * 32 + et * 16 + fr];
    __syncthreads();
#pragma unroll
    for (int et = 0; et < 2; ++et) {
      f32x4 ar = {0.f, 0.f, 0.f, 0.f}, ai = {0.f, 0.f, 0.f, 0.f};
#pragma unroll
      for (int ks = 0; ks < 2; ++ks) {
        ar = __builtin_amdgcn_mfma_f32_16x16x32_bf16(xh[ks], wh[0][et][ks], ar, 0, 0, 0);
        ai = __builtin_amdgcn_mfma_f32_16x16x32_bf16(xh[ks], wh[1][et][ks], ai, 0, 0, 0);
        ar = __builtin_amdgcn_mfma_f32_16x16x32_bf16(xl[ks], wh[0][et][ks], ar, 0, 0, 0);
        ai = __builtin_amdgcn_mfma_f32_16x16x32_bf16(xl[ks], wh[1][et][ks], ai, 0, 0, 0);
        ar = __builtin_amdgcn_mfma_f32_16x16x32_bf16(xh[ks], wl[0][et][ks], ar, 0, 0, 0);
        ai = __builtin_amdgcn_mfma_f32_16x16x32_bf16(xh[ks], wl[1][et][ks], ai, 0, 0, 0);
      }
      const int ch = n * 64 + eh * 32 + et * 16 + fr;
#pragma unroll
      for (int j = 0; j < 4; ++j) {
        const int t = tt * 16 + fq * 4 + j;
        const float rg = sigmoidf_(ar[j] + bav[et]), ig = sigmoidf_(ai[j] + bxv[et]);
        const float a = __expf(rg * lsv[et]);
        As[t * 256 + ch] = a;
        xcs[t * PX + ch] = sqrtf(fmaxf(1.f - a * a, 0.f)) * (ig * xo[et][j]);
      }
    }
  }
  __syncthreads();
  {
    const int ch = tid & 255, half = tid >> 8, tb = half * 32;
    float Hh = 0.f, Ac = 1.f;
#pragma unroll 8
    for (int i = 0; i < 32; ++i) {
      const int t = tb + i;
      const float a = As[t * 256 + ch], bt = xcs[t * PX + ch];
      Hh = a * Hh + bt; Ac *= a;
      LA[(size_t)(t0 + t) * 256 + ch] = Ac; LB[(size_t)(t0 + t) * 256 + ch] = Hh;
    }
    LTA[(size_t)(c * 2 + half) * 256 + ch] = Ac; LTH[(size_t)(c * 2 + half) * 256 + ch] = Hh;
  }
  __syncthreads();
}

__device__ __forceinline__ void ph_prep(const Params& p, int l, float* sm) {
  const int bid0_ = bidx();
  const int tid0_ = tidx();
  const int lane = tid0_ & 63, wave = tid0_ >> 6;
  const bf16raw* P = (const bf16raw*)(p.ws + WS_PROJ);
  bf16raw* QAb = (bf16raw*)(p.ws + WS_QA); bf16raw* KAb = (bf16raw*)(p.ws + WS_KA); bf16raw* VAb = (bf16raw*)(p.ws + WS_VA);
  float* QB = (float*)(p.ws + WS_QB); bf16raw* KBb = (bf16raw*)(p.ws + WS_KB); bf16raw* QBb = (bf16raw*)(p.ws + WS_QBB);
  float* KMP = (float*)(p.ws + WS_KMP); bf16raw* VBt = (bf16raw*)(p.ws + WS_VBT);
  const float* aqg = p.in[8] + l * 32; const float* akg = p.in[9] + l * 32;
  const float* bqg = p.in[15] + l * 64; const float* bkg = p.in[16] + l * 64;
  const float* wg2 = p.in[17] + l * 16 * 128; const float* bg = p.in[18] + l * 128;
  bf16raw* vsl = (bf16raw*)sm;
  const bf16raw* VBn = (const bf16raw*)(p.ws + WS_VB);
  for (int tile = bid0_; tile < S / 64; tile += gridDim.x) {
    __syncthreads();
#pragma unroll
    for (int u = 0; u < 4; ++u) { const int idx = tid0_ + u * 512, r = idx >> 5, c8 = (idx & 31) * 8; *(uint4*)(vsl + r * 264 + c8) = *(const uint4*)(VBn + (size_t)(tile * 64 + r) * 256 + c8); }
    __syncthreads();
    {
      const int col = tid0_ & 255, half = tid0_ >> 8;
      unsigned w[16];
#pragma unroll
      for (int i = 0; i < 16; ++i) w[i] = (unsigned)vsl[(half * 32 + 2 * i) * 264 + col] | ((unsigned)vsl[(half * 32 + 2 * i + 1) * 264 + col] << 16);
      uint4* dst = (uint4*)(VBt + (size_t)col * S + tile * 64 + half * 32);
#pragma unroll
      for (int i = 0; i < 4; ++i) dst[i] = make_uint4(w[4 * i], w[4 * i + 1], w[4 * i + 2], w[4 * i + 3]);
    }
  }
  __syncthreads();
  for (int c = bid0_; c < S / 64; c += gridDim.x) gla_local_item(p, l, c, sm);
  for (int c = bid0_; c < S / 64; c += gridDim.x) lru_local_item(p, l, c, sm);
}

__device__ __forceinline__ void ph_scan(const Params& p, float* sm) {
  const int bid0_ = bidx();
  const int tid = tidx();
  const float* SC = (const float*)(p.ws + WS_SC); const float* DEC = (const float*)(p.ws + WS_DEC); float* STo = (float*)(p.ws + WS_ST);
  float* gA = sm; float* gH = sm + 512; float* gC = sm + 1024;
  for (int b = bid0_; b < 256; b += gridDim.x) {
    const int chain = tid & 31, grp = tid >> 5, gid = b * 32 + chain;
    float sv[16], dv[16];
#pragma unroll
    for (int i = 0; i < 16; ++i) { const int c = grp * 16 + i; sv[i] = SC[(size_t)c * 8192 + gid]; dv[i] = DEC[c * 128 + (gid >> 6)]; }
    float A = 1.f, H = 0.f;
#pragma unroll
    for (int i = 0; i < 16; ++i) { H = dv[i] * H + sv[i]; A *= dv[i]; }
    __syncthreads();
    gA[tid] = A; gH[tid] = H;
    __syncthreads();
    if (tid < 32) {
      float carry = 0.f;
#pragma unroll
      for (int g = 0; g < 16; ++g) { gC[g * 32 + tid] = carry; carry = gA[g * 32 + tid] * carry + gH[g * 32 + tid]; }
    }
    __syncthreads();
    float st = gC[tid];
#pragma unroll
    for (int i = 0; i < 16; ++i) { const int c = grp * 16 + i; STo[(size_t)c * 8192 + gid] = st; st = dv[i] * st + sv[i]; }
  }
}
__device__ __forceinline__ void ph_scan_lru(const Params& p, float* sm) {
  const int bid0_ = bidx();
  const int tid = tidx();
  const float* LTA = (const float*)(p.ws + WS_LTA); const float* LTH = (const float*)(p.ws + WS_LTH); float* LC = (float*)(p.ws + WS_LC);
  for (int b = bid0_; b < 48; b += gridDim.x) {
    if (b < 16) continue;
    const int ch = (b - 16) * 8 + (tid & 7), grp = tid >> 3;
    float a[8], h[8];
#pragma unroll
    for (int i = 0; i < 8; ++i) { a[i] = LTA[(grp * 8 + i) * 256 + ch]; h[i] = LTH[(grp * 8 + i) * 256 + ch]; }
    float A = 1.f, H = 0.f;
#pragma unroll
    for (int i = 0; i < 8; ++i) { H = a[i] * H + h[i]; A *= a[i]; }
    __syncthreads();
    sm[tid] = A; sm[512 + tid] = H;
    __syncthreads();
    if (tid < 8) {
      float carry = 0.f;
      for (int g = 0; g < 64; ++g) { const float ga = sm[g * 8 + tid], gh = sm[512 + g * 8 + tid]; sm[1024 + g * 8 + tid] = carry; carry = ga * carry + gh; }
    }
    __syncthreads();
    float carry = sm[1024 + tid];
#pragma unroll
    for (int i = 0; i < 8; ++i) { LC[(grp * 8 + i) * 256 + ch] = carry; carry = a[i] * carry + h[i]; }
  }
}

__device__ __forceinline__ void moba_gate_item(const Params& p, int l, int it, float* sm) {
  const int tid = tidx();
  const int h = it & 3, own = it >> 2, qi = own * 256 + (tid >> 1), half = tid & 1;
  const float* QB = (const float*)(p.ws + WS_QB); const float* KMP = (const float*)(p.ws + WS_KMP);
  int* LCNT = (int*)(p.ws + WS_LCNT) + l * 256; int* LIST = (int*)(p.ws + WS_MLIST); float2* ML = (float2*)(p.ws + WS_ML);
  float* km = sm;
  int* lcnt = (int*)(sm + 4096); int* lbase = lcnt + 64;
  __syncthreads();
  for (int idx = tid; idx < own * 64; idx += NT) {
    const int n = idx >> 6, c = idx & 63;
    const float* kp = KMP + (size_t)(4 * n) * 256 + h * 64 + c;
    km[idx] = (kp[0] + kp[256] + kp[512] + kp[768]) * (1.f / 256.f);
  }
  if (tid < 64) lcnt[tid] = 0;
  __syncthreads();
  float q[64];
  {
    const float4* qp = (const float4*)(QB + (size_t)qi * 256 + h * 64);
#pragma unroll
    for (int i = 0; i < 16; ++i) { float4 t = qp[i]; q[4 * i] = t.x; q[4 * i + 1] = t.y; q[4 * i + 2] = t.z; q[4 * i + 3] = t.w; }
  }
  int s0 = -1, s1 = -1, s2 = -1;
  float g0 = -INFINITY, g1 = -INFINITY, g2 = -INFINITY;
#pragma unroll 1
  for (int n = half; n < own; n += 2) {
    const float4* kmp = (const float4*)(km + n * 64);
    float a = 0.f;
#pragma unroll
    for (int i = 0; i < 16; ++i) { float4 t = kmp[i]; a += q[4 * i] * t.x + q[4 * i + 1] * t.y + q[4 * i + 2] * t.z + q[4 * i + 3] * t.w; }
    if (a > g0) { g2 = g1; s2 = s1; g1 = g0; s1 = s0; g0 = a; s0 = n; }
    else if (a > g1) { g2 = g1; s2 = s1; g1 = a; s1 = n; }
    else if (a > g2) { g2 = a; s2 = n; }
  }
  {
    const float pg0 = __shfl_xor(g0, 1), pg1 = __shfl_xor(g1, 1), pg2 = __shfl_xor(g2, 1);
    const int ps0 = __shfl_xor(s0, 1), ps1 = __shfl_xor(s1, 1), ps2 = __shfl_xor(s2, 1);
#define MOBA_INS(A, N) do { const float a_ = (A); const int n_ = (N); if (n_ >= 0) {                                                   \
      if (a_ > g0 || (a_ == g0 && n_ < s0) || s0 < 0) { g2 = g1; s2 = s1; g1 = g0; s1 = s0; g0 = a_; s0 = n_; }                         \
      else if (a_ > g1 || (a_ == g1 && n_ < s1) || s1 < 0) { g2 = g1; s2 = s1; g1 = a_; s1 = n_; }                                      \
      else if (a_ > g2 || (a_ == g2 && n_ < s2) || s2 < 0) { g2 = a_; s2 = n_; } } } while (0)
    MOBA_INS(pg0, ps0); MOBA_INS(pg1, ps1); MOBA_INS(pg2, ps2);
#undef MOBA_INS
  }
  int r0 = 0, r1 = 0, r2 = 0;
  if (half == 0) {
    if (s0 >= 0) r0 = atomicAdd(&lcnt[s0], 1);
    if (s1 >= 0) r1 = atomicAdd(&lcnt[s1], 1);
    if (s2 >= 0) r2 = atomicAdd(&lcnt[s2], 1);
  }
  __syncthreads();
  if (tid < 64) { const int c = lcnt[tid]; lbase[tid] = c > 0 ? atomicAdd(&LCNT[h * 64 + tid], c) : 0; }
  __syncthreads();
  if (half == 0) {
    const float2 dead = make_float2(-INFINITY, 0.f);
    const size_t sl = ((size_t)qi * 4 + h) * 4;
    if (s0 >= 0) LIST[(size_t)(h * 64 + s0) * 16384 + lbase[s0] + r0] = qi | (0 << 16); else ML[sl + 0] = dead;
    if (s1 >= 0) LIST[(size_t)(h * 64 + s1) * 16384 + lbase[s1] + r1] = qi | (1 << 16); else ML[sl + 1] = dead;
    if (s2 >= 0) LIST[(size_t)(h * 64 + s2) * 16384 + lbase[s2] + r2] = qi | (2 << 16); else ML[sl + 2] = dead;
  }
}

__device__ __forceinline__ void moba_attn_item(const Params& p, int h, int n, int chunk, int own, int len, float* sm) {
  typedef short bf16x8_t __attribute__((ext_vector_type(8)));
  typedef short bf16x4_t __attribute__((ext_vector_type(4)));
  typedef float f32x4_t __attribute__((ext_vector_type(4)));
  const int tid = tidx(), lane = tid & 63, wave = tid >> 6, qc = lane & 15, kg = lane >> 4;
  const bf16raw* KBb = (const bf16raw*)(p.ws + WS_KB); const bf16raw* QBb = (const bf16raw*)(p.ws + WS_QBB); const bf16raw* VBt = (const bf16raw*)(p.ws + WS_VBT);
  const int* LIST = (const int*)(p.ws + WS_MLIST); float2* ML = (float2*)(p.ws + WS_ML); bf16raw* PART = (bf16raw*)(p.ws + WS_PART);
  bf16raw* Ks = (bf16raw*)sm;
  bf16raw* Vt = (bf16raw*)sm + 256 * 72;
  __syncthreads();
#pragma unroll
  for (int u = 0; u < 4; ++u) {
    const int idx = tid + u * 512, key = idx >> 3, ch = idx & 7;
    *(uint4*)(Ks + key * 72 + ch * 8) = *(const uint4*)(KBb + (size_t)(n * 256 + key) * 256 + h * 64 + ch * 8);
    const int d = idx >> 5, c2 = idx & 31;
    *(uint4*)(Vt + d * 264 + c2 * 8) = *(const uint4*)(VBt + (size_t)(h * 64 + d) * S + n * 256 + c2 * 8);
  }
#pragma unroll 1
  for (int sub = 0; sub < 2; ++sub) {
  if (!own && chunk * 256 + sub * 128 >= len) break;
  const int slot_in = chunk * 256 + sub * 128 + wave * 16 + qc;
  int qi, src; bool valid = true;
  if (own) { qi = n * 256 + slot_in; src = 3; }
  else { valid = slot_in < len; const int e = LIST[(size_t)(h * 64 + n) * 16384 + (valid ? slot_in : 0)]; qi = e & 0xffff; src = e >> 16; }
  const bf16x8_t q0 = *(const bf16x8_t*)(QBb + (size_t)qi * 256 + h * 64 + kg * 8), q1 = *(const bf16x8_t*)(QBb + (size_t)qi * 256 + h * 64 + 32 + kg * 8);
  if (sub == 0) __syncthreads();
  const int nkeys = (own && sub == 0) ? 128 : 256;
  const int nkt = nkeys >> 4;
  f32x4_t sacc[16];
  float mx = -INFINITY;
  const int qpos = slot_in;
#pragma unroll
  for (int kt = 0; kt < 16; ++kt) {
    if (kt < nkt) {
      const bf16x8_t k0 = *(const bf16x8_t*)(Ks + (kt * 16 + qc) * 72 + kg * 8), k1 = *(const bf16x8_t*)(Ks + (kt * 16 + qc) * 72 + 32 + kg * 8);
      f32x4_t a = {0.f, 0.f, 0.f, 0.f};
      a = __builtin_amdgcn_mfma_f32_16x16x32_bf16(k0, q0, a, 0, 0, 0);
      a = __builtin_amdgcn_mfma_f32_16x16x32_bf16(k1, q1, a, 0, 0, 0);
      if (own) {
#pragma unroll
        for (int r = 0; r < 4; ++r) if (kt * 16 + kg * 4 + r > qpos) a[r] = -INFINITY;
      }
      sacc[kt] = a;
      mx = fmaxf(mx, fmaxf(fmaxf(a[0], a[1]), fmaxf(a[2], a[3])));
    } else sacc[kt] = (f32x4_t){-INFINITY, -INFINITY, -INFINITY, -INFINITY};
  }
  mx = fmaxf(mx, __shfl_xor(mx, 16)); mx = fmaxf(mx, __shfl_xor(mx, 32));
  float lsum = 0.f;
#pragma unroll
  for (int kt = 0; kt < 16; ++kt)
#pragma unroll
    for (int r = 0; r < 4; ++r) { const float pv = __builtin_amdgcn_exp2f(sacc[kt][r] - mx); sacc[kt][r] = pv; lsum += pv; }
  lsum += __shfl_xor(lsum, 16); lsum += __shfl_xor(lsum, 32);
  f32x4_t o[4];
#pragma unroll
  for (int dt = 0; dt < 4; ++dt) o[dt] = (f32x4_t){0.f, 0.f, 0.f, 0.f};
#pragma unroll
  for (int ks = 0; ks < 8; ++ks) {
    if (ks * 2 < nkt) {
      bf16x8_t pf;
      {
        const unsigned w0 = pk2(sacc[2 * ks][0], sacc[2 * ks][1]), w1 = pk2(sacc[2 * ks][2], sacc[2 * ks][3]);
        const unsigned w2 = pk2(sacc[2 * ks + 1][0], sacc[2 * ks + 1][1]), w3 = pk2(sacc[2 * ks + 1][2], sacc[2 * ks + 1][3]);
        const uint4 w = make_uint4(w0, w1, w2, w3);
        pf = __builtin_bit_cast(bf16x8_t, w);
      }
#pragma unroll
      for (int dt = 0; dt < 4; ++dt) {
        const bf16x4_t va = *(const bf16x4_t*)(Vt + (dt * 16 + qc) * 264 + ks * 32 + kg * 4), vb = *(const bf16x4_t*)(Vt + (dt * 16 + qc) * 264 + ks * 32 + 16 + kg * 4);
        const bf16x8_t vf = {va[0], va[1], va[2], va[3], vb[0], vb[1], vb[2], vb[3]};
        o[dt] = __builtin_amdgcn_mfma_f32_16x16x32_bf16(vf, pf, o[dt], 0, 0, 0);
      }
    }
  }
  if (valid) {
    const size_t sl = ((size_t)qi * 4 + h) * 4 + src;
    const float inv = 1.f / lsum;
#pragma unroll
    for (int dt = 0; dt < 4; ++dt) *(uint2*)(PART + sl * 64 + dt * 16 + kg * 4) = make_uint2(pk2(o[dt][0] * inv, o[dt][1] * inv), pk2(o[dt][2] * inv, o[dt][3] * inv));
    if (kg == 0) ML[sl] = make_float2(mx, lsum);
  }
  }
}

__device__ __forceinline__ void moba_attn(const Params& p, int l, float* sm) {
  const int bid0_ = bidx();
  const int tid = tidx();
  const int* LCNT = (const int*)(p.ws + WS_LCNT) + l * 256;
  int* pre = (int*)(sm + 36000);
  __syncthreads();
  if (tid < 64) {
    const int4 c4 = *(const int4*)(LCNT + tid * 4);
    const int n0 = (c4.x + 255) >> 8, n1 = (c4.y + 255) >> 8, n2 = (c4.z + 255) >> 8, n3 = (c4.w + 255) >> 8;
    const int tot = n0 + n1 + n2 + n3;
    int inc = tot;
#pragma unroll
    for (int o = 1; o < 64; o <<= 1) { const int t = __shfl_up(inc, o); if (tid >= o) inc += t; }
    const int ex = inc - tot;
    pre[tid * 4] = ex; pre[tid * 4 + 1] = ex + n0; pre[tid * 4 + 2] = ex + n0 + n1; pre[tid * 4 + 3] = ex + n0 + n1 + n2;
    if (tid == 63) pre[256] = inc;
  }
  __syncthreads();
  const int ng = pre[256];
  for (int it = bid0_; it < ng + 256; it += gridDim.x) {
    if (it < ng) {
      int lo = 0, hi = 255;
      while (lo < hi) { const int mid = (lo + hi + 1) >> 1; if (pre[mid] <= it) lo = mid; else hi = mid - 1; }
      moba_attn_item(p, lo >> 6, lo & 63, it - pre[lo], 0, LCNT[lo], sm);
    } else {
      const int w = it - ng;
      moba_attn_item(p, w & 3, w >> 2, 0, 1, 256, sm);
    }
  }
}

__device__ __forceinline__ void gla_out_item(const Params& p, int l, int it2, float* sm) {
  typedef short bf16x8_t __attribute__((ext_vector_type(8)));
  typedef short bf16x4_t __attribute__((ext_vector_type(4)));
  typedef float f32x4_t __attribute__((ext_vector_type(4)));
  const int tid = tidx(), lane = tid & 63, wave = tid >> 6, qc = lane & 15, kg = lane >> 4;
  const int c = it2 >> 1, hp = it2 & 1;
  const bf16raw* P = (const bf16raw*)(p.ws + WS_PROJ);
  const float* BC = (const float*)(p.ws + WS_GA);
  const float* ST = (const float*)(p.ws + WS_ST);
  bf16raw* Y = (bf16raw*)(p.ws + WS_Y);
  const float* cog = p.in[19] + l * 64;
  bf16raw* L = (bf16raw*)sm;
  const size_t t0 = (size_t)c * 64;
  __syncthreads();
  {
    const int hh = tid >> 8, h = hp * 2 + hh;
    bf16raw* Qs = L + hh * 12288; bf16raw* Ks = Qs + 2560; bf16raw* St = Ks + 2560; bf16raw* Vt = St + 2560;
    {
      const int t = (tid >> 2) & 63, d8 = (tid & 3) * 8;
      const bf16raw* qp = P + (t0 + t) * PDIN + PC_CQ + h * 32 + d8; const bf16raw* kp = P + (t0 + t) * PDIN + PC_CK + h * 32 + d8;
      const float4 qa = ld4bf(qp), qb = ld4bf(qp + 4), ka = ld4bf(kp), kb = ld4bf(kp + 4);
      const float4 ba = *(const float4*)(BC + (t0 + t) * 128 + h * 32 + d8), bb = *(const float4*)(BC + (t0 + t) * 128 + h * 32 + d8 + 4);
      const float sc = 0.17677669529663687f;
      *(uint4*)(Qs + t * 40 + d8) = make_uint4(pk2(qa.x * sc * __expf(ba.x), qa.y * sc * __expf(ba.y)), pk2(qa.z * sc * __expf(ba.z), qa.w * sc * __expf(ba.w)),
                                               pk2(qb.x * sc * __expf(bb.x), qb.y * sc * __expf(bb.y)), pk2(qb.z * sc * __expf(bb.z), qb.w * sc * __expf(bb.w)));
      *(uint4*)(Ks + t * 40 + d8) = make_uint4(pk2(ka.x * __expf(-ba.x), ka.y * __expf(-ba.y)), pk2(ka.z * __expf(-ba.z), ka.w * __expf(-ba.w)),
                                               pk2(kb.x * __expf(-bb.x), kb.y * __expf(-bb.y)), pk2(kb.z * __expf(-bb.z), kb.w * __expf(-bb.w)));
    }
    {
      const int j = (tid >> 2) & 63, e0 = (tid & 3) * 16;
      const bf16raw* vp = P + (t0 + j) * PDIN + PC_CV + h * 64 + e0;
      const uint4 va = *(const uint4*)vp, vb = *(const uint4*)(vp + 8);
      const unsigned w[8] = {va.x, va.y, va.z, va.w, vb.x, vb.y, vb.z, vb.w};
#pragma unroll
      for (int q = 0; q < 8; ++q) { Vt[(e0 + 2 * q) * 72 + j] = (bf16raw)(w[q] & 0xffff); Vt[(e0 + 2 * q + 1) * 72 + j] = (bf16raw)(w[q] >> 16); }
    }
    {
      const int d = (tid >> 3) & 31, e0 = (tid & 7) * 8;
      const float* sp = ST + ((size_t)c * 4 + h) * 2048 + d * 64 + e0;
      const float4 sa = *(const float4*)sp, sb = *(const float4*)(sp + 4);
      const float v[8] = {sa.x, sa.y, sa.z, sa.w, sb.x, sb.y, sb.z, sb.w};
#pragma unroll
      for (int q = 0; q < 8; ++q) St[(e0 + q) * 40 + d] = (bf16raw)(pk2(v[q], 0.f) & 0xffff);
    }
  }
  __syncthreads();
  {
    const int hh = wave >> 2, itile = wave & 3, h = hp * 2 + hh;
    const bf16raw* Qs = L + hh * 12288; const bf16raw* Ks = Qs + 2560; const bf16raw* St = Ks + 2560; const bf16raw* Vt = St + 2560;
    const bf16x8_t qf = *(const bf16x8_t*)(Qs + (itile * 16 + qc) * 40 + kg * 8);
    f32x4_t att[4];
#pragma unroll
    for (int jt = 0; jt < 4; ++jt) {
      f32x4_t a = {0.f, 0.f, 0.f, 0.f};
      if (jt <= itile) {
        const bf16x8_t kf = *(const bf16x8_t*)(Ks + (jt * 16 + qc) * 40 + kg * 8);
        a = __builtin_amdgcn_mfma_f32_16x16x32_bf16(kf, qf, a, 0, 0, 0);
        if (jt == itile) {
#pragma unroll
          for (int r = 0; r < 4; ++r) if (kg * 4 + r > qc) a[r] = 0.f;
        }
      }
      att[jt] = a;
    }
    bf16x8_t pf[2];
#pragma unroll
    for (int s2 = 0; s2 < 2; ++s2) {
      const uint4 w = make_uint4(pk2(att[2 * s2][0], att[2 * s2][1]), pk2(att[2 * s2][2], att[2 * s2][3]), pk2(att[2 * s2 + 1][0], att[2 * s2 + 1][1]),
                                 pk2(att[2 * s2 + 1][2], att[2 * s2 + 1][3]));
      pf[s2] = __builtin_bit_cast(bf16x8_t, w);
    }
    f32x4_t o[4];
    float ss = 0.f;
#pragma unroll
    for (int et = 0; et < 4; ++et) {
      f32x4_t acc = {0.f, 0.f, 0.f, 0.f};
      const bf16x8_t sf = *(const bf16x8_t*)(St + (et * 16 + qc) * 40 + kg * 8);
      acc = __builtin_amdgcn_mfma_f32_16x16x32_bf16(sf, qf, acc, 0, 0, 0);
#pragma unroll
      for (int s2 = 0; s2 < 2; ++s2) {
        if (2 * s2 <= itile) {
          const bf16x4_t va = *(const bf16x4_t*)(Vt + (et * 16 + qc) * 72 + s2 * 32 + kg * 4), vb = *(const bf16x4_t*)(Vt + (et * 16 + qc) * 72 + s2 * 32 + 16 + kg * 4);
          const bf16x8_t vf = {va[0], va[1], va[2], va[3], vb[0], vb[1], vb[2], vb[3]};
          acc = __builtin_amdgcn_mfma_f32_16x16x32_bf16(vf, pf[s2], acc, 0, 0, 0);
        }
      }
      o[et] = acc;
      ss += acc[0] * acc[0] + acc[1] * acc[1] + acc[2] * acc[2] + acc[3] * acc[3];
    }
    ss += __shfl_xor(ss, 16); ss += __shfl_xor(ss, 32);
    const float r = rsqrtf(ss * (1.f / 64.f) + 1e-6f);
    const size_t t = t0 + itile * 16 + qc;
#pragma unroll
    for (int et = 0; et < 4; ++et) {
      const int e = et * 16 + kg * 4;
      const float4 rr = ld4bf(P + t * PDIN + PC_CR + h * 64 + e), g = *(const float4*)(cog + e);
      *(uint2*)(Y + t * 1024 + 512 + h * 64 + e) = make_uint2(pk2(o[et][0] * r * g.x * rr.x * sigmoidf_(rr.x), o[et][1] * r * g.y * rr.y * sigmoidf_(rr.y)),
                                                             pk2(o[et][2] * r * g.z * rr.z * sigmoidf_(rr.z), o[et][3] * r * g.w * rr.w * sigmoidf_(rr.w)));
    }
  }
}

__device__ __forceinline__ void lru_out(const Params& p) {
  const int bid0_ = bidx();
  const int tid = tidx();
  const float* LA = (const float*)(p.ws + WS_LA); const float* LB = (const float*)(p.ws + WS_LB); const float* LC = (const float*)(p.ws + WS_LC);
  const bf16raw* P = (const bf16raw*)(p.ws + WS_PROJ);
  bf16raw* Y = (bf16raw*)(p.ws + WS_Y);
  for (int idx = bid0_ * NT + tid; idx < S * 64; idx += gridDim.x * NT) {
    const int t = idx >> 6, c4 = (idx & 63) * 4;
    const float4 a = *(const float4*)(LA + (size_t)t * 256 + c4), b = *(const float4*)(LB + (size_t)t * 256 + c4);
    const float4 cr = *(const float4*)(LC + (size_t)(t >> 5) * 256 + c4), g = ld4bf(P + (size_t)t * PDIN + PC_DG + c4);
    *(uint2*)(Y + (size_t)t * 1024 + 768 + c4) = make_uint2(pk2((b.x + a.x * cr.x) * gelu_tanh(g.x), (b.y + a.y * cr.y) * gelu_tanh(g.y)),
                                                          pk2((b.z + a.z * cr.z) * gelu_tanh(g.z), (b.w + a.w * cr.w) * gelu_tanh(g.w)));
  }
}

__device__ __forceinline__ void ph_mix(const Params& p, int l, float* sm) {
  const int bid0_ = bidx();
  const int grp = bid0_ % 3;
  if (grp == 0) { __syncthreads(); convert_rest(p, sm, l); __syncthreads(); }
  moba_attn(p, l, sm);
  for (int it = bid0_; it < 512; it += gridDim.x) gla_out_item(p, l, it, sm);
  lru_out(p);
  __syncthreads();
  if (grp == 1) { convert_rest(p, sm, l); __syncthreads(); }
  {
    const attn_body::AttnTensors AT{(const attn_body::bf16*)(p.ws + WS_QA), (const attn_body::bf16*)(p.ws + WS_KA), (const attn_body::bf16*)(p.ws + WS_VA),
                                    (attn_body::bf16*)(p.ws + WS_OA), (const attn_body::bf16*)(p.ws + WS_ZERO)};
    const attn_body::StaticOrder so((int)gridDim.x, bid0_);
    attn_body::attn_phase<attn_body::StaticOrder>((char*)sm, AT, so);
  }
  if (grp == 2) { __syncthreads(); convert_rest(p, sm, l); }
}

__device__ __forceinline__ void ph_fin(const Params& p, int l) {
  const int bid0_ = bidx();
  const int tid0_ = tidx();
  const int lane = tid0_ & 63, wave = tid0_ >> 6;
  const bf16raw* OA = (const bf16raw*)(p.ws + WS_OA);
  const bf16raw* P = (const bf16raw*)(p.ws + WS_PROJ);
  bf16raw* Y = (bf16raw*)(p.ws + WS_Y);
  const float lam = lam_of(p, l), li = lam_init_of(l);
  const float2* ML = (const float2*)(p.ws + WS_ML); const bf16raw* PART = (const bf16raw*)(p.ws + WS_PART);
  const float* aog = p.in[14] + l * 64; const float* cog = p.in[19] + l * 64;
#pragma unroll 2
  for (int row = bid0_ * 8 + wave; row < S; row += gridDim.x * 8) {
    int h = lane >> 4, c = (lane & 15) * 4;
    {
      const uint2 u1 = *(const uint2*)(OA + ((size_t)row * 8 + h * 2) * 64 + c), u2 = *(const uint2*)(OA + ((size_t)row * 8 + h * 2 + 1) * 64 + c);
      const float4 o1 = make_float4(bf2f(u1.x & 0xffff), bf2f(u1.x >> 16), bf2f(u1.y & 0xffff), bf2f(u1.y >> 16));
      const float4 o2 = make_float4(bf2f(u2.x & 0xffff), bf2f(u2.x >> 16), bf2f(u2.y & 0xffff), bf2f(u2.y >> 16));
      float4 o = make_float4(o1.x - lam * o2.x, o1.y - lam * o2.y, o1.z - lam * o2.z, o1.w - lam * o2.w);
      float ss = o.x * o.x + o.y * o.y + o.z * o.z + o.w * o.w;
#pragma unroll
      for (int k = 1; k < 16; k <<= 1) ss += __shfl_xor(ss, k);
      float r = rsqrtf(ss * (1.f / 64.f) + 1e-6f) * (1.f - li);
      float4 g = *(const float4*)(aog + c);
      *(uint2*)(Y + (size_t)row * 1024 + h * 64 + c) = make_uint2(pk2(o.x * r * g.x, o.y * r * g.y), pk2(o.z * r * g.z, o.w * r * g.w));
    }
    {
      const size_t sl = ((size_t)row * 4 + h) * 4;
      const float2 m0 = ML[sl], m1 = ML[sl + 1], m2 = ML[sl + 2], m3 = ML[sl + 3];
      const float M = fmaxf(fmaxf(m0.x, m1.x), fmaxf(m2.x, m3.x));
      const float w0 = m0.y * __builtin_amdgcn_exp2f(m0.x - M), w1 = m1.y * __builtin_amdgcn_exp2f(m1.x - M), w2 = m2.y * __builtin_amdgcn_exp2f(m2.x - M),
                  w3 = m3.y * __builtin_amdgcn_exp2f(m3.x - M);
      const float inv = 1.f / (w0 + w1 + w2 + w3);
      float4 o = make_float4(0.f, 0.f, 0.f, 0.f);
      if (w0 > 0.f) { const float4 t = ld4bf(PART + (sl + 0) * 64 + c); o.x += w0 * t.x; o.y += w0 * t.y; o.z += w0 * t.z; o.w += w0 * t.w; }
      if (w1 > 0.f) { const float4 t = ld4bf(PART + (sl + 1) * 64 + c); o.x += w1 * t.x; o.y += w1 * t.y; o.z += w1 * t.z; o.w += w1 * t.w; }
      if (w2 > 0.f) { const float4 t = ld4bf(PART + (sl + 2) * 64 + c); o.x += w2 * t.x; o.y += w2 * t.y; o.z += w2 * t.z; o.w += w2 * t.w; }
      { const float4 t = ld4bf(PART + (sl + 3) * 64 + c); o.x += w3 * t.x; o.y += w3 * t.y; o.z += w3 * t.z; o.w += w3 * t.w; }
      *(uint2*)(Y + (size_t)row * 1024 + 256 + h * 64 + c) = make_uint2(pk2(o.x * inv, o.y * inv), pk2(o.z * inv, o.w * inv));
    }
  }
}

__device__ __forceinline__ void ph_outproj(const Params& p, int l, float* sm) {
  const int bid0_ = bidx();
  pg8::Gemm g{(const pg8::bf16_t*)(p.ws + WS_Y), (const pg8::bf16_t*)(p.ws + WS_WOUT) + (size_t)l * 1024 * 1024, S, 1024, 1024};
  pg8::StaticOrder so; so.init(S, 1024, (int)gridDim.x, bid0_);
  pg8::EpiOutproj E{l == 0 ? p.in[0] : (const float*)nullptr, (const pg8::bf16_t*)(p.ws + WS_XA), (const float*)(p.ws + WS_MOD) + l * 6144 + 2 * 1024, (pg8::bf16_t*)(p.ws + WS_X1)};
  pg8::gemm_phase<pg8::EpiOutproj, pg8::StaticOrder, true, true>((PG8_LAS unsigned char*)sm, g, so, E);
}

__device__ __forceinline__ void ph_gather(const Params& p, int l, float* sm) {
  const int bid0_ = bidx();
  const int tid0_ = tidx();
  const int* cnt = (const int*)(p.ws + WS_CNT) + l * 32;
  int* ps = (int*)sm;
  __syncthreads();
  int* cl = ps + 64;
  if (tid0_ < 32) cl[tid0_] = (cnt[tid0_] + 255) & ~255;
  __syncthreads();
  if (tid0_ < 33) { int a = 0; for (int e = 0; e < tid0_; ++e) a += cl[e]; ps[tid0_] = a; }
  __syncthreads();
  int* srow = (int*)(p.ws + WS_SROW);
  if (bid0_ == 0) {
    int* texp = (int*)(p.ws + WS_TEXP);
    const int nt = ps[32] >> 8;
    if (tid0_ == 0) texp[0] = nt;
    if (tid0_ < 32) { texp[352 + tid0_] = ps[tid0_] >> 8; texp[384 + tid0_] = cl[tid0_] >> 8; }
    if (tid0_ < 320) {
      int e = 0;
      for (int k = 0; k < 32; ++k) if (tid0_ * 256 >= ps[k + 1]) e = k + 1;
      texp[1 + tid0_] = e < 32 ? e : 31;
    }
  }
  for (int e = bid0_; e < 32; e += gridDim.x)
    for (int i = cnt[e] + tid0_; i < cl[e]; i += NT) srow[ps[e] + i] = 0;
  const int* eidx = (const int*)(p.ws + WS_EIDX);
  int* rpos = (int*)(p.ws + WS_RPOS);
  for (int r = bid0_ * NT + tid0_; r < S * 4; r += gridDim.x * NT) {
    const int ei = eidx[r], e = ei & 255, rank = ei >> 8;
    const int dest = ps[e] + rank;
    srow[dest] = r >> 2;
    rpos[r] = dest;
  }
}

__device__ __forceinline__ void ph_up(const Params& p, int l, float* sm) {
  const int bid0_ = bidx();
  pg8::Gemm g{(const pg8::bf16_t*)(p.ws + WS_H), (const pg8::bf16_t*)(p.ws + WS_WUP) + (size_t)l * NE * 2048 * 1024, MOE_ROWS, 2048, 1024};
  int* tab = (int*)(sm + 33000);
  unsigned* rowoff = (unsigned*)(sm + 33104);
  const int t_ = tidx();
  const int* cnt = (const int*)(p.ws + WS_CNT) + l * 32;
  pg8::moe_build_units<8>(cnt, (int)gridDim.x, bid0_, tab, t_);
  pg8::moe_build_rowoff((const int*)(p.ws + WS_ELIST), cnt, tab, rowoff, t_);
  pg8::MoeOrder<8, 1> so{tab, (unsigned*)(p.ws + WS_RDY) + l * 320};
  pg8::EpiUp E{__builtin_amdgcn_make_buffer_rsrc((void*)(p.ws + WS_ACT), 0, (int)((size_t)MOE_ROWS * 1024 * 2), 0x00020000), p.in[30] + (size_t)l * NE * 2048};
  pg8::gemm_phase<pg8::EpiUp, pg8::MoeOrder<8, 1>, true, true, true>((PG8_LAS unsigned char*)sm, g, so, E, rowoff);
}

__device__ __forceinline__ void ph_down(const Params& p, int l, float* sm) {
  const int bid0_ = bidx();
  pg8::Gemm g{(const pg8::bf16_t*)(p.ws + WS_ACT), (const pg8::bf16_t*)(p.ws + WS_WDN) + (size_t)l * NE * 1024 * 1024, MOE_ROWS, 1024, 1024};
  int* tab = (int*)(sm + 33000);
  pg8::moe_build_units<4>((const int*)(p.ws + WS_CNT) + l * 32, (int)gridDim.x, bid0_, tab, tidx(), true);
  pg8::MoeOrder<4, 2> so{tab, (unsigned*)(p.ws + WS_RDY) + l * 320};
  pg8::EpiDown E{(pg8::bf16_t*)(p.ws + WS_YS), p.in[32] + (size_t)l * NE * 1024};
  pg8::gemm_phase<pg8::EpiDown, pg8::MoeOrder<4, 2>, true, true>((PG8_LAS unsigned char*)sm, g, so, E);
}

__device__ __forceinline__ void ph_combine(const Params& p, int l, float* sm) {
  const int bid0_ = bidx();
  const int tid0_ = tidx();
  const int lane = tid0_ & 63, wave = tid0_ >> 6;
  const bf16raw* X1 = (const bf16raw*)(p.ws + WS_X1); const bf16raw* YS = (const bf16raw*)(p.ws + WS_YS);
  const float* gatebuf = (const float*)(p.ws + WS_GATE);
  const int* eidx = (const int*)(p.ws + WS_EIDX);
  const int* cnt = (const int*)(p.ws + WS_CNT) + l * 32;
  const float* g2 = (const float*)(p.ws + WS_MOD) + l * 6144 + 5 * 1024;
  bf16raw* xa = (bf16raw*)(p.ws + WS_XA);
  const float* modn = (const float*)(p.ws + WS_MOD) + 6144;
  const float* gain = p.in[4] + 1024;
  bf16raw* H = (bf16raw*)(p.ws + WS_H);
  int* ps = (int*)sm;
  __syncthreads();
  if (tid0_ < 33) { int a = 0; for (int e = 0; e < tid0_; ++e) a += (cnt[e] + 255) & ~255; ps[tid0_] = a; }
  __syncthreads();
#pragma unroll 2
  for (int row = bid0_ * 8 + wave; row < S; row += gridDim.x * 8) {
    const float4 gt = *(const float4*)(gatebuf + row * 4);
    const int4 ei = *(const int4*)(eidx + row * 4);
    const int4 rp = make_int4(ps[ei.x & 255] + (ei.x >> 8), ps[ei.y & 255] + (ei.y >> 8), ps[ei.z & 255] + (ei.z >> 8), ps[ei.w & 255] + (ei.w >> 8));
    float4 v[4];
    float ss = 0.f;
#pragma unroll
    for (int j = 0; j < 4; ++j) {
      const int c = (lane + 64 * j) * 4;
      const uint2 y0 = *(const uint2*)(YS + (size_t)rp.x * 1024 + c), y1 = *(const uint2*)(YS + (size_t)rp.y * 1024 + c);
      const uint2 y2 = *(const uint2*)(YS + (size_t)rp.z * 1024 + c), y3 = *(const uint2*)(YS + (size_t)rp.w * 1024 + c);
      float4 a;
      a.x = gt.x * bf2f(y0.x & 0xffff) + gt.y * bf2f(y1.x & 0xffff) + gt.z * bf2f(y2.x & 0xffff) + gt.w * bf2f(y3.x & 0xffff);
      a.y = gt.x * bf2f(y0.x >> 16) + gt.y * bf2f(y1.x >> 16) + gt.z * bf2f(y2.x >> 16) + gt.w * bf2f(y3.x >> 16);
      a.z = gt.x * bf2f(y0.y & 0xffff) + gt.y * bf2f(y1.y & 0xffff) + gt.z * bf2f(y2.y & 0xffff) + gt.w * bf2f(y3.y & 0xffff);
      a.w = gt.x * bf2f(y0.y >> 16) + gt.y * bf2f(y1.y >> 16) + gt.z * bf2f(y2.y >> 16) + gt.w * bf2f(y3.y >> 16);
      const float4 x = ld4bf(X1 + (size_t)row * 1024 + c), g = *(const float4*)(g2 + c);
      v[j] = make_float4(x.x + g.x * a.x, x.y + g.y * a.y, x.z + g.z * a.z, x.w + g.w * a.w);
      if (l == 0) *(uint2*)(xa + (size_t)row * 1024 + c) = make_uint2(pk2(v[j].x, v[j].y), pk2(v[j].z, v[j].w)); else *(float4*)(p.out + (size_t)row * 1024 + c) = v[j];
      ss += v[j].x * v[j].x + v[j].y * v[j].y + v[j].z * v[j].z + v[j].w * v[j].w;
    }
    if (l == 0) {
      ss = wave_sum(ss);
      const float r = rsqrtf(ss * (1.f / 1024.f) + 1e-6f);
      uint2* hr = (uint2*)(H + (size_t)row * 1024) + lane;
#pragma unroll
      for (int j = 0; j < 4; ++j) {
        const int c = (lane + 64 * j) * 4;
        const float4 g = *(const float4*)(gain + c), a = *(const float4*)(modn + 1024 + c), b = *(const float4*)(modn + c);
        hr[64 * j] = make_uint2(pk2(v[j].x * r * g.x * (1.f + a.x) + b.x, v[j].y * r * g.y * (1.f + a.y) + b.y),
                                pk2(v[j].z * r * g.z * (1.f + a.z) + b.z, v[j].w * r * g.w * (1.f + a.w) + b.w));
      }
    }
  }
}

#define LAS __attribute__((address_space(3)))
#define XB_TMO      128
#define XB_XCNT(j)  (256  + 64 * (j))
#define XB_XSUB(j)  (1280 + 64 * (j))
#define XB_XGEN(j)  (2304 + 64 * (j))
#define XB_TOP      3328
#define XB_TOPGEN   3392
#define XCD_BAR_WORDS 3456
#define XB_SPIN_CAP (1u << 18)

__device__ __forceinline__ unsigned xb_ld(unsigned* p)              { return __hip_atomic_load(p, __ATOMIC_RELAXED, __HIP_MEMORY_SCOPE_AGENT); }
__device__ __forceinline__ unsigned xb_add(unsigned* p, unsigned v) { return __hip_atomic_fetch_add(p, v, __ATOMIC_RELAXED, __HIP_MEMORY_SCOPE_AGENT); }
__device__ __forceinline__ unsigned xb_xcc_id() { return (unsigned)__builtin_amdgcn_s_getreg((3 << 11) | 20) & 0xFu; }
#define XB_SPIN(cond, bar) do { unsigned _sp = 0; while (cond) { __builtin_amdgcn_s_sleep(1); \
    if ((++_sp & 255u) == 0u) { if (xb_ld(&(bar)[XB_TMO])) break; if (_sp > XB_SPIN_CAP) { atomicAdd(&(bar)[XB_TMO], 1u); break; } } } } while (0)

struct XcdBarrier {
    unsigned* bar; unsigned x;
    volatile LAS unsigned* st;
};

__device__ __forceinline__ XcdBarrier xcd_barrier_post(unsigned* bar, volatile LAS unsigned* st) {
    XcdBarrier b; b.bar = bar; b.x = xb_xcc_id(); b.st = st;
    if (threadIdx.x == 0) (void)xb_add(&bar[XB_XCNT(b.x)], 1u);
    return b;
}
__device__ __forceinline__ void xcd_barrier_complete(unsigned* bar, unsigned x, unsigned& nloc, unsigned& nx) {
    const unsigned G = gridDim.x * gridDim.y * gridDim.z;
    unsigned sum, cnt, mine, sp = 0u;
    for (;;) {
        sum = 0u; cnt = 0u; mine = 0u;
#pragma unroll
        for (unsigned j = 0; j < 16; ++j) { const unsigned c = xb_ld(&bar[XB_XCNT(j)]); sum += c; cnt += (c > 0u) ? 1u : 0u; mine = (j == x) ? c : mine; }
        if (sum == G) break;
        __builtin_amdgcn_s_sleep(1);
        if ((++sp & 255u) == 0u) { if (xb_ld(&bar[XB_TMO])) break; if (sp > XB_SPIN_CAP) { atomicAdd(&bar[XB_TMO], 1u); break; } }
    }
    nloc = mine > 0u ? mine : 1u; nx = cnt > 0u ? cnt : 1u;
}

__device__ __forceinline__ void xcd_barrier(const XcdBarrier& b) {
    asm volatile("s_waitcnt vmcnt(0)" ::: "memory");
    __syncthreads();
    if (threadIdx.x == 0) {
        unsigned* bar = b.bar; asm volatile("" : "+s"(bar));
        const unsigned bx_ = xb_xcc_id();
        __builtin_amdgcn_s_waitcnt(0);
        unsigned nloc = b.st[0], nx = b.st[1];
        if (nloc == 0u) { xcd_barrier_complete(bar, bx_, nloc, nx); b.st[0] = nloc; b.st[1] = nx; }
        const unsigned old = xb_add(&bar[XB_XSUB(bx_)], 1u);
        const unsigned gen = old / nloc;
        if (old + 1u == (gen + 1u) * nloc) {
            __builtin_amdgcn_fence(__ATOMIC_RELEASE, "agent");
            asm volatile("s_waitcnt vmcnt(0)" ::: "memory");
            const unsigned og = xb_add(&bar[XB_TOP], 1u);
            const unsigned tg = og / nx;
            if (og + 1u == (tg + 1u) * nx) xb_add(&bar[XB_TOPGEN], 1u);
            else XB_SPIN(xb_ld(&bar[XB_TOPGEN]) == tg, bar);
            __builtin_amdgcn_fence(__ATOMIC_ACQUIRE, "agent");
            xb_add(&bar[XB_XGEN(bx_)], 1u);
            asm volatile("s_waitcnt vmcnt(0)" ::: "memory");
        } else {
            XB_SPIN(xb_ld(&bar[XB_XGEN(bx_)]) == gen, bar);
            __builtin_amdgcn_fence(__ATOMIC_ACQUIRE, "agent");
            asm volatile("s_waitcnt vmcnt(0)" ::: "memory");
        }
    }
    __syncthreads();
}

template <int SUB>
__device__ __forceinline__ void run_sub(const Params& p, int l, float* sm) {
  const int bid0_ = bidx();
  asm volatile("" : "+s"(l));
  if (SUB == 0) ph_norm(p, l, 0, sm);
  else if (SUB == 1) ph_inproj(p, l, sm);
  else if (SUB == 2) ph_prep(p, l, sm);
  else if (SUB == 3) { ph_scan(p, sm); ph_scan_lru(p, sm); for (int it = bid0_; it < 256; it += gridDim.x) moba_gate_item(p, l, (it - 16) & 255, sm); }
  else if (SUB == 4) ph_mix(p, l, sm);
  else if (SUB == 5) ph_fin(p, l);
  else if (SUB == 6) ph_outproj(p, l, sm);
  else if (SUB == 7) ph_norm2(p, l, sm);
  else if (SUB == 8) ph_gather(p, l, sm);
  else if (SUB == 9) ph_up(p, l, sm);
  else if (SUB == 10) ph_down(p, l, sm);
  else if (SUB == 11) ph_combine(p, l, sm);
}

#if MK_SINGLE
__global__ void __launch_bounds__(NT, 2) mega(Params p) {
  extern __shared__ __attribute__((aligned(16))) unsigned char lds_raw[];
  float* sm = (float*)lds_raw;
  cg::grid_group grid = cg::this_grid();
  unsigned* barw = (unsigned*)(p.ws + WS_BAR);
  volatile LAS unsigned* bst = (volatile LAS unsigned*)((LAS unsigned char*)lds_raw + (LDS_BYTES - 64));
  if (threadIdx.x < 2) bst[threadIdx.x] = 0u;
  if (blockIdx.x == 0) for (int i = threadIdx.x; i < XCD_BAR_WORDS; i += NT) barw[i] = 0u;
  ph_mod(p, sm);
  ph_convert(p, sm);
  grid.sync();
  const XcdBarrier gb = xcd_barrier_post(barw, bst);
#define GSYNC() xcd_barrier(gb)
  run_sub<0>(p, 0, sm); GSYNC();
#pragma unroll 1
  for (int l = 0; l < 2; ++l) {
    run_sub<1>(p, l, sm); GSYNC();
    run_sub<2>(p, l, sm); GSYNC();
    run_sub<3>(p, l, sm); GSYNC();
    run_sub<4>(p, l, sm); GSYNC();
    run_sub<5>(p, l, sm); GSYNC();
    run_sub<6>(p, l, sm); GSYNC();
    run_sub<7>(p, l, sm); GSYNC();
    run_sub<9>(p, l, sm);
    run_sub<10>(p, l, sm); GSYNC();
    run_sub<11>(p, l, sm);
    if (l == 0) GSYNC();
  }
#undef GSYNC
}
#else
template <int SUB>
__global__ void __launch_bounds__(NT, 2) phk(Params p, int l) {
  extern __shared__ __attribute__((aligned(16))) unsigned char lds_raw[];
  float* sm = (float*)lds_raw;
  if (SUB < 0) { ph_mod(p, sm); ph_convert(p, sm); }
  else run_sub<(SUB < 0 ? 0 : SUB)>(p, l, sm);
}
template <int SUB> static void launch_ph(const Params& p, int l, hipStream_t stream) {
  static bool attr = false;
  if (!attr) { (void)hipFuncSetAttribute((const void*)phk<SUB>, hipFuncAttributeMaxDynamicSharedMemorySize, LDS_BYTES); attr = true; }
  hipLaunchKernelGGL(phk<SUB>, dim3(256), dim3(NT), LDS_BYTES, stream, p, l);
}
#endif

extern "C" void kernel_launch(void* const* d_in, const int* in_sizes, int n_in, void* d_out, int out_size, void* d_ws, size_t ws_size,
                              hipStream_t stream) {
  Params p{};
  for (int i = 0; i < 33; ++i) p.in[i] = (const float*)d_in[i];
  p.out = (float*)d_out;
  p.ws = (char*)d_ws;
#if MK_SINGLE
  static int grid_blocks = 0;
  if (!grid_blocks) {
    int dev = 0, cus = 0, per_cu = 0;
    (void)hipGetDevice(&dev);
    (void)hipDeviceGetAttribute(&cus, hipDeviceAttributeMultiprocessorCount, dev);
    (void)hipFuncSetAttribute((const void*)mega, hipFuncAttributeMaxDynamicSharedMemorySize, LDS_BYTES);
    (void)hipOccupancyMaxActiveBlocksPerMultiprocessor(&per_cu, mega, NT, LDS_BYTES);
    if (per_cu < 1) per_cu = 1;
    if (per_cu > 1) per_cu = 1;
    grid_blocks = cus * per_cu;
  }
  void* args[] = {&p};
  hipError_t e = hipLaunchCooperativeKernel((void*)mega, dim3(grid_blocks), dim3(NT), args, LDS_BYTES, stream);
  if (e != hipSuccess) fprintf(stderr, "cooperative launch failed: %s (grid %d)\n", hipGetErrorString(e), grid_blocks);
#else
  launch_ph<-1>(p, 0, stream);
  for (int l = 0; l < 2; ++l) {
    if (l == 0) launch_ph<0>(p, l, stream);
    launch_ph<1>(p, l, stream); launch_ph<2>(p, l, stream); launch_ph<3>(p, l, stream);
    launch_ph<4>(p, l, stream); launch_ph<5>(p, l, stream); launch_ph<6>(p, l, stream); launch_ph<7>(p, l, stream);
    launch_ph<9>(p, l, stream); launch_ph<10>(p, l, stream); launch_ph<11>(p, l, stream);
  }
#endif
}
```

```cpp
#include <hip/hip_runtime.h>
#include <hip/hip_cooperative_groups.h>
#include <cstdio>
#include <cstdint>
namespace cg = cooperative_groups;

#ifndef MK_SINGLE
#define MK_SINGLE 1
#endif
#ifndef PROBE
#define PROBE 0
#endif

constexpr int S = 16384, D = 1024, DIN = 2832, NE = 32;
constexpr int NT = 512;
constexpr size_t MiB = 1u << 20;
constexpr size_t WS_MOD = 0;
constexpr size_t WS_CNT = 64 * 1024;
constexpr size_t WS_TEXP = 128 * 1024;
constexpr size_t WS_KMP = 1 * MiB;
constexpr size_t WS_BAR = 256 * 1024;
constexpr size_t WS_SROW = 320 * 1024;
constexpr size_t WS_RDY = 216 * 1024;
constexpr size_t WS_ZERO = 224 * 1024;
constexpr size_t WS_LCNT = 192 * 1024;
constexpr size_t WS_EIDX = 2 * MiB;
constexpr size_t WS_RPOS = 2 * MiB + 512 * 1024;
constexpr size_t WS_GATE = 3 * MiB;
constexpr size_t WS_H = 8 * MiB;
constexpr size_t WS_VBT = 40 * MiB;
constexpr size_t WS_ELIST = 66 * MiB;
constexpr size_t WS_MLIST = 48 * MiB;
constexpr size_t WS_ML = 64 * MiB;
constexpr size_t WS_PROJ = 72 * MiB;
constexpr size_t WS_Y = 250 * MiB;
constexpr size_t WS_X1 = 314 * MiB;
constexpr size_t WS_XA = 378 * MiB;
constexpr size_t WS_QA = 442 * MiB;
constexpr size_t WS_KA = 458 * MiB;
constexpr size_t WS_QB = 474 * MiB;
constexpr size_t WS_KB = 490 * MiB;
constexpr size_t WS_QBB = 498 * MiB;
constexpr size_t WS_GA = 506 * MiB;
constexpr size_t WS_LA = 514 * MiB;
constexpr size_t WS_LB = 530 * MiB;
constexpr size_t WS_OA = 546 * MiB;
constexpr size_t WS_VA = 562 * MiB;
constexpr size_t WS_SC = 578 * MiB;
constexpr size_t WS_DEC = 586 * MiB;
constexpr size_t WS_LTA = 587 * MiB;
constexpr size_t WS_LTH = 588 * MiB;
constexpr size_t WS_LC = 589 * MiB;
constexpr int MOE_ROWS = 73728;
constexpr size_t WS_ST = 1490 * MiB;
constexpr size_t WS_PART = 1426 * MiB;
constexpr size_t WS_VB = 594 * MiB;
constexpr size_t WS_XS = 602 * MiB;
constexpr size_t WS_ACT = 738 * MiB;
constexpr size_t WS_YS = 882 * MiB;
constexpr size_t WS_WIN = 1026 * MiB;
constexpr size_t WS_WOUT = 1038 * MiB;
constexpr size_t WS_WUP = 1042 * MiB;
constexpr size_t WS_WDN = 1298 * MiB;
constexpr int LDS_BYTES = 147456;

struct Params {
  const float* in[33];
  float* out;
  char* ws;
};

constexpr int PDIN = 1296;
constexpr int PC_CQ = 0, PC_CK = 128, PC_CV = 256, PC_CG = 512, PC_CR = 528, PC_DX = 784, PC_DG = 1040;

__device__ __forceinline__ int bidx() { int b = blockIdx.x; asm volatile("" : "+s"(b)); return b; }
__device__ __forceinline__ int tidx() { int t = threadIdx.x; asm volatile("" : "+v"(t)); return t; }
__device__ __forceinline__ float wave_sum(float v) {
#pragma unroll
  for (int o = 1; o < 64; o <<= 1) v += __shfl_xor(v, o);
  return v;
}
__device__ __forceinline__ float sigmoidf_(float x) { return __builtin_amdgcn_rcpf(1.f + __builtin_amdgcn_exp2f(-1.4426950408889634f * x)); }
__device__ __forceinline__ float logsigmoidf_(float z) { return fminf(z, 0.f) - log1pf(__expf(-fabsf(z))); }
__device__ __forceinline__ float gelu_tanh(float x) {
  float u = 0.7978845608028654f * (x + 0.044715f * x * x * x);
  float t = 1.f - 2.f * __builtin_amdgcn_rcpf(__expf(2.f * u) + 1.f);
  return 0.5f * x * (1.f + t);
}
__device__ __forceinline__ float lam_init_of(int l) { return l == 0 ? 0.2f : (0.8f - 0.6f * 0.7408182206817179f); }
__device__ __forceinline__ float lam_of(const Params& p, int l) {
  float s1 = 0.f, s2 = 0.f;
  for (int i = 0; i < 32; ++i) {
    s1 += p.in[10][l * 32 + i] * p.in[11][l * 32 + i];
    s2 += p.in[12][l * 32 + i] * p.in[13][l * 32 + i];
  }
  return __expf(s1) - __expf(s2) + lam_init_of(l);
}

typedef unsigned short bf16raw;
__device__ __forceinline__ unsigned f2bf(float f) { unsigned u = __builtin_bit_cast(unsigned, f); return (u + 0x7fffu + ((u >> 16) & 1u)) >> 16; }
typedef float f32x2v_ __attribute__((ext_vector_type(2))); typedef __bf16 bf16x2v_ __attribute__((ext_vector_type(2)));
__device__ __forceinline__ unsigned pk2(float lo, float hi) { f32x2v_ v = {lo, hi}; bf16x2v_ b = __builtin_convertvector(v, bf16x2v_); return __builtin_bit_cast(unsigned, b); }
__device__ __forceinline__ float4 ld4bf(const unsigned short* p) { const uint2 u = *(const uint2*)p; return make_float4(__builtin_bit_cast(float, u.x << 16), __builtin_bit_cast(float, u.x & 0xffff0000u), __builtin_bit_cast(float, u.y << 16), __builtin_bit_cast(float, u.y & 0xffff0000u)); }
__device__ __forceinline__ float bf2f(unsigned short h) { return __builtin_bit_cast(float, (unsigned)h << 16); }

namespace pg8 {
#define PG8_LAS __attribute__((address_space(3)))
typedef unsigned short bf16_t;
typedef short bf16x8 __attribute__((ext_vector_type(8)));
typedef float f32x4 __attribute__((ext_vector_type(4)));
typedef unsigned u32x4 __attribute__((ext_vector_type(4)));
constexpr int BM = 256, BK = 64, HALF = 128, HTB = HALF * BK * 2  , STAGE_BYTES = 8 * HTB, NXCD = 8, WGM = 8;

__host__ __device__ __forceinline__ int lds_byte(int r, int c) { const int st = (r >> 4) * 2 + (c >> 5), rr = r & 15, cc = c & 31, ob = rr * 64 + cc * 2; return st * 1024 + (ob ^ (((ob >> 9) & 1) << 5)); }
__host__ __device__ __forceinline__ void stage_rc(int b, int& R, int& C) {
  const int bid0_ = bidx(); const int st = b / 1024, sb = b % 1024, swz = sb ^ (((sb >> 9) & 1) << 5); R = (st >> 1) * 16 + swz / 64; C = (st & 1) * 32 + (swz % 64) / 2; }
__host__ __device__ __forceinline__ int perm32(int rho) { const int n = rho >> 4, i = rho & 15; return 8 * (i >> 2) + 4 * n + (i & 3); }

struct Unit { int pm, pn; };
struct Gemm { const bf16_t* A; const bf16_t* Bt; int M, N, K; };

struct StaticOrder {
    int nM, nN, nwg, G, c;
    __host__ __device__ void init(int M, int N, int G_, int c_) { nM = M / BM; nN = N / BM; nwg = nM * nN; G = G_; c = c_; }
    __host__ __device__ bool next(int i, Unit& u) const {
        const long L = (long)i * G + c; if (L >= nwg) return false;
        int wgid = (int)L; { const int q = nwg / NXCD, r = nwg % NXCD, xcd = wgid % NXCD, off = wgid / NXCD; wgid = (xcd < r ? xcd * (q + 1) : r * (q + 1) + (xcd - r) * q) + off; }
        const int nig = WGM * nN, gid = wgid / nig, fm = gid * WGM, gsz = (nM - fm) < WGM ? (nM - fm) : WGM;
        u.pm = fm + ((wgid % nig) % gsz); u.pn = (wgid % nig) / gsz; return true;
    }
    __device__ __forceinline__ void a_ready(const Unit&) const {}
    __device__ __forceinline__ void done(const Unit&) const {}
};

__device__ __forceinline__ unsigned cvt_pk_bf16(float lo, float hi) { unsigned r; asm volatile("v_cvt_pk_bf16_f32 %0, %1, %2" : "=v"(r) : "v"(lo), "v"(hi)); return r; }
typedef float f32x2 __attribute__((ext_vector_type(2)));
template <class Epi, class Sched, bool ALIGN_EPI = false, bool SP2 = false, bool GATHER = false>
__device__ __forceinline__ void gemm_phase(PG8_LAS unsigned char* lds, const Gemm g, const Sched& S, const Epi& E, const unsigned* rowoff = nullptr) {
    static_assert(!GATHER || SP2, "row gather is wired into the SP2 loop only");
    const int tid = tidx(), wid = __builtin_amdgcn_readfirstlane(tid >> 6), lane = tid & 63, wr = wid >> 2, wc = wid & 3, fr = lane & 15, fq = lane >> 4;
    const int K = g.K, nt = K / BK;
    unsigned voffA[2], voffB[2]; int RA[2], CA[2];
#pragma unroll
    for (int i = 0; i < 2; ++i) { int R, C; stage_rc(tid * 16 + i * 8192, R, C); const int Rb = Epi::PERM ? ((R & ~31) + perm32(R & 31)) : R;
        voffA[i] = (unsigned)(R * K + C) * 2u; voffB[i] = (unsigned)(Rb * K + C) * 2u; RA[i] = R; CA[i] = C; }
    const size_t kstep = (size_t)(BK * 2);
    const size_t hstep = (size_t)HALF * K * 2;
    const size_t tstep = 2 * hstep;
    const unsigned ldsw = (unsigned)wid * 1024u;
    const int aoff = lds_byte(wr * 64 + fr, fq * 8), boff = lds_byte(wc * 32 + fr, fq * 8);
#define PG8_SA(b, h) (((b) * 2 + (h)) * HTB)
#define PG8_SB(b, h) ((4 + (b) * 2 + (h)) * HTB)
#define PG8_STAGE(bufoff, gbase, voff) do { _Pragma("unroll") for (int _i = 0; _i < 2; ++_i) \
        __builtin_amdgcn_global_load_lds((const unsigned*)((const char*)(gbase) + (voff)[_i]), (PG8_LAS unsigned*)(lds + (bufoff) + ldsw + _i * 8192), 16, 0, 0); } while (0)
#define PG8_STAGE2(bufoff, gbase, o0, o1) do { \
        __builtin_amdgcn_global_load_lds((const unsigned*)((const char*)(gbase) + (o0)), (PG8_LAS unsigned*)(lds + (bufoff) + ldsw), 16, 0, 0); \
        __builtin_amdgcn_global_load_lds((const unsigned*)((const char*)(gbase) + (o1)), (PG8_LAS unsigned*)(lds + (bufoff) + ldsw + 8192), 16, 0, 0); } while (0)
#define PG8_GOFF(dst, pm_) do { _Pragma("unroll") for (int _h = 0; _h < 2; ++_h) _Pragma("unroll") for (int _i = 0; _i < 2; ++_i) \
        dst[_h][_i] = rowoff[(pm_) * BM + _h * HALF + RA[_i]] + (unsigned)CA[_i] * 2u; } while (0)
#define PG8_LDA(dst, b, h) do { _Pragma("unroll") for (int m = 0; m < 4; ++m) _Pragma("unroll") for (int k = 0; k < 2; ++k) dst[m][k] = *(const PG8_LAS bf16x8*)(lds + PG8_SA(b, h) + aoff + m * 2048 + k * 1024); } while (0)
#define PG8_LDB(dst, b, h) do { _Pragma("unroll") for (int n = 0; n < 2; ++n) _Pragma("unroll") for (int k = 0; k < 2; ++k) dst[n][k] = *(const PG8_LAS bf16x8*)(lds + PG8_SB(b, h) + boff + n * 2048 + k * 1024); } while (0)
#define PG8_MMA(ai, bj, At, Bt) do { __builtin_amdgcn_s_setprio(1); _Pragma("unroll") for (int m = 0; m < 4; ++m) _Pragma("unroll") for (int n = 0; n < 2; ++n) _Pragma("unroll") for (int k = 0; k < 2; ++k) \
        acc[ai][bj][m][n] = __builtin_amdgcn_mfma_f32_16x16x32_bf16(Bt[n][k], At[m][k], acc[ai][bj][m][n], 0, 0, 0); __builtin_amdgcn_s_setprio(0); } while (0)
#define PG8_WAIT_V(n) asm volatile("s_waitcnt vmcnt(" #n ")" ::: "memory")
#define PG8_WAIT_L(n) asm volatile("s_waitcnt lgkmcnt(" #n ")" ::: "memory")
#define PG8_BAR __builtin_amdgcn_s_barrier()
#define PG8_SCHED __builtin_amdgcn_sched_barrier(0)
    Unit cur, nxt; int ui = 0;
    if (!S.next(0, cur)) return;
    f32x4 acc[2][2][4][2];
#pragma unroll
    for (int a = 0; a < 2; ++a)
#pragma unroll
        for (int b = 0; b < 2; ++b)
#pragma unroll
            for (int m = 0; m < 4; ++m)
#pragma unroll
                for (int n = 0; n < 2; ++n) acc[a][b][m][n] = (f32x4){0.f, 0.f, 0.f, 0.f};
    bf16x8 At[4][2], B0[2][2], B1[2][2];
    const char* cA = GATHER ? (const char*)g.A : (const char*)g.A + (size_t)cur.pm * tstep; const char* cB = (const char*)g.Bt + (size_t)cur.pn * tstep;
    unsigned vA[2][2], vN[2][2];
    if constexpr (GATHER) { PG8_GOFF(vA, 0); _Pragma("unroll") for (int _h = 0; _h < 2; ++_h) _Pragma("unroll") for (int _i = 0; _i < 2; ++_i) vN[_h][_i] = vA[_h][_i]; }
#define PG8_STA(bufoff, ptr, h, nx) do { if constexpr (GATHER) { PG8_STAGE2(bufoff, ptr, (nx) ? vN[h][0] : vA[h][0], (nx) ? vN[h][1] : vA[h][1]); } else { PG8_STAGE(bufoff, (ptr) + (h) * hstep, voffA); } } while (0)
    S.a_ready(cur);
    if constexpr (SP2) {
        PG8_STAGE(PG8_SB(0, 0), cB, voffB); PG8_STAGE(PG8_SB(0, 1), cB + hstep, voffB); PG8_STA(PG8_SA(0, 0), cA, 0, false); PG8_STA(PG8_SA(0, 1), cA, 1, false);
        if (wr == 1) PG8_BAR;
        PG8_WAIT_V(2); PG8_BAR;
        PG8_STAGE(PG8_SB(1, 0), cB + kstep, voffB); PG8_STA(PG8_SA(1, 0), cA + kstep, 0, false); PG8_STAGE(PG8_SB(1, 1), cB + hstep + kstep, voffB);
        PG8_WAIT_V(6); PG8_BAR;
    } else {
        PG8_STAGE(PG8_SB(0, 0), cB, voffB); PG8_STAGE(PG8_SA(0, 0), cA, voffA); PG8_STAGE(PG8_SB(0, 1), cB + hstep, voffB); PG8_STAGE(PG8_SA(0, 1), cA + hstep, voffA);
        if (wr == 1) PG8_BAR;
        PG8_WAIT_V(4); PG8_BAR;
        PG8_STAGE(PG8_SB(1, 0), cB + kstep, voffB); PG8_STA(PG8_SA(1, 0), cA + kstep, 0, false); PG8_STAGE(PG8_SB(1, 1), cB + hstep + kstep, voffB);
        PG8_WAIT_V(6); PG8_BAR;
    }
    for (;;) {
        const bool has_next = S.next(ui + 1, nxt);
        const char* nA = GATHER ? cA : (has_next ? (const char*)g.A + (size_t)nxt.pm * tstep : cA); const char* nB = has_next ? (const char*)g.Bt + (size_t)nxt.pn * tstep : cB;
        if constexpr (GATHER) { if (has_next) { PG8_GOFF(vN, ui + 1); } }
        for (int t = 0; t < nt; t += 2) {
            const bool last = (t == nt - 2);
            const char* a1 = cA + (size_t)(t + 1) * kstep;
            const char* a2 = last ? nA : cA + (size_t)(t + 2) * kstep; const bool nx_ = GATHER && last; const char* b2 = last ? nB : cB + (size_t)(t + 2) * kstep;
            const char* a3 = a2 + kstep; const char* b3 = b2 + kstep;
            if (last && has_next) S.a_ready(nxt);
            if constexpr (SP2) {
            PG8_LDB(B0, 0, 0); PG8_LDB(B1, 0, 1); PG8_SCHED; PG8_LDA(At, 0, 0); PG8_STA(PG8_SA(1, 1), a1, 1, false);
            PG8_WAIT_V(8); PG8_WAIT_L(0); PG8_BAR; PG8_MMA(0, 0, At, B0); PG8_MMA(0, 1, At, B1); PG8_BAR; PG8_SCHED;
            PG8_LDA(At, 0, 1); PG8_STAGE(PG8_SB(0, 0), b2, voffB); PG8_STAGE(PG8_SB(0, 1), b2 + hstep, voffB); PG8_STA(PG8_SA(0, 0), a2, 0, nx_);
            PG8_WAIT_V(8); PG8_WAIT_L(0); PG8_BAR; PG8_MMA(1, 0, At, B0); PG8_MMA(1, 1, At, B1); PG8_BAR; PG8_SCHED;
            PG8_LDB(B0, 1, 0); PG8_LDB(B1, 1, 1); PG8_SCHED; PG8_LDA(At, 1, 0); PG8_STA(PG8_SA(0, 1), a2, 1, nx_);
            PG8_WAIT_V(8); PG8_WAIT_L(0); PG8_BAR; PG8_MMA(0, 0, At, B0); PG8_MMA(0, 1, At, B1); PG8_BAR; PG8_SCHED;
            PG8_LDA(At, 1, 1); PG8_STAGE(PG8_SB(1, 0), b3, voffB); PG8_STAGE(PG8_SB(1, 1), b3 + hstep, voffB); PG8_STA(PG8_SA(1, 0), a3, 0, nx_);
            PG8_WAIT_V(8); PG8_WAIT_L(0); PG8_BAR; PG8_MMA(1, 0, At, B0); PG8_MMA(1, 1, At, B1); PG8_BAR; PG8_SCHED;
            } else {
            PG8_LDB(B0, 0, 0); PG8_SCHED; PG8_LDA(At, 0, 0); PG8_STA(PG8_SA(1, 1), a1, 1, false);
            PG8_WAIT_L(8); PG8_BAR; PG8_WAIT_L(0); PG8_MMA(0, 0, At, B0); PG8_BAR; PG8_SCHED;
            PG8_LDB(B1, 0, 1); PG8_STAGE(PG8_SB(0, 0), b2, voffB);
            PG8_BAR; PG8_WAIT_L(0); PG8_MMA(0, 1, At, B1); PG8_BAR;
            PG8_LDA(At, 0, 1); PG8_STA(PG8_SA(0, 0), a2, 0, nx_);
            PG8_BAR; PG8_WAIT_L(0); PG8_MMA(1, 0, At, B0); PG8_BAR; PG8_SCHED;
            PG8_STAGE(PG8_SB(0, 1), b2 + hstep, voffB);
            PG8_WAIT_V(6); PG8_BAR; PG8_MMA(1, 1, At, B1); PG8_BAR;
            PG8_LDB(B0, 1, 0); PG8_SCHED; PG8_LDA(At, 1, 0); PG8_STA(PG8_SA(0, 1), a2, 1, nx_);
            PG8_WAIT_L(8); PG8_BAR; PG8_WAIT_L(0); PG8_MMA(0, 0, At, B0); PG8_BAR; PG8_SCHED;
            PG8_LDB(B1, 1, 1); PG8_STAGE(PG8_SB(1, 0), b3, voffB);
            PG8_BAR; PG8_WAIT_L(0); PG8_MMA(0, 1, At, B1); PG8_BAR;
            PG8_LDA(At, 1, 1); PG8_STA(PG8_SA(1, 0), a3, 0, nx_);
            PG8_BAR; PG8_WAIT_L(0); PG8_MMA(1, 0, At, B0); PG8_BAR; PG8_SCHED;
            PG8_STAGE(PG8_SB(1, 1), b3 + hstep, voffB);
            PG8_WAIT_V(6); PG8_BAR; PG8_MMA(1, 1, At, B1); PG8_BAR;
            }
        }
        if constexpr (ALIGN_EPI) { if (wr == 0) PG8_BAR; }
        if constexpr (!Epi::AFTER_DRAIN) { E(acc, cur, wr, wc, fr, fq); S.done(cur); }
        if (!has_next) break;
#pragma unroll
        for (int a = 0; a < 2; ++a)
#pragma unroll
            for (int b = 0; b < 2; ++b)
#pragma unroll
                for (int m = 0; m < 4; ++m)
#pragma unroll
                    for (int n = 0; n < 2; ++n) acc[a][b][m][n] = (f32x4){0.f, 0.f, 0.f, 0.f};
        cur = nxt; cA = nA; cB = nB; ++ui;
        if constexpr (GATHER) { _Pragma("unroll") for (int _h = 0; _h < 2; ++_h) _Pragma("unroll") for (int _i = 0; _i < 2; ++_i) vA[_h][_i] = vN[_h][_i]; }
        if constexpr (ALIGN_EPI) { if (wr == 1) PG8_BAR; }
    }
    PG8_WAIT_V(0);
    if constexpr (!ALIGN_EPI) { if (wr == 0) PG8_BAR; }
    PG8_BAR;
    if constexpr (Epi::AFTER_DRAIN) { E.fused(acc, cur, wr, wc, fr, fq, lds, wid, lane); S.done(cur); }
#undef PG8_SA
#undef PG8_SB
#undef PG8_STAGE
#undef PG8_STAGE2
#undef PG8_GOFF
#undef PG8_STA
#undef PG8_LDA
#undef PG8_LDB
#undef PG8_MMA
#undef PG8_WAIT_V
#undef PG8_WAIT_L
#undef PG8_BAR
#undef PG8_SCHED
}
}

namespace pg8 {
struct EpiInproj {
  static constexpr bool PERM = true, AFTER_DRAIN = false;
  bf16_t* QAb; bf16_t* KAb; bf16_t* VAb;
  float* QB; bf16_t* QBb; bf16_t* KBb; bf16_t* VB; float* KMP;
  bf16_t* P2;
  const float* aqg; const float* akg; const float* bqg; const float* bkg; float c2;
  __device__ __forceinline__ static u32x4 pk8(const f32x4& a, const f32x4& b) { u32x4 w; w.x = cvt_pk_bf16(a[0], a[1]); w.y = cvt_pk_bf16(a[2], a[3]); w.z = cvt_pk_bf16(b[0], b[1]); w.w = cvt_pk_bf16(b[2], b[3]); return w; }
  __device__ __forceinline__ void operator()(const f32x4 (&acc)[2][2][4][2], const Unit& u, int wr, int wc, int fr, int fq) const {
    const int row0 = u.pm * BM + wr * 64 + fr, t = u.pn;
    if (t >= 6) {
      const int col0 = (t - 6) * BM + wc * 32 + 8 * fq;
#pragma unroll
      for (int ai = 0; ai < 2; ++ai)
#pragma unroll
        for (int m = 0; m < 4; ++m) {
          bf16_t* rp = P2 + (size_t)(row0 + ai * HALF + m * 16) * 1296;
#pragma unroll
          for (int bj = 0; bj < 2; ++bj) { const int col = col0 + bj * HALF; if (col < 1296) *(u32x4*)(rp + col) = pk8(acc[ai][bj][m][0], acc[ai][bj][m][1]); }
        }
    } else if (t <= 1) {
      const float* gp = (t == 0 ? aqg : akg) + 8 * fq;
      const f32x4 g0 = *(const f32x4*)gp, g1 = *(const f32x4*)(gp + 4);
      bf16_t* dst = t == 0 ? QAb : KAb;
      const float sc = t == 0 ? c2 : 1.f;
#pragma unroll
      for (int ai = 0; ai < 2; ++ai)
#pragma unroll
        for (int m = 0; m < 4; ++m)
#pragma unroll
          for (int bj = 0; bj < 2; ++bj) {
            const f32x4 v0 = acc[ai][bj][m][0], v1 = acc[ai][bj][m][1];
            float ss = (v0[0] * v0[0] + v0[1] * v0[1]) + (v0[2] * v0[2] + v0[3] * v0[3]) + (v1[0] * v1[0] + v1[1] * v1[1]) + (v1[2] * v1[2] + v1[3] * v1[3]);
            ss += __shfl_xor(ss, 16); ss += __shfl_xor(ss, 32);
            const float r = rsqrtf(ss * (1.f / 32.f) + 1e-6f) * sc;
            bf16_t* o = dst + (size_t)(row0 + ai * HALF + m * 16) * 512 + (bj * 4 + wc) * 64 + 8 * fq;
            *(u32x4*)o = pk8(v0 * g0 * r, v1 * g1 * r);
          }
    } else if (t == 2) {
#pragma unroll
      for (int ai = 0; ai < 2; ++ai)
#pragma unroll
        for (int m = 0; m < 4; ++m)
#pragma unroll
          for (int bj = 0; bj < 2; ++bj) {
            const u32x4 w = pk8(acc[ai][bj][m][0], acc[ai][bj][m][1]);
            *(u32x4*)(VAb + (size_t)(row0 + ai * HALF + m * 16) * 256 + bj * HALF + wc * 32 + 8 * fq) = w;
          }
    } else if (t == 5) {
#pragma unroll
      for (int ai = 0; ai < 2; ++ai)
#pragma unroll
        for (int m = 0; m < 4; ++m)
#pragma unroll
          for (int bj = 0; bj < 2; ++bj)
            *(u32x4*)(VB + (size_t)(row0 + ai * HALF + m * 16) * 256 + bj * HALF + wc * 32 + 8 * fq) = pk8(acc[ai][bj][m][0], acc[ai][bj][m][1]);
    } else {
      const float* gp = (t == 3 ? bqg : bkg) + 8 * fq;
      f32x4 g[2][2];
#pragma unroll
      for (int bj = 0; bj < 2; ++bj) { g[bj][0] = *(const f32x4*)(gp + 32 * bj); g[bj][1] = *(const f32x4*)(gp + 32 * bj + 4); }
#pragma unroll
      for (int ai = 0; ai < 2; ++ai) {
        f32x4 cs[2][2];
#pragma unroll
        for (int bj = 0; bj < 2; ++bj) { cs[bj][0] = (f32x4){0.f, 0.f, 0.f, 0.f}; cs[bj][1] = (f32x4){0.f, 0.f, 0.f, 0.f}; }
#pragma unroll
        for (int m = 0; m < 4; ++m) {
          float ss = 0.f;
#pragma unroll
          for (int bj = 0; bj < 2; ++bj)
#pragma unroll
            for (int n = 0; n < 2; ++n) { const f32x4 v = acc[ai][bj][m][n]; ss += (v[0] * v[0] + v[1] * v[1]) + (v[2] * v[2] + v[3] * v[3]); }
          ss += __shfl_xor(ss, 16); ss += __shfl_xor(ss, 32);
          const float r = rsqrtf(ss * (1.f / 64.f) + 1e-6f);
          const size_t ro = (size_t)(row0 + ai * HALF + m * 16) * 256 + wc * 64 + 8 * fq;
#pragma unroll
          for (int bj = 0; bj < 2; ++bj) {
            const f32x4 n0 = acc[ai][bj][m][0] * g[bj][0] * r, n1 = acc[ai][bj][m][1] * g[bj][1] * r;
            if (t == 3) {
              *(f32x4*)(QB + ro + 32 * bj) = n0; *(f32x4*)(QB + ro + 32 * bj + 4) = n1;
              const float qs = 0.125f * 1.4426950408889634f;
              *(u32x4*)(QBb + ro + 32 * bj) = pk8(n0 * qs, n1 * qs);
            } else {
              *(u32x4*)(KBb + ro + 32 * bj) = pk8(n0, n1);
              cs[bj][0] += n0; cs[bj][1] += n1;
            }
          }
        }
        if (t == 4) {
#pragma unroll
          for (int bj = 0; bj < 2; ++bj)
#pragma unroll
            for (int n = 0; n < 2; ++n)
#pragma unroll
              for (int j = 0; j < 4; ++j) { float v = cs[bj][n][j]; v += __shfl_xor(v, 1); v += __shfl_xor(v, 2); v += __shfl_xor(v, 4); v += __shfl_xor(v, 8); cs[bj][n][j] = v; }
          if (fr == 0) {
            float* kp = KMP + (size_t)(u.pm * 4 + ai * 2 + wr) * 256 + wc * 64 + 8 * fq;
#pragma unroll
            for (int bj = 0; bj < 2; ++bj) { *(f32x4*)(kp + 32 * bj) = cs[bj][0]; *(f32x4*)(kp + 32 * bj + 4) = cs[bj][1]; }
          }
        }
      }
    }
  }
};
struct EpiOutproj {
  static constexpr bool PERM = true, AFTER_DRAIN = false;
  const float* xin32; const bf16_t* xin16; const float* g1; bf16_t* X1;
  __device__ __forceinline__ void operator()(const f32x4 (&acc)[2][2][4][2], const Unit& u, int wr, int wc, int fr, int fq) const {
    const int row0 = u.pm * BM + wr * 64 + fr, col0 = u.pn * BM + wc * 32 + 8 * fq;
#pragma unroll
    for (int bj = 0; bj < 2; ++bj) {
      const int col = col0 + bj * HALF;
      const f32x4 g0 = *(const f32x4*)(g1 + col), g1v = *(const f32x4*)(g1 + col + 4);
#pragma unroll
      for (int ai = 0; ai < 2; ++ai)
#pragma unroll
        for (int m = 0; m < 4; ++m) {
          const size_t off = (size_t)(row0 + ai * HALF + m * 16) * 1024 + col;
          f32x4 x0, x1;
          if (xin32) { x0 = *(const f32x4*)(xin32 + off); x1 = *(const f32x4*)(xin32 + off + 4); }
          else {
            const u32x4 w = *(const u32x4*)(xin16 + off);
            x0 = (f32x4){__builtin_bit_cast(float, w.x << 16), __builtin_bit_cast(float, w.x & 0xffff0000u), __builtin_bit_cast(float, w.y << 16), __builtin_bit_cast(float, w.y & 0xffff0000u)};
            x1 = (f32x4){__builtin_bit_cast(float, w.z << 16), __builtin_bit_cast(float, w.z & 0xffff0000u), __builtin_bit_cast(float, w.w << 16), __builtin_bit_cast(float, w.w & 0xffff0000u)};
          }
          const f32x4 v0 = x0 + g0 * acc[ai][bj][m][0], v1 = x1 + g1v * acc[ai][bj][m][1];
          u32x4 o; o.x = cvt_pk_bf16(v0[0], v0[1]); o.y = cvt_pk_bf16(v0[2], v0[3]); o.z = cvt_pk_bf16(v1[0], v1[1]); o.w = cvt_pk_bf16(v1[2], v1[3]);
          *(u32x4*)(X1 + off) = o;
        }
    }
  }
};
struct EpiUp {
  static constexpr bool PERM = true, AFTER_DRAIN = false;
  __amdgpu_buffer_rsrc_t act;
  const float* bup;
  __device__ __forceinline__ void operator()(const f32x4 (&acc)[2][2][4][2], const Unit& u, int wr, int wc, int fr, int fq) const {
    const int e = u.pn >> 3, j = u.pn & 7;
    const int row0 = u.pm * BM + wr * 64 + fr, col0 = j * 128 + wc * 32 + 8 * fq;
    const float* bg = bup + (size_t)e * 2048 + col0; const float* bl = bg + 1024;
    f32x4 bgv[2], blv[2];
#pragma unroll
    for (int n = 0; n < 2; ++n) { bgv[n] = *(const f32x4*)(bg + 4 * n); blv[n] = *(const f32x4*)(bl + 4 * n); }
#pragma unroll
    for (int ai = 0; ai < 2; ++ai)
#pragma unroll
      for (int m = 0; m < 4; ++m) {
        float o[8];
#pragma unroll
        for (int n = 0; n < 2; ++n) {
          const f32x4 gg = acc[ai][0][m][n] + bgv[n], ll = acc[ai][1][m][n] + blv[n];
#pragma unroll
          for (int c = 0; c < 4; ++c) {
            float g = fminf(gg[c], 7.f), lin = fminf(fmaxf(ll[c], -7.f), 7.f);
            float glu = g * __builtin_amdgcn_rcpf(1.f + __builtin_amdgcn_exp2f(-1.702f * 1.4426950408889634f * g));
            o[n * 4 + c] = (lin + 1.f) * glu;
          }
        }
        u32x4 w; w.x = cvt_pk_bf16(o[0], o[1]); w.y = cvt_pk_bf16(o[2], o[3]); w.z = cvt_pk_bf16(o[4], o[5]); w.w = cvt_pk_bf16(o[6], o[7]);
        __builtin_amdgcn_raw_buffer_store_b128(w, act, (unsigned)(((row0 + ai * HALF + m * 16) * 1024 + col0) * 2), 0,   16);
      }
  }
};
struct EpiDown {
  static constexpr bool PERM = true, AFTER_DRAIN = false;
  bf16_t* YS; const float* bdn;
  __device__ __forceinline__ void operator()(const f32x4 (&acc)[2][2][4][2], const Unit& u, int wr, int wc, int fr, int fq) const {
    const int e = u.pn >> 2, j = u.pn & 3;
    const int row0 = u.pm * BM + wr * 64 + fr, col0 = j * 256 + wc * 32 + 8 * fq;
    f32x4 bv[2][2];
#pragma unroll
    for (int bj = 0; bj < 2; ++bj)
#pragma unroll
      for (int n = 0; n < 2; ++n) bv[bj][n] = *(const f32x4*)(bdn + (size_t)e * 1024 + col0 + bj * HALF + 4 * n);
#pragma unroll
    for (int ai = 0; ai < 2; ++ai)
#pragma unroll
      for (int m = 0; m < 4; ++m) {
        bf16_t* rp = YS + (size_t)(row0 + ai * HALF + m * 16) * 1024 + col0;
#pragma unroll
        for (int bj = 0; bj < 2; ++bj) {
          const f32x4 v0 = acc[ai][bj][m][0] + bv[bj][0], v1 = acc[ai][bj][m][1] + bv[bj][1];
          u32x4 w; w.x = cvt_pk_bf16(v0[0], v0[1]); w.y = cvt_pk_bf16(v0[2], v0[3]); w.z = cvt_pk_bf16(v1[0], v1[1]); w.w = cvt_pk_bf16(v1[2], v1[3]);
          *(u32x4*)(rp + bj * HALF) = w;
        }
      }
  }
};
#ifndef MOE_ORDER
#define MOE_ORDER 0
#endif
template <int NJ> __device__ __forceinline__ void moe_build_units(const int* cnt, int G, int c, int* tab, int tid, bool rotate = false) {
  if (tid < 24) {
    int pm = -1, pn = -1, ex = 0, r0 = 0;
    {
      int cc = c;
      if (rotate) {
        int T = 0; for (int e = 0; e < 32; ++e) T += (cnt[e] + 255) >> 8;
        int r8 = 8 * T; while (r8 >= G) r8 -= G;
        cc = c - r8; if (cc < 0) cc += G;
      }
      const long L = (long)tid * G + cc; const int t = (int)(L / NJ);
      int acc = 0;
      for (int e = 0; e < 32; ++e) {
        const int ne = (cnt[e] + 255) >> 8;
        if (pm < 0 && t < acc + ne) { pm = t; pn = e * NJ + (int)(L % NJ); ex = e; r0 = (t - acc) << 8; }
        acc += ne;
      }
    }
    tab[4 * tid] = pm; tab[4 * tid + 1] = pn; tab[4 * tid + 2] = ex; tab[4 * tid + 3] = r0;
  }
  __syncthreads();
}
__device__ __forceinline__ void moe_build_rowoff(const int* elist, const int* cnt, const int* tab, unsigned* rowoff, int tid) {
  for (int i = tid; i < 13 * 256; i += 512) {
    const int u = i >> 8, pm = tab[4 * u];
    unsigned v = 0u;
    if (pm >= 0) { const int e = tab[4 * u + 2], r = tab[4 * u + 3] + (i & 255); if (r < cnt[e]) v = (unsigned)elist[e * 16384 + r] * 2048u; }
    rowoff[i] = v;
  }
  __syncthreads();
}
template <int NJ, int MODE = 0> struct MoeOrder {
  const int* tab;
  unsigned* rdy;
  __device__ __forceinline__ bool next(int i, Unit& u) const {
    if (i >= 24) return false;
    const int pm = tab[4 * i]; if (pm < 0) return false;
    u.pm = pm; u.pn = tab[4 * i + 1]; return true;
  }
  __device__ __forceinline__ void a_ready(const Unit& u) const {
    if constexpr (MODE == 2) {
      if (threadIdx.x < 64) {
        unsigned polls = 0;
        while ((unsigned)__builtin_amdgcn_readfirstlane(__hip_atomic_load(rdy + u.pm, __ATOMIC_RELAXED, __HIP_MEMORY_SCOPE_AGENT)) < 64u) {
          if (++polls > (1u << 22)) break;
          __builtin_amdgcn_s_sleep(2);
        }
        __builtin_amdgcn_fence(__ATOMIC_ACQUIRE, "agent");
        asm volatile("s_waitcnt vmcnt(0)" ::: "memory");
      }
      asm volatile("" ::: "memory"); __builtin_amdgcn_s_barrier(); asm volatile("" ::: "memory");
    }
  }
  __device__ __forceinline__ void done(const Unit& u) const {
    if constexpr (MODE == 1) {
      asm volatile("s_waitcnt vmcnt(0)" ::: "memory");
      if ((threadIdx.x & 63) == 0) __hip_atomic_fetch_add(rdy + u.pm, 1u, __ATOMIC_RELAXED, __HIP_MEMORY_SCOPE_AGENT);
    }
  }
};
}

#include <hip/hip_bf16.h>
#include <cmath>
namespace attn_body {
using bf16=__hip_bfloat16;
using bf16x8=__attribute__((ext_vector_type(8)))short;
using s16x4=__attribute__((ext_vector_type(4)))short;
using f32x16=__attribute__((ext_vector_type(16)))float;
using u32x4=__attribute__((ext_vector_type(4)))unsigned;
constexpr int BATCH=1,NHEAD=8,SEQ=16384,D=64,DM=NHEAD*D;
constexpr int NW=8,QBLK=32,QB=QBLK*NW,KVBLK=64,NQB=SEQ/QB;
constexpr int ATTN_PITCH=DM, ATTN_UNIT_ROWS=QB;
__device__ __forceinline__ int crow(int r,int hi){return (r&3)+8*(r>>2)+4*hi;}
#define SBAR() __builtin_amdgcn_sched_barrier(0)
__device__ __forceinline__ void cmask(f32x16&p0,f32x16&p1,int jb,int qrel,int hi){
  const float NEG=-INFINITY; int kb=64*jb+4*hi;
  #pragma unroll
  for(int r=0;r<16;++r){int kv=kb+(r&3)+8*(r>>2); if(kv>qrel)p0[r]=NEG; if(kv+32>qrel)p1[r]=NEG;}
}

constexpr int NSLOT=3, SLOTB=8192;
constexpr int LDS_K=0, LDS_V=NSLOT*SLOTB, LDS_WS=2*NSLOT*SLOTB, LDS_OST=LDS_WS+NW*64*4, LDS_BYTES=LDS_OST+NW*4096;
constexpr float C2=0.17677669529663687f*1.4426950408889634f;
__device__ __forceinline__ void glds16(const void*gsrc,unsigned lds_dst){unsigned keep;
  asm volatile("s_mov_b32 %0, m0\n\ts_mov_b32 m0, %2\n\ts_nop 0\n\tglobal_load_lds_dwordx4 %1, off\n\ts_mov_b32 m0, %0":"=&s"(keep):"v"(gsrc),"s"(lds_dst):"memory");}
__device__ __forceinline__ float max3f(float a,float b,float c){float r;asm("v_max3_f32 %0, %1, %2, %3":"=v"(r):"v"(a),"v"(b),"v"(c));return r;}
__device__ __forceinline__ float max2f(float a,float b){float r;asm("v_max_f32_e32 %0, %1, %2":"=v"(r):"v"(a),"v"(b));return r;}
__device__ __forceinline__ float fadd_s(float a,float b){float r;asm("v_add_f32_e32 %0, %1, %2":"=v"(r):"v"(a),"v"(b));return r;}
__device__ __forceinline__ float fsub_s(float a,float b){float r;asm("v_sub_f32_e32 %0, %1, %2":"=v"(r):"v"(a),"v"(b));return r;}
typedef float f32x2_t __attribute__((ext_vector_type(2))); typedef __bf16 bf16x2_t __attribute__((ext_vector_type(2)));
__device__ __forceinline__ unsigned cvtpk_s(float lo,float hi){f32x2_t v={lo,hi};bf16x2_t b=__builtin_convertvector(v,bf16x2_t);return __builtin_bit_cast(unsigned,b);}
#define WAIT_BAR(N) asm volatile("s_waitcnt vmcnt(" #N ") lgkmcnt(0)\n\ts_barrier":::"memory")

__device__ __forceinline__ void qkt(f32x16&p0,f32x16&p1,const char*Kslot,const bf16x8*qr,const f32x16&negm,int r32,int hi){
  const char*kb=Kslot+hi*1024+r32*16;
  #pragma unroll
  for(int d0=0;d0<2;++d0){
    const bf16x8 b0=*reinterpret_cast<const bf16x8*>(kb+d0*2048);
    const bf16x8 b1=*reinterpret_cast<const bf16x8*>(kb+d0*2048+512);
    if(d0==0){p0=__builtin_amdgcn_mfma_f32_32x32x16_bf16(b0,qr[0],negm,0,0,0);p1=__builtin_amdgcn_mfma_f32_32x32x16_bf16(b1,qr[0],negm,0,0,0);}
    else{p0=__builtin_amdgcn_mfma_f32_32x32x16_bf16(b0,qr[d0],p0,0,0,0);p1=__builtin_amdgcn_mfma_f32_32x32x16_bf16(b1,qr[d0],p1,0,0,0);}}
}
typedef __attribute__((address_space(3))) const char* lds_cptr;
typedef short v4i16_t __attribute__((ext_vector_type(4)));
__device__ __forceinline__ void kload8(bf16x8*kf,lds_cptr kp){
  kf[0]=*(const __attribute__((address_space(3))) bf16x8*)(kp);      kf[1]=*(const __attribute__((address_space(3))) bf16x8*)(kp+512);
  kf[2]=*(const __attribute__((address_space(3))) bf16x8*)(kp+2048); kf[3]=*(const __attribute__((address_space(3))) bf16x8*)(kp+2560);
  kf[4]=*(const __attribute__((address_space(3))) bf16x8*)(kp+4096); kf[5]=*(const __attribute__((address_space(3))) bf16x8*)(kp+4608);
  kf[6]=*(const __attribute__((address_space(3))) bf16x8*)(kp+6144); kf[7]=*(const __attribute__((address_space(3))) bf16x8*)(kp+6656);
}
__device__ __forceinline__ void kload2(bf16x8*kf,lds_cptr kp,int j){ kf[2*j]=*(const __attribute__((address_space(3))) bf16x8*)(kp+j*2048); kf[2*j+1]=*(const __attribute__((address_space(3))) bf16x8*)(kp+j*2048+512); }
__device__ __forceinline__ s16x4 vtr(lds_cptr p){ return __builtin_bit_cast(s16x4,__builtin_amdgcn_ds_read_tr16_b64_v4i16((__attribute__((address_space(3))) v4i16_t*)p)); }
__device__ __forceinline__ float rowmax(const f32x16&p0,const f32x16&p1){
  float a=max3f(p0[0],p0[1],p1[0]),b=max3f(p0[2],p0[3],p1[1]);a=max3f(a,p1[2],p1[3]);
  #pragma unroll
  for(int r=4;r<16;r+=4){a=max3f(a,p0[r],p0[r+1]);b=max3f(b,p0[r+2],p0[r+3]);a=max3f(a,p1[r],p1[r+1]);b=max3f(b,p1[r+2],p1[r+3]);}
  const float m=max2f(a,b);
  auto rr=__builtin_amdgcn_permlane32_swap(__float_as_uint(m),__float_as_uint(m),false,false);
  return max2f(__uint_as_float(rr[0]),__uint_as_float(rr[1]));
}
__device__ __forceinline__ void pv(f32x16*o,int vb,bf16x8 pa0,bf16x8 pa1,bf16x8 pa2,bf16x8 pa3){
  #pragma unroll
  for(int d0=0;d0<2;++d0){s16x4 lo[4],hi[4];
    #pragma unroll
    for(int ks=0;ks<4;++ks){
      asm volatile("ds_read_b64_tr_b16 %0,%1 offset:%c2":"=&v"(lo[ks]):"v"(vb),"i"(d0*4096+ks*1024):"memory");
      asm volatile("ds_read_b64_tr_b16 %0,%1 offset:%c2":"=&v"(hi[ks]):"v"(vb),"i"(d0*4096+ks*1024+512):"memory");}
    asm volatile("s_waitcnt lgkmcnt(0)":::"memory");SBAR();
    #define PK(k) (bf16x8){lo[k][0],lo[k][1],lo[k][2],lo[k][3],hi[k][0],hi[k][1],hi[k][2],hi[k][3]}
    o[d0]=__builtin_amdgcn_mfma_f32_32x32x16_bf16(pa0,PK(0),o[d0],0,0,0);
    o[d0]=__builtin_amdgcn_mfma_f32_32x32x16_bf16(pa1,PK(1),o[d0],0,0,0);
    o[d0]=__builtin_amdgcn_mfma_f32_32x32x16_bf16(pa2,PK(2),o[d0],0,0,0);
    o[d0]=__builtin_amdgcn_mfma_f32_32x32x16_bf16(pa3,PK(3),o[d0],0,0,0);
    #undef PK
  }
}

#ifndef ATTN_STORE16
#define ATTN_STORE16(p,v) (*(u32x4*)(p)=(v))
#endif
template<int THRL> __device__ __forceinline__ void attn_unit(int b,int h,int qb,const bf16*Q,const bf16*__restrict__ K,const bf16*__restrict__ V,bf16*O,char*shm,const bf16*ATTN_ZERO16){
  const int tid=tidx(),lane=tid&63,r32=lane&31,hi=lane>>5; const int wid=__builtin_amdgcn_readfirstlane(tid>>6);
  const long rowbase=(long)b*SEQ; const int q0=qb*QB;
  const bf16*Qw=Q+(rowbase+q0+wid*QBLK)*DM+h*D;
  constexpr int VP=DM/2;
  const bf16*Kh=K+rowbase*DM+h*D,*Vh=V+rowbase*VP+(h>>1)*D;
  const unsigned lds0=(unsigned)(uintptr_t)shm;
  float*wsf=(float*)(shm+LDS_WS)+wid*64;
  const bf16*ksrc=(wid<4)?Kh+(long)lane*DM+wid*8:ATTN_ZERO16; const long kstep_=(wid<4)?(long)KVBLK*DM:0L;
  const bf16*vsrc=Vh+(long)(16*(wid&3)+(lane>>2))*VP+(wid>>2)*32+(lane&3)*8;
  const unsigned kdst=lds0+LDS_K+wid*1024, vdst=lds0+LDS_V+wid*1024;
  #define DMA_K(t,slot) glds16(ksrc+(long)(t)*kstep_,(unsigned)__builtin_amdgcn_readfirstlane(kdst+(slot)))
  #define DMA_V(t,slot) glds16(vsrc+(long)(t)*KVBLK*VP,(unsigned)__builtin_amdgcn_readfirstlane(vdst+(slot)))
  const int vb0=(int)(lds0+LDS_V)+((lane>>4)&1)*32+(lane&3)*8+(4*hi+((lane&15)>>2))*64;
  const char*Kbase=shm+LDS_K; bf16x8 kf[8];
  const lds_cptr shm3=(lds_cptr)shm; const lds_cptr kp0=shm3+LDS_K+hi*1024+r32*16; const lds_cptr vp0=shm3+LDS_V+((lane>>4)&1)*32+(lane&3)*8+(4*hi+((lane&15)>>2))*64;
  const int NT=(q0+QB)/KVBLK;
  DMA_K(0,0);DMA_V(0,0);DMA_K(1,SLOTB);
  bf16x8 qr[4];
  #pragma unroll
  for(int d0=0;d0<4;++d0)qr[d0]=*reinterpret_cast<const bf16x8*>(&Qw[(long)r32*DM+d0*16+hi*8]);
  float mhat=0.f,l_reg=0.f;f32x16 o[2];o[0]=f32x16{};o[1]=f32x16{};f32x16 negm=f32x16{};asm volatile("":"+v"(negm));
  const int qrel=wid*QBLK+r32;
  #define CMASK(P0,P1,t) do{int jb_=(t)-(NT-4); if(jb_>=0)cmask(P0,P1,jb_,qrel,hi);}while(0)
  bool resc=false;
  #define START(P0,P1) do{ const float rm=rowmax(P0,P1); resc=false; \
    { const float dl=rm; mhat=fadd_s(mhat,dl); \
      _Pragma("unroll") for(int r=0;r<16;++r){P0[r]=fsub_s(P0[r],dl);P1[r]=fsub_s(P1[r],dl);} \
      _Pragma("unroll") for(int r=0;r<16;++r)negm[r]=-mhat; asm volatile("":"+v"(negm)); } \
    _Pragma("unroll") for(int r=0;r<16;++r)P0[r]=__builtin_amdgcn_exp2f(P0[r]); }while(0)
  #define RESC() do{ if(resc){ asm volatile("s_waitcnt lgkmcnt(0)":::"memory"); \
      _Pragma("unroll") for(int d_=0;d_<2;++d_) _Pragma("unroll") for(int r=0;r<16;++r)o[d_][r]*=wsf[crow(r,hi)]; } }while(0)
  f32x16 pA0,pA1,pB0,pB1;
  int sl_prev=0,sl_cur=0,sl_next=SLOTB;
  #define ROT() do{sl_prev=sl_cur;sl_cur=sl_next;sl_next=(sl_next==(NSLOT-1)*SLOTB)?0:sl_next+SLOTB;}while(0)
  DMA_K(2,2*SLOTB);
  WAIT_BAR(3);
  qkt(pA0,pA1,Kbase,qr,negm,r32,hi);asm volatile("s_nop 15\n\ts_nop 7":"+v"(pA0),"+v"(pA1));CMASK(pA0,pA1,0);
  START(pA0,pA1);
  _Pragma("unroll") for(int r=0;r<16;++r)pA1[r]=__builtin_amdgcn_exp2f(pA1[r]);
  WAIT_BAR(0);
  DMA_K(3,0);DMA_V(1,SLOTB);
  ROT();
  kload8(kf,kp0+sl_cur);
  WAIT_BAR(2);
  s16x4 vlo[8],vhi[8]; u32x4 pw0,pw1,pw2,pw3;
  #define PKW(P,B) cvtpk_s(P[B],P[B+1])
  #define PAF(k) __builtin_bit_cast(bf16x8,pw##k)
  #define VFR(i) (bf16x8){vlo[i][0],vlo[i][1],vlo[i][2],vlo[i][3],vhi[i][0],vhi[i][1],vhi[i][2],vhi[i][3]}
  #define PIN(x) asm volatile("":"+v"(x))
  #define MX3(a,b,c) __builtin_fmaxf(__builtin_fmaxf((a),(b)),(c))
  #define GAPA(MF,A0,A1,A2,A3,W0,W1,PW) do{ MF; sacc+=A0; sacc+=A1; sacc+=A2; sacc+=A3; PIN(sacc); W0; W1; PIN(PW); SBAR(); }while(0)
  #define EX(v) __builtin_amdgcn_exp2f(v)
  #define GAPB(MF,X,B) do{ MF; X[B]=EX(X[B]); X[B+1]=EX(X[B+1]); X[B+2]=EX(X[B+2]); X[B+3]=EX(X[B+3]); PIN(X); SBAR(); }while(0)
  #define VRD(i) do{ vlo[i]=vtr(vp_+(((i)>>2)*4096+((i)&3)*1024)); vhi[i]=vtr(vp_+(((i)>>2)*4096+((i)&3)*1024+512)); }while(0)
  #define KRD(G,j) do{ if(G){ kload2(kf,kp0+sl_next,j); SBAR(); } }while(0)
  #define STEP(C0,C1,P0,P1,t,GK,GV,GL) do{ SBAR(); \
    const lds_cptr vp_=vp0+sl_prev; \
    VRD(0); SBAR(); float sacc=(P0[0]+P0[1]); \
    GAPA(C0=__builtin_amdgcn_mfma_f32_32x32x16_bf16(kf[0],qr[0],negm,0,0,0), P0[2],P0[3],P0[4],P0[5],     pw0[0]=PKW(P0,0), pw0[1]=PKW(P0,2), pw0); \
    VRD(4); SBAR(); GAPA(C1=__builtin_amdgcn_mfma_f32_32x32x16_bf16(kf[1],qr[0],negm,0,0,0), P0[6],P0[7],P0[8],P0[9],     pw0[2]=PKW(P0,4), pw0[3]=PKW(P0,6), pw0); \
    VRD(1); SBAR(); GAPA(C0=__builtin_amdgcn_mfma_f32_32x32x16_bf16(kf[2],qr[1],C0,0,0,0),   P0[10],P0[11],P0[12],P0[13], pw1[0]=PKW(P0,8), pw1[1]=PKW(P0,10), pw1); \
    VRD(5); SBAR(); GAPA(C1=__builtin_amdgcn_mfma_f32_32x32x16_bf16(kf[3],qr[1],C1,0,0,0),   P0[14],P0[15],P1[0],P1[1],   pw1[2]=PKW(P0,12),pw1[3]=PKW(P0,14), pw1); \
    VRD(2); SBAR(); GAPA((void)0,   P1[2],P1[3],P1[4],P1[5],     pw2[0]=PKW(P1,0), pw2[1]=PKW(P1,2), pw2); \
    VRD(6); SBAR(); GAPA((void)0,   P1[6],P1[7],P1[8],P1[9],     pw2[2]=PKW(P1,4), pw2[3]=PKW(P1,6), pw2); \
    VRD(3); SBAR(); GAPA((void)0,   P1[10],P1[11],P1[12],P1[13], pw3[0]=PKW(P1,8), pw3[1]=PKW(P1,10), pw3); \
    VRD(7); SBAR(); GAPA((void)0,   P1[14],P1[15],0.f,0.f,       pw3[2]=PKW(P1,12),pw3[3]=PKW(P1,14), pw3); \
    l_reg+=sacc; \
    if(GK){DMA_K((t)+3,sl_cur);} if(GV){DMA_V((t)+1,sl_next);} \
    CMASK(C0,C1,t); \
    { float a=MX3(C0[0],C0[1],C1[0]),b=MX3(C0[2],C0[3],C1[1]); a=MX3(a,C1[2],C1[3]); \
      _Pragma("unroll") for(int r=4;r<16;r+=4){a=MX3(a,C0[r],C0[r+1]);b=MX3(b,C0[r+2],C0[r+3]);a=MX3(a,C1[r],C1[r+1]);b=MX3(b,C1[r+2],C1[r+3]);} \
      float rm=__builtin_fmaxf(a,b); { auto rr=__builtin_amdgcn_permlane32_swap(__float_as_uint(rm),__float_as_uint(rm),false,false); rm=__builtin_fmaxf(__uint_as_float(rr[0]),__uint_as_float(rr[1])); } \
      resc=false; \
      if(__builtin_expect(__any(rm>(float)THRL),0)){ const float dl=__builtin_fmaxf(rm,0.f); mhat+=dl; \
        _Pragma("unroll") for(int r=0;r<16;++r){C0[r]-=dl;C1[r]-=dl;} \
        _Pragma("unroll") for(int r=0;r<16;++r)negm[r]=-mhat; asm volatile("":"+v"(negm)); \
        const float f=__builtin_amdgcn_exp2f(-dl); l_reg*=f; if(hi==0)wsf[r32]=f; resc=true; } } \
    SBAR(); \
    GAPB(o[0]=__builtin_amdgcn_mfma_f32_32x32x16_bf16(PAF(0),VFR(0),o[0],0,0,0), C0,0); \
    GAPB(o[1]=__builtin_amdgcn_mfma_f32_32x32x16_bf16(PAF(0),VFR(4),o[1],0,0,0), C0,4); \
    KRD(GL,0); GAPB(o[0]=__builtin_amdgcn_mfma_f32_32x32x16_bf16(PAF(1),VFR(1),o[0],0,0,0), C0,8); \
    KRD(GL,1); GAPB(o[1]=__builtin_amdgcn_mfma_f32_32x32x16_bf16(PAF(1),VFR(5),o[1],0,0,0), C0,12); \
    KRD(GL,2); GAPB(o[0]=__builtin_amdgcn_mfma_f32_32x32x16_bf16(PAF(2),VFR(2),o[0],0,0,0), C1,0); \
    KRD(GL,3); GAPB(o[1]=__builtin_amdgcn_mfma_f32_32x32x16_bf16(PAF(2),VFR(6),o[1],0,0,0), C1,4); \
    GAPB(o[0]=__builtin_amdgcn_mfma_f32_32x32x16_bf16(PAF(3),VFR(3),o[0],0,0,0), C1,8); \
    GAPB(o[1]=__builtin_amdgcn_mfma_f32_32x32x16_bf16(PAF(3),VFR(7),o[1],0,0,0), C1,12); \
    }while(0)
  int t=1;
  #undef CMASK
  #define CMASK(P0,P1,t) do{}while(0)
  for(;t+5<NT;t+=2){
    STEP(pB0,pB1,pA0,pA1,t,true,true,true);     WAIT_BAR(2); RESC(); ROT();
    STEP(pA0,pA1,pB0,pB1,t+1,true,true,true);   WAIT_BAR(2); RESC(); ROT();
  }
  #undef CMASK
  #define CMASK(P0,P1,t) do{int jb_=(t)-(NT-4); if(jb_>=0)cmask(P0,P1,jb_,qrel,hi);}while(0)
  #define ENDW(tt) do{ if((tt)+3<NT){WAIT_BAR(2);} else if((tt)+2<NT){WAIT_BAR(1);} else {WAIT_BAR(0);} }while(0)
  for(;t+1<NT;t+=2){
    STEP(pB0,pB1,pA0,pA1,t,(t+3<NT),(t+1<NT),(t+1<NT));       ENDW(t);   RESC(); ROT();
    STEP(pA0,pA1,pB0,pB1,t+1,(t+4<NT),(t+2<NT),(t+2<NT));     ENDW(t+1); RESC(); ROT();
  }
  STEP(pB0,pB1,pA0,pA1,NT-1,false,false,false); RESC();
  { float sacc=pB0[0]+pB0[1]; _Pragma("unroll") for(int r=2;r<16;++r)sacc+=pB0[r]; _Pragma("unroll") for(int r=0;r<16;++r)sacc+=pB1[r]; l_reg+=sacc;
    pw0=(u32x4){PKW(pB0,0),PKW(pB0,2),PKW(pB0,4),PKW(pB0,6)};pw1=(u32x4){PKW(pB0,8),PKW(pB0,10),PKW(pB0,12),PKW(pB0,14)};pw2=(u32x4){PKW(pB1,0),PKW(pB1,2),PKW(pB1,4),PKW(pB1,6)};pw3=(u32x4){PKW(pB1,8),PKW(pB1,10),PKW(pB1,12),PKW(pB1,14)};
    SBAR(); pv(o,vb0+sl_cur,PAF(0),PAF(1),PAF(2),PAF(3)); }
  #undef PKW
  #undef PAF
  #undef VFR
  #undef PIN
  #undef MX3
  #undef GAPA
  #undef GAPB
  #undef EX
  #undef VRD
  #undef KRD
  #undef STEP
  #undef ENDW
  {auto rr=__builtin_amdgcn_permlane32_swap(__float_as_uint(l_reg),__float_as_uint(l_reg),false,false);l_reg=__uint_as_float(rr[0])+__uint_as_float(rr[1]);}
  if(hi==0)wsf[32+r32]=l_reg;asm volatile("s_waitcnt lgkmcnt(0)":::"memory");
  float rli[16];
  #pragma unroll
  for(int r=0;r<16;++r)rli[r]=__builtin_amdgcn_rcpf(wsf[32+crow(r,hi)]);
  bf16*Ow=O+(rowbase+q0+wid*QBLK)*DM+h*D;
  { bf16*stg=(bf16*)(shm+LDS_OST)+wid*2048;
    #pragma unroll
    for(int r=0;r<16;++r){const int orow=crow(r,hi);
      #pragma unroll
      for(int d0=0;d0<2;++d0)stg[orow*64+d0*32+r32]=__float2bfloat16(o[d0][r]*rli[r]);}
    asm volatile("s_waitcnt lgkmcnt(0)":::"memory");
    #pragma unroll
    for(int i=0;i<4;++i){const int row=i*8+(lane>>3),ch=lane&7; const u32x4 v=*(const u32x4*)(stg+row*64+ch*8); ATTN_STORE16(Ow+(long)row*DM+ch*8,v);} }
  asm volatile("s_waitcnt lgkmcnt(0)\n\ts_barrier":::"memory");
  #undef DMA_K
  #undef DMA_V
  #undef CMASK
  #undef START
  #undef RESC
  #undef ROT
}
constexpr int ATTN_LDS_BYTES=LDS_BYTES;
struct AttnTensors { const bf16* Q; const bf16* K; const bf16* V; bf16* O; const bf16* Z; };
struct AttnUnit { int bh; int qb; };
struct StaticOrder {
  int vcu,grid;
  __device__ __forceinline__ explicit StaticOrder(int grid_,int block):vcu((block%8)*(grid_/8)+block/8),grid(grid_){}
  __device__ __forceinline__ bool next(int i,AttnUnit&u)const{ const int L=(i>>1)*grid+vcu; if(L>=256)return false; const int s=L&31; u.bh=L>>5; u.qb=(i&1)?63-s:s; return true; }
  __device__ __forceinline__ void a_ready(const AttnUnit&)const{}
  __device__ __forceinline__ void done(const AttnUnit&)const{}
};
template<class Sched,int THRL=8> __device__ __forceinline__ void attn_phase(char*lds,const AttnTensors&T,const Sched&S){
  AttnUnit u;
  for(int i=0;S.next(i,u);++i){ S.a_ready(u); attn_unit<THRL>(u.bh/NHEAD,u.bh%NHEAD,u.qb,T.Q,T.K,T.V,T.O,lds,T.Z); S.done(u); }
}
#undef SBAR
#undef WAIT_BAR
}

__device__ __forceinline__ void transpose_item(const float* W, int N, int k0, int n0, bf16raw* WT, int drow0, float* scr, int lane, int hi_off = 32) {
  const int c4 = (lane & 15) * 4, r0 = lane >> 4;
  const bool inb = (n0 + c4) < N;
  float4 v[16];
  typedef float f32x4nt_ __attribute__((ext_vector_type(4)));
#pragma unroll
  for (int i = 0; i < 16; ++i) {
    if (inb) { const f32x4nt_ t = __builtin_nontemporal_load((const f32x4nt_*)(W + (size_t)(k0 + 4 * i + r0) * N + n0 + c4)); v[i] = make_float4(t[0], t[1], t[2], t[3]); }
    else v[i] = make_float4(0.f, 0.f, 0.f, 0.f);
  }
#pragma unroll
  for (int i = 0; i < 16; ++i) {
    float* sp = scr + (4 * i + r0) * 65 + c4;
    sp[0] = v[i].x; sp[1] = v[i].y; sp[2] = v[i].z; sp[3] = v[i].w;
  }
  __builtin_amdgcn_fence(__ATOMIC_RELEASE, "wavefront"); __builtin_amdgcn_wave_barrier(); __builtin_amdgcn_fence(__ATOMIC_ACQUIRE, "wavefront");
  const int c = lane & 7;
#pragma unroll
  for (int j = 0; j < 8; ++j) {
    const int n = (lane >> 3) + 8 * j;
    const float* sp = scr + (8 * c) * 65 + n;
    uint4 o;
    o.x = pk2(sp[0 * 65], sp[1 * 65]); o.y = pk2(sp[2 * 65], sp[3 * 65]); o.z = pk2(sp[4 * 65], sp[5 * 65]); o.w = pk2(sp[6 * 65], sp[7 * 65]);
    if (n0 + n < N) { typedef unsigned u32x4nt_ __attribute__((ext_vector_type(4))); const u32x4nt_ ov = {o.x, o.y, o.z, o.w}; __builtin_nontemporal_store(ov, (u32x4nt_*)(WT + (size_t)(drow0 + (n & 31) + (n >> 5) * hi_off) * 1024 + k0 + 8 * c)); }
  }
  __builtin_amdgcn_fence(__ATOMIC_RELEASE, "wavefront"); __builtin_amdgcn_wave_barrier(); __builtin_amdgcn_fence(__ATOMIC_ACQUIRE, "wavefront");
}
constexpr int CV_IN = 16 * 45, CV_OUT = 16 * 16, CV_UP = 32 * 16 * 32, CV_DN = 32 * 16 * 16;
__device__ __forceinline__ void convert_one(const Params& p, int l, int r, float* scr, int lane) {
  if (r < CV_IN) {
    const int kb = r / 45, nb = r % 45;
    const int n0 = nb * 64;
    int drow = n0, hio = 32;
    if (n0 >= 768 && n0 < 1280) { const int t = n0 - 768; drow = 768 + (t >> 8) * 256 + ((t >> 6) & 3) * 32; hio = 128; }
    transpose_item(p.in[6] + (size_t)l * 1024 * DIN, DIN, kb * 64, n0, (bf16raw*)(p.ws + WS_WIN) + (size_t)l * 3072 * 1024, drow, scr, lane, hio);
    return;
  }
  r -= CV_IN;
  if (r < CV_OUT) {
    const int kb = r / 16, nb = r % 16;
    transpose_item(p.in[7] + (size_t)l * 1024 * 1024, 1024, kb * 64, nb * 64, (bf16raw*)(p.ws + WS_WOUT) + (size_t)l * 1024 * 1024, nb * 64, scr, lane);
    return;
  }
  r -= CV_OUT;
  if (r < CV_UP) {
    const int e = r / (16 * 32), r2 = r % (16 * 32), kb = r2 / 32, nb = r2 % 32, n0 = nb * 64;
    const int drow = n0 < 1024 ? (n0 >> 7) * 256 + (n0 & 127) : ((n0 - 1024) >> 7) * 256 + 128 + ((n0 - 1024) & 127);
    transpose_item(p.in[29] + ((size_t)l * NE + e) * 1024 * 2048, 2048, kb * 64, n0, (bf16raw*)(p.ws + WS_WUP) + ((size_t)l * NE + e) * 2048 * 1024, drow, scr, lane);
    return;
  }
  r -= CV_UP;
  {
    const int e = r / (16 * 16), r2 = r % (16 * 16), kb = r2 / 16, nb = r2 % 16;
    transpose_item(p.in[31] + ((size_t)l * NE + e) * 1024 * 1024, 1024, kb * 64, nb * 64, (bf16raw*)(p.ws + WS_WDN) + ((size_t)l * NE + e) * 1024 * 1024, nb * 64, scr, lane);
  }
}
__device__ __forceinline__ void ph_convert(const Params& p, float* sm) {
  const int bid0_ = bidx();
  const int tid0_ = tidx();
  const int lane = tid0_ & 63, wave = tid0_ >> 6;
  float* scr = sm + wave * (64 * 65 + 16);
  const int gw = bid0_ * 8 + wave, NGW = gridDim.x * 8;
  for (int it = gw; it < 2 * CV_IN; it += NGW) convert_one(p, it / CV_IN, it % CV_IN, scr, lane);
  for (int i = bid0_ * NT + tid0_; i < 2 * 240 * 128; i += gridDim.x * NT) {
    const int l = i / (240 * 128), r = i % (240 * 128);
    *(uint4*)((bf16raw*)(p.ws + WS_WIN) + (size_t)l * 3072 * 1024 + (size_t)2832 * 1024 + (size_t)r * 8) = make_uint4(0u, 0u, 0u, 0u);
  }
}
typedef float cvf4_t __attribute__((ext_vector_type(4)));
typedef unsigned cvu4_t __attribute__((ext_vector_type(4)));
__device__ __forceinline__ void cv_desc(const Params& p, int l, int it, const float*& src, int& N, bf16raw*& dst) {
  if (it < CV_OUT) {
    const int kb = it >> 4, nb = it & 15;
    N = 1024; src = p.in[7] + (size_t)l * 1024 * 1024 + (size_t)(kb * 64) * 1024 + nb * 64;
    dst = (bf16raw*)(p.ws + WS_WOUT) + (size_t)l * 1024 * 1024 + (size_t)(nb * 64) * 1024 + kb * 64;
  } else if (it < CV_OUT + CV_UP) {
    const int r = it - CV_OUT, e = r >> 9, r2 = r & 511, kb = r2 >> 5, nb = r2 & 31, n0 = nb * 64;
    const int drow = n0 < 1024 ? (n0 >> 7) * 256 + (n0 & 127) : ((n0 - 1024) >> 7) * 256 + 128 + ((n0 - 1024) & 127);
    N = 2048; src = p.in[29] + ((size_t)l * NE + e) * 1024 * 2048 + (size_t)(kb * 64) * 2048 + n0;
    dst = (bf16raw*)(p.ws + WS_WUP) + ((size_t)l * NE + e) * 2048 * 1024 + (size_t)drow * 1024 + kb * 64;
  } else {
    const int r = it - CV_OUT - CV_UP, e = r >> 8, r2 = r & 255, kb = r2 >> 4, nb = r2 & 15;
    N = 1024; src = p.in[31] + ((size_t)l * NE + e) * 1024 * 1024 + (size_t)(kb * 64) * 1024 + nb * 64;
    dst = (bf16raw*)(p.ws + WS_WDN) + ((size_t)l * NE + e) * 1024 * 1024 + (size_t)(nb * 64) * 1024 + kb * 64;
  }
}
#define CV_LOAD(V, SRC, NN) do { _Pragma("unroll") for (int i_ = 0; i_ < 16; ++i_) V[i_] = __builtin_nontemporal_load((const cvf4_t*)((SRC) + (size_t)(4 * i_ + (lane >> 4)) * (NN) + (lane & 15) * 4)); } while (0)
#define CV_PROC(V, DST) do { \
    _Pragma("unroll") for (int i_ = 0; i_ < 16; ++i_) { float* sp_ = scr + (4 * i_ + (lane >> 4)) * 65 + (lane & 15) * 4; sp_[0] = V[i_][0]; sp_[1] = V[i_][1]; sp_[2] = V[i_][2]; sp_[3] = V[i_][3]; } \
    __builtin_amdgcn_fence(__ATOMIC_RELEASE, "wavefront"); __builtin_amdgcn_wave_barrier(); __builtin_amdgcn_fence(__ATOMIC_ACQUIRE, "wavefront"); \
    _Pragma("unroll") for (int j_ = 0; j_ < 8; ++j_) { \
      const int n_ = (lane >> 3) + 8 * j_; const float* sp_ = scr + (8 * (lane & 7)) * 65 + n_; \
      const cvu4_t ov_ = {pk2(sp_[0 * 65], sp_[1 * 65]), pk2(sp_[2 * 65], sp_[3 * 65]), pk2(sp_[4 * 65], sp_[5 * 65]), pk2(sp_[6 * 65], sp_[7 * 65])}; \
      __builtin_nontemporal_store(ov_, (cvu4_t*)((DST) + (size_t)n_ * 1024 + 8 * (lane & 7))); } \
    __builtin_amdgcn_fence(__ATOMIC_RELEASE, "wavefront"); __builtin_amdgcn_wave_barrier(); __builtin_amdgcn_fence(__ATOMIC_ACQUIRE, "wavefront"); } while (0)
__device__ __forceinline__ void convert_rest(const Params& p, float* sm, int l) {
  const int bid0_ = bidx();
  const int tid0_ = tidx();
  const int lane = tid0_ & 63, wave = __builtin_amdgcn_readfirstlane(tid0_ >> 6);
  float* scr = sm + wave * (64 * 65 + 16);
  const int gw = bid0_ * 8 + wave, NGW = gridDim.x * 8;
  constexpr int END = CV_OUT + CV_UP + CV_DN;
  cvf4_t va[16], vb[16];
  const float* sa = nullptr; const float* sb = nullptr; int Na = 0, Nb = 0; bf16raw* da = nullptr; bf16raw* db = nullptr;
  int it = gw;
  if (it < END) { cv_desc(p, l, it, sa, Na, da); CV_LOAD(va, sa, Na); }
#pragma unroll 1
  while (it < END) {
    const int i1 = it + NGW;
    if (i1 < END) { cv_desc(p, l, i1, sb, Nb, db); CV_LOAD(vb, sb, Nb); }
    CV_PROC(va, da);
    if (i1 >= END) break;
    const int i2 = i1 + NGW;
    if (i2 < END) { cv_desc(p, l, i2, sa, Na, da); CV_LOAD(va, sa, Na); }
    CV_PROC(vb, db);
    it = i2;
  }
}
#undef CV_LOAD
#undef CV_PROC

__device__ __forceinline__ void ph_mod(const Params& p, float* sm) {
  const int bid0_ = bidx();
  const int tid0_ = tidx();
  float* mod = (float*)(p.ws + WS_MOD);
  const float* c = p.in[1];
  if (bid0_ == 0 && tid0_ < 64) ((int*)(p.ws + WS_CNT))[tid0_] = 0;
  if (bid0_ == 0) ((int*)(p.ws + WS_LCNT))[tid0_] = 0;
  if (bid0_ == 0 && tid0_ < 16) ((int*)(p.ws + WS_ZERO))[tid0_] = 0;
  if (bid0_ == 0) for (int i = tid0_; i < 640; i += NT) ((unsigned*)(p.ws + WS_RDY))[i] = 0u;
  float* cs = sm;
  float* red = sm + 1024;
  for (int it = bid0_; it < 96; it += gridDim.x) {
    const int l = it / 48, col0 = (it % 48) * 128;
    __syncthreads();
    for (int i = tid0_; i < 1024; i += NT) { const float cv = c[i]; cs[i] = cv / (1.f + __expf(-cv)); }
    __syncthreads();
    const int cg4 = (tid0_ & 31) * 4, kc = tid0_ >> 5;
    const float* w = p.in[2] + (size_t)l * 1024 * 6144 + (size_t)(kc * 64) * 6144 + col0 + cg4;
    float4 acc = make_float4(0.f, 0.f, 0.f, 0.f);
#pragma unroll 16
    for (int i = 0; i < 64; ++i) {
      const float4 wv = *(const float4*)(w + (size_t)i * 6144);
      const float sv = cs[kc * 64 + i];
      acc.x += sv * wv.x; acc.y += sv * wv.y; acc.z += sv * wv.z; acc.w += sv * wv.w;
    }
    *(float4*)(red + kc * 128 + cg4) = acc;
    __syncthreads();
    if (tid0_ < 128) {
      float t = 0.f;
#pragma unroll
      for (int k = 0; k < 16; ++k) t += red[k * 128 + tid0_];
      mod[l * 6144 + col0 + tid0_] = t + p.in[3][l * 6144 + col0 + tid0_];
    }
  }
  __syncthreads();
}

__device__ __forceinline__ void ph_norm(const Params& p, int l, int which, float* sm) {
  const int bid0_ = bidx();
  const int tid0_ = tidx();
  const int lane = tid0_ & 63, wave = tid0_ >> 6;
  const float* mod = (const float*)(p.ws + WS_MOD) + l * 6144;
  const float* xin = which == 0 ? (l == 0 ? p.in[0] : (const float*)(p.ws + WS_XA)) : (const float*)(p.ws + WS_X1);
  const float* gain = (which == 0 ? p.in[4] : p.in[5]) + l * 1024;
  const float* sh = mod + (which == 0 ? 0 : 3) * 1024;
  const float* sc = mod + (which == 0 ? 1 : 4) * 1024;
  bf16raw* H = (bf16raw*)(p.ws + WS_H);
  const float* rw = p.in[27] + (size_t)l * 1024 * 32;
  const float* rb = p.in[28] + l * 32;
  int* cnt = (int*)(p.ws + WS_CNT) + l * 32;
  int* eidx = (int*)(p.ws + WS_EIDX);
  float* gatebuf = (float*)(p.ws + WS_GATE);
  for (int rbase = bid0_ * 8; rbase < S; rbase += gridDim.x * 8) {
    const int row = rbase + wave;
    const float4* xr = (const float4*)(xin + (size_t)row * 1024) + lane;
    float4 v[4];
    float ss = 0.f;
#pragma unroll
    for (int j = 0; j < 4; ++j) {
      v[j] = xr[64 * j];
      ss += v[j].x * v[j].x + v[j].y * v[j].y + v[j].z * v[j].z + v[j].w * v[j].w;
    }
    ss = wave_sum(ss);
    float r = rsqrtf(ss * (1.f / 1024.f) + 1e-6f);
    uint2* hr = (uint2*)(H + (size_t)row * 1024) + lane;
#pragma unroll
    for (int j = 0; j < 4; ++j) {
      int col = (lane + 64 * j) * 4;
      float4 g = *(const float4*)(gain + col), a = *(const float4*)(sc + col), b = *(const float4*)(sh + col);
      v[j].x = v[j].x * r * g.x * (1.f + a.x) + b.x;
      v[j].y = v[j].y * r * g.y * (1.f + a.y) + b.y;
      v[j].z = v[j].z * r * g.z * (1.f + a.z) + b.z;
      v[j].w = v[j].w * r * g.w * (1.f + a.w) + b.w;
      hr[64 * j] = make_uint2(pk2(v[j].x, v[j].y), pk2(v[j].z, v[j].w));
    }
  }
}

__device__ __forceinline__ void ph_norm2(const Params& p, int l, float* sm) {
  const int bid0_ = bidx();
  const int tid = tidx();
  const int lane = tid & 63, wave = tid >> 6;
  const float* mod = (const float*)(p.ws + WS_MOD) + l * 6144;
  const bf16raw* xin = (const bf16raw*)(p.ws + WS_X1);
  const float* gain = p.in[5] + l * 1024;
  const float* sh = mod + 3 * 1024; const float* sc = mod + 4 * 1024;
  bf16raw* H = (bf16raw*)(p.ws + WS_H);
  const float* rw = p.in[27] + (size_t)l * 1024 * 32;
  const float* rb = p.in[28] + l * 32;
  int* cnt = (int*)(p.ws + WS_CNT) + l * 32;
  int* eidx = (int*)(p.ws + WS_EIDX);
  int* elist = (int*)(p.ws + WS_ELIST);
  float* gatebuf = (float*)(p.ws + WS_GATE);
  unsigned short* whi = (unsigned short*)sm;
  unsigned short* wlo = whi + 32 * 1032;
  float* fl = sm + 33024;
  float* gab = fl;
  float* lgp = fl;
  float* cpart = fl + 2048;
  float* cexp = fl + 2560;
  float* rr = fl + 2592;
  int* lcnt = (int*)(fl + 2656);
  int* lbase = lcnt + 32;
  __syncthreads();
  for (int k = tid; k < 1024; k += 512) { gab[k] = gain[k] * (1.f + sc[k]); gab[1024 + k] = sh[k]; }
  __syncthreads();
  {
    const int e = tid & 31, kg = tid >> 5;
    float cacc = 0.f;
#pragma unroll 2
    for (int k8 = 0; k8 < 8; ++k8) {
      const int k0 = kg * 64 + k8 * 8;
      float w[8];
#pragma unroll
      for (int i = 0; i < 8; ++i) w[i] = rw[(size_t)(k0 + i) * 32 + e];
      const float4 g0 = *(const float4*)(gab + k0), g1 = *(const float4*)(gab + k0 + 4);
      const float4 s0 = *(const float4*)(gab + 1024 + k0), s1 = *(const float4*)(gab + 1024 + k0 + 4);
      cacc += s0.x * w[0] + s0.y * w[1] + s0.z * w[2] + s0.w * w[3] + s1.x * w[4] + s1.y * w[5] + s1.z * w[6] + s1.w * w[7];
      w[0] *= g0.x; w[1] *= g0.y; w[2] *= g0.z; w[3] *= g0.w; w[4] *= g1.x; w[5] *= g1.y; w[6] *= g1.z; w[7] *= g1.w;
      unsigned hi[4], lo[4];
#pragma unroll
      for (int i = 0; i < 4; ++i) {
        hi[i] = pk2(w[2 * i], w[2 * i + 1]);
        lo[i] = pk2(w[2 * i] - __builtin_bit_cast(float, hi[i] << 16), w[2 * i + 1] - __builtin_bit_cast(float, hi[i] & 0xffff0000u));
      }
      *(uint4*)(whi + e * 1032 + k0) = make_uint4(hi[0], hi[1], hi[2], hi[3]);
      *(uint4*)(wlo + e * 1032 + k0) = make_uint4(lo[0], lo[1], lo[2], lo[3]);
    }
    cpart[kg * 32 + e] = cacc;
  }
  float4 ga[4], gb[4];
#pragma unroll
  for (int j = 0; j < 4; ++j) { ga[j] = *(const float4*)(gab + (lane + 64 * j) * 4); gb[j] = *(const float4*)(gab + 1024 + (lane + 64 * j) * 4); }
  for (int rbase = bid0_ * 64; rbase < S; rbase += gridDim.x * 64) {
    if (tid < 32) lcnt[tid] = 0;
#pragma unroll 2
    for (int ri = 0; ri < 8; ++ri) {
      const int rl = wave * 8 + ri, row = rbase + rl;
      const bf16raw* xr = xin + (size_t)row * 1024 + lane * 4;
      float4 v[4];
      float ss = 0.f;
#pragma unroll
      for (int j = 0; j < 4; ++j) { v[j] = ld4bf(xr + 256 * j); ss += v[j].x * v[j].x + v[j].y * v[j].y + v[j].z * v[j].z + v[j].w * v[j].w; }
      ss = wave_sum(ss);
      const float r = rsqrtf(ss * (1.f / 1024.f) + 1e-6f);
      if (lane == 0) rr[rl] = r;
      uint2* hr = (uint2*)(H + (size_t)row * 1024) + lane;
#pragma unroll
      for (int j = 0; j < 4; ++j) {
        const float4 g = ga[j], b = gb[j];
        hr[64 * j] = make_uint2(pk2(v[j].x * r * g.x + b.x, v[j].y * r * g.y + b.y), pk2(v[j].z * r * g.z + b.z, v[j].w * r * g.w + b.w));
      }
    }
    typedef short bf16x8 __attribute__((ext_vector_type(8)));
    typedef float f32x4 __attribute__((ext_vector_type(4)));
    const int rt = wave & 3, kh = wave >> 2, fr = lane & 15, fq = lane >> 4;
    bf16x8 xf[16];
    {
      const bf16raw* xp = xin + (size_t)(rbase + rt * 16 + fr) * 1024 + kh * 512 + fq * 8;
#pragma unroll
      for (int ks = 0; ks < 16; ++ks) xf[ks] = *(const bf16x8*)(xp + ks * 32);
    }
    __syncthreads();
    if (tid < 32) {
      float c = rb[tid];
#pragma unroll
      for (int g = 0; g < 16; ++g) c += cpart[g * 32 + tid];
      cexp[tid] = c;
    }
    f32x4 d0 = {0.f, 0.f, 0.f, 0.f}, d1 = {0.f, 0.f, 0.f, 0.f};
    {
      const unsigned short* wh = whi + fr * 1032 + kh * 512 + fq * 8;
      const unsigned short* wl = wlo + fr * 1032 + kh * 512 + fq * 8;
#pragma unroll
      for (int ks = 0; ks < 16; ++ks) {
        const bf16x8 h0 = *(const bf16x8*)(wh + ks * 32), l0 = *(const bf16x8*)(wl + ks * 32);
        const bf16x8 h1 = *(const bf16x8*)(wh + 16 * 1032 + ks * 32), l1 = *(const bf16x8*)(wl + 16 * 1032 + ks * 32);
        d0 = __builtin_amdgcn_mfma_f32_16x16x32_bf16(xf[ks], h0, d0, 0, 0, 0);
        d1 = __builtin_amdgcn_mfma_f32_16x16x32_bf16(xf[ks], h1, d1, 0, 0, 0);
        d0 = __builtin_amdgcn_mfma_f32_16x16x32_bf16(xf[ks], l0, d0, 0, 0, 0);
        d1 = __builtin_amdgcn_mfma_f32_16x16x32_bf16(xf[ks], l1, d1, 0, 0, 0);
      }
    }
    if (kh == 1) {
#pragma unroll
      for (int j = 0; j < 4; ++j) { lgp[(rt * 16 + fq * 4 + j) * 32 + fr] = d0[j]; lgp[(rt * 16 + fq * 4 + j) * 32 + 16 + fr] = d1[j]; }
    }
    __syncthreads();
    if (kh == 0) {
#pragma unroll
      for (int j = 0; j < 4; ++j) { lgp[(rt * 16 + fq * 4 + j) * 32 + fr] += d0[j]; lgp[(rt * 16 + fq * 4 + j) * 32 + 16 + fr] += d1[j]; }
    }
    __syncthreads();
    const int row_l = tid >> 3, eg = tid & 7;
    float acc[4];
    {
      const float4 t = *(const float4*)(lgp + row_l * 32 + eg * 4), c4 = *(const float4*)(cexp + eg * 4);
      const float r = rr[row_l];
      acc[0] = t.x * r + c4.x; acc[1] = t.y * r + c4.y; acc[2] = t.z * r + c4.z; acc[3] = t.w * r + c4.w;
    }
    float tv[4]; int ti[4];
#pragma unroll
    for (int rd = 0; rd < 4; ++rd) {
      float bv = acc[0]; int bi = eg * 4;
#pragma unroll
      for (int c = 1; c < 4; ++c) if (acc[c] > bv) { bv = acc[c]; bi = eg * 4 + c; }
#pragma unroll
      for (int o = 1; o < 8; o <<= 1) {
        const float ov = __shfl_xor(bv, o); const int oi = __shfl_xor(bi, o);
        if (ov > bv || (ov == bv && oi < bi)) { bv = ov; bi = oi; }
      }
      tv[rd] = bv; ti[rd] = bi;
#pragma unroll
      for (int c = 0; c < 4; ++c) if (bi == eg * 4 + c) acc[c] = -INFINITY;
    }
    int rk[4] = {0, 0, 0, 0};
    if (eg == 0) {
#pragma unroll
      for (int k = 0; k < 4; ++k) rk[k] = atomicAdd(&lcnt[ti[k]], 1);
    }
    __syncthreads();
    if (tid < 32) { const int c = lcnt[tid]; lbase[tid] = c > 0 ? atomicAdd(&cnt[tid], c) : 0; }
    __syncthreads();
    if (eg == 0) {
      const int row = rbase + row_l;
      const float e1 = __expf(tv[1] - tv[0]), e2 = __expf(tv[2] - tv[0]), e3 = __expf(tv[3] - tv[0]);
      const float inv = 1.f / (1.f + e1 + e2 + e3);
      *(int4*)(eidx + row * 4) = make_int4(ti[0] | ((lbase[ti[0]] + rk[0]) << 8), ti[1] | ((lbase[ti[1]] + rk[1]) << 8), ti[2] | ((lbase[ti[2]] + rk[2]) << 8),
                                           ti[3] | ((lbase[ti[3]] + rk[3]) << 8));
      *(float4*)(gatebuf + row * 4) = make_float4(inv, e1 * inv, e2 * inv, e3 * inv);
#pragma unroll
      for (int k = 0; k < 4; ++k) elist[ti[k] * S + lbase[ti[k]] + rk[k]] = row;
    }
  }
}

__device__ __forceinline__ void ph_inproj(const Params& p, int l, float* sm) {
  const int bid0_ = bidx();
  pg8::Gemm g{(const pg8::bf16_t*)(p.ws + WS_H), (const pg8::bf16_t*)(p.ws + WS_WIN) + (size_t)l * 3072 * 1024, S, 3072, 1024};
  pg8::StaticOrder so; so.init(S, 3072, (int)gridDim.x, bid0_);
  pg8::EpiInproj E{(pg8::bf16_t*)(p.ws + WS_QA), (pg8::bf16_t*)(p.ws + WS_KA), (pg8::bf16_t*)(p.ws + WS_VA), (float*)(p.ws + WS_QB), (pg8::bf16_t*)(p.ws + WS_QBB), (pg8::bf16_t*)(p.ws + WS_KB),
                   (pg8::bf16_t*)(p.ws + WS_VB), (float*)(p.ws + WS_KMP), (pg8::bf16_t*)(p.ws + WS_PROJ), p.in[8] + l * 32, p.in[9] + l * 32, p.in[15] + l * 64, p.in[16] + l * 64, attn_body::C2};
  pg8::gemm_phase<pg8::EpiInproj, pg8::StaticOrder, true, true>((PG8_LAS unsigned char*)sm, g, so, E);
}

__device__ __forceinline__ void gla_local_item(const Params& p, int l, int c, float* sm) {
  const int tid = tidx();
  const bf16raw* P = (const bf16raw*)(p.ws + WS_PROJ);
  float* BC = (float*)(p.ws + WS_GA);
  float* SC = (float*)(p.ws + WS_SC); float* DEC = (float*)(p.ws + WS_DEC);
  const float* wg2 = p.in[17] + l * 16 * 128; const float* bg = p.in[18] + l * 128;
  typedef short bf16x8 __attribute__((ext_vector_type(8)));
  typedef float f32x4 __attribute__((ext_vector_type(4)));
  typedef unsigned u32x4 __attribute__((ext_vector_type(4)));
  float* gs = sm; float* ks = sm + 8192;
  bf16raw* vsb = (bf16raw*)(sm + 16384);
  bf16raw* kth = (bf16raw*)(sm + 16384 + 8320); bf16raw* ktl = kth + 128 * 72;
  float* part = sm + 33920; float* gls = sm + 34432;
  const size_t t0 = (size_t)c * 64;
  const int d = tid & 127, qtr = tid >> 7;
  float wcol[16];
#pragma unroll
  for (int r = 0; r < 16; ++r) wcol[r] = wg2[r * 128 + d];
  const float bias = bg[d];
  {
    if (tid < 128) {
      const int t = tid >> 1, hf = tid & 1;
      const uint4 w = *(const uint4*)(P + (t0 + t) * PDIN + PC_CG + hf * 8);
      *(float4*)(gls + t * 16 + hf * 8) = make_float4(__builtin_bit_cast(float, w.x << 16), __builtin_bit_cast(float, w.x & 0xffff0000u), __builtin_bit_cast(float, w.y << 16), __builtin_bit_cast(float, w.y & 0xffff0000u));
      *(float4*)(gls + t * 16 + hf * 8 + 4) = make_float4(__builtin_bit_cast(float, w.z << 16), __builtin_bit_cast(float, w.z & 0xffff0000u), __builtin_bit_cast(float, w.w << 16), __builtin_bit_cast(float, w.w & 0xffff0000u));
    }
#pragma unroll
    for (int u = 0; u < 2; ++u) { int idx = tid + u * 512, row = idx >> 4, c8 = (idx & 15) * 8; const uint4 w = *(const uint4*)(P + (t0 + row) * PDIN + PC_CK + c8);
      *(float4*)(ks + row * 128 + c8) = make_float4(__builtin_bit_cast(float, w.x << 16), __builtin_bit_cast(float, w.x & 0xffff0000u), __builtin_bit_cast(float, w.y << 16), __builtin_bit_cast(float, w.y & 0xffff0000u));
      *(float4*)(ks + row * 128 + c8 + 4) = make_float4(__builtin_bit_cast(float, w.z << 16), __builtin_bit_cast(float, w.z & 0xffff0000u), __builtin_bit_cast(float, w.w << 16), __builtin_bit_cast(float, w.w & 0xffff0000u)); }
#pragma unroll
    for (int u = 0; u < 4; ++u) { int idx = tid + u * 512, row = idx >> 5, c8 = (idx & 31) * 8; const uint4 w = *(const uint4*)(P + (t0 + row) * PDIN + PC_CV + c8);
      *(uint2*)(vsb + row * 260 + c8) = make_uint2(w.x, w.y); *(uint2*)(vsb + row * 260 + c8 + 4) = make_uint2(w.z, w.w); }
  }
  __syncthreads();
  float gv[16];
  {
    float run = 0.f;
#pragma unroll
    for (int i = 0; i < 16; ++i) {
      const float* gp = gls + (qtr * 16 + i) * 16;
      const float4 x0 = *(const float4*)gp, x1 = *(const float4*)(gp + 4), x2 = *(const float4*)(gp + 8), x3 = *(const float4*)(gp + 12);
      const float z = bias + x0.x * wcol[0] + x0.y * wcol[1] + x0.z * wcol[2] + x0.w * wcol[3] + x1.x * wcol[4] + x1.y * wcol[5] + x1.z * wcol[6] + x1.w * wcol[7]
                    + x2.x * wcol[8] + x2.y * wcol[9] + x2.z * wcol[10] + x2.w * wcol[11] + x3.x * wcol[12] + x3.y * wcol[13] + x3.z * wcol[14] + x3.w * wcol[15];
      run += logsigmoidf_(z) * (1.f / 16.f);
      gv[i] = run;
    }
    part[qtr * 128 + d] = run;
  }
  __syncthreads();
  {
    float off = 0.f;
#pragma unroll
    for (int q = 0; q < 3; ++q) if (q < qtr) off += part[q * 128 + d];
#pragma unroll
    for (int i = 0; i < 16; ++i) { gv[i] += off; BC[(t0 + qtr * 16 + i) * 128 + d] = gv[i]; }
    if (qtr == 3) gs[63 * 128 + d] = gv[15];
  }
  __syncthreads();
  {
    const float bl = gs[63 * 128 + d];
    if (qtr == 0) DEC[(size_t)c * 128 + d] = __expf(bl);
    float kp[16];
#pragma unroll
    for (int i = 0; i < 16; ++i) kp[i] = ks[(qtr * 16 + i) * 128 + d] * __expf(bl - gv[i]);
    unsigned hi[8], lo[8];
#pragma unroll
    for (int i = 0; i < 8; ++i) {
      hi[i] = pk2(kp[2 * i], kp[2 * i + 1]);
      lo[i] = pk2(kp[2 * i] - __builtin_bit_cast(float, hi[i] << 16), kp[2 * i + 1] - __builtin_bit_cast(float, hi[i] & 0xffff0000u));
    }
    *(uint4*)(kth + d * 72 + qtr * 16) = make_uint4(hi[0], hi[1], hi[2], hi[3]); *(uint4*)(kth + d * 72 + qtr * 16 + 8) = make_uint4(hi[4], hi[5], hi[6], hi[7]);
    *(uint4*)(ktl + d * 72 + qtr * 16) = make_uint4(lo[0], lo[1], lo[2], lo[3]); *(uint4*)(ktl + d * 72 + qtr * 16 + 8) = make_uint4(lo[4], lo[5], lo[6], lo[7]);
  }
  __syncthreads();
  {
    const int lane = tid & 63, wave = tid >> 6, fr = lane & 15, fq = lane >> 4, h = wave >> 1, ddt = wave & 1;
    f32x4 acc[4];
#pragma unroll
    for (int et = 0; et < 4; ++et) acc[et] = (f32x4){0.f, 0.f, 0.f, 0.f};
#pragma unroll
    for (int ksx = 0; ksx < 2; ++ksx) {
      const bf16x8 ah = *(const bf16x8*)(kth + (h * 32 + ddt * 16 + fr) * 72 + ksx * 32 + fq * 8);
      const bf16x8 al = *(const bf16x8*)(ktl + (h * 32 + ddt * 16 + fr) * 72 + ksx * 32 + fq * 8);
#pragma unroll
      for (int et = 0; et < 4; ++et) {
        const bf16raw* vp = vsb + (ksx * 32 + fq * 8) * 260 + h * 64 + et * 16 + fr;
        u32x4 w;
#pragma unroll
        for (int i = 0; i < 4; ++i) w[i] = (unsigned)vp[(2 * i) * 260] | ((unsigned)vp[(2 * i + 1) * 260] << 16);
        const bf16x8 bv = __builtin_bit_cast(bf16x8, w);
        acc[et] = __builtin_amdgcn_mfma_f32_16x16x32_bf16(ah, bv, acc[et], 0, 0, 0);
        acc[et] = __builtin_amdgcn_mfma_f32_16x16x32_bf16(al, bv, acc[et], 0, 0, 0);
      }
    }
    float* o = SC + (((size_t)c * 4 + h) * 32 + ddt * 16 + fq * 4) * 64 + fr;
#pragma unroll
    for (int et = 0; et < 4; ++et)
#pragma unroll
      for (int j = 0; j < 4; ++j) o[j * 64 + et * 16] = acc[et][j];
  }
  __syncthreads();
}

__device__ __forceinline__ void lru_local_item(const Params& p, int l, int c, float* sm) {
  typedef short bf16x8 __attribute__((ext_vector_type(8)));
  typedef float f32x4 __attribute__((ext_vector_type(4)));
  typedef unsigned u32x4 __attribute__((ext_vector_type(4)));
  const int tid = tidx();
  const int lane = tid & 63, wave = tid >> 6, fr = lane & 15, fq = lane >> 4;
  const bf16raw* P = (const bf16raw*)(p.ws + WS_PROJ);
  float* LA = (float*)(p.ws + WS_LA); float* LB = (float*)(p.ws + WS_LB);
  float* LTA = (float*)(p.ws + WS_LTA); float* LTH = (float*)(p.ws + WS_LTH);
  const float* cw = p.in[20] + l * 4 * 256; const float* cb = p.in[21] + l * 256;
  const float* wa = p.in[22] + (size_t)l * 4 * 64 * 64; const float* ba = p.in[23] + l * 256;
  const float* wx = p.in[24] + (size_t)l * 4 * 64 * 64; const float* bx = p.in[25] + l * 256;
  const float* lam = p.in[26] + l * 256;
  constexpr int PX = 260;
  float* xcs = sm;
  float* As = sm + 64 * PX;
  const int t0 = c * 64;
  bf16raw* dxs = (bf16raw*)(sm + 64 * PX);
  const int n = wave >> 1, eh = wave & 1;
  bf16x8 wh[2][2][2], wl[2][2][2];
#pragma unroll
  for (int g = 0; g < 2; ++g)
#pragma unroll
    for (int et = 0; et < 2; ++et)
#pragma unroll
      for (int ks = 0; ks < 2; ++ks) {
        const float* wp = (g == 0 ? wa : wx) + (size_t)(n * 64 + ks * 32 + fq * 8) * 64 + eh * 32 + et * 16 + fr;
        float w[8];
#pragma unroll
        for (int i = 0; i < 8; ++i) w[i] = wp[i * 64];
        u32x4 hi, lo;
#pragma unroll
        for (int i = 0; i < 4; ++i) {
          hi[i] = pk2(w[2 * i], w[2 * i + 1]);
          lo[i] = pk2(w[2 * i] - __builtin_bit_cast(float, hi[i] << 16), w[2 * i + 1] - __builtin_bit_cast(float, hi[i] & 0xffff0000u));
        }
        wh[g][et][ks] = __builtin_bit_cast(bf16x8, hi); wl[g][et][ks] = __builtin_bit_cast(bf16x8, lo);
      }
  float lsv[2], bav[2], bxv[2];
#pragma unroll
  for (int et = 0; et < 2; ++et) { const int ch = n * 64 + eh * 32 + et * 16 + fr; lsv[et] = 8.f * logsigmoidf_(lam[ch]); bav[et] = ba[ch]; bxv[et] = bx[ch]; }
  for (int i = tid; i < 67 * 32; i += NT) {
    const int r = i >> 5, c8 = (i & 31) * 8, ts = t0 - 3 + r;
    *(uint4*)(dxs + r * 256 + c8) = ts >= 0 ? *(const uint4*)(P + (size_t)ts * PDIN + PC_DX + c8) : make_uint4(0u, 0u, 0u, 0u);
  }
  __syncthreads();
  {
    const int ch = tid & 255;
    const float w0 = cw[ch], w1 = cw[256 + ch], w2 = cw[512 + ch], w3 = cw[768 + ch], bb = cb[ch];
#pragma unroll 4
    for (int tt = tid >> 8; tt < 64; tt += 2)
      xcs[tt * PX + ch] = bb + w0 * bf2f(dxs[tt * 256 + ch]) + w1 * bf2f(dxs[(tt + 1) * 256 + ch]) + w2 * bf2f(dxs[(tt + 2) * 256 + ch]) + w3 * bf2f(dxs[(tt + 3) * 256 + ch]);
  }
  __syncthreads();
#pragma unroll 1
  for (int tt = 0; tt < 4; ++tt) {
    bf16x8 xh[2], xl[2];
#pragma unroll
    for (int ks = 0; ks < 2; ++ks) {
      const float* xp = xcs + (tt * 16 + fr) * PX + n * 64 + ks * 32 + fq * 8;
      const float4 v0 = *(const float4*)xp, v1 = *(const float4*)(xp + 4);
      const float f[8] = {v0.x, v0.y, v0.z, v0.w, v1.x, v1.y, v1.z, v1.w};
      u32x4 hi, lo;
#pragma unroll
      for (int i = 0; i < 4; ++i) {
        hi[i] = pk2(f[2 * i], f[2 * i + 1]);
        lo[i] = pk2(f[2 * i] - __builtin_bit_cast(float, hi[i] << 16), f[2 * i + 1] - __builtin_bit_cast(float, hi[i] & 0xffff0000u));
      }
      xh[ks] = __builtin_bit_cast(bf16x8, hi); xl[ks] = __builtin_bit_cast(bf16x8, lo);
    }
    float xo[2][4];
#pragma unroll
    for (int et = 0; et < 2; ++et)
#pragma unroll
      for (int j = 0; j < 4; ++j) xo[et][j] = xcs[(tt * 16 + fq * 4 + j) * PX + n * 64 + eh * 32 + et * 16 + fr];
    __syncthreads();
#pragma unroll
    for (int et = 0; et < 2; ++et) {
      f32x4 ar = {0.f, 0.f, 0.f, 0.f}, ai = {0.f, 0.f, 0.f, 0.f};
#pragma unroll
      for (int ks = 0; ks < 2; ++ks) {
        ar = __builtin_amdgcn_mfma_f32_16x16x32_bf16(xh[ks], wh[0][et][ks], ar, 0, 0, 0);
        ai = __builtin_amdgcn_mfma_f32_16x16x32_bf16(xh[ks], wh[1][et][ks], ai, 0, 0, 0);
        ar = __builtin_amdgcn_mfma_f32_16x16x32_bf16(xl[ks], wh[0][et][ks], ar, 0, 0, 0);
        ai = __builtin_amdgcn_mfma_f32_16x16x32_bf16(xl[ks], wh[1][et][ks], ai, 0, 0, 0);
        ar = __builtin_amdgcn_mfma_f32_16x16x32_bf16(xh[ks], wl[0][et][ks], ar, 0, 0, 0);
        ai = __builtin_amdgcn_mfma_f32_16x16x32_bf16(xh[ks], wl[1][et][ks], ai, 0, 0, 0);
      }
      const int ch = n * 64 + eh * 32 + et * 16 + fr;
#pragma unroll
      for (int j = 0; j < 4; ++j) {
        const int t = tt * 16 + fq * 4 + j;
        const float rg = sigmoidf_(ar[j] + bav[et]), ig = sigmoidf_(ai[j] + bxv[et]);
        const float a = __expf(rg * lsv[et]);
        As[t * 256 + ch] = a;
        xcs[t * PX + ch] = sqrtf(fmaxf(1.f - a * a, 0.f)) * (ig * xo[et][j]);
      }
    }
  }
  __syncthreads();
  {
    const int ch = tid & 255, half = tid >> 8, tb = half * 32;
    float Hh = 0.f, Ac = 1.f;
#pragma unroll 8
    for (int i = 0; i < 32; ++i) {
      const int t = tb + i;
      const float a = As[t * 256 + ch], bt = xcs[t * PX + ch];
      Hh = a * Hh + bt; Ac *= a;
      LA[(size_t)(t0 + t) * 256 + ch] = Ac; LB[(size_t)(t0 + t) * 256 + ch] = Hh;
    }
    LTA[(size_t)(c * 2 + half) * 256 + ch] = Ac; LTH[(size_t)(c * 2 + half) * 256 + ch] = Hh;
  }
  __syncthreads();
}

__device__ __forceinline__ void ph_prep(const Params& p, int l, float* sm) {
  const int bid0_ = bidx();
  const int tid0_ = tidx();
  const int lane = tid0_ & 63, wave = tid0_ >> 6;
  const bf16raw* P = (const bf16raw*)(p.ws + WS_PROJ);
  bf16raw* QAb = (bf16raw*)(p.ws + WS_QA); bf16raw* KAb = (bf16raw*)(p.ws + WS_KA); bf16raw* VAb = (bf16raw*)(p.ws + WS_VA);
  float* QB = (float*)(p.ws + WS_QB); bf16raw* KBb = (bf16raw*)(p.ws + WS_KB); bf16raw* QBb = (bf16raw*)(p.ws + WS_QBB);
  float* KMP = (float*)(p.ws + WS_KMP); bf16raw* VBt = (bf16raw*)(p.ws + WS_VBT);
  const float* aqg = p.in[8] + l * 32; const float* akg = p.in[9] + l * 32;
  const float* bqg = p.in[15] + l * 64; const float* bkg = p.in[16] + l * 64;
  const float* wg2 = p.in[17] + l * 16 * 128; const float* bg = p.in[18] + l * 128;
  bf16raw* vsl = (bf16raw*)sm;
  const bf16raw* VBn = (const bf16raw*)(p.ws + WS_VB);
  for (int tile = bid0_; tile < S / 64; tile += gridDim.x) {
    __syncthreads();
#pragma unroll
    for (int u = 0; u < 4; ++u) { const int idx = tid0_ + u * 512, r = idx >> 5, c8 = (idx & 31) * 8; *(uint4*)(vsl + r * 264 + c8) = *(const uint4*)(VBn + (size_t)(tile * 64 + r) * 256 + c8); }
    __syncthreads();
    {
      const int col = tid0_ & 255, half = tid0_ >> 8;
      unsigned w[16];
#pragma unroll
      for (int i = 0; i < 16; ++i) w[i] = (unsigned)vsl[(half * 32 + 2 * i) * 264 + col] | ((unsigned)vsl[(half * 32 + 2 * i + 1) * 264 + col] << 16);
      uint4* dst = (uint4*)(VBt + (size_t)col * S + tile * 64 + half * 32);
#pragma unroll
      for (int i = 0; i < 4; ++i) dst[i] = make_uint4(w[4 * i], w[4 * i + 1], w[4 * i + 2], w[4 * i + 3]);
    }
  }
  __syncthreads();
  for (int c = bid0_; c < S / 64; c += gridDim.x) gla_local_item(p, l, c, sm);
  for (int c = bid0_; c < S / 64; c += gridDim.x) lru_local_item(p, l, c, sm);
}

__device__ __forceinline__ void ph_scan(const Params& p, float* sm) {
  const int bid0_ = bidx();
  const int tid = tidx();
  const float* SC = (const float*)(p.ws + WS_SC); const float* DEC = (const float*)(p.ws + WS_DEC); float* STo = (float*)(p.ws + WS_ST);
  float* gA = sm; float* gH = sm + 512; float* gC = sm + 1024;
  for (int b = bid0_; b < 256; b += gridDim.x) {
    const int chain = tid & 31, grp = tid >> 5, gid = b * 32 + chain;
    float sv[16], dv[16];
#pragma unroll
    for (int i = 0; i < 16; ++i) { const int c = grp * 16 + i; sv[i] = SC[(size_t)c * 8192 + gid]; dv[i] = DEC[c * 128 + (gid >> 6)]; }
    float A = 1.f, H = 0.f;
#pragma unroll
    for (int i = 0; i < 16; ++i) { H = dv[i] * H + sv[i]; A *= dv[i]; }
    __syncthreads();
    gA[tid] = A; gH[tid] = H;
    __syncthreads();
    if (tid < 32) {
      float carry = 0.f;
#pragma unroll
      for (int g = 0; g < 16; ++g) { gC[g * 32 + tid] = carry; carry = gA[g * 32 + tid] * carry + gH[g * 32 + tid]; }
    }
    __syncthreads();
    float st = gC[tid];
#pragma unroll
    for (int i = 0; i < 16; ++i) { const int c = grp * 16 + i; STo[(size_t)c * 8192 + gid] = st; st = dv[i] * st + sv[i]; }
  }
}
__device__ __forceinline__ void ph_scan_lru(const Params& p, float* sm) {
  const int bid0_ = bidx();
  const int tid = tidx();
  const float* LTA = (const float*)(p.ws + WS_LTA); const float* LTH = (const float*)(p.ws + WS_LTH); float* LC = (float*)(p.ws + WS_LC);
  for (int b = bid0_; b < 48; b += gridDim.x) {
    if (b < 16) continue;
    const int ch = (b - 16) * 8 + (tid & 7), grp = tid >> 3;
    float a[8], h[8];
#pragma unroll
    for (int i = 0; i < 8; ++i) { a[i] = LTA[(grp * 8 + i) * 256 + ch]; h[i] = LTH[(grp * 8 + i) * 256 + ch]; }
    float A = 1.f, H = 0.f;
#pragma unroll
    for (int i = 0; i < 8; ++i) { H = a[i] * H + h[i]; A *= a[i]; }
    __syncthreads();
    sm[tid] = A; sm[512 + tid] = H;
    __syncthreads();
    if (tid < 8) {
      float carry = 0.f;
      for (int g = 0; g < 64; ++g) { const float ga = sm[g * 8 + tid], gh = sm[512 + g * 8 + tid]; sm[1024 + g * 8 + tid] = carry; carry = ga * carry + gh; }
    }
    __syncthreads();
    float carry = sm[1024 + tid];
#pragma unroll
    for (int i = 0; i < 8; ++i) { LC[(grp * 8 + i) * 256 + ch] = carry; carry = a[i] * carry + h[i]; }
  }
}

__device__ __forceinline__ void moba_gate_item(const Params& p, int l, int it, float* sm) {
  typedef short bf16x8 __attribute__((ext_vector_type(8)));
  typedef float f32x4 __attribute__((ext_vector_type(4)));
  typedef unsigned u32x4 __attribute__((ext_vector_type(4)));
  const int tid = tidx(), lane = tid & 63, wave = tid >> 6, fr = lane & 15, fq = lane >> 4;
  const int h = it & 3, own = it >> 2;
  const float* QB = (const float*)(p.ws + WS_QB); const float* KMP = (const float*)(p.ws + WS_KMP);
  int* LCNT = (int*)(p.ws + WS_LCNT) + l * 256; int* LIST = (int*)(p.ws + WS_MLIST); float2* ML = (float2*)(p.ws + WS_ML);
  float* km = sm;
  int* lcnt = (int*)(sm + 64 * 68); int* lbase = lcnt + 64;
  __syncthreads();
  for (int idx = tid; idx < own * 64; idx += NT) {
    const int n = idx >> 6, c = idx & 63;
    const float* kp = KMP + (size_t)(4 * n) * 256 + h * 64 + c;
    km[n * 68 + c] = (kp[0] + kp[256] + kp[512] + kp[768]) * (1.f / 256.f);
  }
  if (tid < 64) lcnt[tid] = 0;
#define MOBA_SPLIT(HI, LO, X0, X1) do { const float f_[8] = {X0.x, X0.y, X0.z, X0.w, X1.x, X1.y, X1.z, X1.w}; u32x4 hi_, lo_;                                   \
    _Pragma("unroll") for (int i_ = 0; i_ < 4; ++i_) { hi_[i_] = pk2(f_[2 * i_], f_[2 * i_ + 1]);                                                                    \
      lo_[i_] = pk2(f_[2 * i_] - __builtin_bit_cast(float, hi_[i_] << 16), f_[2 * i_ + 1] - __builtin_bit_cast(float, hi_[i_] & 0xffff0000u)); }                    \
    HI = __builtin_bit_cast(bf16x8, hi_); LO = __builtin_bit_cast(bf16x8, lo_); } while (0)
  bf16x8 qh[2][2], ql[2][2];
#pragma unroll
  for (int qt = 0; qt < 2; ++qt)
#pragma unroll
    for (int ks = 0; ks < 2; ++ks) {
      const float* qp = QB + (size_t)(own * 256 + wave * 32 + qt * 16 + fr) * 256 + h * 64 + ks * 32 + fq * 8;
      const float4 x0 = *(const float4*)qp, x1 = *(const float4*)(qp + 4);
      MOBA_SPLIT(qh[qt][ks], ql[qt][ks], x0, x1);
    }
  __syncthreads();
  const int ntile = (own + 15) >> 4;
  float g0[2], g1[2], g2[2]; int s0[2], s1[2], s2[2];
#pragma unroll
  for (int qt = 0; qt < 2; ++qt) { g0[qt] = -INFINITY; g1[qt] = -INFINITY; g2[qt] = -INFINITY; s0[qt] = -1; s1[qt] = -1; s2[qt] = -1; }
#pragma unroll
  for (int nt = 0; nt < 4; ++nt) {
    if (nt < ntile) {
      f32x4 acc[2] = {{0.f, 0.f, 0.f, 0.f}, {0.f, 0.f, 0.f, 0.f}};
#pragma unroll
      for (int ks = 0; ks < 2; ++ks) {
        const float* ap = km + (nt * 16 + fr) * 68 + ks * 32 + fq * 8;
        const float4 x0 = *(const float4*)ap, x1 = *(const float4*)(ap + 4);
        bf16x8 ah, al;
        MOBA_SPLIT(ah, al, x0, x1);
#pragma unroll
        for (int qt = 0; qt < 2; ++qt) {
          acc[qt] = __builtin_amdgcn_mfma_f32_16x16x32_bf16(ah, qh[qt][ks], acc[qt], 0, 0, 0);
          acc[qt] = __builtin_amdgcn_mfma_f32_16x16x32_bf16(al, qh[qt][ks], acc[qt], 0, 0, 0);
          acc[qt] = __builtin_amdgcn_mfma_f32_16x16x32_bf16(ah, ql[qt][ks], acc[qt], 0, 0, 0);
        }
      }
#pragma unroll
      for (int qt = 0; qt < 2; ++qt)
#pragma unroll
        for (int j = 0; j < 4; ++j) {
          const int n = nt * 16 + fq * 4 + j; const float a = acc[qt][j];
          if (n < own) {
            if (a > g0[qt]) { g2[qt] = g1[qt]; s2[qt] = s1[qt]; g1[qt] = g0[qt]; s1[qt] = s0[qt]; g0[qt] = a; s0[qt] = n; }
            else if (a > g1[qt]) { g2[qt] = g1[qt]; s2[qt] = s1[qt]; g1[qt] = a; s1[qt] = n; }
            else if (a > g2[qt]) { g2[qt] = a; s2[qt] = n; }
          }
        }
    }
  }
#undef MOBA_SPLIT
#define MOBA_INS(Q, A, N) do { const float a_ = (A); const int n_ = (N); if (n_ >= 0) {                                                                               \
      if (a_ > g0[Q] || (a_ == g0[Q] && n_ < s0[Q]) || s0[Q] < 0) { g2[Q] = g1[Q]; s2[Q] = s1[Q]; g1[Q] = g0[Q]; s1[Q] = s0[Q]; g0[Q] = a_; s0[Q] = n_; }             \
      else if (a_ > g1[Q] || (a_ == g1[Q] && n_ < s1[Q]) || s1[Q] < 0) { g2[Q] = g1[Q]; s2[Q] = s1[Q]; g1[Q] = a_; s1[Q] = n_; }                                       \
      else if (a_ > g2[Q] || (a_ == g2[Q] && n_ < s2[Q]) || s2[Q] < 0) { g2[Q] = a_; s2[Q] = n_; } } } while (0)
#pragma unroll
  for (int qt = 0; qt < 2; ++qt)
#pragma unroll
    for (int o = 16; o < 64; o <<= 1) {
      const float pg0 = __shfl_xor(g0[qt], o), pg1 = __shfl_xor(g1[qt], o), pg2 = __shfl_xor(g2[qt], o);
      const int ps0 = __shfl_xor(s0[qt], o), ps1 = __shfl_xor(s1[qt], o), ps2 = __shfl_xor(s2[qt], o);
      MOBA_INS(qt, pg0, ps0); MOBA_INS(qt, pg1, ps1); MOBA_INS(qt, pg2, ps2);
    }
#undef MOBA_INS
  int r0[2] = {0, 0}, r1[2] = {0, 0}, r2[2] = {0, 0};
  if (fq == 0) {
#pragma unroll
    for (int qt = 0; qt < 2; ++qt) {
      if (s0[qt] >= 0) r0[qt] = atomicAdd(&lcnt[s0[qt]], 1);
      if (s1[qt] >= 0) r1[qt] = atomicAdd(&lcnt[s1[qt]], 1);
      if (s2[qt] >= 0) r2[qt] = atomicAdd(&lcnt[s2[qt]], 1);
    }
  }
  __syncthreads();
  if (tid < 64) { const int c = lcnt[tid]; lbase[tid] = c > 0 ? atomicAdd(&LCNT[h * 64 + tid], c) : 0; }
  __syncthreads();
  if (fq == 0) {
    const float2 dead = make_float2(-INFINITY, 0.f);
#pragma unroll
    for (int qt = 0; qt < 2; ++qt) {
      const int qi = own * 256 + wave * 32 + qt * 16 + fr;
      const size_t sl = ((size_t)qi * 4 + h) * 4;
      if (s0[qt] >= 0) LIST[(size_t)(h * 64 + s0[qt]) * 16384 + lbase[s0[qt]] + r0[qt]] = qi | (0 << 16); else ML[sl + 0] = dead;
      if (s1[qt] >= 0) LIST[(size_t)(h * 64 + s1[qt]) * 16384 + lbase[s1[qt]] + r1[qt]] = qi | (1 << 16); else ML[sl + 1] = dead;
      if (s2[qt] >= 0) LIST[(size_t)(h * 64 + s2[qt]) * 16384 + lbase[s2[qt]] + r2[qt]] = qi | (2 << 16); else ML[sl + 2] = dead;
    }
  }
}

__device__ __forceinline__ void moba_attn_item(const Params& p, int h, int n, int chunk, int own, int len, float* sm) {
  typedef short bf16x8_t __attribute__((ext_vector_type(8)));
  typedef short bf16x4_t __attribute__((ext_vector_type(4)));
  typedef float f32x4_t __attribute__((ext_vector_type(4)));
  const int tid = tidx(), lane = tid & 63, wave = tid >> 6, qc = lane & 15, kg = lane >> 4;
  const bf16raw* KBb = (const bf16raw*)(p.ws + WS_KB); const bf16raw* QBb = (const bf16raw*)(p.ws + WS_QBB); const bf16raw* VBt = (const bf16raw*)(p.ws + WS_VBT);
  const int* LIST = (const int*)(p.ws + WS_MLIST); float2* ML = (float2*)(p.ws + WS_ML); bf16raw* PART = (bf16raw*)(p.ws + WS_PART);
  bf16raw* Ks = (bf16raw*)sm;
  bf16raw* Vt = (bf16raw*)sm + 256 * 72;
  const bool t1 = own || (chunk * 256 + 128 < len);
  int qi[2], src[2]; bool valid[2];
  {
    const int s0 = chunk * 256 + wave * 16 + qc, s1 = s0 + 128;
    if (own) { qi[0] = n * 256 + s0; qi[1] = n * 256 + s1; src[0] = 3; src[1] = 3; valid[0] = true; valid[1] = true; }
    else {
      valid[0] = s0 < len; valid[1] = s1 < len;
      const int* lp = LIST + (size_t)(h * 64 + n) * 16384;
      const int e0 = lp[valid[0] ? s0 : 0], e1 = lp[valid[1] ? s1 : 0];
      qi[0] = e0 & 0xffff; src[0] = e0 >> 16; qi[1] = e1 & 0xffff; src[1] = e1 >> 16;
    }
  }
  typedef unsigned u32x4_t __attribute__((ext_vector_type(4)));
#define MOBA_LD(u, KR, VR) const u32x4_t KR = *(const u32x4_t*)(KBb + (size_t)(n * 256 + ((tid + (u) * 512) >> 3)) * 256 + h * 64 + ((tid + (u) * 512) & 7) * 8); \
                           const u32x4_t VR = *(const u32x4_t*)(VBt + (size_t)(h * 64 + ((tid + (u) * 512) >> 5)) * S + n * 256 + ((tid + (u) * 512) & 31) * 8)
  MOBA_LD(0, kr0, vr0); MOBA_LD(1, kr1, vr1); MOBA_LD(2, kr2, vr2); MOBA_LD(3, kr3, vr3);
#undef MOBA_LD
  bf16x8_t qf[2][2];
#pragma unroll
  for (int tl = 0; tl < 2; ++tl) { qf[tl][0] = *(const bf16x8_t*)(QBb + (size_t)qi[tl] * 256 + h * 64 + kg * 8); qf[tl][1] = *(const bf16x8_t*)(QBb + (size_t)qi[tl] * 256 + h * 64 + 32 + kg * 8); }
  __syncthreads();
#define MOBA_ST(u, KR, VR) *(u32x4_t*)(Ks + ((tid + (u) * 512) >> 3) * 72 + ((tid + (u) * 512) & 7) * 8) = KR; *(u32x4_t*)(Vt + ((tid + (u) * 512) >> 5) * 264 + ((tid + (u) * 512) & 31) * 8) = VR
  MOBA_ST(0, kr0, vr0); MOBA_ST(1, kr1, vr1); MOBA_ST(2, kr2, vr2); MOBA_ST(3, kr3, vr3);
#undef MOBA_ST
  __syncthreads();
  const int nkt0 = own ? 8 : 16;
  f32x4_t sacc[2][16];
  float mx[2] = {-INFINITY, -INFINITY};
#pragma unroll
  for (int kt = 0; kt < 16; ++kt) {
    const bf16x8_t k0 = *(const bf16x8_t*)(Ks + (kt * 16 + qc) * 72 + kg * 8), k1 = *(const bf16x8_t*)(Ks + (kt * 16 + qc) * 72 + 32 + kg * 8);
#pragma unroll
    for (int tl = 0; tl < 2; ++tl) {
      if (tl == 0 ? (kt < nkt0) : t1) {
        f32x4_t a = {0.f, 0.f, 0.f, 0.f};
        a = __builtin_amdgcn_mfma_f32_16x16x32_bf16(k0, qf[tl][0], a, 0, 0, 0);
        a = __builtin_amdgcn_mfma_f32_16x16x32_bf16(k1, qf[tl][1], a, 0, 0, 0);
        if (own) {
          const int qpos = tl * 128 + wave * 16 + qc;
#pragma unroll
          for (int r = 0; r < 4; ++r) if (kt * 16 + kg * 4 + r > qpos) a[r] = -INFINITY;
        }
        sacc[tl][kt] = a;
        mx[tl] = fmaxf(mx[tl], fmaxf(fmaxf(a[0], a[1]), fmaxf(a[2], a[3])));
      } else sacc[tl][kt] = (f32x4_t){-INFINITY, -INFINITY, -INFINITY, -INFINITY};
    }
  }
  float lsum[2] = {0.f, 0.f};
  bf16x8_t pfs[2][8];
#pragma unroll
  for (int tl = 0; tl < 2; ++tl) {
    float m = mx[tl];
    m = fmaxf(m, __shfl_xor(m, 16)); m = fmaxf(m, __shfl_xor(m, 32));
    mx[tl] = m;
    float ls = 0.f;
#pragma unroll
    for (int ks = 0; ks < 8; ++ks) {
      if ((tl == 1 && t1) || (tl == 0 && 2 * ks < nkt0)) {
        float e[8];
#pragma unroll
        for (int r = 0; r < 4; ++r) { e[r] = __builtin_amdgcn_exp2f(sacc[tl][2 * ks][r] - m); e[4 + r] = __builtin_amdgcn_exp2f(sacc[tl][2 * ks + 1][r] - m); }
        ls += ((e[0] + e[1]) + (e[2] + e[3])) + ((e[4] + e[5]) + (e[6] + e[7]));
        const uint4 w = make_uint4(pk2(e[0], e[1]), pk2(e[2], e[3]), pk2(e[4], e[5]), pk2(e[6], e[7]));
        pfs[tl][ks] = __builtin_bit_cast(bf16x8_t, w);
      } else pfs[tl][ks] = (bf16x8_t){0, 0, 0, 0, 0, 0, 0, 0};
    }
    ls += __shfl_xor(ls, 16); ls += __shfl_xor(ls, 32);
    lsum[tl] = ls;
  }
  f32x4_t o[2][4];
#pragma unroll
  for (int tl = 0; tl < 2; ++tl)
#pragma unroll
    for (int dt = 0; dt < 4; ++dt) o[tl][dt] = (f32x4_t){0.f, 0.f, 0.f, 0.f};
#pragma unroll
  for (int ks = 0; ks < 8; ++ks) {
#pragma unroll
    for (int dt = 0; dt < 4; ++dt) {
      const bf16x4_t va = *(const bf16x4_t*)(Vt + (dt * 16 + qc) * 264 + ks * 32 + kg * 4), vb = *(const bf16x4_t*)(Vt + (dt * 16 + qc) * 264 + ks * 32 + 16 + kg * 4);
      const bf16x8_t vf = {va[0], va[1], va[2], va[3], vb[0], vb[1], vb[2], vb[3]};
      if (ks * 2 < nkt0) o[0][dt] = __builtin_amdgcn_mfma_f32_16x16x32_bf16(vf, pfs[0][ks], o[0][dt], 0, 0, 0);
      if (t1) o[1][dt] = __builtin_amdgcn_mfma_f32_16x16x32_bf16(vf, pfs[1][ks], o[1][dt], 0, 0, 0);
    }
  }
#pragma unroll
  for (int tl = 0; tl < 2; ++tl) {
    if ((tl == 0 || t1) && valid[tl]) {
      const size_t sl = ((size_t)qi[tl] * 4 + h) * 4 + src[tl];
      const float inv = 1.f / lsum[tl];
#pragma unroll
      for (int dt = 0; dt < 4; ++dt) *(uint2*)(PART + sl * 64 + dt * 16 + kg * 4) = make_uint2(pk2(o[tl][dt][0] * inv, o[tl][dt][1] * inv), pk2(o[tl][dt][2] * inv, o[tl][dt][3] * inv));
      if (kg == 0) ML[sl] = make_float2(mx[tl], lsum[tl]);
    }
  }
}

__device__ __forceinline__ void moba_attn(const Params& p, int l, float* sm) {
  const int bid0_ = bidx();
  const int tid = tidx();
  const int* LCNT = (const int*)(p.ws + WS_LCNT) + l * 256;
  int* pre = (int*)(sm + 36000);
  __syncthreads();
  if (tid < 64) {
    const int4 c4 = *(const int4*)(LCNT + tid * 4);
    const int n0 = (c4.x + 255) >> 8, n1 = (c4.y + 255) >> 8, n2 = (c4.z + 255) >> 8, n3 = (c4.w + 255) >> 8;
    const int tot = n0 + n1 + n2 + n3;
    int inc = tot;
#pragma unroll
    for (int o = 1; o < 64; o <<= 1) { const int t = __shfl_up(inc, o); if (tid >= o) inc += t; }
    const int ex = inc - tot;
    pre[tid * 4] = ex; pre[tid * 4 + 1] = ex + n0; pre[tid * 4 + 2] = ex + n0 + n1; pre[tid * 4 + 3] = ex + n0 + n1 + n2;
    if (tid == 63) pre[256] = inc;
  }
  __syncthreads();
  const int ng = pre[256];
  for (int it = bid0_; it < ng + 256; it += gridDim.x) {
    if (it < ng) {
      int lo = 0, hi = 255;
      while (lo < hi) { const int mid = (lo + hi + 1) >> 1; if (pre[mid] <= it) lo = mid; else hi = mid - 1; }
      moba_attn_item(p, lo >> 6, lo & 63, it - pre[lo], 0, LCNT[lo], sm);
    } else {
      const int w = it - ng;
      moba_attn_item(p, w & 3, w >> 2, 0, 1, 256, sm);
    }
  }
}

__device__ __forceinline__ void gla_out_item(const Params& p, int l, int it2, float* sm) {
  typedef short bf16x8_t __attribute__((ext_vector_type(8)));
  typedef short bf16x4_t __attribute__((ext_vector_type(4)));
  typedef float f32x4_t __attribute__((ext_vector_type(4)));
  const int tid = tidx(), lane = tid & 63, wave = tid >> 6, qc = lane & 15, kg = lane >> 4;
  const int c = it2 >> 1, hp = it2 & 1;
  const bf16raw* P = (const bf16raw*)(p.ws + WS_PROJ);
  const float* BC = (const float*)(p.ws + WS_GA);
  const float* ST = (const float*)(p.ws + WS_ST);
  bf16raw* Y = (bf16raw*)(p.ws + WS_Y);
  const float* cog = p.in[19] + l * 64;
  bf16raw* L = (bf16raw*)sm;
  const size_t t0 = (size_t)c * 64;
  float4 rrv[4];
#pragma unroll
  for (int et = 0; et < 4; ++et) rrv[et] = ld4bf(P + (t0 + (wave & 3) * 16 + qc) * PDIN + PC_CR + (hp * 2 + (wave >> 2)) * 64 + et * 16 + kg * 4);
  __syncthreads();
  {
    const int hh = tid >> 8, h = hp * 2 + hh;
    bf16raw* Qs = L + hh * 12288; bf16raw* Ks = Qs + 2560; bf16raw* St = Ks + 2560; bf16raw* Vt = St + 2560;
    {
      const int t = (tid >> 2) & 63, d8 = (tid & 3) * 8;
      const bf16raw* qp = P + (t0 + t) * PDIN + PC_CQ + h * 32 + d8; const bf16raw* kp = P + (t0 + t) * PDIN + PC_CK + h * 32 + d8;
      const float4 qa = ld4bf(qp), qb = ld4bf(qp + 4), ka = ld4bf(kp), kb = ld4bf(kp + 4);
      const float4 ba = *(const float4*)(BC + (t0 + t) * 128 + h * 32 + d8), bb = *(const float4*)(BC + (t0 + t) * 128 + h * 32 + d8 + 4);
      const float sc = 0.17677669529663687f;
      *(uint4*)(Qs + t * 40 + d8) = make_uint4(pk2(qa.x * sc * __expf(ba.x), qa.y * sc * __expf(ba.y)), pk2(qa.z * sc * __expf(ba.z), qa.w * sc * __expf(ba.w)),
                                               pk2(qb.x * sc * __expf(bb.x), qb.y * sc * __expf(bb.y)), pk2(qb.z * sc * __expf(bb.z), qb.w * sc * __expf(bb.w)));
      *(uint4*)(Ks + t * 40 + d8) = make_uint4(pk2(ka.x * __expf(-ba.x), ka.y * __expf(-ba.y)), pk2(ka.z * __expf(-ba.z), ka.w * __expf(-ba.w)),
                                               pk2(kb.x * __expf(-bb.x), kb.y * __expf(-bb.y)), pk2(kb.z * __expf(-bb.z), kb.w * __expf(-bb.w)));
    }
    {
      const int j = (tid >> 2) & 63, e0 = (tid & 3) * 16;
      const bf16raw* vp = P + (t0 + j) * PDIN + PC_CV + h * 64 + e0;
      const uint4 va = *(const uint4*)vp, vb = *(const uint4*)(vp + 8);
      const unsigned w[8] = {va.x, va.y, va.z, va.w, vb.x, vb.y, vb.z, vb.w};
#pragma unroll
      for (int q = 0; q < 8; ++q) { Vt[(e0 + 2 * q) * 72 + j] = (bf16raw)(w[q] & 0xffff); Vt[(e0 + 2 * q + 1) * 72 + j] = (bf16raw)(w[q] >> 16); }
    }
    {
      const int d = (tid >> 3) & 31, e0 = (tid & 7) * 8;
      const float* sp = ST + ((size_t)c * 4 + h) * 2048 + d * 64 + e0;
      const float4 sa = *(const float4*)sp, sb = *(const float4*)(sp + 4);
      const float v[8] = {sa.x, sa.y, sa.z, sa.w, sb.x, sb.y, sb.z, sb.w};
#pragma unroll
      for (int q = 0; q < 8; ++q) St[(e0 + q) * 40 + d] = (bf16raw)(pk2(v[q], 0.f) & 0xffff);
    }
  }
  __syncthreads();
  {
    const int hh = wave >> 2, itile = wave & 3, h = hp * 2 + hh;
    const bf16raw* Qs = L + hh * 12288; const bf16raw* Ks = Qs + 2560; const bf16raw* St = Ks + 2560; const bf16raw* Vt = St + 2560;
    const bf16x8_t qf = *(const bf16x8_t*)(Qs + (itile * 16 + qc) * 40 + kg * 8);
    f32x4_t att[4];
#pragma unroll
    for (int jt = 0; jt < 4; ++jt) {
      f32x4_t a = {0.f, 0.f, 0.f, 0.f};
      if (jt <= itile) {
        const bf16x8_t kf = *(const bf16x8_t*)(Ks + (jt * 16 + qc) * 40 + kg * 8);
        a = __builtin_amdgcn_mfma_f32_16x16x32_bf16(kf, qf, a, 0, 0, 0);
        if (jt == itile) {
#pragma unroll
          for (int r = 0; r < 4; ++r) if (kg * 4 + r > qc) a[r] = 0.f;
        }
      }
      att[jt] = a;
    }
    bf16x8_t pf[2];
#pragma unroll
    for (int s2 = 0; s2 < 2; ++s2) {
      const uint4 w = make_uint4(pk2(att[2 * s2][0], att[2 * s2][1]), pk2(att[2 * s2][2], att[2 * s2][3]), pk2(att[2 * s2 + 1][0], att[2 * s2 + 1][1]),
                                 pk2(att[2 * s2 + 1][2], att[2 * s2 + 1][3]));
      pf[s2] = __builtin_bit_cast(bf16x8_t, w);
    }
    f32x4_t o[4];
    float ss = 0.f;
#pragma unroll
    for (int et = 0; et < 4; ++et) {
      f32x4_t acc = {0.f, 0.f, 0.f, 0.f};
      const bf16x8_t sf = *(const bf16x8_t*)(St + (et * 16 + qc) * 40 + kg * 8);
      acc = __builtin_amdgcn_mfma_f32_16x16x32_bf16(sf, qf, acc, 0, 0, 0);
#pragma unroll
      for (int s2 = 0; s2 < 2; ++s2) {
        if (2 * s2 <= itile) {
          const bf16x4_t va = *(const bf16x4_t*)(Vt + (et * 16 + qc) * 72 + s2 * 32 + kg * 4), vb = *(const bf16x4_t*)(Vt + (et * 16 + qc) * 72 + s2 * 32 + 16 + kg * 4);
          const bf16x8_t vf = {va[0], va[1], va[2], va[3], vb[0], vb[1], vb[2], vb[3]};
          acc = __builtin_amdgcn_mfma_f32_16x16x32_bf16(vf, pf[s2], acc, 0, 0, 0);
        }
      }
      o[et] = acc;
      ss += acc[0] * acc[0] + acc[1] * acc[1] + acc[2] * acc[2] + acc[3] * acc[3];
    }
    ss += __shfl_xor(ss, 16); ss += __shfl_xor(ss, 32);
    const float r = rsqrtf(ss * (1.f / 64.f) + 1e-6f);
    const size_t t = t0 + itile * 16 + qc;
#pragma unroll
    for (int et = 0; et < 4; ++et) {
      const int e = et * 16 + kg * 4;
      const float4 rr = rrv[et], g = *(const float4*)(cog + e);
      *(uint2*)(Y + t * 1024 + 512 + h * 64 + e) = make_uint2(pk2(o[et][0] * r * g.x * rr.x * sigmoidf_(rr.x), o[et][1] * r * g.y * rr.y * sigmoidf_(rr.y)),
                                                             pk2(o[et][2] * r * g.z * rr.z * sigmoidf_(rr.z), o[et][3] * r * g.w * rr.w * sigmoidf_(rr.w)));
    }
  }
}

__device__ __forceinline__ void lru_out(const Params& p) {
  const int bid0_ = bidx();
  const int tid = tidx();
  const float* LA = (const float*)(p.ws + WS_LA); const float* LB = (const float*)(p.ws + WS_LB); const float* LC = (const float*)(p.ws + WS_LC);
  const bf16raw* P = (const bf16raw*)(p.ws + WS_PROJ);
  bf16raw* Y = (bf16raw*)(p.ws + WS_Y);
  for (int idx = bid0_ * NT + tid; idx < S * 64; idx += gridDim.x * NT) {
    const int t = idx >> 6, c4 = (idx & 63) * 4;
    const float4 a = *(const float4*)(LA + (size_t)t * 256 + c4), b = *(const float4*)(LB + (size_t)t * 256 + c4);
    const float4 cr = *(const float4*)(LC + (size_t)(t >> 5) * 256 + c4), g = ld4bf(P + (size_t)t * PDIN + PC_DG + c4);
    *(uint2*)(Y + (size_t)t * 1024 + 768 + c4) = make_uint2(pk2((b.x + a.x * cr.x) * gelu_tanh(g.x), (b.y + a.y * cr.y) * gelu_tanh(g.y)),
                                                          pk2((b.z + a.z * cr.z) * gelu_tanh(g.z), (b.w + a.w * cr.w) * gelu_tanh(g.w)));
  }
}

__device__ __forceinline__ void ph_mix(const Params& p, int l, float* sm) {
  const int bid0_ = bidx();
  const int grp = bid0_ % 3;
  if (grp == 0) { __syncthreads(); convert_rest(p, sm, l); __syncthreads(); }
  moba_attn(p, l, sm);
  for (int it = bid0_; it < 512; it += gridDim.x) gla_out_item(p, l, it, sm);
  lru_out(p);
  __syncthreads();
  if (grp == 1) { convert_rest(p, sm, l); __syncthreads(); }
  {
    const attn_body::AttnTensors AT{(const attn_body::bf16*)(p.ws + WS_QA), (const attn_body::bf16*)(p.ws + WS_KA), (const attn_body::bf16*)(p.ws + WS_VA),
                                    (attn_body::bf16*)(p.ws + WS_OA), (const attn_body::bf16*)(p.ws + WS_ZERO)};
    const attn_body::StaticOrder so((int)gridDim.x, bid0_);
    attn_body::attn_phase<attn_body::StaticOrder>((char*)sm, AT, so);
  }
  if (grp == 2) { __syncthreads(); convert_rest(p, sm, l); }
}

__device__ __forceinline__ void ph_fin(const Params& p, int l) {
  const int bid0_ = bidx();
  const int tid0_ = tidx();
  const int lane = tid0_ & 63, wave = tid0_ >> 6;
  const bf16raw* OA = (const bf16raw*)(p.ws + WS_OA);
  const bf16raw* P = (const bf16raw*)(p.ws + WS_PROJ);
  bf16raw* Y = (bf16raw*)(p.ws + WS_Y);
  const float lam = lam_of(p, l), li = lam_init_of(l);
  const float2* ML = (const float2*)(p.ws + WS_ML); const bf16raw* PART = (const bf16raw*)(p.ws + WS_PART);
  const float* aog = p.in[14] + l * 64; const float* cog = p.in[19] + l * 64;
#pragma unroll 2
  for (int row = bid0_ * 8 + wave; row < S; row += gridDim.x * 8) {
    int h = lane >> 4, c = (lane & 15) * 4;
    {
      const uint2 u1 = *(const uint2*)(OA + ((size_t)row * 8 + h * 2) * 64 + c), u2 = *(const uint2*)(OA + ((size_t)row * 8 + h * 2 + 1) * 64 + c);
      const float4 o1 = make_float4(bf2f(u1.x & 0xffff), bf2f(u1.x >> 16), bf2f(u1.y & 0xffff), bf2f(u1.y >> 16));
      const float4 o2 = make_float4(bf2f(u2.x & 0xffff), bf2f(u2.x >> 16), bf2f(u2.y & 0xffff), bf2f(u2.y >> 16));
      float4 o = make_float4(o1.x - lam * o2.x, o1.y - lam * o2.y, o1.z - lam * o2.z, o1.w - lam * o2.w);
      float ss = o.x * o.x + o.y * o.y + o.z * o.z + o.w * o.w;
#pragma unroll
      for (int k = 1; k < 16; k <<= 1) ss += __shfl_xor(ss, k);
      float r = rsqrtf(ss * (1.f / 64.f) + 1e-6f) * (1.f - li);
      float4 g = *(const float4*)(aog + c);
      *(uint2*)(Y + (size_t)row * 1024 + h * 64 + c) = make_uint2(pk2(o.x * r * g.x, o.y * r * g.y), pk2(o.z * r * g.z, o.w * r * g.w));
    }
    {
      const size_t sl = ((size_t)row * 4 + h) * 4;
      const float2 m0 = ML[sl], m1 = ML[sl + 1], m2 = ML[sl + 2], m3 = ML[sl + 3];
      const float M = fmaxf(fmaxf(m0.x, m1.x), fmaxf(m2.x, m3.x));
      const float w0 = m0.y * __builtin_amdgcn_exp2f(m0.x - M), w1 = m1.y * __builtin_amdgcn_exp2f(m1.x - M), w2 = m2.y * __builtin_amdgcn_exp2f(m2.x - M),
                  w3 = m3.y * __builtin_amdgcn_exp2f(m3.x - M);
      const float inv = 1.f / (w0 + w1 + w2 + w3);
      float4 o = make_float4(0.f, 0.f, 0.f, 0.f);
      if (w0 > 0.f) { const float4 t = ld4bf(PART + (sl + 0) * 64 + c); o.x += w0 * t.x; o.y += w0 * t.y; o.z += w0 * t.z; o.w += w0 * t.w; }
      if (w1 > 0.f) { const float4 t = ld4bf(PART + (sl + 1) * 64 + c); o.x += w1 * t.x; o.y += w1 * t.y; o.z += w1 * t.z; o.w += w1 * t.w; }
      if (w2 > 0.f) { const float4 t = ld4bf(PART + (sl + 2) * 64 + c); o.x += w2 * t.x; o.y += w2 * t.y; o.z += w2 * t.z; o.w += w2 * t.w; }
      { const float4 t = ld4bf(PART + (sl + 3) * 64 + c); o.x += w3 * t.x; o.y += w3 * t.y; o.z += w3 * t.z; o.w += w3 * t.w; }
      *(uint2*)(Y + (size_t)row * 1024 + 256 + h * 64 + c) = make_uint2(pk2(o.x * inv, o.y * inv), pk2(o.z * inv, o.w * inv));
    }
  }
}

__device__ __forceinline__ void ph_outproj(const Params& p, int l, float* sm) {
  const int bid0_ = bidx();
  pg8::Gemm g{(const pg8::bf16_t*)(p.ws + WS_Y), (const pg8::bf16_t*)(p.ws + WS_WOUT) + (size_t)l * 1024 * 1024, S, 1024, 1024};
  pg8::StaticOrder so; so.init(S, 1024, (int)gridDim.x, bid0_);
  pg8::EpiOutproj E{l == 0 ? p.in[0] : (const float*)nullptr, (const pg8::bf16_t*)(p.ws + WS_XA), (const float*)(p.ws + WS_MOD) + l * 6144 + 2 * 1024, (pg8::bf16_t*)(p.ws + WS_X1)};
  pg8::gemm_phase<pg8::EpiOutproj, pg8::StaticOrder, true, true>((PG8_LAS unsigned char*)sm, g, so, E);
}

__device__ __forceinline__ void ph_gather(const Params& p, int l, float* sm) {
  const int bid0_ = bidx();
  const int tid0_ = tidx();
  const int* cnt = (const int*)(p.ws + WS_CNT) + l * 32;
  int* ps = (int*)sm;
  __syncthreads();
  int* cl = ps + 64;
  if (tid0_ < 32) cl[tid0_] = (cnt[tid0_] + 255) & ~255;
  __syncthreads();
  if (tid0_ < 33) { int a = 0; for (int e = 0; e < tid0_; ++e) a += cl[e]; ps[tid0_] = a; }
  __syncthreads();
  int* srow = (int*)(p.ws + WS_SROW);
  if (bid0_ == 0) {
    int* texp = (int*)(p.ws + WS_TEXP);
    const int nt = ps[32] >> 8;
    if (tid0_ == 0) texp[0] = nt;
    if (tid0_ < 32) { texp[352 + tid0_] = ps[tid0_] >> 8; texp[384 + tid0_] = cl[tid0_] >> 8; }
    if (tid0_ < 320) {
      int e = 0;
      for (int k = 0; k < 32; ++k) if (tid0_ * 256 >= ps[k + 1]) e = k + 1;
      texp[1 + tid0_] = e < 32 ? e : 31;
    }
  }
  for (int e = bid0_; e < 32; e += gridDim.x)
    for (int i = cnt[e] + tid0_; i < cl[e]; i += NT) srow[ps[e] + i] = 0;
  const int* eidx = (const int*)(p.ws + WS_EIDX);
  int* rpos = (int*)(p.ws + WS_RPOS);
  for (int r = bid0_ * NT + tid0_; r < S * 4; r += gridDim.x * NT) {
    const int ei = eidx[r], e = ei & 255, rank = ei >> 8;
    const int dest = ps[e] + rank;
    srow[dest] = r >> 2;
    rpos[r] = dest;
  }
}

__device__ __forceinline__ void ph_up(const Params& p, int l, float* sm) {
  const int bid0_ = bidx();
  pg8::Gemm g{(const pg8::bf16_t*)(p.ws + WS_H), (const pg8::bf16_t*)(p.ws + WS_WUP) + (size_t)l * NE * 2048 * 1024, MOE_ROWS, 2048, 1024};
  int* tab = (int*)(sm + 33000);
  unsigned* rowoff = (unsigned*)(sm + 33104);
  const int t_ = tidx();
  const int* cnt = (const int*)(p.ws + WS_CNT) + l * 32;
  pg8::moe_build_units<8>(cnt, (int)gridDim.x, bid0_, tab, t_);
  pg8::moe_build_rowoff((const int*)(p.ws + WS_ELIST), cnt, tab, rowoff, t_);
  pg8::MoeOrder<8, 1> so{tab, (unsigned*)(p.ws + WS_RDY) + l * 320};
  pg8::EpiUp E{__builtin_amdgcn_make_buffer_rsrc((void*)(p.ws + WS_ACT), 0, (int)((size_t)MOE_ROWS * 1024 * 2), 0x00020000), p.in[30] + (size_t)l * NE * 2048};
  pg8::gemm_phase<pg8::EpiUp, pg8::MoeOrder<8, 1>, true, true, true>((PG8_LAS unsigned char*)sm, g, so, E, rowoff);
}

__device__ __forceinline__ void ph_down(const Params& p, int l, float* sm) {
  const int bid0_ = bidx();
  pg8::Gemm g{(const pg8::bf16_t*)(p.ws + WS_ACT), (const pg8::bf16_t*)(p.ws + WS_WDN) + (size_t)l * NE * 1024 * 1024, MOE_ROWS, 1024, 1024};
  int* tab = (int*)(sm + 33000);
  pg8::moe_build_units<4>((const int*)(p.ws + WS_CNT) + l * 32, (int)gridDim.x, bid0_, tab, tidx(), true);
  pg8::MoeOrder<4, 2> so{tab, (unsigned*)(p.ws + WS_RDY) + l * 320};
  pg8::EpiDown E{(pg8::bf16_t*)(p.ws + WS_YS), p.in[32] + (size_t)l * NE * 1024};
  pg8::gemm_phase<pg8::EpiDown, pg8::MoeOrder<4, 2>, true, true>((PG8_LAS unsigned char*)sm, g, so, E);
}

__device__ __forceinline__ void ph_combine(const Params& p, int l, float* sm) {
  const int bid0_ = bidx();
  const int tid0_ = tidx();
  const int lane = tid0_ & 63, wave = tid0_ >> 6;
  const bf16raw* X1 = (const bf16raw*)(p.ws + WS_X1); const bf16raw* YS = (const bf16raw*)(p.ws + WS_YS);
  const float* gatebuf = (const float*)(p.ws + WS_GATE);
  const int* eidx = (const int*)(p.ws + WS_EIDX);
  const int* cnt = (const int*)(p.ws + WS_CNT) + l * 32;
  const float* g2 = (const float*)(p.ws + WS_MOD) + l * 6144 + 5 * 1024;
  bf16raw* xa = (bf16raw*)(p.ws + WS_XA);
  const float* modn = (const float*)(p.ws + WS_MOD) + 6144;
  const float* gain = p.in[4] + 1024;
  bf16raw* H = (bf16raw*)(p.ws + WS_H);
  int* ps = (int*)sm;
  __syncthreads();
  if (tid0_ < 33) { int a = 0; for (int e = 0; e < tid0_; ++e) a += (cnt[e] + 255) & ~255; ps[tid0_] = a; }
  __syncthreads();
#pragma unroll 2
  for (int row = bid0_ * 8 + wave; row < S; row += gridDim.x * 8) {
    const float4 gt = *(const float4*)(gatebuf + row * 4);
    const int4 ei = *(const int4*)(eidx + row * 4);
    const int4 rp = make_int4(ps[ei.x & 255] + (ei.x >> 8), ps[ei.y & 255] + (ei.y >> 8), ps[ei.z & 255] + (ei.z >> 8), ps[ei.w & 255] + (ei.w >> 8));
    float4 v[4];
    float ss = 0.f;
#pragma unroll
    for (int j = 0; j < 4; ++j) {
      const int c = (lane + 64 * j) * 4;
      const uint2 y0 = *(const uint2*)(YS + (size_t)rp.x * 1024 + c), y1 = *(const uint2*)(YS + (size_t)rp.y * 1024 + c);
      const uint2 y2 = *(const uint2*)(YS + (size_t)rp.z * 1024 + c), y3 = *(const uint2*)(YS + (size_t)rp.w * 1024 + c);
      float4 a;
      a.x = gt.x * bf2f(y0.x & 0xffff) + gt.y * bf2f(y1.x & 0xffff) + gt.z * bf2f(y2.x & 0xffff) + gt.w * bf2f(y3.x & 0xffff);
      a.y = gt.x * bf2f(y0.x >> 16) + gt.y * bf2f(y1.x >> 16) + gt.z * bf2f(y2.x >> 16) + gt.w * bf2f(y3.x >> 16);
      a.z = gt.x * bf2f(y0.y & 0xffff) + gt.y * bf2f(y1.y & 0xffff) + gt.z * bf2f(y2.y & 0xffff) + gt.w * bf2f(y3.y & 0xffff);
      a.w = gt.x * bf2f(y0.y >> 16) + gt.y * bf2f(y1.y >> 16) + gt.z * bf2f(y2.y >> 16) + gt.w * bf2f(y3.y >> 16);
      const float4 x = ld4bf(X1 + (size_t)row * 1024 + c), g = *(const float4*)(g2 + c);
      v[j] = make_float4(x.x + g.x * a.x, x.y + g.y * a.y, x.z + g.z * a.z, x.w + g.w * a.w);
      if (l == 0) *(uint2*)(xa + (size_t)row * 1024 + c) = make_uint2(pk2(v[j].x, v[j].y), pk2(v[j].z, v[j].w)); else *(float4*)(p.out + (size_t)row * 1024 + c) = v[j];
      ss += v[j].x * v[j].x + v[j].y * v[j].y + v[j].z * v[j].z + v[j].w * v[j].w;
    }
    if (l == 0) {
      ss = wave_sum(ss);
      const float r = rsqrtf(ss * (1.f / 1024.f) + 1e-6f);
      uint2* hr = (uint2*)(H + (size_t)row * 1024) + lane;
#pragma unroll
      for (int j = 0; j < 4; ++j) {
        const int c = (lane + 64 * j) * 4;
        const float4 g = *(const float4*)(gain + c), a = *(const float4*)(modn + 1024 + c), b = *(const float4*)(modn + c);
        hr[64 * j] = make_uint2(pk2(v[j].x * r * g.x * (1.f + a.x) + b.x, v[j].y * r * g.y * (1.f + a.y) + b.y),
                                pk2(v[j].z * r * g.z * (1.f + a.z) + b.z, v[j].w * r * g.w * (1.f + a.w) + b.w));
      }
    }
  }
}

#define LAS __attribute__((address_space(3)))
#define XB_TMO      128
#define XB_XCNT(j)  (256  + 64 * (j))
#define XB_XSUB(j)  (1280 + 64 * (j))
#define XB_XGEN(j)  (2304 + 64 * (j))
#define XB_TOP      3328
#define XB_TOPGEN   3392
#define XCD_BAR_WORDS 3456
#define XB_SPIN_CAP (1u << 18)

__device__ __forceinline__ unsigned xb_ld(unsigned* p)              { return __hip_atomic_load(p, __ATOMIC_RELAXED, __HIP_MEMORY_SCOPE_AGENT); }
__device__ __forceinline__ unsigned xb_add(unsigned* p, unsigned v) { return __hip_atomic_fetch_add(p, v, __ATOMIC_RELAXED, __HIP_MEMORY_SCOPE_AGENT); }
__device__ __forceinline__ unsigned xb_xcc_id() { return (unsigned)__builtin_amdgcn_s_getreg((3 << 11) | 20) & 0xFu; }
#define XB_SPIN(cond, bar) do { unsigned _sp = 0; while (cond) { __builtin_amdgcn_s_sleep(1); \
    if ((++_sp & 255u) == 0u) { if (xb_ld(&(bar)[XB_TMO])) break; if (_sp > XB_SPIN_CAP) { atomicAdd(&(bar)[XB_TMO], 1u); break; } } } } while (0)

struct XcdBarrier {
    unsigned* bar; unsigned x;
    volatile LAS unsigned* st;
};

__device__ __forceinline__ XcdBarrier xcd_barrier_post(unsigned* bar, volatile LAS unsigned* st) {
    XcdBarrier b; b.bar = bar; b.x = xb_xcc_id(); b.st = st;
    if (threadIdx.x == 0) (void)xb_add(&bar[XB_XCNT(b.x)], 1u);
    return b;
}
__device__ __forceinline__ void xcd_barrier_complete(unsigned* bar, unsigned x, unsigned& nloc, unsigned& nx) {
    const unsigned G = gridDim.x * gridDim.y * gridDim.z;
    unsigned sum, cnt, mine, sp = 0u;
    for (;;) {
        sum = 0u; cnt = 0u; mine = 0u;
#pragma unroll
        for (unsigned j = 0; j < 16; ++j) { const unsigned c = xb_ld(&bar[XB_XCNT(j)]); sum += c; cnt += (c > 0u) ? 1u : 0u; mine = (j == x) ? c : mine; }
        if (sum == G) break;
        __builtin_amdgcn_s_sleep(1);
        if ((++sp & 255u) == 0u) { if (xb_ld(&bar[XB_TMO])) break; if (sp > XB_SPIN_CAP) { atomicAdd(&bar[XB_TMO], 1u); break; } }
    }
    nloc = mine > 0u ? mine : 1u; nx = cnt > 0u ? cnt : 1u;
}

__device__ __forceinline__ void xcd_barrier(const XcdBarrier& b) {
    asm volatile("s_waitcnt vmcnt(0)" ::: "memory");
    __syncthreads();
    if (threadIdx.x == 0) {
        unsigned* bar = b.bar; asm volatile("" : "+s"(bar));
        const unsigned bx_ = xb_xcc_id();
        __builtin_amdgcn_s_waitcnt(0);
        unsigned nloc = b.st[0], nx = b.st[1];
        if (nloc == 0u) { xcd_barrier_complete(bar, bx_, nloc, nx); b.st[0] = nloc; b.st[1] = nx; }
        const unsigned old = xb_add(&bar[XB_XSUB(bx_)], 1u);
        const unsigned gen = old / nloc;
        if (old + 1u == (gen + 1u) * nloc) {
            __builtin_amdgcn_fence(__ATOMIC_RELEASE, "agent");
            asm volatile("s_waitcnt vmcnt(0)" ::: "memory");
            const unsigned og = xb_add(&bar[XB_TOP], 1u);
            const unsigned tg = og / nx;
            if (og + 1u == (tg + 1u) * nx) xb_add(&bar[XB_TOPGEN], 1u);
            else XB_SPIN(xb_ld(&bar[XB_TOPGEN]) == tg, bar);
            __builtin_amdgcn_fence(__ATOMIC_ACQUIRE, "agent");
            xb_add(&bar[XB_XGEN(bx_)], 1u);
            asm volatile("s_waitcnt vmcnt(0)" ::: "memory");
        } else {
            XB_SPIN(xb_ld(&bar[XB_XGEN(bx_)]) == gen, bar);
            __builtin_amdgcn_fence(__ATOMIC_ACQUIRE, "agent");
            asm volatile("s_waitcnt vmcnt(0)" ::: "memory");
        }
    }
    __syncthreads();
}

template <int SUB>
__device__ __forceinline__ void run_sub(const Params& p, int l, float* sm) {
  const int bid0_ = bidx();
  asm volatile("" : "+s"(l));
  if (SUB == 0) ph_norm(p, l, 0, sm);
  else if (SUB == 1) ph_inproj(p, l, sm);
  else if (SUB == 2) ph_prep(p, l, sm);
  else if (SUB == 3) { ph_scan(p, sm); ph_scan_lru(p, sm); for (int it = bid0_; it < 256; it += gridDim.x) moba_gate_item(p, l, (it - 16) & 255, sm); }
  else if (SUB == 4) ph_mix(p, l, sm);
  else if (SUB == 5) ph_fin(p, l);
  else if (SUB == 6) ph_outproj(p, l, sm);
  else if (SUB == 7) ph_norm2(p, l, sm);
  else if (SUB == 8) ph_gather(p, l, sm);
  else if (SUB == 9) ph_up(p, l, sm);
  else if (SUB == 10) ph_down(p, l, sm);
  else if (SUB == 11) ph_combine(p, l, sm);
}

#if MK_SINGLE
__global__ void __launch_bounds__(NT, 2) mega(Params p) {
  extern __shared__ __attribute__((aligned(16))) unsigned char lds_raw[];
  float* sm = (float*)lds_raw;
  cg::grid_group grid = cg::this_grid();
  unsigned* barw = (unsigned*)(p.ws + WS_BAR);
  volatile LAS unsigned* bst = (volatile LAS unsigned*)((LAS unsigned char*)lds_raw + (LDS_BYTES - 64));
  if (threadIdx.x < 2) bst[threadIdx.x] = 0u;
  if (blockIdx.x == 0) for (int i = threadIdx.x; i < XCD_BAR_WORDS; i += NT) barw[i] = 0u;
  ph_mod(p, sm);
  ph_convert(p, sm);
  grid.sync();
  const XcdBarrier gb = xcd_barrier_post(barw, bst);
#define GSYNC() xcd_barrier(gb)
  run_sub<0>(p, 0, sm); GSYNC();
#pragma unroll 1
  for (int l = 0; l < 2; ++l) {
    run_sub<1>(p, l, sm); GSYNC();
    run_sub<2>(p, l, sm); GSYNC();
    run_sub<3>(p, l, sm); GSYNC();
    run_sub<4>(p, l, sm); GSYNC();
    run_sub<5>(p, l, sm); GSYNC();
    run_sub<6>(p, l, sm); GSYNC();
    run_sub<7>(p, l, sm); GSYNC();
    run_sub<9>(p, l, sm);
    run_sub<10>(p, l, sm); GSYNC();
    run_sub<11>(p, l, sm);
    if (l == 0) GSYNC();
  }
#undef GSYNC
}
#else
template <int SUB>
__global__ void __launch_bounds__(NT, 2) phk(Params p, int l) {
  extern __shared__ __attribute__((aligned(16))) unsigned char lds_raw[];
  float* sm = (float*)lds_raw;
  if (SUB < 0) { ph_mod(p, sm); ph_convert(p, sm); }
  else run_sub<(SUB < 0 ? 0 : SUB)>(p, l, sm);
}
template <int SUB> static void launch_ph(const Params& p, int l, hipStream_t stream) {
  static bool attr = false;
  if (!attr) { (void)hipFuncSetAttribute((const void*)phk<SUB>, hipFuncAttributeMaxDynamicSharedMemorySize, LDS_BYTES); attr = true; }
  hipLaunchKernelGGL(phk<SUB>, dim3(256), dim3(NT), LDS_BYTES, stream, p, l);
}
#endif

extern "C" void kernel_launch(void* const* d_in, const int* in_sizes, int n_in, void* d_out, int out_size, void* d_ws, size_t ws_size,
                              hipStream_t stream) {
  Params p{};
  for (int i = 0; i < 33; ++i) p.in[i] = (const float*)d_in[i];
  p.out = (float*)d_out;
  p.ws = (char*)d_ws;
#if MK_SINGLE
  static int grid_blocks = 0;
  if (!grid_blocks) {
    int dev = 0, cus = 0, per_cu = 0;
    (void)hipGetDevice(&dev);
    (void)hipDeviceGetAttribute(&cus, hipDeviceAttributeMultiprocessorCount, dev);
    (void)hipFuncSetAttribute((const void*)mega, hipFuncAttributeMaxDynamicSharedMemorySize, LDS_BYTES);
    (void)hipOccupancyMaxActiveBlocksPerMultiprocessor(&per_cu, mega, NT, LDS_BYTES);
    if (per_cu < 1) per_cu = 1;
    if (per_cu > 1) per_cu = 1;
    grid_blocks = cus * per_cu;
  }
  void* args[] = {&p};
  hipError_t e = hipLaunchCooperativeKernel((void*)mega, dim3(grid_blocks), dim3(NT), args, LDS_BYTES, stream);
  if (e != hipSuccess) fprintf(stderr, "cooperative launch failed: %s (grid %d)\n", hipGetErrorString(e), grid_blocks);
#else
  launch_ph<-1>(p, 0, stream);
  for (int l = 0; l < 2; ++l) {
    if (l == 0) launch_ph<0>(p, l, stream);
    launch_ph<1>(p, l, stream); launch_ph<2>(p, l, stream); launch_ph<3>(p, l, stream);
    launch_ph<4>(p, l, stream); launch_ph<5>(p, l, stream); launch_ph<6>(p, l, stream); launch_ph<7>(p, l, stream);
    launch_ph<9>(p, l, stream); launch_ph<10>(p, l, stream); launch_ph<11>(p, l, stream);
  }
#endif
}
```

```cpp
#include <hip/hip_runtime.h>
#include <hip/hip_cooperative_groups.h>
#include <cstdio>
#include <cstdint>
namespace cg = cooperative_groups;

#ifndef MK_SINGLE
#define MK_SINGLE 1
#endif
#ifndef PROBE
#define PROBE 0
#endif

constexpr int S = 16384, D = 1024, DIN = 2832, NE = 32;
constexpr int NT = 512;
constexpr size_t MiB = 1u << 20;
constexpr size_t WS_MOD = 0;
constexpr size_t WS_CNT = 64 * 1024;
constexpr size_t WS_TEXP = 128 * 1024;
constexpr size_t WS_KMP = 1 * MiB;
constexpr size_t WS_BAR = 256 * 1024;
constexpr size_t WS_SROW = 320 * 1024;
constexpr size_t WS_RDY = 216 * 1024;
constexpr size_t WS_ZERO = 224 * 1024;
constexpr size_t WS_LCNT = 192 * 1024;
constexpr size_t WS_EIDX = 2 * MiB;
constexpr size_t WS_RPOS = 2 * MiB + 512 * 1024;
constexpr size_t WS_GATE = 3 * MiB;
constexpr size_t WS_H = 8 * MiB;
constexpr size_t WS_VBT = 40 * MiB;
constexpr size_t WS_ELIST = 66 * MiB;
constexpr size_t WS_MLIST = 48 * MiB;
constexpr size_t WS_ML = 64 * MiB;
constexpr size_t WS_PROJ = 72 * MiB;
constexpr size_t WS_Y = 250 * MiB;
constexpr size_t WS_X1 = 314 * MiB;
constexpr size_t WS_XA = 378 * MiB;
constexpr size_t WS_QA = 442 * MiB;
constexpr size_t WS_KA = 458 * MiB;
constexpr size_t WS_QB = 474 * MiB;
constexpr size_t WS_KB = 490 * MiB;
constexpr size_t WS_QBB = 498 * MiB;
constexpr size_t WS_GA = 506 * MiB;
constexpr size_t WS_LA = 514 * MiB;
constexpr size_t WS_LB = 530 * MiB;
constexpr size_t WS_OA = 546 * MiB;
constexpr size_t WS_VA = 562 * MiB;
constexpr size_t WS_SC = 578 * MiB;
constexpr size_t WS_DEC = 586 * MiB;
constexpr size_t WS_LTA = 587 * MiB;
constexpr size_t WS_LTH = 588 * MiB;
constexpr size_t WS_LC = 589 * MiB;
constexpr int MOE_ROWS = 73728;
constexpr size_t WS_ST = 1490 * MiB;
constexpr size_t WS_PART = 1426 * MiB;
constexpr size_t WS_VB = 594 * MiB;
constexpr size_t WS_XS = 602 * MiB;
constexpr size_t WS_ACT = 738 * MiB;
constexpr size_t WS_YS = 882 * MiB;
constexpr size_t WS_WIN = 1026 * MiB;
constexpr size_t WS_WOUT = 1038 * MiB;
constexpr size_t WS_WUP = 1042 * MiB;
constexpr size_t WS_WDN = 1298 * MiB;
constexpr int LDS_BYTES = 147456;

struct Params {
  const float* in[33];
  float* out;
  char* ws;
};

constexpr int PDIN = 1296;
constexpr int PC_CQ = 0, PC_CK = 128, PC_CV = 256, PC_CG = 512, PC_CR = 528, PC_DX = 784, PC_DG = 1040;

__device__ __forceinline__ int bidx() { int b = blockIdx.x; asm volatile("" : "+s"(b)); return b; }
__device__ __forceinline__ int tidx() { int t = threadIdx.x; asm volatile("" : "+v"(t)); return t; }
__device__ __forceinline__ float wave_sum(float v) {
#pragma unroll
  for (int o = 1; o < 64; o <<= 1) v += __shfl_xor(v, o);
  return v;
}
__device__ __forceinline__ float sigmoidf_(float x) { return __builtin_amdgcn_rcpf(1.f + __builtin_amdgcn_exp2f(-1.4426950408889634f * x)); }
__device__ __forceinline__ float logsigmoidf_(float z) { return fminf(z, 0.f) - log1pf(__expf(-fabsf(z))); }
__device__ __forceinline__ float gelu_tanh(float x) {
  float u = 0.7978845608028654f * (x + 0.044715f * x * x * x);
  float t = 1.f - 2.f * __builtin_amdgcn_rcpf(__expf(2.f * u) + 1.f);
  return 0.5f * x * (1.f + t);
}
__device__ __forceinline__ float lam_init_of(int l) { return l == 0 ? 0.2f : (0.8f - 0.6f * 0.7408182206817179f); }
__device__ __forceinline__ float lam_of(const Params& p, int l) {
  float s1 = 0.f, s2 = 0.f;
  for (int i = 0; i < 32; ++i) {
    s1 += p.in[10][l * 32 + i] * p.in[11][l * 32 + i];
    s2 += p.in[12][l * 32 + i] * p.in[13][l * 32 + i];
  }
  return __expf(s1) - __expf(s2) + lam_init_of(l);
}

typedef unsigned short bf16raw;
__device__ __forceinline__ unsigned f2bf(float f) { unsigned u = __builtin_bit_cast(unsigned, f); return (u + 0x7fffu + ((u >> 16) & 1u)) >> 16; }
typedef float f32x2v_ __attribute__((ext_vector_type(2))); typedef __bf16 bf16x2v_ __attribute__((ext_vector_type(2)));
__device__ __forceinline__ unsigned pk2(float lo, float hi) { f32x2v_ v = {lo, hi}; bf16x2v_ b = __builtin_convertvector(v, bf16x2v_); return __builtin_bit_cast(unsigned, b); }
__device__ __forceinline__ float4 ld4bf(const unsigned short* p) { const uint2 u = *(const uint2*)p; return make_float4(__builtin_bit_cast(float, u.x << 16), __builtin_bit_cast(float, u.x & 0xffff0000u), __builtin_bit_cast(float, u.y << 16), __builtin_bit_cast(float, u.y & 0xffff0000u)); }
__device__ __forceinline__ float bf2f(unsigned short h) { return __builtin_bit_cast(float, (unsigned)h << 16); }

namespace pg8 {
#define PG8_LAS __attribute__((address_space(3)))
typedef unsigned short bf16_t;
typedef short bf16x8 __attribute__((ext_vector_type(8)));
typedef float f32x4 __attribute__((ext_vector_type(4)));
typedef unsigned u32x4 __attribute__((ext_vector_type(4)));
constexpr int BM = 256, BK = 64, HALF = 128, HTB = HALF * BK * 2  , STAGE_BYTES = 8 * HTB, NXCD = 8, WGM = 8;

__host__ __device__ __forceinline__ int lds_byte(int r, int c) { const int st = (r >> 4) * 2 + (c >> 5), rr = r & 15, cc = c & 31, ob = rr * 64 + cc * 2; return st * 1024 + (ob ^ (((ob >> 9) & 1) << 5)); }
__host__ __device__ __forceinline__ void stage_rc(int b, int& R, int& C) {
  const int bid0_ = bidx(); const int st = b / 1024, sb = b % 1024, swz = sb ^ (((sb >> 9) & 1) << 5); R = (st >> 1) * 16 + swz / 64; C = (st & 1) * 32 + (swz % 64) / 2; }
__host__ __device__ __forceinline__ int perm32(int rho) { const int n = rho >> 4, i = rho & 15; return 8 * (i >> 2) + 4 * n + (i & 3); }

struct Unit { int pm, pn; };
struct Gemm { const bf16_t* A; const bf16_t* Bt; int M, N, K; };

struct StaticOrder {
    int nM, nN, nwg, G, c;
    __host__ __device__ void init(int M, int N, int G_, int c_) { nM = M / BM; nN = N / BM; nwg = nM * nN; G = G_; c = c_; }
    __host__ __device__ bool next(int i, Unit& u) const {
        const long L = (long)i * G + c; if (L >= nwg) return false;
        int wgid = (int)L; { const int q = nwg / NXCD, r = nwg % NXCD, xcd = wgid % NXCD, off = wgid / NXCD; wgid = (xcd < r ? xcd * (q + 1) : r * (q + 1) + (xcd - r) * q) + off; }
        const int nig = WGM * nN, gid = wgid / nig, fm = gid * WGM, gsz = (nM - fm) < WGM ? (nM - fm) : WGM;
        u.pm = fm + ((wgid % nig) % gsz); u.pn = (wgid % nig) / gsz; return true;
    }
    __device__ __forceinline__ void a_ready(const Unit&) const {}
    __device__ __forceinline__ void done(const Unit&) const {}
};

__device__ __forceinline__ unsigned cvt_pk_bf16(float lo, float hi) { unsigned r; asm volatile("v_cvt_pk_bf16_f32 %0, %1, %2" : "=v"(r) : "v"(lo), "v"(hi)); return r; }
typedef float f32x2 __attribute__((ext_vector_type(2)));
template <class Epi, class Sched, bool ALIGN_EPI = false, bool SP2 = false, bool GATHER = false>
__device__ __forceinline__ void gemm_phase(PG8_LAS unsigned char* lds, const Gemm g, const Sched& S, const Epi& E, const unsigned* rowoff = nullptr) {
    static_assert(!GATHER || SP2, "row gather is wired into the SP2 loop only");
    const int tid = tidx(), wid = __builtin_amdgcn_readfirstlane(tid >> 6), lane = tid & 63, wr = wid >> 2, wc = wid & 3, fr = lane & 15, fq = lane >> 4;
    const int K = g.K, nt = K / BK;
    unsigned voffA[2], voffB[2]; int RA[2], CA[2];
#pragma unroll
    for (int i = 0; i < 2; ++i) { int R, C; stage_rc(tid * 16 + i * 8192, R, C); const int Rb = Epi::PERM ? ((R & ~31) + perm32(R & 31)) : R;
        voffA[i] = (unsigned)(R * K + C) * 2u; voffB[i] = (unsigned)(Rb * K + C) * 2u; RA[i] = R; CA[i] = C; }
    const size_t kstep = (size_t)(BK * 2);
    const size_t hstep = (size_t)HALF * K * 2;
    const size_t tstep = 2 * hstep;
    const unsigned ldsw = (unsigned)wid * 1024u;
    const int aoff = lds_byte(wr * 64 + fr, fq * 8), boff = lds_byte(wc * 32 + fr, fq * 8);
#define PG8_SA(b, h) (((b) * 2 + (h)) * HTB)
#define PG8_SB(b, h) ((4 + (b) * 2 + (h)) * HTB)
#define PG8_STAGE(bufoff, gbase, voff) do { _Pragma("unroll") for (int _i = 0; _i < 2; ++_i) \
        __builtin_amdgcn_global_load_lds((const unsigned*)((const char*)(gbase) + (voff)[_i]), (PG8_LAS unsigned*)(lds + (bufoff) + ldsw + _i * 8192), 16, 0, 0); } while (0)
#define PG8_STAGE2(bufoff, gbase, o0, o1) do { \
        __builtin_amdgcn_global_load_lds((const unsigned*)((const char*)(gbase) + (o0)), (PG8_LAS unsigned*)(lds + (bufoff) + ldsw), 16, 0, 0); \
        __builtin_amdgcn_global_load_lds((const unsigned*)((const char*)(gbase) + (o1)), (PG8_LAS unsigned*)(lds + (bufoff) + ldsw + 8192), 16, 0, 0); } while (0)
#define PG8_GOFF(dst, pm_) do { _Pragma("unroll") for (int _h = 0; _h < 2; ++_h) _Pragma("unroll") for (int _i = 0; _i < 2; ++_i) \
        dst[_h][_i] = rowoff[(pm_) * BM + _h * HALF + RA[_i]] + (unsigned)CA[_i] * 2u; } while (0)
#define PG8_LDA(dst, b, h) do { _Pragma("unroll") for (int m = 0; m < 4; ++m) _Pragma("unroll") for (int k = 0; k < 2; ++k) dst[m][k] = *(const PG8_LAS bf16x8*)(lds + PG8_SA(b, h) + aoff + m * 2048 + k * 1024); } while (0)
#define PG8_LDB(dst, b, h) do { _Pragma("unroll") for (int n = 0; n < 2; ++n) _Pragma("unroll") for (int k = 0; k < 2; ++k) dst[n][k] = *(const PG8_LAS bf16x8*)(lds + PG8_SB(b, h) + boff + n * 2048 + k * 1024); } while (0)
#define PG8_MMA(ai, bj, At, Bt) do { __builtin_amdgcn_s_setprio(1); _Pragma("unroll") for (int m = 0; m < 4; ++m) _Pragma("unroll") for (int n = 0; n < 2; ++n) _Pragma("unroll") for (int k = 0; k < 2; ++k) \
        acc[ai][bj][m][n] = __builtin_amdgcn_mfma_f32_16x16x32_bf16(Bt[n][k], At[m][k], acc[ai][bj][m][n], 0, 0, 0); __builtin_amdgcn_s_setprio(0); } while (0)
#define PG8_WAIT_V(n) asm volatile("s_waitcnt vmcnt(" #n ")" ::: "memory")
#define PG8_WAIT_L(n) asm volatile("s_waitcnt lgkmcnt(" #n ")" ::: "memory")
#define PG8_BAR __builtin_amdgcn_s_barrier()
#define PG8_SCHED __builtin_amdgcn_sched_barrier(0)
    Unit cur, nxt; int ui = 0;
    if (!S.next(0, cur)) return;
    f32x4 acc[2][2][4][2];
#pragma unroll
    for (int a = 0; a < 2; ++a)
#pragma unroll
        for (int b = 0; b < 2; ++b)
#pragma unroll
            for (int m = 0; m < 4; ++m)
#pragma unroll
                for (int n = 0; n < 2; ++n) acc[a][b][m][n] = (f32x4){0.f, 0.f, 0.f, 0.f};
    bf16x8 At[4][2], B0[2][2], B1[2][2];
    const char* cA = GATHER ? (const char*)g.A : (const char*)g.A + (size_t)cur.pm * tstep; const char* cB = (const char*)g.Bt + (size_t)cur.pn * tstep;
    unsigned vA[2][2], vN[2][2];
    if constexpr (GATHER) { PG8_GOFF(vA, 0); _Pragma("unroll") for (int _h = 0; _h < 2; ++_h) _Pragma("unroll") for (int _i = 0; _i < 2; ++_i) vN[_h][_i] = vA[_h][_i]; }
#define PG8_STA(bufoff, ptr, h, nx) do { if constexpr (GATHER) { PG8_STAGE2(bufoff, ptr, (nx) ? vN[h][0] : vA[h][0], (nx) ? vN[h][1] : vA[h][1]); } else { PG8_STAGE(bufoff, (ptr) + (h) * hstep, voffA); } } while (0)
    S.a_ready(cur);
    if constexpr (SP2) {
        PG8_STAGE(PG8_SB(0, 0), cB, voffB); PG8_STAGE(PG8_SB(0, 1), cB + hstep, voffB); PG8_STA(PG8_SA(0, 0), cA, 0, false); PG8_STA(PG8_SA(0, 1), cA, 1, false);
        if (wr == 1) PG8_BAR;
        PG8_WAIT_V(2); PG8_BAR;
        PG8_STAGE(PG8_SB(1, 0), cB + kstep, voffB); PG8_STA(PG8_SA(1, 0), cA + kstep, 0, false); PG8_STAGE(PG8_SB(1, 1), cB + hstep + kstep, voffB);
        PG8_WAIT_V(6); PG8_BAR;
    } else {
        PG8_STAGE(PG8_SB(0, 0), cB, voffB); PG8_STAGE(PG8_SA(0, 0), cA, voffA); PG8_STAGE(PG8_SB(0, 1), cB + hstep, voffB); PG8_STAGE(PG8_SA(0, 1), cA + hstep, voffA);
        if (wr == 1) PG8_BAR;
        PG8_WAIT_V(4); PG8_BAR;
        PG8_STAGE(PG8_SB(1, 0), cB + kstep, voffB); PG8_STA(PG8_SA(1, 0), cA + kstep, 0, false); PG8_STAGE(PG8_SB(1, 1), cB + hstep + kstep, voffB);
        PG8_WAIT_V(6); PG8_BAR;
    }
    for (;;) {
        const bool has_next = S.next(ui + 1, nxt);
        const char* nA = GATHER ? cA : (has_next ? (const char*)g.A + (size_t)nxt.pm * tstep : cA); const char* nB = has_next ? (const char*)g.Bt + (size_t)nxt.pn * tstep : cB;
        if constexpr (GATHER) { if (has_next) { PG8_GOFF(vN, ui + 1); } }
        for (int t = 0; t < nt; t += 2) {
            const bool last = (t == nt - 2);
            const char* a1 = cA + (size_t)(t + 1) * kstep;
            const char* a2 = last ? nA : cA + (size_t)(t + 2) * kstep; const bool nx_ = GATHER && last; const char* b2 = last ? nB : cB + (size_t)(t + 2) * kstep;
            const char* a3 = a2 + kstep; const char* b3 = b2 + kstep;
            if (last && has_next) S.a_ready(nxt);
            if constexpr (SP2) {
            PG8_LDB(B0, 0, 0); PG8_LDB(B1, 0, 1); PG8_SCHED; PG8_LDA(At, 0, 0); PG8_STA(PG8_SA(1, 1), a1, 1, false);
            PG8_WAIT_V(8); PG8_WAIT_L(0); PG8_BAR; PG8_MMA(0, 0, At, B0); PG8_MMA(0, 1, At, B1); PG8_BAR; PG8_SCHED;
            PG8_LDA(At, 0, 1); PG8_STAGE(PG8_SB(0, 0), b2, voffB); PG8_STAGE(PG8_SB(0, 1), b2 + hstep, voffB); PG8_STA(PG8_SA(0, 0), a2, 0, nx_);
            PG8_WAIT_V(8); PG8_WAIT_L(0); PG8_BAR; PG8_MMA(1, 0, At, B0); PG8_MMA(1, 1, At, B1); PG8_BAR; PG8_SCHED;
            PG8_LDB(B0, 1, 0); PG8_LDB(B1, 1, 1); PG8_SCHED; PG8_LDA(At, 1, 0); PG8_STA(PG8_SA(0, 1), a2, 1, nx_);
            PG8_WAIT_V(8); PG8_WAIT_L(0); PG8_BAR; PG8_MMA(0, 0, At, B0); PG8_MMA(0, 1, At, B1); PG8_BAR; PG8_SCHED;
            PG8_LDA(At, 1, 1); PG8_STAGE(PG8_SB(1, 0), b3, voffB); PG8_STAGE(PG8_SB(1, 1), b3 + hstep, voffB); PG8_STA(PG8_SA(1, 0), a3, 0, nx_);
            PG8_WAIT_V(8); PG8_WAIT_L(0); PG8_BAR; PG8_MMA(1, 0, At, B0); PG8_MMA(1, 1, At, B1); PG8_BAR; PG8_SCHED;
            } else {
            PG8_LDB(B0, 0, 0); PG8_SCHED; PG8_LDA(At, 0, 0); PG8_STA(PG8_SA(1, 1), a1, 1, false);
            PG8_WAIT_L(8); PG8_BAR; PG8_WAIT_L(0); PG8_MMA(0, 0, At, B0); PG8_BAR; PG8_SCHED;
            PG8_LDB(B1, 0, 1); PG8_STAGE(PG8_SB(0, 0), b2, voffB);
            PG8_BAR; PG8_WAIT_L(0); PG8_MMA(0, 1, At, B1); PG8_BAR;
            PG8_LDA(At, 0, 1); PG8_STA(PG8_SA(0, 0), a2, 0, nx_);
            PG8_BAR; PG8_WAIT_L(0); PG8_MMA(1, 0, At, B0); PG8_BAR; PG8_SCHED;
            PG8_STAGE(PG8_SB(0, 1), b2 + hstep, voffB);
            PG8_WAIT_V(6); PG8_BAR; PG8_MMA(1, 1, At, B1); PG8_BAR;
            PG8_LDB(B0, 1, 0); PG8_SCHED; PG8_LDA(At, 1, 0); PG8_STA(PG8_SA(0, 1), a2, 1, nx_);
            PG8_WAIT_L(8); PG8_BAR; PG8_WAIT_L(0); PG8_MMA(0, 0, At, B0); PG8_BAR; PG8_SCHED;
            PG8_LDB(B1, 1, 1); PG8_STAGE(PG8_SB(1, 0), b3, voffB);
            PG8_BAR; PG8_WAIT_L(0); PG8_MMA(0, 1, At, B1); PG8_BAR;
            PG8_LDA(At, 1, 1); PG8_STA(PG8_SA(1, 0), a3, 0, nx_);
            PG8_BAR; PG8_WAIT_L(0); PG8_MMA(1, 0, At, B0); PG8_BAR; PG8_SCHED;
            PG8_STAGE(PG8_SB(1, 1), b3 + hstep, voffB);
            PG8_WAIT_V(6); PG8_BAR; PG8_MMA(1, 1, At, B1); PG8_BAR;
            }
        }
        if constexpr (ALIGN_EPI) { if (wr == 0) PG8_BAR; }
        if constexpr (!Epi::AFTER_DRAIN) { E(acc, cur, wr, wc, fr, fq); S.done(cur); }
        if (!has_next) break;
#pragma unroll
        for (int a = 0; a < 2; ++a)
#pragma unroll
            for (int b = 0; b < 2; ++b)
#pragma unroll
                for (int m = 0; m < 4; ++m)
#pragma unroll
                    for (int n = 0; n < 2; ++n) acc[a][b][m][n] = (f32x4){0.f, 0.f, 0.f, 0.f};
        cur = nxt; cA = nA; cB = nB; ++ui;
        if constexpr (GATHER) { _Pragma("unroll") for (int _h = 0; _h < 2; ++_h) _Pragma("unroll") for (int _i = 0; _i < 2; ++_i) vA[_h][_i] = vN[_h][_i]; }
        if constexpr (ALIGN_EPI) { if (wr == 1) PG8_BAR; }
    }
    PG8_WAIT_V(0);
    if constexpr (!ALIGN_EPI) { if (wr == 0) PG8_BAR; }
    PG8_BAR;
    if constexpr (Epi::AFTER_DRAIN) { E.fused(acc, cur, wr, wc, fr, fq, lds, wid, lane); S.done(cur); }
#undef PG8_SA
#undef PG8_SB
#undef PG8_STAGE
#undef PG8_STAGE2
#undef PG8_GOFF
#undef PG8_STA
#undef PG8_LDA
#undef PG8_LDB
#undef PG8_MMA
#undef PG8_WAIT_V
#undef PG8_WAIT_L
#undef PG8_BAR
#undef PG8_SCHED
}
}

namespace pg8 {
struct EpiInproj {
  static constexpr bool PERM = true, AFTER_DRAIN = false;
  bf16_t* QAb; bf16_t* KAb; bf16_t* VAb;
  float* QB; bf16_t* QBb; bf16_t* KBb; bf16_t* VB; float* KMP;
  bf16_t* P2;
  const float* aqg; const float* akg; const float* bqg; const float* bkg; float c2;
  __device__ __forceinline__ static u32x4 pk8(const f32x4& a, const f32x4& b) { u32x4 w; w.x = cvt_pk_bf16(a[0], a[1]); w.y = cvt_pk_bf16(a[2], a[3]); w.z = cvt_pk_bf16(b[0], b[1]); w.w = cvt_pk_bf16(b[2], b[3]); return w; }
  __device__ __forceinline__ void operator()(const f32x4 (&acc)[2][2][4][2], const Unit& u, int wr, int wc, int fr, int fq) const {
    const int row0 = u.pm * BM + wr * 64 + fr, t = u.pn;
    if (t >= 6) {
      const int col0 = (t - 6) * BM + wc * 32 + 8 * fq;
#pragma unroll
      for (int ai = 0; ai < 2; ++ai)
#pragma unroll
        for (int m = 0; m < 4; ++m) {
          bf16_t* rp = P2 + (size_t)(row0 + ai * HALF + m * 16) * 1296;
#pragma unroll
          for (int bj = 0; bj < 2; ++bj) { const int col = col0 + bj * HALF; if (col < 1296) *(u32x4*)(rp + col) = pk8(acc[ai][bj][m][0], acc[ai][bj][m][1]); }
        }
    } else if (t <= 1) {
      const float* gp = (t == 0 ? aqg : akg) + 8 * fq;
      const f32x4 g0 = *(const f32x4*)gp, g1 = *(const f32x4*)(gp + 4);
      bf16_t* dst = t == 0 ? QAb : KAb;
      const float sc = t == 0 ? c2 : 1.f;
#pragma unroll
      for (int ai = 0; ai < 2; ++ai)
#pragma unroll
        for (int m = 0; m < 4; ++m)
#pragma unroll
          for (int bj = 0; bj < 2; ++bj) {
            const f32x4 v0 = acc[ai][bj][m][0], v1 = acc[ai][bj][m][1];
            float ss = (v0[0] * v0[0] + v0[1] * v0[1]) + (v0[2] * v0[2] + v0[3] * v0[3]) + (v1[0] * v1[0] + v1[1] * v1[1]) + (v1[2] * v1[2] + v1[3] * v1[3]);
            ss += __shfl_xor(ss, 16); ss += __shfl_xor(ss, 32);
            const float r = rsqrtf(ss * (1.f / 32.f) + 1e-6f) * sc;
            bf16_t* o = dst + (size_t)(row0 + ai * HALF + m * 16) * 512 + (bj * 4 + wc) * 64 + 8 * fq;
            *(u32x4*)o = pk8(v0 * g0 * r, v1 * g1 * r);
          }
    } else if (t == 2) {
#pragma unroll
      for (int ai = 0; ai < 2; ++ai)
#pragma unroll
        for (int m = 0; m < 4; ++m)
#pragma unroll
          for (int bj = 0; bj < 2; ++bj) {
            const u32x4 w = pk8(acc[ai][bj][m][0], acc[ai][bj][m][1]);
            *(u32x4*)(VAb + (size_t)(row0 + ai * HALF + m * 16) * 256 + bj * HALF + wc * 32 + 8 * fq) = w;
          }
    } else if (t == 5) {
#pragma unroll
      for (int ai = 0; ai < 2; ++ai)
#pragma unroll
        for (int m = 0; m < 4; ++m)
#pragma unroll
          for (int bj = 0; bj < 2; ++bj)
            *(u32x4*)(VB + (size_t)(row0 + ai * HALF + m * 16) * 256 + bj * HALF + wc * 32 + 8 * fq) = pk8(acc[ai][bj][m][0], acc[ai][bj][m][1]);
    } else {
      const float* gp = (t == 3 ? bqg : bkg) + 8 * fq;
      f32x4 g[2][2];
#pragma unroll
      for (int bj = 0; bj < 2; ++bj) { g[bj][0] = *(const f32x4*)(gp + 32 * bj); g[bj][1] = *(const f32x4*)(gp + 32 * bj + 4); }
#pragma unroll
      for (int ai = 0; ai < 2; ++ai) {
        f32x4 cs[2][2];
#pragma unroll
        for (int bj = 0; bj < 2; ++bj) { cs[bj][0] = (f32x4){0.f, 0.f, 0.f, 0.f}; cs[bj][1] = (f32x4){0.f, 0.f, 0.f, 0.f}; }
#pragma unroll
        for (int m = 0; m < 4; ++m) {
          float ss = 0.f;
#pragma unroll
          for (int bj = 0; bj < 2; ++bj)
#pragma unroll
            for (int n = 0; n < 2; ++n) { const f32x4 v = acc[ai][bj][m][n]; ss += (v[0] * v[0] + v[1] * v[1]) + (v[2] * v[2] + v[3] * v[3]); }
          ss += __shfl_xor(ss, 16); ss += __shfl_xor(ss, 32);
          const float r = rsqrtf(ss * (1.f / 64.f) + 1e-6f);
          const size_t ro = (size_t)(row0 + ai * HALF + m * 16) * 256 + wc * 64 + 8 * fq;
#pragma unroll
          for (int bj = 0; bj < 2; ++bj) {
            const f32x4 n0 = acc[ai][bj][m][0] * g[bj][0] * r, n1 = acc[ai][bj][m][1] * g[bj][1] * r;
            if (t == 3) {
              *(f32x4*)(QB + ro + 32 * bj) = n0; *(f32x4*)(QB + ro + 32 * bj + 4) = n1;
              const float qs = 0.125f * 1.4426950408889634f;
              *(u32x4*)(QBb + ro + 32 * bj) = pk8(n0 * qs, n1 * qs);
            } else {
              *(u32x4*)(KBb + ro + 32 * bj) = pk8(n0, n1);
              cs[bj][0] += n0; cs[bj][1] += n1;
            }
          }
        }
        if (t == 4) {
#pragma unroll
          for (int bj = 0; bj < 2; ++bj)
#pragma unroll
            for (int n = 0; n < 2; ++n)
#pragma unroll
              for (int j = 0; j < 4; ++j) { float v = cs[bj][n][j]; v += __shfl_xor(v, 1); v += __shfl_xor(v, 2); v += __shfl_xor(v, 4); v += __shfl_xor(v, 8); cs[bj][n][j] = v; }
          if (fr == 0) {
            float* kp = KMP + (size_t)(u.pm * 4 + ai * 2 + wr) * 256 + wc * 64 + 8 * fq;
#pragma unroll
            for (int bj = 0; bj < 2; ++bj) { *(f32x4*)(kp + 32 * bj) = cs[bj][0]; *(f32x4*)(kp + 32 * bj + 4) = cs[bj][1]; }
          }
        }
      }
    }
  }
};
struct EpiOutproj {
  static constexpr bool PERM = true, AFTER_DRAIN = false;
  const float* xin32; const bf16_t* xin16; const float* g1; bf16_t* X1;
  __device__ __forceinline__ void operator()(const f32x4 (&acc)[2][2][4][2], const Unit& u, int wr, int wc, int fr, int fq) const {
    const int row0 = u.pm * BM + wr * 64 + fr, col0 = u.pn * BM + wc * 32 + 8 * fq;
#pragma unroll
    for (int bj = 0; bj < 2; ++bj) {
      const int col = col0 + bj * HALF;
      const f32x4 g0 = *(const f32x4*)(g1 + col), g1v = *(const f32x4*)(g1 + col + 4);
#pragma unroll
      for (int ai = 0; ai < 2; ++ai)
#pragma unroll
        for (int m = 0; m < 4; ++m) {
          const size_t off = (size_t)(row0 + ai * HALF + m * 16) * 1024 + col;
          f32x4 x0, x1;
          if (xin32) { x0 = *(const f32x4*)(xin32 + off); x1 = *(const f32x4*)(xin32 + off + 4); }
          else {
            const u32x4 w = *(const u32x4*)(xin16 + off);
            x0 = (f32x4){__builtin_bit_cast(float, w.x << 16), __builtin_bit_cast(float, w.x & 0xffff0000u), __builtin_bit_cast(float, w.y << 16), __builtin_bit_cast(float, w.y & 0xffff0000u)};
            x1 = (f32x4){__builtin_bit_cast(float, w.z << 16), __builtin_bit_cast(float, w.z & 0xffff0000u), __builtin_bit_cast(float, w.w << 16), __builtin_bit_cast(float, w.w & 0xffff0000u)};
          }
          const f32x4 v0 = x0 + g0 * acc[ai][bj][m][0], v1 = x1 + g1v * acc[ai][bj][m][1];
          u32x4 o; o.x = cvt_pk_bf16(v0[0], v0[1]); o.y = cvt_pk_bf16(v0[2], v0[3]); o.z = cvt_pk_bf16(v1[0], v1[1]); o.w = cvt_pk_bf16(v1[2], v1[3]);
          *(u32x4*)(X1 + off) = o;
        }
    }
  }
};
struct EpiUp {
  static constexpr bool PERM = true, AFTER_DRAIN = false;
  __amdgpu_buffer_rsrc_t act;
  const float* bup;
  __device__ __forceinline__ void operator()(const f32x4 (&acc)[2][2][4][2], const Unit& u, int wr, int wc, int fr, int fq) const {
    const int e = u.pn >> 3, j = u.pn & 7;
    const int row0 = u.pm * BM + wr * 64 + fr, col0 = j * 128 + wc * 32 + 8 * fq;
    const float* bg = bup + (size_t)e * 2048 + col0; const float* bl = bg + 1024;
    f32x4 bgv[2], blv[2];
#pragma unroll
    for (int n = 0; n < 2; ++n) { bgv[n] = *(const f32x4*)(bg + 4 * n); blv[n] = *(const f32x4*)(bl + 4 * n); }
#pragma unroll
    for (int ai = 0; ai < 2; ++ai)
#pragma unroll
      for (int m = 0; m < 4; ++m) {
        float o[8];
#pragma unroll
        for (int n = 0; n < 2; ++n) {
          const f32x4 gg = acc[ai][0][m][n] + bgv[n], ll = acc[ai][1][m][n] + blv[n];
#pragma unroll
          for (int c = 0; c < 4; ++c) {
            float g = fminf(gg[c], 7.f), lin = fminf(fmaxf(ll[c], -7.f), 7.f);
            float glu = g * __builtin_amdgcn_rcpf(1.f + __builtin_amdgcn_exp2f(-1.702f * 1.4426950408889634f * g));
            o[n * 4 + c] = (lin + 1.f) * glu;
          }
        }
        u32x4 w; w.x = cvt_pk_bf16(o[0], o[1]); w.y = cvt_pk_bf16(o[2], o[3]); w.z = cvt_pk_bf16(o[4], o[5]); w.w = cvt_pk_bf16(o[6], o[7]);
        __builtin_amdgcn_raw_buffer_store_b128(w, act, (unsigned)(((row0 + ai * HALF + m * 16) * 1024 + col0) * 2), 0,   16);
      }
  }
};
struct EpiDown {
  static constexpr bool PERM = true, AFTER_DRAIN = false;
  bf16_t* YS; const float* bdn;
  __device__ __forceinline__ void operator()(const f32x4 (&acc)[2][2][4][2], const Unit& u, int wr, int wc, int fr, int fq) const {
    const int e = u.pn >> 2, j = u.pn & 3;
    const int row0 = u.pm * BM + wr * 64 + fr, col0 = j * 256 + wc * 32 + 8 * fq;
    f32x4 bv[2][2];
#pragma unroll
    for (int bj = 0; bj < 2; ++bj)
#pragma unroll
      for (int n = 0; n < 2; ++n) bv[bj][n] = *(const f32x4*)(bdn + (size_t)e * 1024 + col0 + bj * HALF + 4 * n);
#pragma unroll
    for (int ai = 0; ai < 2; ++ai)
#pragma unroll
      for (int m = 0; m < 4; ++m) {
        bf16_t* rp = YS + (size_t)(row0 + ai * HALF + m * 16) * 1024 + col0;
#pragma unroll
        for (int bj = 0; bj < 2; ++bj) {
          const f32x4 v0 = acc[ai][bj][m][0] + bv[bj][0], v1 = acc[ai][bj][m][1] + bv[bj][1];
          u32x4 w; w.x = cvt_pk_bf16(v0[0], v0[1]); w.y = cvt_pk_bf16(v0[2], v0[3]); w.z = cvt_pk_bf16(v1[0], v1[1]); w.w = cvt_pk_bf16(v1[2], v1[3]);
          *(u32x4*)(rp + bj * HALF) = w;
        }
      }
  }
};
#ifndef MOE_ORDER
#define MOE_ORDER 0
#endif
template <int NJ> __device__ __forceinline__ void moe_build_units(const int* cnt, int G, int c, int* tab, int tid, bool rotate = false) {
  if (tid < 24) {
    int pm = -1, pn = -1, ex = 0, r0 = 0;
    {
      int cc = c;
      if (rotate) {
        int T = 0; for (int e = 0; e < 32; ++e) T += (cnt[e] + 255) >> 8;
        int r8 = 8 * T; while (r8 >= G) r8 -= G;
        cc = c - r8; if (cc < 0) cc += G;
      }
      const long L = (long)tid * G + cc; const int t = (int)(L / NJ);
      int acc = 0;
      for (int e = 0; e < 32; ++e) {
        const int ne = (cnt[e] + 255) >> 8;
        if (pm < 0 && t < acc + ne) { pm = t; pn = e * NJ + (int)(L % NJ); ex = e; r0 = (t - acc) << 8; }
        acc += ne;
      }
    }
    tab[4 * tid] = pm; tab[4 * tid + 1] = pn; tab[4 * tid + 2] = ex; tab[4 * tid + 3] = r0;
  }
  __syncthreads();
}
__device__ __forceinline__ void moe_build_rowoff(const int* elist, const int* cnt, const int* tab, unsigned* rowoff, int tid) {
  for (int i = tid; i < 13 * 256; i += 512) {
    const int u = i >> 8, pm = tab[4 * u];
    unsigned v = 0u;
    if (pm >= 0) { const int e = tab[4 * u + 2], r = tab[4 * u + 3] + (i & 255); if (r < cnt[e]) v = (unsigned)elist[e * 16384 + r] * 2048u; }
    rowoff[i] = v;
  }
  __syncthreads();
}
template <int NJ, int MODE = 0> struct MoeOrder {
  const int* tab;
  unsigned* rdy;
  __device__ __forceinline__ bool next(int i, Unit& u) const {
    if (i >= 24) return false;
    const int pm = tab[4 * i]; if (pm < 0) return false;
    u.pm = pm; u.pn = tab[4 * i + 1]; return true;
  }
  __device__ __forceinline__ void a_ready(const Unit& u) const {
    if constexpr (MODE == 2) {
      if (threadIdx.x < 64) {
        unsigned polls = 0;
        while ((unsigned)__builtin_amdgcn_readfirstlane(__hip_atomic_load(rdy + u.pm, __ATOMIC_RELAXED, __HIP_MEMORY_SCOPE_AGENT)) < 64u) {
          if (++polls > (1u << 22)) break;
          __builtin_amdgcn_s_sleep(2);
        }
        __builtin_amdgcn_fence(__ATOMIC_ACQUIRE, "agent");
        asm volatile("s_waitcnt vmcnt(0)" ::: "memory");
      }
      asm volatile("" ::: "memory"); __builtin_amdgcn_s_barrier(); asm volatile("" ::: "memory");
    }
  }
  __device__ __forceinline__ void done(const Unit& u) const {
    if constexpr (MODE == 1) {
      asm volatile("s_waitcnt vmcnt(0)" ::: "memory");
      if ((threadIdx.x & 63) == 0) __hip_atomic_fetch_add(rdy + u.pm, 1u, __ATOMIC_RELAXED, __HIP_MEMORY_SCOPE_AGENT);
    }
  }
};
}

#include <hip/hip_bf16.h>
#include <cmath>
namespace attn_body {
using bf16=__hip_bfloat16;
using bf16x8=__attribute__((ext_vector_type(8)))short;
using s16x4=__attribute__((ext_vector_type(4)))short;
using f32x16=__attribute__((ext_vector_type(16)))float;
using u32x4=__attribute__((ext_vector_type(4)))unsigned;
constexpr int BATCH=1,NHEAD=8,SEQ=16384,D=64,DM=NHEAD*D;
constexpr int NW=8,QBLK=32,QB=QBLK*NW,KVBLK=64,NQB=SEQ/QB;
constexpr int ATTN_PITCH=DM, ATTN_UNIT_ROWS=QB;
__device__ __forceinline__ int crow(int r,int hi){return (r&3)+8*(r>>2)+4*hi;}
#define SBAR() __builtin_amdgcn_sched_barrier(0)
__device__ __forceinline__ void cmask(f32x16&p0,f32x16&p1,int jb,int qrel,int hi){
  const float NEG=-INFINITY; int kb=64*jb+4*hi;
  #pragma unroll
  for(int r=0;r<16;++r){int kv=kb+(r&3)+8*(r>>2); if(kv>qrel)p0[r]=NEG; if(kv+32>qrel)p1[r]=NEG;}
}

constexpr int NSLOT=3, SLOTB=8192;
constexpr int LDS_K=0, LDS_V=NSLOT*SLOTB, LDS_WS=2*NSLOT*SLOTB, LDS_OST=LDS_WS+NW*64*4, LDS_BYTES=LDS_OST+NW*4096;
constexpr float C2=0.17677669529663687f*1.4426950408889634f;
__device__ __forceinline__ void glds16(const void*gsrc,unsigned lds_dst){unsigned keep;
  asm volatile("s_mov_b32 %0, m0\n\ts_mov_b32 m0, %2\n\ts_nop 0\n\tglobal_load_lds_dwordx4 %1, off\n\ts_mov_b32 m0, %0":"=&s"(keep):"v"(gsrc),"s"(lds_dst):"memory");}
__device__ __forceinline__ float max3f(float a,float b,float c){float r;asm("v_max3_f32 %0, %1, %2, %3":"=v"(r):"v"(a),"v"(b),"v"(c));return r;}
__device__ __forceinline__ float max2f(float a,float b){float r;asm("v_max_f32_e32 %0, %1, %2":"=v"(r):"v"(a),"v"(b));return r;}
__device__ __forceinline__ float fadd_s(float a,float b){float r;asm("v_add_f32_e32 %0, %1, %2":"=v"(r):"v"(a),"v"(b));return r;}
__device__ __forceinline__ float fsub_s(float a,float b){float r;asm("v_sub_f32_e32 %0, %1, %2":"=v"(r):"v"(a),"v"(b));return r;}
typedef float f32x2_t __attribute__((ext_vector_type(2))); typedef __bf16 bf16x2_t __attribute__((ext_vector_type(2)));
__device__ __forceinline__ unsigned cvtpk_s(float lo,float hi){f32x2_t v={lo,hi};bf16x2_t b=__builtin_convertvector(v,bf16x2_t);return __builtin_bit_cast(unsigned,b);}
#define WAIT_BAR(N) asm volatile("s_waitcnt vmcnt(" #N ") lgkmcnt(0)\n\ts_barrier":::"memory")

__device__ __forceinline__ void qkt(f32x16&p0,f32x16&p1,const char*Kslot,const bf16x8*qr,const f32x16&negm,int r32,int hi){
  const char*kb=Kslot+hi*1024+r32*16;
  #pragma unroll
  for(int d0=0;d0<2;++d0){
    const bf16x8 b0=*reinterpret_cast<const bf16x8*>(kb+d0*2048);
    const bf16x8 b1=*reinterpret_cast<const bf16x8*>(kb+d0*2048+512);
    if(d0==0){p0=__builtin_amdgcn_mfma_f32_32x32x16_bf16(b0,qr[0],negm,0,0,0);p1=__builtin_amdgcn_mfma_f32_32x32x16_bf16(b1,qr[0],negm,0,0,0);}
    else{p0=__builtin_amdgcn_mfma_f32_32x32x16_bf16(b0,qr[d0],p0,0,0,0);p1=__builtin_amdgcn_mfma_f32_32x32x16_bf16(b1,qr[d0],p1,0,0,0);}}
}
typedef __attribute__((address_space(3))) const char* lds_cptr;
typedef short v4i16_t __attribute__((ext_vector_type(4)));
__device__ __forceinline__ void kload8(bf16x8*kf,lds_cptr kp){
  kf[0]=*(const __attribute__((address_space(3))) bf16x8*)(kp);      kf[1]=*(const __attribute__((address_space(3))) bf16x8*)(kp+512);
  kf[2]=*(const __attribute__((address_space(3))) bf16x8*)(kp+2048); kf[3]=*(const __attribute__((address_space(3))) bf16x8*)(kp+2560);
  kf[4]=*(const __attribute__((address_space(3))) bf16x8*)(kp+4096); kf[5]=*(const __attribute__((address_space(3))) bf16x8*)(kp+4608);
  kf[6]=*(const __attribute__((address_space(3))) bf16x8*)(kp+6144); kf[7]=*(const __attribute__((address_space(3))) bf16x8*)(kp+6656);
}
__device__ __forceinline__ void kload2(bf16x8*kf,lds_cptr kp,int j){ kf[2*j]=*(const __attribute__((address_space(3))) bf16x8*)(kp+j*2048); kf[2*j+1]=*(const __attribute__((address_space(3))) bf16x8*)(kp+j*2048+512); }
__device__ __forceinline__ s16x4 vtr(lds_cptr p){ return __builtin_bit_cast(s16x4,__builtin_amdgcn_ds_read_tr16_b64_v4i16((__attribute__((address_space(3))) v4i16_t*)p)); }
__device__ __forceinline__ float rowmax(const f32x16&p0,const f32x16&p1){
  float a=max3f(p0[0],p0[1],p1[0]),b=max3f(p0[2],p0[3],p1[1]);a=max3f(a,p1[2],p1[3]);
  #pragma unroll
  for(int r=4;r<16;r+=4){a=max3f(a,p0[r],p0[r+1]);b=max3f(b,p0[r+2],p0[r+3]);a=max3f(a,p1[r],p1[r+1]);b=max3f(b,p1[r+2],p1[r+3]);}
  const float m=max2f(a,b);
  auto rr=__builtin_amdgcn_permlane32_swap(__float_as_uint(m),__float_as_uint(m),false,false);
  return max2f(__uint_as_float(rr[0]),__uint_as_float(rr[1]));
}
__device__ __forceinline__ void pv(f32x16*o,int vb,bf16x8 pa0,bf16x8 pa1,bf16x8 pa2,bf16x8 pa3){
  #pragma unroll
  for(int d0=0;d0<2;++d0){s16x4 lo[4],hi[4];
    #pragma unroll
    for(int ks=0;ks<4;++ks){
      asm volatile("ds_read_b64_tr_b16 %0,%1 offset:%c2":"=&v"(lo[ks]):"v"(vb),"i"(d0*4096+ks*1024):"memory");
      asm volatile("ds_read_b64_tr_b16 %0,%1 offset:%c2":"=&v"(hi[ks]):"v"(vb),"i"(d0*4096+ks*1024+512):"memory");}
    asm volatile("s_waitcnt lgkmcnt(0)":::"memory");SBAR();
    #define PK(k) (bf16x8){lo[k][0],lo[k][1],lo[k][2],lo[k][3],hi[k][0],hi[k][1],hi[k][2],hi[k][3]}
    o[d0]=__builtin_amdgcn_mfma_f32_32x32x16_bf16(pa0,PK(0),o[d0],0,0,0);
    o[d0]=__builtin_amdgcn_mfma_f32_32x32x16_bf16(pa1,PK(1),o[d0],0,0,0);
    o[d0]=__builtin_amdgcn_mfma_f32_32x32x16_bf16(pa2,PK(2),o[d0],0,0,0);
    o[d0]=__builtin_amdgcn_mfma_f32_32x32x16_bf16(pa3,PK(3),o[d0],0,0,0);
    #undef PK
  }
}

#ifndef ATTN_STORE16
#define ATTN_STORE16(p,v) (*(u32x4*)(p)=(v))
#endif
template<int THRL> __device__ __forceinline__ void attn_unit(int b,int h,int qb,const bf16*Q,const bf16*__restrict__ K,const bf16*__restrict__ V,bf16*O,char*shm,const bf16*ATTN_ZERO16){
  const int tid=tidx(),lane=tid&63,r32=lane&31,hi=lane>>5; const int wid=__builtin_amdgcn_readfirstlane(tid>>6);
  const long rowbase=(long)b*SEQ; const int q0=qb*QB;
  const bf16*Qw=Q+(rowbase+q0+wid*QBLK)*DM+h*D;
  constexpr int VP=DM/2;
  const bf16*Kh=K+rowbase*DM+h*D,*Vh=V+rowbase*VP+(h>>1)*D;
  const unsigned lds0=(unsigned)(uintptr_t)shm;
  float*wsf=(float*)(shm+LDS_WS)+wid*64;
  const bf16*ksrc=(wid<4)?Kh+(long)lane*DM+wid*8:ATTN_ZERO16; const long kstep_=(wid<4)?(long)KVBLK*DM:0L;
  const bf16*vsrc=Vh+(long)(16*(wid&3)+(lane>>2))*VP+(wid>>2)*32+(lane&3)*8;
  const unsigned kdst=lds0+LDS_K+wid*1024, vdst=lds0+LDS_V+wid*1024;
  #define DMA_K(t,slot) glds16(ksrc+(long)(t)*kstep_,(unsigned)__builtin_amdgcn_readfirstlane(kdst+(slot)))
  #define DMA_V(t,slot) glds16(vsrc+(long)(t)*KVBLK*VP,(unsigned)__builtin_amdgcn_readfirstlane(vdst+(slot)))
  const int vb0=(int)(lds0+LDS_V)+((lane>>4)&1)*32+(lane&3)*8+(4*hi+((lane&15)>>2))*64;
  const char*Kbase=shm+LDS_K; bf16x8 kf[8];
  const lds_cptr shm3=(lds_cptr)shm; const lds_cptr kp0=shm3+LDS_K+hi*1024+r32*16; const lds_cptr vp0=shm3+LDS_V+((lane>>4)&1)*32+(lane&3)*8+(4*hi+((lane&15)>>2))*64;
  const int NT=(q0+QB)/KVBLK;
  DMA_K(0,0);DMA_V(0,0);DMA_K(1,SLOTB);
  bf16x8 qr[4];
  #pragma unroll
  for(int d0=0;d0<4;++d0)qr[d0]=*reinterpret_cast<const bf16x8*>(&Qw[(long)r32*DM+d0*16+hi*8]);
  float mhat=0.f,l_reg=0.f;f32x16 o[2];o[0]=f32x16{};o[1]=f32x16{};f32x16 negm=f32x16{};asm volatile("":"+v"(negm));
  const int qrel=wid*QBLK+r32;
  #define CMASK(P0,P1,t) do{int jb_=(t)-(NT-4); if(jb_>=0)cmask(P0,P1,jb_,qrel,hi);}while(0)
  bool resc=false;
  #define START(P0,P1) do{ const float rm=rowmax(P0,P1); resc=false; \
    { const float dl=rm; mhat=fadd_s(mhat,dl); \
      _Pragma("unroll") for(int r=0;r<16;++r){P0[r]=fsub_s(P0[r],dl);P1[r]=fsub_s(P1[r],dl);} \
      _Pragma("unroll") for(int r=0;r<16;++r)negm[r]=-mhat; asm volatile("":"+v"(negm)); } \
    _Pragma("unroll") for(int r=0;r<16;++r)P0[r]=__builtin_amdgcn_exp2f(P0[r]); }while(0)
  #define RESC() do{ if(resc){ asm volatile("s_waitcnt lgkmcnt(0)":::"memory"); \
      _Pragma("unroll") for(int d_=0;d_<2;++d_) _Pragma("unroll") for(int r=0;r<16;++r)o[d_][r]*=wsf[crow(r,hi)]; } }while(0)
  f32x16 pA0,pA1,pB0,pB1;
  int sl_prev=0,sl_cur=0,sl_next=SLOTB;
  #define ROT() do{sl_prev=sl_cur;sl_cur=sl_next;sl_next=(sl_next==(NSLOT-1)*SLOTB)?0:sl_next+SLOTB;}while(0)
  DMA_K(2,2*SLOTB);
  WAIT_BAR(3);
  qkt(pA0,pA1,Kbase,qr,negm,r32,hi);asm volatile("s_nop 15\n\ts_nop 7":"+v"(pA0),"+v"(pA1));CMASK(pA0,pA1,0);
  START(pA0,pA1);
  _Pragma("unroll") for(int r=0;r<16;++r)pA1[r]=__builtin_amdgcn_exp2f(pA1[r]);
  WAIT_BAR(0);
  DMA_K(3,0);DMA_V(1,SLOTB);
  ROT();
  kload8(kf,kp0+sl_cur);
  WAIT_BAR(2);
  s16x4 vlo[8],vhi[8]; u32x4 pw0,pw1,pw2,pw3;
  #define PKW(P,B) cvtpk_s(P[B],P[B+1])
  #define PAF(k) __builtin_bit_cast(bf16x8,pw##k)
  #define VFR(i) (bf16x8){vlo[i][0],vlo[i][1],vlo[i][2],vlo[i][3],vhi[i][0],vhi[i][1],vhi[i][2],vhi[i][3]}
  #define PIN(x) asm volatile("":"+v"(x))
  #define MX3(a,b,c) __builtin_fmaxf(__builtin_fmaxf((a),(b)),(c))
  #define GAPA(MF,A0,A1,A2,A3,W0,W1,PW) do{ MF; sacc+=A0; sacc+=A1; sacc+=A2; sacc+=A3; PIN(sacc); W0; W1; PIN(PW); SBAR(); }while(0)
  #define EX(v) __builtin_amdgcn_exp2f(v)
  #define GAPB(MF,X,B) do{ MF; X[B]=EX(X[B]); X[B+1]=EX(X[B+1]); X[B+2]=EX(X[B+2]); X[B+3]=EX(X[B+3]); PIN(X); SBAR(); }while(0)
  #define VRD(i) do{ vlo[i]=vtr(vp_+(((i)>>2)*4096+((i)&3)*1024)); vhi[i]=vtr(vp_+(((i)>>2)*4096+((i)&3)*1024+512)); }while(0)
  #define KRD(G,j) do{ if(G){ kload2(kf,kp0+sl_next,j); SBAR(); } }while(0)
  #define STEP(C0,C1,P0,P1,t,GK,GV,GL) do{ SBAR(); \
    const lds_cptr vp_=vp0+sl_prev; \
    VRD(0); SBAR(); float sacc=(P0[0]+P0[1]); \
    GAPA(C0=__builtin_amdgcn_mfma_f32_32x32x16_bf16(kf[0],qr[0],negm,0,0,0), P0[2],P0[3],P0[4],P0[5],     pw0[0]=PKW(P0,0), pw0[1]=PKW(P0,2), pw0); \
    VRD(4); SBAR(); GAPA(C1=__builtin_amdgcn_mfma_f32_32x32x16_bf16(kf[1],qr[0],negm,0,0,0), P0[6],P0[7],P0[8],P0[9],     pw0[2]=PKW(P0,4), pw0[3]=PKW(P0,6), pw0); \
    VRD(1); SBAR(); GAPA(C0=__builtin_amdgcn_mfma_f32_32x32x16_bf16(kf[2],qr[1],C0,0,0,0),   P0[10],P0[11],P0[12],P0[13], pw1[0]=PKW(P0,8), pw1[1]=PKW(P0,10), pw1); \
    VRD(5); SBAR(); GAPA(C1=__builtin_amdgcn_mfma_f32_32x32x16_bf16(kf[3],qr[1],C1,0,0,0),   P0[14],P0[15],P1[0],P1[1],   pw1[2]=PKW(P0,12),pw1[3]=PKW(P0,14), pw1); \
    VRD(2); SBAR(); GAPA((void)0,   P1[2],P1[3],P1[4],P1[5],     pw2[0]=PKW(P1,0), pw2[1]=PKW(P1,2), pw2); \
    VRD(6); SBAR(); GAPA((void)0,   P1[6],P1[7],P1[8],P1[9],     pw2[2]=PKW(P1,4), pw2[3]=PKW(P1,6), pw2); \
    VRD(3); SBAR(); GAPA((void)0,   P1[10],P1[11],P1[12],P1[13], pw3[0]=PKW(P1,8), pw3[1]=PKW(P1,10), pw3); \
    VRD(7); SBAR(); GAPA((void)0,   P1[14],P1[15],0.f,0.f,       pw3[2]=PKW(P1,12),pw3[3]=PKW(P1,14), pw3); \
    l_reg+=sacc; \
    if(GK){DMA_K((t)+3,sl_cur);} if(GV){DMA_V((t)+1,sl_next);} \
    CMASK(C0,C1,t); \
    { float a=MX3(C0[0],C0[1],C1[0]),b=MX3(C0[2],C0[3],C1[1]); a=MX3(a,C1[2],C1[3]); \
      _Pragma("unroll") for(int r=4;r<16;r+=4){a=MX3(a,C0[r],C0[r+1]);b=MX3(b,C0[r+2],C0[r+3]);a=MX3(a,C1[r],C1[r+1]);b=MX3(b,C1[r+2],C1[r+3]);} \
      float rm=__builtin_fmaxf(a,b); { auto rr=__builtin_amdgcn_permlane32_swap(__float_as_uint(rm),__float_as_uint(rm),false,false); rm=__builtin_fmaxf(__uint_as_float(rr[0]),__uint_as_float(rr[1])); } \
      resc=false; \
      if(__builtin_expect(__any(rm>(float)THRL),0)){ const float dl=__builtin_fmaxf(rm,0.f); mhat+=dl; \
        _Pragma("unroll") for(int r=0;r<16;++r){C0[r]-=dl;C1[r]-=dl;} \
        _Pragma("unroll") for(int r=0;r<16;++r)negm[r]=-mhat; asm volatile("":"+v"(negm)); \
        const float f=__builtin_amdgcn_exp2f(-dl); l_reg*=f; if(hi==0)wsf[r32]=f; resc=true; } } \
    SBAR(); \
    GAPB(o[0]=__builtin_amdgcn_mfma_f32_32x32x16_bf16(PAF(0),VFR(0),o[0],0,0,0), C0,0); \
    GAPB(o[1]=__builtin_amdgcn_mfma_f32_32x32x16_bf16(PAF(0),VFR(4),o[1],0,0,0), C0,4); \
    KRD(GL,0); GAPB(o[0]=__builtin_amdgcn_mfma_f32_32x32x16_bf16(PAF(1),VFR(1),o[0],0,0,0), C0,8); \
    KRD(GL,1); GAPB(o[1]=__builtin_amdgcn_mfma_f32_32x32x16_bf16(PAF(1),VFR(5),o[1],0,0,0), C0,12); \
    KRD(GL,2); GAPB(o[0]=__builtin_amdgcn_mfma_f32_32x32x16_bf16(PAF(2),VFR(2),o[0],0,0,0), C1,0); \
    KRD(GL,3); GAPB(o[1]=__builtin_amdgcn_mfma_f32_32x32x16_bf16(PAF(2),VFR(6),o[1],0,0,0), C1,4); \
    GAPB(o[0]=__builtin_amdgcn_mfma_f32_32x32x16_bf16(PAF(3),VFR(3),o[0],0,0,0), C1,8); \
    GAPB(o[1]=__builtin_amdgcn_mfma_f32_32x32x16_bf16(PAF(3),VFR(7),o[1],0,0,0), C1,12); \
    }while(0)
  int t=1;
  #undef CMASK
  #define CMASK(P0,P1,t) do{}while(0)
  for(;t+5<NT;t+=2){
    STEP(pB0,pB1,pA0,pA1,t,true,true,true);     WAIT_BAR(2); RESC(); ROT();
    STEP(pA0,pA1,pB0,pB1,t+1,true,true,true);   WAIT_BAR(2); RESC(); ROT();
  }
  #undef CMASK
  #define CMASK(P0,P1,t) do{int jb_=(t)-(NT-4); if(jb_>=0)cmask(P0,P1,jb_,qrel,hi);}while(0)
  #define ENDW(tt) do{ if((tt)+3<NT){WAIT_BAR(2);} else if((tt)+2<NT){WAIT_BAR(1);} else {WAIT_BAR(0);} }while(0)
  for(;t+1<NT;t+=2){
    STEP(pB0,pB1,pA0,pA1,t,(t+3<NT),(t+1<NT),(t+1<NT));       ENDW(t);   RESC(); ROT();
    STEP(pA0,pA1,pB0,pB1,t+1,(t+4<NT),(t+2<NT),(t+2<NT));     ENDW(t+1); RESC(); ROT();
  }
  STEP(pB0,pB1,pA0,pA1,NT-1,false,false,false); RESC();
  { float sacc=pB0[0]+pB0[1]; _Pragma("unroll") for(int r=2;r<16;++r)sacc+=pB0[r]; _Pragma("unroll") for(int r=0;r<16;++r)sacc+=pB1[r]; l_reg+=sacc;
    pw0=(u32x4){PKW(pB0,0),PKW(pB0,2),PKW(pB0,4),PKW(pB0,6)};pw1=(u32x4){PKW(pB0,8),PKW(pB0,10),PKW(pB0,12),PKW(pB0,14)};pw2=(u32x4){PKW(pB1,0),PKW(pB1,2),PKW(pB1,4),PKW(pB1,6)};pw3=(u32x4){PKW(pB1,8),PKW(pB1,10),PKW(pB1,12),PKW(pB1,14)};
    SBAR(); pv(o,vb0+sl_cur,PAF(0),PAF(1),PAF(2),PAF(3)); }
  #undef PKW
  #undef PAF
  #undef VFR
  #undef PIN
  #undef MX3
  #undef GAPA
  #undef GAPB
  #undef EX
  #undef VRD
  #undef KRD
  #undef STEP
  #undef ENDW
  {auto rr=__builtin_amdgcn_permlane32_swap(__float_as_uint(l_reg),__float_as_uint(l_reg),false,false);l_reg=__uint_as_float(rr[0])+__uint_as_float(rr[1]);}
  if(hi==0)wsf[32+r32]=l_reg;asm volatile("s_waitcnt lgkmcnt(0)":::"memory");
  float rli[16];
  #pragma unroll
  for(int r=0;r<16;++r)rli[r]=__builtin_amdgcn_rcpf(wsf[32+crow(r,hi)]);
  bf16*Ow=O+(rowbase+q0+wid*QBLK)*DM+h*D;
  { bf16*stg=(bf16*)(shm+LDS_OST)+wid*2048;
    #pragma unroll
    for(int r=0;r<16;++r){const int orow=crow(r,hi);
      #pragma unroll
      for(int d0=0;d0<2;++d0)stg[orow*64+d0*32+r32]=__float2bfloat16(o[d0][r]*rli[r]);}
    asm volatile("s_waitcnt lgkmcnt(0)":::"memory");
    #pragma unroll
    for(int i=0;i<4;++i){const int row=i*8+(lane>>3),ch=lane&7; const u32x4 v=*(const u32x4*)(stg+row*64+ch*8); ATTN_STORE16(Ow+(long)row*DM+ch*8,v);} }
  asm volatile("s_waitcnt lgkmcnt(0)\n\ts_barrier":::"memory");
  #undef DMA_K
  #undef DMA_V
  #undef CMASK
  #undef START
  #undef RESC
  #undef ROT
}
constexpr int ATTN_LDS_BYTES=LDS_BYTES;
struct AttnTensors { const bf16* Q; const bf16* K; const bf16* V; bf16* O; const bf16* Z; };
struct AttnUnit { int bh; int qb; };
struct StaticOrder {
  int vcu,grid;
  __device__ __forceinline__ explicit StaticOrder(int grid_,int block):vcu((block%8)*(grid_/8)+block/8),grid(grid_){}
  __device__ __forceinline__ bool next(int i,AttnUnit&u)const{ const int L=(i>>1)*grid+vcu; if(L>=256)return false; const int s=L&31; u.bh=L>>5; u.qb=(i&1)?63-s:s; return true; }
  __device__ __forceinline__ void a_ready(const AttnUnit&)const{}
  __device__ __forceinline__ void done(const AttnUnit&)const{}
};
template<class Sched,int THRL=8> __device__ __forceinline__ void attn_phase(char*lds,const AttnTensors&T,const Sched&S){
  AttnUnit u;
  for(int i=0;S.next(i,u);++i){ S.a_ready(u); attn_unit<THRL>(u.bh/NHEAD,u.bh%NHEAD,u.qb,T.Q,T.K,T.V,T.O,lds,T.Z); S.done(u); }
}
#undef SBAR
#undef WAIT_BAR
}

__device__ __forceinline__ void transpose_item(const float* W, int N, int k0, int n0, bf16raw* WT, int drow0, float* scr, int lane, int hi_off = 32) {
  const int c4 = (lane & 15) * 4, r0 = lane >> 4;
  const bool inb = (n0 + c4) < N;
  float4 v[16];
  typedef float f32x4nt_ __attribute__((ext_vector_type(4)));
#pragma unroll
  for (int i = 0; i < 16; ++i) {
    if (inb) { const f32x4nt_ t = __builtin_nontemporal_load((const f32x4nt_*)(W + (size_t)(k0 + 4 * i + r0) * N + n0 + c4)); v[i] = make_float4(t[0], t[1], t[2], t[3]); }
    else v[i] = make_float4(0.f, 0.f, 0.f, 0.f);
  }
#pragma unroll
  for (int i = 0; i < 16; ++i) {
    float* sp = scr + (4 * i + r0) * 65 + c4;
    sp[0] = v[i].x; sp[1] = v[i].y; sp[2] = v[i].z; sp[3] = v[i].w;
  }
  __builtin_amdgcn_fence(__ATOMIC_RELEASE, "wavefront"); __builtin_amdgcn_wave_barrier(); __builtin_amdgcn_fence(__ATOMIC_ACQUIRE, "wavefront");
  const int c = lane & 7;
#pragma unroll
  for (int j = 0; j < 8; ++j) {
    const int n = (lane >> 3) + 8 * j;
    const float* sp = scr + (8 * c) * 65 + n;
    uint4 o;
    o.x = pk2(sp[0 * 65], sp[1 * 65]); o.y = pk2(sp[2 * 65], sp[3 * 65]); o.z = pk2(sp[4 * 65], sp[5 * 65]); o.w = pk2(sp[6 * 65], sp[7 * 65]);
    if (n0 + n < N) { typedef unsigned u32x4nt_ __attribute__((ext_vector_type(4))); const u32x4nt_ ov = {o.x, o.y, o.z, o.w}; __builtin_nontemporal_store(ov, (u32x4nt_*)(WT + (size_t)(drow0 + (n & 31) + (n >> 5) * hi_off) * 1024 + k0 + 8 * c)); }
  }
  __builtin_amdgcn_fence(__ATOMIC_RELEASE, "wavefront"); __builtin_amdgcn_wave_barrier(); __builtin_amdgcn_fence(__ATOMIC_ACQUIRE, "wavefront");
}
constexpr int CV_IN = 16 * 45, CV_OUT = 16 * 16, CV_UP = 32 * 16 * 32, CV_DN = 32 * 16 * 16;
__device__ __forceinline__ void convert_one(const Params& p, int l, int r, float* scr, int lane) {
  if (r < CV_IN) {
    const int kb = r / 45, nb = r % 45;
    const int n0 = nb * 64;
    int drow = n0, hio = 32;
    if (n0 >= 768 && n0 < 1280) { const int t = n0 - 768; drow = 768 + (t >> 8) * 256 + ((t >> 6) & 3) * 32; hio = 128; }
    transpose_item(p.in[6] + (size_t)l * 1024 * DIN, DIN, kb * 64, n0, (bf16raw*)(p.ws + WS_WIN) + (size_t)l * 3072 * 1024, drow, scr, lane, hio);
    return;
  }
  r -= CV_IN;
  if (r < CV_OUT) {
    const int kb = r / 16, nb = r % 16;
    transpose_item(p.in[7] + (size_t)l * 1024 * 1024, 1024, kb * 64, nb * 64, (bf16raw*)(p.ws + WS_WOUT) + (size_t)l * 1024 * 1024, nb * 64, scr, lane);
    return;
  }
  r -= CV_OUT;
  if (r < CV_UP) {
    const int e = r / (16 * 32), r2 = r % (16 * 32), kb = r2 / 32, nb = r2 % 32, n0 = nb * 64;
    const int drow = n0 < 1024 ? (n0 >> 7) * 256 + (n0 & 127) : ((n0 - 1024) >> 7) * 256 + 128 + ((n0 - 1024) & 127);
    transpose_item(p.in[29] + ((size_t)l * NE + e) * 1024 * 2048, 2048, kb * 64, n0, (bf16raw*)(p.ws + WS_WUP) + ((size_t)l * NE + e) * 2048 * 1024, drow, scr, lane);
    return;
  }
  r -= CV_UP;
  {
    const int e = r / (16 * 16), r2 = r % (16 * 16), kb = r2 / 16, nb = r2 % 16;
    transpose_item(p.in[31] + ((size_t)l * NE + e) * 1024 * 1024, 1024, kb * 64, nb * 64, (bf16raw*)(p.ws + WS_WDN) + ((size_t)l * NE + e) * 1024 * 1024, nb * 64, scr, lane);
  }
}
__device__ __forceinline__ void ph_convert(const Params& p, float* sm) {
  const int bid0_ = bidx();
  const int tid0_ = tidx();
  const int lane = tid0_ & 63, wave = tid0_ >> 6;
  float* scr = sm + wave * (64 * 65 + 16);
  const int gw = bid0_ * 8 + wave, NGW = gridDim.x * 8;
  for (int it = gw; it < 2 * CV_IN; it += NGW) convert_one(p, it / CV_IN, it % CV_IN, scr, lane);
  for (int i = bid0_ * NT + tid0_; i < 2 * 240 * 128; i += gridDim.x * NT) {
    const int l = i / (240 * 128), r = i % (240 * 128);
    *(uint4*)((bf16raw*)(p.ws + WS_WIN) + (size_t)l * 3072 * 1024 + (size_t)2832 * 1024 + (size_t)r * 8) = make_uint4(0u, 0u, 0u, 0u);
  }
}
typedef float cvf4_t __attribute__((ext_vector_type(4)));
typedef unsigned cvu4_t __attribute__((ext_vector_type(4)));
__device__ __forceinline__ void cv_desc(const Params& p, int l, int it, const float*& src, int& N, bf16raw*& dst) {
  if (it < CV_OUT) {
    const int kb = it >> 4, nb = it & 15;
    N = 1024; src = p.in[7] + (size_t)l * 1024 * 1024 + (size_t)(kb * 64) * 1024 + nb * 64;
    dst = (bf16raw*)(p.ws + WS_WOUT) + (size_t)l * 1024 * 1024 + (size_t)(nb * 64) * 1024 + kb * 64;
  } else if (it < CV_OUT + CV_UP) {
    const int r = it - CV_OUT, e = r >> 9, r2 = r & 511, kb = r2 >> 5, nb = r2 & 31, n0 = nb * 64;
    const int drow = n0 < 1024 ? (n0 >> 7) * 256 + (n0 & 127) : ((n0 - 1024) >> 7) * 256 + 128 + ((n0 - 1024) & 127);
    N = 2048; src = p.in[29] + ((size_t)l * NE + e) * 1024 * 2048 + (size_t)(kb * 64) * 2048 + n0;
    dst = (bf16raw*)(p.ws + WS_WUP) + ((size_t)l * NE + e) * 2048 * 1024 + (size_t)drow * 1024 + kb * 64;
  } else {
    const int r = it - CV_OUT - CV_UP, e = r >> 8, r2 = r & 255, kb = r2 >> 4, nb = r2 & 15;
    N = 1024; src = p.in[31] + ((size_t)l * NE + e) * 1024 * 1024 + (size_t)(kb * 64) * 1024 + nb * 64;
    dst = (bf16raw*)(p.ws + WS_WDN) + ((size_t)l * NE + e) * 1024 * 1024 + (size_t)(nb * 64) * 1024 + kb * 64;
  }
}
#define CV_LOAD(V, SRC, NN) do { _Pragma("unroll") for (int i_ = 0; i_ < 16; ++i_) V[i_] = __builtin_nontemporal_load((const cvf4_t*)((SRC) + (size_t)(4 * i_ + (lane >> 4)) * (NN) + (lane & 15) * 4)); } while (0)
#define CV_PROC(V, DST) do { \
    _Pragma("unroll") for (int i_ = 0; i_ < 16; ++i_) { float* sp_ = scr + (4 * i_ + (lane >> 4)) * 65 + (lane & 15) * 4; sp_[0] = V[i_][0]; sp_[1] = V[i_][1]; sp_[2] = V[i_][2]; sp_[3] = V[i_][3]; } \
    __builtin_amdgcn_fence(__ATOMIC_RELEASE, "wavefront"); __builtin_amdgcn_wave_barrier(); __builtin_amdgcn_fence(__ATOMIC_ACQUIRE, "wavefront"); \
    _Pragma("unroll") for (int j_ = 0; j_ < 8; ++j_) { \
      const int n_ = (lane >> 3) + 8 * j_; const float* sp_ = scr + (8 * (lane & 7)) * 65 + n_; \
      const cvu4_t ov_ = {pk2(sp_[0 * 65], sp_[1 * 65]), pk2(sp_[2 * 65], sp_[3 * 65]), pk2(sp_[4 * 65], sp_[5 * 65]), pk2(sp_[6 * 65], sp_[7 * 65])}; \
      __builtin_nontemporal_store(ov_, (cvu4_t*)((DST) + (size_t)n_ * 1024 + 8 * (lane & 7))); } \
    __builtin_amdgcn_fence(__ATOMIC_RELEASE, "wavefront"); __builtin_amdgcn_wave_barrier(); __builtin_amdgcn_fence(__ATOMIC_ACQUIRE, "wavefront"); } while (0)
__device__ __forceinline__ void convert_rest(const Params& p, float* sm, int l) {
  const int bid0_ = bidx();
  const int tid0_ = tidx();
  const int lane = tid0_ & 63, wave = __builtin_amdgcn_readfirstlane(tid0_ >> 6);
  float* scr = sm + wave * (64 * 65 + 16);
  const int gw = bid0_ * 8 + wave, NGW = gridDim.x * 8;
  constexpr int END = CV_OUT + CV_UP + CV_DN;
  cvf4_t va[16], vb[16];
  const float* sa = nullptr; const float* sb = nullptr; int Na = 0, Nb = 0; bf16raw* da = nullptr; bf16raw* db = nullptr;
  int it = gw;
  if (it < END) { cv_desc(p, l, it, sa, Na, da); CV_LOAD(va, sa, Na); }
#pragma unroll 1
  while (it < END) {
    const int i1 = it + NGW;
    if (i1 < END) { cv_desc(p, l, i1, sb, Nb, db); CV_LOAD(vb, sb, Nb); }
    CV_PROC(va, da);
    if (i1 >= END) break;
    const int i2 = i1 + NGW;
    if (i2 < END) { cv_desc(p, l, i2, sa, Na, da); CV_LOAD(va, sa, Na); }
    CV_PROC(vb, db);
    it = i2;
  }
}
#undef CV_LOAD
#undef CV_PROC

__device__ __forceinline__ void ph_mod(const Params& p, float* sm) {
  const int bid0_ = bidx();
  const int tid0_ = tidx();
  float* mod = (float*)(p.ws + WS_MOD);
  const float* c = p.in[1];
  if (bid0_ == 0 && tid0_ < 64) ((int*)(p.ws + WS_CNT))[tid0_] = 0;
  if (bid0_ == 0) ((int*)(p.ws + WS_LCNT))[tid0_] = 0;
  if (bid0_ == 0 && tid0_ < 16) ((int*)(p.ws + WS_ZERO))[tid0_] = 0;
  if (bid0_ == 0) for (int i = tid0_; i < 640; i += NT) ((unsigned*)(p.ws + WS_RDY))[i] = 0u;
  float* cs = sm;
  float* red = sm + 1024;
  for (int it = bid0_; it < 96; it += gridDim.x) {
    const int l = it / 48, col0 = (it % 48) * 128;
    __syncthreads();
    for (int i = tid0_; i < 1024; i += NT) { const float cv = c[i]; cs[i] = cv / (1.f + __expf(-cv)); }
    __syncthreads();
    const int cg4 = (tid0_ & 31) * 4, kc = tid0_ >> 5;
    const float* w = p.in[2] + (size_t)l * 1024 * 6144 + (size_t)(kc * 64) * 6144 + col0 + cg4;
    float4 acc = make_float4(0.f, 0.f, 0.f, 0.f);
#pragma unroll 16
    for (int i = 0; i < 64; ++i) {
      const float4 wv = *(const float4*)(w + (size_t)i * 6144);
      const float sv = cs[kc * 64 + i];
      acc.x += sv * wv.x; acc.y += sv * wv.y; acc.z += sv * wv.z; acc.w += sv * wv.w;
    }
    *(float4*)(red + kc * 128 + cg4) = acc;
    __syncthreads();
    if (tid0_ < 128) {
      float t = 0.f;
#pragma unroll
      for (int k = 0; k < 16; ++k) t += red[k * 128 + tid0_];
      mod[l * 6144 + col0 + tid0_] = t + p.in[3][l * 6144 + col0 + tid0_];
    }
  }
  __syncthreads();
}

__device__ __forceinline__ void ph_norm(const Params& p, int l, int which, float* sm) {
  const int bid0_ = bidx();
  const int tid0_ = tidx();
  const int lane = tid0_ & 63, wave = tid0_ >> 6;
  const float* mod = (const float*)(p.ws + WS_MOD) + l * 6144;
  const float* xin = which == 0 ? (l == 0 ? p.in[0] : (const float*)(p.ws + WS_XA)) : (const float*)(p.ws + WS_X1);
  const float* gain = (which == 0 ? p.in[4] : p.in[5]) + l * 1024;
  const float* sh = mod + (which == 0 ? 0 : 3) * 1024;
  const float* sc = mod + (which == 0 ? 1 : 4) * 1024;
  bf16raw* H = (bf16raw*)(p.ws + WS_H);
  const float* rw = p.in[27] + (size_t)l * 1024 * 32;
  const float* rb = p.in[28] + l * 32;
  int* cnt = (int*)(p.ws + WS_CNT) + l * 32;
  int* eidx = (int*)(p.ws + WS_EIDX);
  float* gatebuf = (float*)(p.ws + WS_GATE);
  for (int rbase = bid0_ * 8; rbase < S; rbase += gridDim.x * 8) {
    const int row = rbase + wave;
    const float4* xr = (const float4*)(xin + (size_t)row * 1024) + lane;
    float4 v[4];
    float ss = 0.f;
#pragma unroll
    for (int j = 0; j < 4; ++j) {
      v[j] = xr[64 * j];
      ss += v[j].x * v[j].x + v[j].y * v[j].y + v[j].z * v[j].z + v[j].w * v[j].w;
    }
    ss = wave_sum(ss);
    float r = rsqrtf(ss * (1.f / 1024.f) + 1e-6f);
    uint2* hr = (uint2*)(H + (size_t)row * 1024) + lane;
#pragma unroll
    for (int j = 0; j < 4; ++j) {
      int col = (lane + 64 * j) * 4;
      float4 g = *(const float4*)(gain + col), a = *(const float4*)(sc + col), b = *(const float4*)(sh + col);
      v[j].x = v[j].x * r * g.x * (1.f + a.x) + b.x;
      v[j].y = v[j].y * r * g.y * (1.f + a.y) + b.y;
      v[j].z = v[j].z * r * g.z * (1.f + a.z) + b.z;
      v[j].w = v[j].w * r * g.w * (1.f + a.w) + b.w;
      hr[64 * j] = make_uint2(pk2(v[j].x, v[j].y), pk2(v[j].z, v[j].w));
    }
  }
}

__device__ __forceinline__ void ph_norm2(const Params& p, int l, float* sm) {
  const int bid0_ = bidx();
  const int tid = tidx();
  const int lane = tid & 63, wave = tid >> 6;
  const float* mod = (const float*)(p.ws + WS_MOD) + l * 6144;
  const bf16raw* xin = (const bf16raw*)(p.ws + WS_X1);
  const float* gain = p.in[5] + l * 1024;
  const float* sh = mod + 3 * 1024; const float* sc = mod + 4 * 1024;
  bf16raw* H = (bf16raw*)(p.ws + WS_H);
  const float* rw = p.in[27] + (size_t)l * 1024 * 32;
  const float* rb = p.in[28] + l * 32;
  int* cnt = (int*)(p.ws + WS_CNT) + l * 32;
  int* eidx = (int*)(p.ws + WS_EIDX);
  int* elist = (int*)(p.ws + WS_ELIST);
  float* gatebuf = (float*)(p.ws + WS_GATE);
  unsigned short* whi = (unsigned short*)sm;
  unsigned short* wlo = whi + 32 * 1032;
  float* fl = sm + 33024;
  float* gab = fl;
  float* lgp = fl;
  float* cpart = fl + 2048;
  float* cexp = fl + 2560;
  float* rr = fl + 2592;
  int* lcnt = (int*)(fl + 2656);
  int* lbase = lcnt + 32;
  __syncthreads();
  for (int k = tid; k < 1024; k += 512) { gab[k] = gain[k] * (1.f + sc[k]); gab[1024 + k] = sh[k]; }
  __syncthreads();
  {
    const int e = tid & 31, kg = tid >> 5;
    float cacc = 0.f;
#pragma unroll 2
    for (int k8 = 0; k8 < 8; ++k8) {
      const int k0 = kg * 64 + k8 * 8;
      float w[8];
#pragma unroll
      for (int i = 0; i < 8; ++i) w[i] = rw[(size_t)(k0 + i) * 32 + e];
      const float4 g0 = *(const float4*)(gab + k0), g1 = *(const float4*)(gab + k0 + 4);
      const float4 s0 = *(const float4*)(gab + 1024 + k0), s1 = *(const float4*)(gab + 1024 + k0 + 4);
      cacc += s0.x * w[0] + s0.y * w[1] + s0.z * w[2] + s0.w * w[3] + s1.x * w[4] + s1.y * w[5] + s1.z * w[6] + s1.w * w[7];
      w[0] *= g0.x; w[1] *= g0.y; w[2] *= g0.z; w[3] *= g0.w; w[4] *= g1.x; w[5] *= g1.y; w[6] *= g1.z; w[7] *= g1.w;
      unsigned hi[4], lo[4];
#pragma unroll
      for (int i = 0; i < 4; ++i) {
        hi[i] = pk2(w[2 * i], w[2 * i + 1]);
        lo[i] = pk2(w[2 * i] - __builtin_bit_cast(float, hi[i] << 16), w[2 * i + 1] - __builtin_bit_cast(float, hi[i] & 0xffff0000u));
      }
      *(uint4*)(whi + e * 1032 + k0) = make_uint4(hi[0], hi[1], hi[2], hi[3]);
      *(uint4*)(wlo + e * 1032 + k0) = make_uint4(lo[0], lo[1], lo[2], lo[3]);
    }
    cpart[kg * 32 + e] = cacc;
  }
  float4 ga[4], gb[4];
#pragma unroll
  for (int j = 0; j < 4; ++j) { ga[j] = *(const float4*)(gab + (lane + 64 * j) * 4); gb[j] = *(const float4*)(gab + 1024 + (lane + 64 * j) * 4); }
  for (int rbase = bid0_ * 64; rbase < S; rbase += gridDim.x * 64) {
    if (tid < 32) lcnt[tid] = 0;
#pragma unroll 2
    for (int ri = 0; ri < 8; ++ri) {
      const int rl = wave * 8 + ri, row = rbase + rl;
      const bf16raw* xr = xin + (size_t)row * 1024 + lane * 4;
      float4 v[4];
      float ss = 0.f;
#pragma unroll
      for (int j = 0; j < 4; ++j) { v[j] = ld4bf(xr + 256 * j); ss += v[j].x * v[j].x + v[j].y * v[j].y + v[j].z * v[j].z + v[j].w * v[j].w; }
      ss = wave_sum(ss);
      const float r = rsqrtf(ss * (1.f / 1024.f) + 1e-6f);
      if (lane == 0) rr[rl] = r;
      uint2* hr = (uint2*)(H + (size_t)row * 1024) + lane;
#pragma unroll
      for (int j = 0; j < 4; ++j) {
        const float4 g = ga[j], b = gb[j];
        hr[64 * j] = make_uint2(pk2(v[j].x * r * g.x + b.x, v[j].y * r * g.y + b.y), pk2(v[j].z * r * g.z + b.z, v[j].w * r * g.w + b.w));
      }
    }
    typedef short bf16x8 __attribute__((ext_vector_type(8)));
    typedef float f32x4 __attribute__((ext_vector_type(4)));
    const int rt = wave & 3, kh = wave >> 2, fr = lane & 15, fq = lane >> 4;
    bf16x8 xf[16];
    {
      const bf16raw* xp = xin + (size_t)(rbase + rt * 16 + fr) * 1024 + kh * 512 + fq * 8;
#pragma unroll
      for (int ks = 0; ks < 16; ++ks) xf[ks] = *(const bf16x8*)(xp + ks * 32);
    }
    __syncthreads();
    if (tid < 32) {
      float c = rb[tid];
#pragma unroll
      for (int g = 0; g < 16; ++g) c += cpart[g * 32 + tid];
      cexp[tid] = c;
    }
    f32x4 d0 = {0.f, 0.f, 0.f, 0.f}, d1 = {0.f, 0.f, 0.f, 0.f};
    {
      const unsigned short* wh = whi + fr * 1032 + kh * 512 + fq * 8;
      const unsigned short* wl = wlo + fr * 1032 + kh * 512 + fq * 8;
#pragma unroll
      for (int ks = 0; ks < 16; ++ks) {
        const bf16x8 h0 = *(const bf16x8*)(wh + ks * 32), l0 = *(const bf16x8*)(wl + ks * 32);
        const bf16x8 h1 = *(const bf16x8*)(wh + 16 * 1032 + ks * 32), l1 = *(const bf16x8*)(wl + 16 * 1032 + ks * 32);
        d0 = __builtin_amdgcn_mfma_f32_16x16x32_bf16(xf[ks], h0, d0, 0, 0, 0);
        d1 = __builtin_amdgcn_mfma_f32_16x16x32_bf16(xf[ks], h1, d1, 0, 0, 0);
        d0 = __builtin_amdgcn_mfma_f32_16x16x32_bf16(xf[ks], l0, d0, 0, 0, 0);
        d1 = __builtin_amdgcn_mfma_f32_16x16x32_bf16(xf[ks], l1, d1, 0, 0, 0);
      }
    }
    if (kh == 1) {
#pragma unroll
      for (int j = 0; j < 4; ++j) { lgp[(rt * 16 + fq * 4 + j) * 32 + fr] = d0[j]; lgp[(rt * 16 + fq * 4 + j) * 32 + 16 + fr] = d1[j]; }
    }
    __syncthreads();
    if (kh == 0) {
#pragma unroll
      for (int j = 0; j < 4; ++j) { lgp[(rt * 16 + fq * 4 + j) * 32 + fr] += d0[j]; lgp[(rt * 16 + fq * 4 + j) * 32 + 16 + fr] += d1[j]; }
    }
    __syncthreads();
    const int row_l = tid >> 3, eg = tid & 7;
    float acc[4];
    {
      const float4 t = *(const float4*)(lgp + row_l * 32 + eg * 4), c4 = *(const float4*)(cexp + eg * 4);
      const float r = rr[row_l];
      acc[0] = t.x * r + c4.x; acc[1] = t.y * r + c4.y; acc[2] = t.z * r + c4.z; acc[3] = t.w * r + c4.w;
    }
    float tv[4]; int ti[4];
#pragma unroll
    for (int rd = 0; rd < 4; ++rd) {
      float bv = acc[0]; int bi = eg * 4;
#pragma unroll
      for (int c = 1; c < 4; ++c) if (acc[c] > bv) { bv = acc[c]; bi = eg * 4 + c; }
#pragma unroll
      for (int o = 1; o < 8; o <<= 1) {
        const float ov = __shfl_xor(bv, o); const int oi = __shfl_xor(bi, o);
        if (ov > bv || (ov == bv && oi < bi)) { bv = ov; bi = oi; }
      }
      tv[rd] = bv; ti[rd] = bi;
#pragma unroll
      for (int c = 0; c < 4; ++c) if (bi == eg * 4 + c) acc[c] = -INFINITY;
    }
    int rk[4] = {0, 0, 0, 0};
    if (eg == 0) {
#pragma unroll
      for (int k = 0; k < 4; ++k) rk[k] = atomicAdd(&lcnt[ti[k]], 1);
    }
    __syncthreads();
    if (tid < 32) { const int c = lcnt[tid]; lbase[tid] = c > 0 ? atomicAdd(&cnt[tid], c) : 0; }
    __syncthreads();
    if (eg == 0) {
      const int row = rbase + row_l;
      const float e1 = __expf(tv[1] - tv[0]), e2 = __expf(tv[2] - tv[0]), e3 = __expf(tv[3] - tv[0]);
      const float inv = 1.f / (1.f + e1 + e2 + e3);
      *(int4*)(eidx + row * 4) = make_int4(ti[0] | ((lbase[ti[0]] + rk[0]) << 8), ti[1] | ((lbase[ti[1]] + rk[1]) << 8), ti[2] | ((lbase[ti[2]] + rk[2]) << 8),
                                           ti[3] | ((lbase[ti[3]] + rk[3]) << 8));
      *(float4*)(gatebuf + row * 4) = make_float4(inv, e1 * inv, e2 * inv, e3 * inv);
#pragma unroll
      for (int k = 0; k < 4; ++k) elist[ti[k] * S + lbase[ti[k]] + rk[k]] = row;
    }
  }
}

__device__ __forceinline__ void ph_inproj(const Params& p, int l, float* sm) {
  const int bid0_ = bidx();
  pg8::Gemm g{(const pg8::bf16_t*)(p.ws + WS_H), (const pg8::bf16_t*)(p.ws + WS_WIN) + (size_t)l * 3072 * 1024, S, 3072, 1024};
  pg8::StaticOrder so; so.init(S, 3072, (int)gridDim.x, bid0_);
  pg8::EpiInproj E{(pg8::bf16_t*)(p.ws + WS_QA), (pg8::bf16_t*)(p.ws + WS_KA), (pg8::bf16_t*)(p.ws + WS_VA), (float*)(p.ws + WS_QB), (pg8::bf16_t*)(p.ws + WS_QBB), (pg8::bf16_t*)(p.ws + WS_KB),
                   (pg8::bf16_t*)(p.ws + WS_VB), (float*)(p.ws + WS_KMP), (pg8::bf16_t*)(p.ws + WS_PROJ), p.in[8] + l * 32, p.in[9] + l * 32, p.in[15] + l * 64, p.in[16] + l * 64, attn_body::C2};
  pg8::gemm_phase<pg8::EpiInproj, pg8::StaticOrder, true, true>((PG8_LAS unsigned char*)sm, g, so, E);
}

__device__ __forceinline__ void gla_local_item(const Params& p, int l, int c, float* sm) {
  const int tid = tidx();
  const bf16raw* P = (const bf16raw*)(p.ws + WS_PROJ);
  float* BC = (float*)(p.ws + WS_GA);
  float* SC = (float*)(p.ws + WS_SC); float* DEC = (float*)(p.ws + WS_DEC);
  const float* wg2 = p.in[17] + l * 16 * 128; const float* bg = p.in[18] + l * 128;
  typedef short bf16x8 __attribute__((ext_vector_type(8)));
  typedef float f32x4 __attribute__((ext_vector_type(4)));
  typedef unsigned u32x4 __attribute__((ext_vector_type(4)));
  float* gs = sm; float* ks = sm + 8192;
  bf16raw* vsb = (bf16raw*)(sm + 16384);
  bf16raw* kth = (bf16raw*)(sm + 16384 + 8320); bf16raw* ktl = kth + 128 * 72;
  float* part = sm + 33920; float* gls = sm + 34432;
  const size_t t0 = (size_t)c * 64;
  const int d = tid & 127, qtr = tid >> 7;
  float wcol[16];
#pragma unroll
  for (int r = 0; r < 16; ++r) wcol[r] = wg2[r * 128 + d];
  const float bias = bg[d];
  {
    if (tid < 128) {
      const int t = tid >> 1, hf = tid & 1;
      const uint4 w = *(const uint4*)(P + (t0 + t) * PDIN + PC_CG + hf * 8);
      *(float4*)(gls + t * 16 + hf * 8) = make_float4(__builtin_bit_cast(float, w.x << 16), __builtin_bit_cast(float, w.x & 0xffff0000u), __builtin_bit_cast(float, w.y << 16), __builtin_bit_cast(float, w.y & 0xffff0000u));
      *(float4*)(gls + t * 16 + hf * 8 + 4) = make_float4(__builtin_bit_cast(float, w.z << 16), __builtin_bit_cast(float, w.z & 0xffff0000u), __builtin_bit_cast(float, w.w << 16), __builtin_bit_cast(float, w.w & 0xffff0000u));
    }
#pragma unroll
    for (int u = 0; u < 2; ++u) { int idx = tid + u * 512, row = idx >> 4, c8 = (idx & 15) * 8; const uint4 w = *(const uint4*)(P + (t0 + row) * PDIN + PC_CK + c8);
      *(float4*)(ks + row * 128 + c8) = make_float4(__builtin_bit_cast(float, w.x << 16), __builtin_bit_cast(float, w.x & 0xffff0000u), __builtin_bit_cast(float, w.y << 16), __builtin_bit_cast(float, w.y & 0xffff0000u));
      *(float4*)(ks + row * 128 + c8 + 4) = make_float4(__builtin_bit_cast(float, w.z << 16), __builtin_bit_cast(float, w.z & 0xffff0000u), __builtin_bit_cast(float, w.w << 16), __builtin_bit_cast(float, w.w & 0xffff0000u)); }
#pragma unroll
    for (int u = 0; u < 4; ++u) { int idx = tid + u * 512, row = idx >> 5, c8 = (idx & 31) * 8; const uint4 w = *(const uint4*)(P + (t0 + row) * PDIN + PC_CV + c8);
      *(uint2*)(vsb + row * 260 + c8) = make_uint2(w.x, w.y); *(uint2*)(vsb + row * 260 + c8 + 4) = make_uint2(w.z, w.w); }
  }
  __syncthreads();
  float gv[16];
  {
    float run = 0.f;
#pragma unroll
    for (int i = 0; i < 16; ++i) {
      const float* gp = gls + (qtr * 16 + i) * 16;
      const float4 x0 = *(const float4*)gp, x1 = *(const float4*)(gp + 4), x2 = *(const float4*)(gp + 8), x3 = *(const float4*)(gp + 12);
      const float z = bias + x0.x * wcol[0] + x0.y * wcol[1] + x0.z * wcol[2] + x0.w * wcol[3] + x1.x * wcol[4] + x1.y * wcol[5] + x1.z * wcol[6] + x1.w * wcol[7]
                    + x2.x * wcol[8] + x2.y * wcol[9] + x2.z * wcol[10] + x2.w * wcol[11] + x3.x * wcol[12] + x3.y * wcol[13] + x3.z * wcol[14] + x3.w * wcol[15];
      run += logsigmoidf_(z) * (1.f / 16.f);
      gv[i] = run;
    }
    part[qtr * 128 + d] = run;
  }
  __syncthreads();
  {
    float off = 0.f;
#pragma unroll
    for (int q = 0; q < 3; ++q) if (q < qtr) off += part[q * 128 + d];
#pragma unroll
    for (int i = 0; i < 16; ++i) { gv[i] += off; BC[(t0 + qtr * 16 + i) * 128 + d] = gv[i]; }
    if (qtr == 3) gs[63 * 128 + d] = gv[15];
  }
  __syncthreads();
  {
    const float bl = gs[63 * 128 + d];
    if (qtr == 0) DEC[(size_t)c * 128 + d] = __expf(bl);
    float kp[16];
#pragma unroll
    for (int i = 0; i < 16; ++i) kp[i] = ks[(qtr * 16 + i) * 128 + d] * __expf(bl - gv[i]);
    unsigned hi[8], lo[8];
#pragma unroll
    for (int i = 0; i < 8; ++i) {
      hi[i] = pk2(kp[2 * i], kp[2 * i + 1]);
      lo[i] = pk2(kp[2 * i] - __builtin_bit_cast(float, hi[i] << 16), kp[2 * i + 1] - __builtin_bit_cast(float, hi[i] & 0xffff0000u));
    }
    *(uint4*)(kth + d * 72 + qtr * 16) = make_uint4(hi[0], hi[1], hi[2], hi[3]); *(uint4*)(kth + d * 72 + qtr * 16 + 8) = make_uint4(hi[4], hi[5], hi[6], hi[7]);
    *(uint4*)(ktl + d * 72 + qtr * 16) = make_uint4(lo[0], lo[1], lo[2], lo[3]); *(uint4*)(ktl + d * 72 + qtr * 16 + 8) = make_uint4(lo[4], lo[5], lo[6], lo[7]);
  }
  __syncthreads();
  {
    const int lane = tid & 63, wave = tid >> 6, fr = lane & 15, fq = lane >> 4, h = wave >> 1, ddt = wave & 1;
    f32x4 acc[4];
#pragma unroll
    for (int et = 0; et < 4; ++et) acc[et] = (f32x4){0.f, 0.f, 0.f, 0.f};
#pragma unroll
    for (int ksx = 0; ksx < 2; ++ksx) {
      const bf16x8 ah = *(const bf16x8*)(kth + (h * 32 + ddt * 16 + fr) * 72 + ksx * 32 + fq * 8);
      const bf16x8 al = *(const bf16x8*)(ktl + (h * 32 + ddt * 16 + fr) * 72 + ksx * 32 + fq * 8);
#pragma unroll
      for (int et = 0; et < 4; ++et) {
        const bf16raw* vp = vsb + (ksx * 32 + fq * 8) * 260 + h * 64 + et * 16 + fr;
        u32x4 w;
#pragma unroll
        for (int i = 0; i < 4; ++i) w[i] = (unsigned)vp[(2 * i) * 260] | ((unsigned)vp[(2 * i + 1) * 260] << 16);
        const bf16x8 bv = __builtin_bit_cast(bf16x8, w);
        acc[et] = __builtin_amdgcn_mfma_f32_16x16x32_bf16(ah, bv, acc[et], 0, 0, 0);
        acc[et] = __builtin_amdgcn_mfma_f32_16x16x32_bf16(al, bv, acc[et], 0, 0, 0);
      }
    }
    float* o = SC + (((size_t)c * 4 + h) * 32 + ddt * 16 + fq * 4) * 64 + fr;
#pragma unroll
    for (int et = 0; et < 4; ++et)
#pragma unroll
      for (int j = 0; j < 4; ++j) o[j * 64 + et * 16] = acc[et][j];
  }
  __syncthreads();
}

__device__ __forceinline__ void lru_local_item(const Params& p, int l, int c, float* sm) {
  typedef short bf16x8 __attribute__((ext_vector_type(8)));
  typedef float f32x4 __attribute__((ext_vector_type(4)));
  typedef unsigned u32x4 __attribute__((ext_vector_type(4)));
  const int tid = tidx();
  const int lane = tid & 63, wave = tid >> 6, fr = lane & 15, fq = lane >> 4;
  const bf16raw* P = (const bf16raw*)(p.ws + WS_PROJ);
  float* LA = (float*)(p.ws + WS_LA); float* LB = (float*)(p.ws + WS_LB);
  float* LTA = (float*)(p.ws + WS_LTA); float* LTH = (float*)(p.ws + WS_LTH);
  const float* cw = p.in[20] + l * 4 * 256; const float* cb = p.in[21] + l * 256;
  const float* wa = p.in[22] + (size_t)l * 4 * 64 * 64; const float* ba = p.in[23] + l * 256;
  const float* wx = p.in[24] + (size_t)l * 4 * 64 * 64; const float* bx = p.in[25] + l * 256;
  const float* lam = p.in[26] + l * 256;
  constexpr int PX = 260;
  float* xcs = sm;
  float* As = sm + 64 * PX;
  const int t0 = c * 64;
  bf16raw* dxs = (bf16raw*)(sm + 64 * PX);
  const int n = wave >> 1, eh = wave & 1;
  bf16x8 wh[2][2][2], wl[2][2][2];
#pragma unroll
  for (int g = 0; g < 2; ++g)
#pragma unroll
    for (int et = 0; et < 2; ++et)
#pragma unroll
      for (int ks = 0; ks < 2; ++ks) {
        const float* wp = (g == 0 ? wa : wx) + (size_t)(n * 64 + ks * 32 + fq * 8) * 64 + eh * 32 + et * 16 + fr;
        float w[8];
#pragma unroll
        for (int i = 0; i < 8; ++i) w[i] = wp[i * 64];
        u32x4 hi, lo;
#pragma unroll
        for (int i = 0; i < 4; ++i) {
          hi[i] = pk2(w[2 * i], w[2 * i + 1]);
          lo[i] = pk2(w[2 * i] - __builtin_bit_cast(float, hi[i] << 16), w[2 * i + 1] - __builtin_bit_cast(float, hi[i] & 0xffff0000u));
        }
        wh[g][et][ks] = __builtin_bit_cast(bf16x8, hi); wl[g][et][ks] = __builtin_bit_cast(bf16x8, lo);
      }
  float lsv[2], bav[2], bxv[2];
#pragma unroll
  for (int et = 0; et < 2; ++et) { const int ch = n * 64 + eh * 32 + et * 16 + fr; lsv[et] = 8.f * logsigmoidf_(lam[ch]); bav[et] = ba[ch]; bxv[et] = bx[ch]; }
  for (int i = tid; i < 67 * 32; i += NT) {
    const int r = i >> 5, c8 = (i & 31) * 8, ts = t0 - 3 + r;
    *(uint4*)(dxs + r * 256 + c8) = ts >= 0 ? *(const uint4*)(P + (size_t)ts * PDIN + PC_DX + c8) : make_uint4(0u, 0u, 0u, 0u);
  }
  __syncthreads();
  {
    const int ch = tid & 255;
    const float w0 = cw[ch], w1 = cw[256 + ch], w2 = cw[512 + ch], w3 = cw[768 + ch], bb = cb[ch];
#pragma unroll 4
    for (int tt = tid >> 8; tt < 64; tt += 2)
      xcs[tt * PX + ch] = bb + w0 * bf2f(dxs[tt * 256 + ch]) + w1 * bf2f(dxs[(tt + 1) * 256 + ch]) + w2 * bf2f(dxs[(tt + 2) * 256 + ch]) + w3 * bf2f(dxs[(tt + 3) * 256 + ch]);
  }
  __syncthreads();
#pragma unroll 1
  for (int tt = 0; tt < 4; ++tt) {
    bf16x8 xh[2], xl[2];
#pragma unroll
    for (int ks = 0; ks < 2; ++ks) {
      const float* xp = xcs + (tt * 16 + fr) * PX + n * 64 + ks * 32 + fq * 8;
      const float4 v0 = *(const float4*)xp, v1 = *(const float4*)(xp + 4);
      const float f[8] = {v0.x, v0.y, v0.z, v0.w, v1.x, v1.y, v1.z, v1.w};
      u32x4 hi, lo;
#pragma unroll
      for (int i = 0; i < 4; ++i) {
        hi[i] = pk2(f[2 * i], f[2 * i + 1]);
        lo[i] = pk2(f[2 * i] - __builtin_bit_cast(float, hi[i] << 16), f[2 * i + 1] - __builtin_bit_cast(float, hi[i] & 0xffff0000u));
      }
      xh[ks] = __builtin_bit_cast(bf16x8, hi); xl[ks] = __builtin_bit_cast(bf16x8, lo);
    }
    float xo[2][4];
#pragma unroll
    for (int et = 0; et < 2; ++et)
#pragma unroll
      for (int j = 0; j < 4; ++j) xo[et][j] = xcs[(tt * 16 + fq * 4 + j) * PX + n * 64 + eh * 32 + et * 16 + fr];
    __syncthreads();
#pragma unroll
    for (int et = 0; et < 2; ++et) {
      f32x4 ar = {0.f, 0.f, 0.f, 0.f}, ai = {0.f, 0.f, 0.f, 0.f};
#pragma unroll
      for (int ks = 0; ks < 2; ++ks) {
        ar = __builtin_amdgcn_mfma_f32_16x16x32_bf16(xh[ks], wh[0][et][ks], ar, 0, 0, 0);
        ai = __builtin_amdgcn_mfma_f32_16x16x32_bf16(xh[ks], wh[1][et][ks], ai, 0, 0, 0);
        ar = __builtin_amdgcn_mfma_f32_16x16x32_bf16(xl[ks], wh[0][et][ks], ar, 0, 0, 0);
        ai = __builtin_amdgcn_mfma_f32_16x16x32_bf16(xl[ks], wh[1][et][ks], ai, 0, 0, 0);
        ar = __builtin_amdgcn_mfma_f32_16x16x32_bf16(xh[ks], wl[0][et][ks], ar, 0, 0, 0);
        ai = __builtin_amdgcn_mfma_f32_16x16x32_bf16(xh[ks], wl[1][et][ks], ai, 0, 0, 0);
      }
      const int ch = n * 64 + eh * 32 + et * 16 + fr;
#pragma unroll
      for (int j = 0; j < 4; ++j) {
        const int t = tt * 16 + fq * 4 + j;
        const float rg = sigmoidf_(ar[j] + bav[et]), ig = sigmoidf_(ai[j] + bxv[et]);
        const float a = __expf(rg * lsv[et]);
        As[t * 256 + ch] = a;
        xcs[t * PX + ch] = sqrtf(fmaxf(1.f - a * a, 0.f)) * (ig * xo[et][j]);
      }
    }
  }
  __syncthreads();
  {
    const int ch = tid & 255, half = tid >> 8, tb = half * 32;
    float Hh = 0.f, Ac = 1.f;
#pragma unroll 8
    for (int i = 0; i < 32; ++i) {
      const int t = tb + i;
      const float a = As[t * 256 + ch], bt = xcs[t * PX + ch];
      Hh = a * Hh + bt; Ac *= a;
      LA[(size_t)(t0 + t) * 256 + ch] = Ac; LB[(size_t)(t0 + t) * 256 + ch] = Hh;
    }
    LTA[(size_t)(c * 2 + half) * 256 + ch] = Ac; LTH[(size_t)(c * 2 + half) * 256 + ch] = Hh;
  }
  __syncthreads();
}

__device__ __forceinline__ void ph_prep(const Params& p, int l, float* sm) {
  const int bid0_ = bidx();
  const int tid0_ = tidx();
  const int lane = tid0_ & 63, wave = tid0_ >> 6;
  const bf16raw* P = (const bf16raw*)(p.ws + WS_PROJ);
  bf16raw* QAb = (bf16raw*)(p.ws + WS_QA); bf16raw* KAb = (bf16raw*)(p.ws + WS_KA); bf16raw* VAb = (bf16raw*)(p.ws + WS_VA);
  float* QB = (float*)(p.ws + WS_QB); bf16raw* KBb = (bf16raw*)(p.ws + WS_KB); bf16raw* QBb = (bf16raw*)(p.ws + WS_QBB);
  float* KMP = (float*)(p.ws + WS_KMP); bf16raw* VBt = (bf16raw*)(p.ws + WS_VBT);
  const float* aqg = p.in[8] + l * 32; const float* akg = p.in[9] + l * 32;
  const float* bqg = p.in[15] + l * 64; const float* bkg = p.in[16] + l * 64;
  const float* wg2 = p.in[17] + l * 16 * 128; const float* bg = p.in[18] + l * 128;
  bf16raw* vsl = (bf16raw*)sm;
  const bf16raw* VBn = (const bf16raw*)(p.ws + WS_VB);
  for (int tile = bid0_; tile < S / 64; tile += gridDim.x) {
    __syncthreads();
#pragma unroll
    for (int u = 0; u < 4; ++u) { const int idx = tid0_ + u * 512, r = idx >> 5, c8 = (idx & 31) * 8; *(uint4*)(vsl + r * 264 + c8) = *(const uint4*)(VBn + (size_t)(tile * 64 + r) * 256 + c8); }
    __syncthreads();
    {
      const int col = tid0_ & 255, half = tid0_ >> 8;
      unsigned w[16];
#pragma unroll
      for (int i = 0; i < 16; ++i) w[i] = (unsigned)vsl[(half * 32 + 2 * i) * 264 + col] | ((unsigned)vsl[(half * 32 + 2 * i + 1) * 264 + col] << 16);
      uint4* dst = (uint4*)(VBt + (size_t)col * S + tile * 64 + half * 32);
#pragma unroll
      for (int i = 0; i < 4; ++i) dst[i] = make_uint4(w[4 * i], w[4 * i + 1], w[4 * i + 2], w[4 * i + 3]);
    }
  }
  __syncthreads();
  for (int c = bid0_; c < S / 64; c += gridDim.x) gla_local_item(p, l, c, sm);
  for (int c = bid0_; c < S / 64; c += gridDim.x) lru_local_item(p, l, c, sm);
}

__device__ __forceinline__ void ph_scan(const Params& p, float* sm) {
  const int bid0_ = bidx();
  const int tid = tidx();
  const float* SC = (const float*)(p.ws + WS_SC); const float* DEC = (const float*)(p.ws + WS_DEC); float* STo = (float*)(p.ws + WS_ST);
  float* gA = sm; float* gH = sm + 512; float* gC = sm + 1024;
  for (int b = bid0_; b < 256; b += gridDim.x) {
    const int chain = tid & 31, grp = tid >> 5, gid = b * 32 + chain;
    float sv[16], dv[16];
#pragma unroll
    for (int i = 0; i < 16; ++i) { const int c = grp * 16 + i; sv[i] = SC[(size_t)c * 8192 + gid]; dv[i] = DEC[c * 128 + (gid >> 6)]; }
    float A = 1.f, H = 0.f;
#pragma unroll
    for (int i = 0; i < 16; ++i) { H = dv[i] * H + sv[i]; A *= dv[i]; }
    __syncthreads();
    gA[tid] = A; gH[tid] = H;
    __syncthreads();
    if (tid < 32) {
      float carry = 0.f;
#pragma unroll
      for (int g = 0; g < 16; ++g) { gC[g * 32 + tid] = carry; carry = gA[g * 32 + tid] * carry + gH[g * 32 + tid]; }
    }
    __syncthreads();
    float st = gC[tid];
#pragma unroll
    for (int i = 0; i < 16; ++i) { const int c = grp * 16 + i; STo[(size_t)c * 8192 + gid] = st; st = dv[i] * st + sv[i]; }
  }
}
__device__ __forceinline__ void ph_scan_lru(const Params& p, float* sm) {
  const int bid0_ = bidx();
  const int tid = tidx();
  const float* LTA = (const float*)(p.ws + WS_LTA); const float* LTH = (const float*)(p.ws + WS_LTH); float* LC = (float*)(p.ws + WS_LC);
  for (int b = bid0_; b < 48; b += gridDim.x) {
    if (b < 16) continue;
    const int ch = (b - 16) * 8 + (tid & 7), grp = tid >> 3;
    float a[8], h[8];
#pragma unroll
    for (int i = 0; i < 8; ++i) { a[i] = LTA[(grp * 8 + i) * 256 + ch]; h[i] = LTH[(grp * 8 + i) * 256 + ch]; }
    float A = 1.f, H = 0.f;
#pragma unroll
    for (int i = 0; i < 8; ++i) { H = a[i] * H + h[i]; A *= a[i]; }
    __syncthreads();
    sm[tid] = A; sm[512 + tid] = H;
    __syncthreads();
    if (tid < 8) {
      float carry = 0.f;
      for (int g = 0; g < 64; ++g) { const float ga = sm[g * 8 + tid], gh = sm[512 + g * 8 + tid]; sm[1024 + g * 8 + tid] = carry; carry = ga * carry + gh; }
    }
    __syncthreads();
    float carry = sm[1024 + tid];
#pragma unroll
    for (int i = 0; i < 8; ++i) { LC[(grp * 8 + i) * 256 + ch] = carry; carry = a[i] * carry + h[i]; }
  }
}

__device__ __forceinline__ void moba_gate_item(const Params& p, int l, int it, float* sm) {
  typedef short bf16x8 __attribute__((ext_vector_type(8)));
  typedef float f32x4 __attribute__((ext_vector_type(4)));
  typedef unsigned u32x4 __attribute__((ext_vector_type(4)));
  const int tid = tidx(), lane = tid & 63, wave = tid >> 6, fr = lane & 15, fq = lane >> 4;
  const int h = it & 3, own = it >> 2;
  const float* QB = (const float*)(p.ws + WS_QB); const float* KMP = (const float*)(p.ws + WS_KMP);
  int* LCNT = (int*)(p.ws + WS_LCNT) + l * 256; int* LIST = (int*)(p.ws + WS_MLIST); float2* ML = (float2*)(p.ws + WS_ML);
  float* km = sm;
  int* lcnt = (int*)(sm + 64 * 68); int* lbase = lcnt + 64;
  __syncthreads();
  for (int idx = tid; idx < own * 64; idx += NT) {
    const int n = idx >> 6, c = idx & 63;
    const float* kp = KMP + (size_t)(4 * n) * 256 + h * 64 + c;
    km[n * 68 + c] = (kp[0] + kp[256] + kp[512] + kp[768]) * (1.f / 256.f);
  }
  if (tid < 64) lcnt[tid] = 0;
#define MOBA_SPLIT(HI, LO, X0, X1) do { const float f_[8] = {X0.x, X0.y, X0.z, X0.w, X1.x, X1.y, X1.z, X1.w}; u32x4 hi_, lo_;                                   \
    _Pragma("unroll") for (int i_ = 0; i_ < 4; ++i_) { hi_[i_] = pk2(f_[2 * i_], f_[2 * i_ + 1]);                                                                    \
      lo_[i_] = pk2(f_[2 * i_] - __builtin_bit_cast(float, hi_[i_] << 16), f_[2 * i_ + 1] - __builtin_bit_cast(float, hi_[i_] & 0xffff0000u)); }                    \
    HI = __builtin_bit_cast(bf16x8, hi_); LO = __builtin_bit_cast(bf16x8, lo_); } while (0)
  bf16x8 qh[2][2], ql[2][2];
#pragma unroll
  for (int qt = 0; qt < 2; ++qt)
#pragma unroll
    for (int ks = 0; ks < 2; ++ks) {
      const float* qp = QB + (size_t)(own * 256 + wave * 32 + qt * 16 + fr) * 256 + h * 64 + ks * 32 + fq * 8;
      const float4 x0 = *(const float4*)qp, x1 = *(const float4*)(qp + 4);
      MOBA_SPLIT(qh[qt][ks], ql[qt][ks], x0, x1);
    }
  __syncthreads();
  const int ntile = (own + 15) >> 4;
  float g0[2], g1[2], g2[2]; int s0[2], s1[2], s2[2];
#pragma unroll
  for (int qt = 0; qt < 2; ++qt) { g0[qt] = -INFINITY; g1[qt] = -INFINITY; g2[qt] = -INFINITY; s0[qt] = -1; s1[qt] = -1; s2[qt] = -1; }
#pragma unroll
  for (int nt = 0; nt < 4; ++nt) {
    if (nt < ntile) {
      f32x4 acc[2] = {{0.f, 0.f, 0.f, 0.f}, {0.f, 0.f, 0.f, 0.f}};
#pragma unroll
      for (int ks = 0; ks < 2; ++ks) {
        const float* ap = km + (nt * 16 + fr) * 68 + ks * 32 + fq * 8;
        const float4 x0 = *(const float4*)ap, x1 = *(const float4*)(ap + 4);
        bf16x8 ah, al;
        MOBA_SPLIT(ah, al, x0, x1);
#pragma unroll
        for (int qt = 0; qt < 2; ++qt) {
          acc[qt] = __builtin_amdgcn_mfma_f32_16x16x32_bf16(ah, qh[qt][ks], acc[qt], 0, 0, 0);
          acc[qt] = __builtin_amdgcn_mfma_f32_16x16x32_bf16(al, qh[qt][ks], acc[qt], 0, 0, 0);
          acc[qt] = __builtin_amdgcn_mfma_f32_16x16x32_bf16(ah, ql[qt][ks], acc[qt], 0, 0, 0);
        }
      }
#pragma unroll
      for (int qt = 0; qt < 2; ++qt)
#pragma unroll
        for (int j = 0; j < 4; ++j) {
          const int n = nt * 16 + fq * 4 + j; const float a = acc[qt][j];
          if (n < own) {
            if (a > g0[qt]) { g2[qt] = g1[qt]; s2[qt] = s1[qt]; g1[qt] = g0[qt]; s1[qt] = s0[qt]; g0[qt] = a; s0[qt] = n; }
            else if (a > g1[qt]) { g2[qt] = g1[qt]; s2[qt] = s1[qt]; g1[qt] = a; s1[qt] = n; }
            else if (a > g2[qt]) { g2[qt] = a; s2[qt] = n; }
          }
        }
    }
  }
#undef MOBA_SPLIT
#define MOBA_INS(Q, A, N) do { const float a_ = (A); const int n_ = (N); if (n_ >= 0) {                                                                               \
      if (a_ > g0[Q] || (a_ == g0[Q] && n_ < s0[Q]) || s0[Q] < 0) { g2[Q] = g1[Q]; s2[Q] = s1[Q]; g1[Q] = g0[Q]; s1[Q] = s0[Q]; g0[Q] = a_; s0[Q] = n_; }             \
      else if (a_ > g1[Q] || (a_ == g1[Q] && n_ < s1[Q]) || s1[Q] < 0) { g2[Q] = g1[Q]; s2[Q] = s1[Q]; g1[Q] = a_; s1[Q] = n_; }                                       \
      else if (a_ > g2[Q] || (a_ == g2[Q] && n_ < s2[Q]) || s2[Q] < 0) { g2[Q] = a_; s2[Q] = n_; } } } while (0)
#pragma unroll
  for (int qt = 0; qt < 2; ++qt)
#pragma unroll
    for (int o = 16; o < 64; o <<= 1) {
      const float pg0 = __shfl_xor(g0[qt], o), pg1 = __shfl_xor(g1[qt], o), pg2 = __shfl_xor(g2[qt], o);
      const int ps0 = __shfl_xor(s0[qt], o), ps1 = __shfl_xor(s1[qt], o), ps2 = __shfl_xor(s2[qt], o);
      MOBA_INS(qt, pg0, ps0); MOBA_INS(qt, pg1, ps1); MOBA_INS(qt, pg2, ps2);
    }
#undef MOBA_INS
  int r0[2] = {0, 0}, r1[2] = {0, 0}, r2[2] = {0, 0};
  if (fq == 0) {
#pragma unroll
    for (int qt = 0; qt < 2; ++qt) {
      if (s0[qt] >= 0) r0[qt] = atomicAdd(&lcnt[s0[qt]], 1);
      if (s1[qt] >= 0) r1[qt] = atomicAdd(&lcnt[s1[qt]], 1);
      if (s2[qt] >= 0) r2[qt] = atomicAdd(&lcnt[s2[qt]], 1);
    }
  }
  __syncthreads();
  if (tid < 64) { const int c = lcnt[tid]; lbase[tid] = c > 0 ? atomicAdd(&LCNT[h * 64 + tid], c) : 0; }
  __syncthreads();
  if (fq == 0) {
    const float2 dead = make_float2(-INFINITY, 0.f);
#pragma unroll
    for (int qt = 0; qt < 2; ++qt) {
      const int qi = own * 256 + wave * 32 + qt * 16 + fr;
      const size_t sl = ((size_t)qi * 4 + h) * 4;
      if (s0[qt] >= 0) LIST[(size_t)(h * 64 + s0[qt]) * 16384 + lbase[s0[qt]] + r0[qt]] = qi | (0 << 16); else ML[sl + 0] = dead;
      if (s1[qt] >= 0) LIST[(size_t)(h * 64 + s1[qt]) * 16384 + lbase[s1[qt]] + r1[qt]] = qi | (1 << 16); else ML[sl + 1] = dead;
      if (s2[qt] >= 0) LIST[(size_t)(h * 64 + s2[qt]) * 16384 + lbase[s2[qt]] + r2[qt]] = qi | (2 << 16); else ML[sl + 2] = dead;
    }
  }
}

__device__ __forceinline__ void moba_attn_item(const Params& p, int h, int n, int chunk, int own, int len, float* sm) {
  typedef short bf16x8_t __attribute__((ext_vector_type(8)));
  typedef short bf16x4_t __attribute__((ext_vector_type(4)));
  typedef float f32x4_t __attribute__((ext_vector_type(4)));
  const int tid = tidx(), lane = tid & 63, wave = tid >> 6, qc = lane & 15, kg = lane >> 4;
  const bf16raw* KBb = (const bf16raw*)(p.ws + WS_KB); const bf16raw* QBb = (const bf16raw*)(p.ws + WS_QBB); const bf16raw* VBt = (const bf16raw*)(p.ws + WS_VBT);
  const int* LIST = (const int*)(p.ws + WS_MLIST); float2* ML = (float2*)(p.ws + WS_ML); bf16raw* PART = (bf16raw*)(p.ws + WS_PART);
  bf16raw* Ks = (bf16raw*)sm;
  bf16raw* Vt = (bf16raw*)sm + 256 * 72;
  const bool t1 = own || (chunk * 256 + 128 < len);
  int qi[2], src[2]; bool valid[2];
  {
    const int s0 = chunk * 256 + wave * 16 + qc, s1 = s0 + 128;
    if (own) { qi[0] = n * 256 + s0; qi[1] = n * 256 + s1; src[0] = 3; src[1] = 3; valid[0] = true; valid[1] = true; }
    else {
      valid[0] = s0 < len; valid[1] = s1 < len;
      const int* lp = LIST + (size_t)(h * 64 + n) * 16384;
      const int e0 = lp[valid[0] ? s0 : 0], e1 = lp[valid[1] ? s1 : 0];
      qi[0] = e0 & 0xffff; src[0] = e0 >> 16; qi[1] = e1 & 0xffff; src[1] = e1 >> 16;
    }
  }
  typedef unsigned u32x4_t __attribute__((ext_vector_type(4)));
#define MOBA_LD(u, KR, VR) const u32x4_t KR = *(const u32x4_t*)(KBb + (size_t)(n * 256 + ((tid + (u) * 512) >> 3)) * 256 + h * 64 + ((tid + (u) * 512) & 7) * 8); \
                           const u32x4_t VR = *(const u32x4_t*)(VBt + (size_t)(h * 64 + ((tid + (u) * 512) >> 5)) * S + n * 256 + ((tid + (u) * 512) & 31) * 8)
  MOBA_LD(0, kr0, vr0); MOBA_LD(1, kr1, vr1); MOBA_LD(2, kr2, vr2); MOBA_LD(3, kr3, vr3);
#undef MOBA_LD
  bf16x8_t qf[2][2];
#pragma unroll
  for (int tl = 0; tl < 2; ++tl) { qf[tl][0] = *(const bf16x8_t*)(QBb + (size_t)qi[tl] * 256 + h * 64 + kg * 8); qf[tl][1] = *(const bf16x8_t*)(QBb + (size_t)qi[tl] * 256 + h * 64 + 32 + kg * 8); }
  __syncthreads();
#define MOBA_ST(u, KR, VR) *(u32x4_t*)(Ks + ((tid + (u) * 512) >> 3) * 72 + ((tid + (u) * 512) & 7) * 8) = KR; *(u32x4_t*)(Vt + ((tid + (u) * 512) >> 5) * 264 + ((tid + (u) * 512) & 31) * 8) = VR
  MOBA_ST(0, kr0, vr0); MOBA_ST(1, kr1, vr1); MOBA_ST(2, kr2, vr2); MOBA_ST(3, kr3, vr3);
#undef MOBA_ST
  __syncthreads();
  const int nkt0 = own ? 8 : 16;
  f32x4_t sacc[2][16];
  float mx[2] = {-INFINITY, -INFINITY};
#pragma unroll
  for (int kt = 0; kt < 16; ++kt) {
    const bf16x8_t k0 = *(const bf16x8_t*)(Ks + (kt * 16 + qc) * 72 + kg * 8), k1 = *(const bf16x8_t*)(Ks + (kt * 16 + qc) * 72 + 32 + kg * 8);
#pragma unroll
    for (int tl = 0; tl < 2; ++tl) {
      if (tl == 0 ? (kt < nkt0) : t1) {
        f32x4_t a = {0.f, 0.f, 0.f, 0.f};
        a = __builtin_amdgcn_mfma_f32_16x16x32_bf16(k0, qf[tl][0], a, 0, 0, 0);
        a = __builtin_amdgcn_mfma_f32_16x16x32_bf16(k1, qf[tl][1], a, 0, 0, 0);
        if (own) {
          const int qpos = tl * 128 + wave * 16 + qc;
#pragma unroll
          for (int r = 0; r < 4; ++r) if (kt * 16 + kg * 4 + r > qpos) a[r] = -INFINITY;
        }
        sacc[tl][kt] = a;
        mx[tl] = fmaxf(mx[tl], fmaxf(fmaxf(a[0], a[1]), fmaxf(a[2], a[3])));
      } else sacc[tl][kt] = (f32x4_t){-INFINITY, -INFINITY, -INFINITY, -INFINITY};
    }
  }
  float lsum[2] = {0.f, 0.f};
  bf16x8_t pfs[2][8];
#pragma unroll
  for (int tl = 0; tl < 2; ++tl) {
    float m = mx[tl];
    m = fmaxf(m, __shfl_xor(m, 16)); m = fmaxf(m, __shfl_xor(m, 32));
    mx[tl] = m;
    float ls = 0.f;
#pragma unroll
    for (int ks = 0; ks < 8; ++ks) {
      if ((tl == 1 && t1) || (tl == 0 && 2 * ks < nkt0)) {
        float e[8];
#pragma unroll
        for (int r = 0; r < 4; ++r) { e[r] = __builtin_amdgcn_exp2f(sacc[tl][2 * ks][r] - m); e[4 + r] = __builtin_amdgcn_exp2f(sacc[tl][2 * ks + 1][r] - m); }
        ls += ((e[0] + e[1]) + (e[2] + e[3])) + ((e[4] + e[5]) + (e[6] + e[7]));
        const uint4 w = make_uint4(pk2(e[0], e[1]), pk2(e[2], e[3]), pk2(e[4], e[5]), pk2(e[6], e[7]));
        pfs[tl][ks] = __builtin_bit_cast(bf16x8_t, w);
      } else pfs[tl][ks] = (bf16x8_t){0, 0, 0, 0, 0, 0, 0, 0};
    }
    ls += __shfl_xor(ls, 16); ls += __shfl_xor(ls, 32);
    lsum[tl] = ls;
  }
  f32x4_t o[2][4];
#pragma unroll
  for (int tl = 0; tl < 2; ++tl)
#pragma unroll
    for (int dt = 0; dt < 4; ++dt) o[tl][dt] = (f32x4_t){0.f, 0.f, 0.f, 0.f};
#pragma unroll
  for (int ks = 0; ks < 8; ++ks) {
#pragma unroll
    for (int dt = 0; dt < 4; ++dt) {
      const bf16x4_t va = *(const bf16x4_t*)(Vt + (dt * 16 + qc) * 264 + ks * 32 + kg * 4), vb = *(const bf16x4_t*)(Vt + (dt * 16 + qc) * 264 + ks * 32 + 16 + kg * 4);
      const bf16x8_t vf = {va[0], va[1], va[2], va[3], vb[0], vb[1], vb[2], vb[3]};
      if (ks * 2 < nkt0) o[0][dt] = __builtin_amdgcn_mfma_f32_16x16x32_bf16(vf, pfs[0][ks], o[0][dt], 0, 0, 0);
      if (t1) o[1][dt] = __builtin_amdgcn_mfma_f32_16x16x32_bf16(vf, pfs[1][ks], o[1][dt], 0, 0, 0);
    }
  }
#pragma unroll
  for (int tl = 0; tl < 2; ++tl) {
    if ((tl == 0 || t1) && valid[tl]) {
      const size_t sl = ((size_t)qi[tl] * 4 + h) * 4 + src[tl];
      const float inv = 1.f / lsum[tl];
#pragma unroll
      for (int dt = 0; dt < 4; ++dt) *(uint2*)(PART + sl * 64 + dt * 16 + kg * 4) = make_uint2(pk2(o[tl][dt][0] * inv, o[tl][dt][1] * inv), pk2(o[tl][dt][2] * inv, o[tl][dt][3] * inv));
      if (kg == 0) ML[sl] = make_float2(mx[tl], lsum[tl]);
    }
  }
}

__device__ __forceinline__ void moba_attn(const Params& p, int l, float* sm) {
  const int bid0_ = bidx();
  const int tid = tidx();
  const int* LCNT = (const int*)(p.ws + WS_LCNT) + l * 256;
  int* pre = (int*)(sm + 36000);
  __syncthreads();
  if (tid < 64) {
    const int4 c4 = *(const int4*)(LCNT + tid * 4);
    const int n0 = (c4.x + 255) >> 8, n1 = (c4.y + 255) >> 8, n2 = (c4.z + 255) >> 8, n3 = (c4.w + 255) >> 8;
    const int tot = n0 + n1 + n2 + n3;
    int inc = tot;
#pragma unroll
    for (int o = 1; o < 64; o <<= 1) { const int t = __shfl_up(inc, o); if (tid >= o) inc += t; }
    const int ex = inc - tot;
    pre[tid * 4] = ex; pre[tid * 4 + 1] = ex + n0; pre[tid * 4 + 2] = ex + n0 + n1; pre[tid * 4 + 3] = ex + n0 + n1 + n2;
    if (tid == 63) pre[256] = inc;
  }
  __syncthreads();
  const int ng = pre[256];
  for (int it = bid0_; it < ng + 256; it += gridDim.x) {
    if (it < ng) {
      int lo = 0, hi = 255;
      while (lo < hi) { const int mid = (lo + hi + 1) >> 1; if (pre[mid] <= it) lo = mid; else hi = mid - 1; }
      moba_attn_item(p, lo >> 6, lo & 63, it - pre[lo], 0, LCNT[lo], sm);
    } else {
      const int w = it - ng;
      moba_attn_item(p, w & 3, w >> 2, 0, 1, 256, sm);
    }
  }
}

__device__ __forceinline__ void gla_out_item(const Params& p, int l, int it2, float* sm) {
  typedef short bf16x8_t __attribute__((ext_vector_type(8)));
  typedef short bf16x4_t __attribute__((ext_vector_type(4)));
  typedef float f32x4_t __attribute__((ext_vector_type(4)));
  const int tid = tidx(), lane = tid & 63, wave = tid >> 6, qc = lane & 15, kg = lane >> 4;
  const int c = it2 >> 1, hp = it2 & 1;
  const bf16raw* P = (const bf16raw*)(p.ws + WS_PROJ);
  const float* BC = (const float*)(p.ws + WS_GA);
  const float* ST = (const float*)(p.ws + WS_ST);
  bf16raw* Y = (bf16raw*)(p.ws + WS_Y);
  const float* cog = p.in[19] + l * 64;
  bf16raw* L = (bf16raw*)sm;
  const size_t t0 = (size_t)c * 64;
  float4 rrv[4];
#pragma unroll
  for (int et = 0; et < 4; ++et) rrv[et] = ld4bf(P + (t0 + (wave & 3) * 16 + qc) * PDIN + PC_CR + (hp * 2 + (wave >> 2)) * 64 + et * 16 + kg * 4);
  __syncthreads();
  {
    const int hh = tid >> 8, h = hp * 2 + hh;
    bf16raw* Qs = L + hh * 12288; bf16raw* Ks = Qs + 2560; bf16raw* St = Ks + 2560; bf16raw* Vt = St + 2560;
    {
      const int t = (tid >> 2) & 63, d8 = (tid & 3) * 8;
      const bf16raw* qp = P + (t0 + t) * PDIN + PC_CQ + h * 32 + d8; const bf16raw* kp = P + (t0 + t) * PDIN + PC_CK + h * 32 + d8;
      const float4 qa = ld4bf(qp), qb = ld4bf(qp + 4), ka = ld4bf(kp), kb = ld4bf(kp + 4);
      const float4 ba = *(const float4*)(BC + (t0 + t) * 128 + h * 32 + d8), bb = *(const float4*)(BC + (t0 + t) * 128 + h * 32 + d8 + 4);
      const float sc = 0.17677669529663687f;
      *(uint4*)(Qs + t * 40 + d8) = make_uint4(pk2(qa.x * sc * __expf(ba.x), qa.y * sc * __expf(ba.y)), pk2(qa.z * sc * __expf(ba.z), qa.w * sc * __expf(ba.w)),
                                               pk2(qb.x * sc * __expf(bb.x), qb.y * sc * __expf(bb.y)), pk2(qb.z * sc * __expf(bb.z), qb.w * sc * __expf(bb.w)));
      *(uint4*)(Ks + t * 40 + d8) = make_uint4(pk2(ka.x * __expf(-ba.x), ka.y * __expf(-ba.y)), pk2(ka.z * __expf(-ba.z), ka.w * __expf(-ba.w)),
                                               pk2(kb.x * __expf(-bb.x), kb.y * __expf(-bb.y)), pk2(kb.z * __expf(-bb.z), kb.w * __expf(-bb.w)));
    }
    {
      const int j = (tid >> 2) & 63, e0 = (tid & 3) * 16;
      const bf16raw* vp = P + (t0 + j) * PDIN + PC_CV + h * 64 + e0;
      const uint4 va = *(const uint4*)vp, vb = *(const uint4*)(vp + 8);
      const unsigned w[8] = {va.x, va.y, va.z, va.w, vb.x, vb.y, vb.z, vb.w};
#pragma unroll
      for (int q = 0; q < 8; ++q) { Vt[(e0 + 2 * q) * 72 + j] = (bf16raw)(w[q] & 0xffff); Vt[(e0 + 2 * q + 1) * 72 + j] = (bf16raw)(w[q] >> 16); }
    }
    {
      const int d = (tid >> 3) & 31, e0 = (tid & 7) * 8;
      const float* sp = ST + ((size_t)c * 4 + h) * 2048 + d * 64 + e0;
      const float4 sa = *(const float4*)sp, sb = *(const float4*)(sp + 4);
      const float v[8] = {sa.x, sa.y, sa.z, sa.w, sb.x, sb.y, sb.z, sb.w};
#pragma unroll
      for (int q = 0; q < 8; ++q) St[(e0 + q) * 40 + d] = (bf16raw)(pk2(v[q], 0.f) & 0xffff);
    }
  }
  __syncthreads();
  {
    const int hh = wave >> 2, itile = wave & 3, h = hp * 2 + hh;
    const bf16raw* Qs = L + hh * 12288; const bf16raw* Ks = Qs + 2560; const bf16raw* St = Ks + 2560; const bf16raw* Vt = St + 2560;
    const bf16x8_t qf = *(const bf16x8_t*)(Qs + (itile * 16 + qc) * 40 + kg * 8);
    f32x4_t att[4];
#pragma unroll
    for (int jt = 0; jt < 4; ++jt) {
      f32x4_t a = {0.f, 0.f, 0.f, 0.f};
      if (jt <= itile) {
        const bf16x8_t kf = *(const bf16x8_t*)(Ks + (jt * 16 + qc) * 40 + kg * 8);
        a = __builtin_amdgcn_mfma_f32_16x16x32_bf16(kf, qf, a, 0, 0, 0);
        if (jt == itile) {
#pragma unroll
          for (int r = 0; r < 4; ++r) if (kg * 4 + r > qc) a[r] = 0.f;
        }
      }
      att[jt] = a;
    }
    bf16x8_t pf[2];
#pragma unroll
    for (int s2 = 0; s2 < 2; ++s2) {
      const uint4 w = make_uint4(pk2(att[2 * s2][0], att[2 * s2][1]), pk2(att[2 * s2][2], att[2 * s2][3]), pk2(att[2 * s2 + 1][0], att[2 * s2 + 1][1]),
                                 pk2(att[2 * s2 + 1][2], att[2 * s2 + 1][3]));
      pf[s2] = __builtin_bit_cast(bf16x8_t, w);
    }
    f32x4_t o[4];
    float ss = 0.f;
#pragma unroll
    for (int et = 0; et < 4; ++et) {
      f32x4_t acc = {0.f, 0.f, 0.f, 0.f};
      const bf16x8_t sf = *(const bf16x8_t*)(St + (et * 16 + qc) * 40 + kg * 8);
      acc = __builtin_amdgcn_mfma_f32_16x16x32_bf16(sf, qf, acc, 0, 0, 0);
#pragma unroll
      for (int s2 = 0; s2 < 2; ++s2) {
        if (2 * s2 <= itile) {
          const bf16x4_t va = *(const bf16x4_t*)(Vt + (et * 16 + qc) * 72 + s2 * 32 + kg * 4), vb = *(const bf16x4_t*)(Vt + (et * 16 + qc) * 72 + s2 * 32 + 16 + kg * 4);
          const bf16x8_t vf = {va[0], va[1], va[2], va[3], vb[0], vb[1], vb[2], vb[3]};
          acc = __builtin_amdgcn_mfma_f32_16x16x32_bf16(vf, pf[s2], acc, 0, 0, 0);
        }
      }
      o[et] = acc;
      ss += acc[0] * acc[0] + acc[1] * acc[1] + acc[2] * acc[2] + acc[3] * acc[3];
    }
    ss += __shfl_xor(ss, 16); ss += __shfl_xor(ss, 32);
    const float r = rsqrtf(ss * (1.f / 64.f) + 1e-6f);
    const size_t t = t0 + itile * 16 + qc;
#pragma unroll
    for (int et = 0; et < 4; ++et) {
      const int e = et * 16 + kg * 4;
      const float4 rr = rrv[et], g = *(const float4*)(cog + e);
      *(uint2*)(Y + t * 1024 + 512 + h * 64 + e) = make_uint2(pk2(o[et][0] * r * g.x * rr.x * sigmoidf_(rr.x), o[et][1] * r * g.y * rr.y * sigmoidf_(rr.y)),
                                                             pk2(o[et][2] * r * g.z * rr.z * sigmoidf_(rr.z), o[et][3] * r * g.w * rr.w * sigmoidf_(rr.w)));
    }
  }
}

__device__ __forceinline__ void lru_out(const Params& p) {
  const int bid0_ = bidx();
  const int tid = tidx();
  const float* LA = (const float*)(p.ws + WS_LA); const float* LB = (const float*)(p.ws + WS_LB); const float* LC = (const float*)(p.ws + WS_LC);
  const bf16raw* P = (const bf16raw*)(p.ws + WS_PROJ);
  bf16raw* Y = (bf16raw*)(p.ws + WS_Y);
  for (int idx = bid0_ * NT + tid; idx < S * 64; idx += gridDim.x * NT) {
    const int t = idx >> 6, c4 = (idx & 63) * 4;
    const float4 a = *(const float4*)(LA + (size_t)t * 256 + c4), b = *(const float4*)(LB + (size_t)t * 256 + c4);
    const float4 cr = *(const float4*)(LC + (size_t)(t >> 5) * 256 + c4), g = ld4bf(P + (size_t)t * PDIN + PC_DG + c4);
    *(uint2*)(Y + (size_t)t * 1024 + 768 + c4) = make_uint2(pk2((b.x + a.x * cr.x) * gelu_tanh(g.x), (b.y + a.y * cr.y) * gelu_tanh(g.y)),
                                                          pk2((b.z + a.z * cr.z) * gelu_tanh(g.z), (b.w + a.w * cr.w) * gelu_tanh(g.w)));
  }
}

__device__ __forceinline__ void ph_mix(const Params& p, int l, float* sm) {
  const int bid0_ = bidx();
  const int grp = bid0_ % 3;
  if (grp == 0) { __syncthreads(); convert_rest(p, sm, l); __syncthreads(); }
  moba_attn(p, l, sm);
  for (int it = bid0_; it < 512; it += gridDim.x) gla_out_item(p, l, it, sm);
  lru_out(p);
  __syncthreads();
  if (grp == 1) { convert_rest(p, sm, l); __syncthreads(); }
  {
    const attn_body::AttnTensors AT{(const attn_body::bf16*)(p.ws + WS_QA), (const attn_body::bf16*)(p.ws + WS_KA), (const attn_body::bf16*)(p.ws + WS_VA),
                                    (attn_body::bf16*)(p.ws + WS_OA), (const attn_body::bf16*)(p.ws + WS_ZERO)};
    const attn_body::StaticOrder so((int)gridDim.x, bid0_);
    attn_body::attn_phase<attn_body::StaticOrder>((char*)sm, AT, so);
  }
  if (grp == 2) { __syncthreads(); convert_rest(p, sm, l); }
}

__device__ __forceinline__ void ph_fin(const Params& p, int l) {
  const int bid0_ = bidx();
  const int tid0_ = tidx();
  const int lane = tid0_ & 63, wave = tid0_ >> 6;
  const bf16raw* OA = (const bf16raw*)(p.ws + WS_OA);
  bf16raw* Y = (bf16raw*)(p.ws + WS_Y);
  const float lam = lam_of(p, l), li = lam_init_of(l);
  const float2* ML = (const float2*)(p.ws + WS_ML); const bf16raw* PART = (const bf16raw*)(p.ws + WS_PART);
  const float* aog = p.in[14] + l * 64;
  const int rsel = lane >> 5, h = (lane >> 3) & 3, c = (lane & 7) * 8;
  const float4 ga = *(const float4*)(aog + c), gb = *(const float4*)(aog + c + 4);
#define BF8(W, F) do { F[0] = __builtin_bit_cast(float, W.x << 16); F[1] = __builtin_bit_cast(float, W.x & 0xffff0000u); F[2] = __builtin_bit_cast(float, W.y << 16); F[3] = __builtin_bit_cast(float, W.y & 0xffff0000u); \
                       F[4] = __builtin_bit_cast(float, W.z << 16); F[5] = __builtin_bit_cast(float, W.z & 0xffff0000u); F[6] = __builtin_bit_cast(float, W.w << 16); F[7] = __builtin_bit_cast(float, W.w & 0xffff0000u); } while (0)
#pragma unroll 2
  for (int row0 = (bid0_ * 8 + wave) * 2; row0 < S; row0 += gridDim.x * 16) {
    const int row = row0 + rsel;
    const uint4 u1 = *(const uint4*)(OA + ((size_t)row * 8 + h * 2) * 64 + c), u2 = *(const uint4*)(OA + ((size_t)row * 8 + h * 2 + 1) * 64 + c);
    const size_t sl = ((size_t)row * 4 + h) * 4;
    const float2 m0 = ML[sl], m1 = ML[sl + 1], m2 = ML[sl + 2], m3 = ML[sl + 3];
    const uint4 p0 = *(const uint4*)(PART + (sl + 0) * 64 + c), p1 = *(const uint4*)(PART + (sl + 1) * 64 + c), p2 = *(const uint4*)(PART + (sl + 2) * 64 + c), p3 = *(const uint4*)(PART + (sl + 3) * 64 + c);
    {
      float a1[8], a2[8], o[8];
      BF8(u1, a1); BF8(u2, a2);
      float ss = 0.f;
#pragma unroll
      for (int i = 0; i < 8; ++i) { o[i] = a1[i] - lam * a2[i]; ss += o[i] * o[i]; }
      ss += __shfl_xor(ss, 1); ss += __shfl_xor(ss, 2); ss += __shfl_xor(ss, 4);
      const float r = rsqrtf(ss * (1.f / 64.f) + 1e-6f) * (1.f - li);
      *(uint4*)(Y + (size_t)row * 1024 + h * 64 + c) = make_uint4(pk2(o[0] * r * ga.x, o[1] * r * ga.y), pk2(o[2] * r * ga.z, o[3] * r * ga.w), pk2(o[4] * r * gb.x, o[5] * r * gb.y), pk2(o[6] * r * gb.z, o[7] * r * gb.w));
    }
    {
      const float M = fmaxf(fmaxf(m0.x, m1.x), fmaxf(m2.x, m3.x));
      const float w0 = m0.y * __builtin_amdgcn_exp2f(m0.x - M), w1 = m1.y * __builtin_amdgcn_exp2f(m1.x - M), w2 = m2.y * __builtin_amdgcn_exp2f(m2.x - M),
                  w3 = m3.y * __builtin_amdgcn_exp2f(m3.x - M);
      const float inv = 1.f / (w0 + w1 + w2 + w3);
      float t0[8], t1[8], t2[8], t3[8], o[8];
      BF8(p0, t0); BF8(p1, t1); BF8(p2, t2); BF8(p3, t3);
#pragma unroll
      for (int i = 0; i < 8; ++i) {
        float acc = w3 * t3[i];
        acc += (w0 > 0.f) ? w0 * t0[i] : 0.f; acc += (w1 > 0.f) ? w1 * t1[i] : 0.f; acc += (w2 > 0.f) ? w2 * t2[i] : 0.f;
        o[i] = acc * inv;
      }
      *(uint4*)(Y + (size_t)row * 1024 + 256 + h * 64 + c) = make_uint4(pk2(o[0], o[1]), pk2(o[2], o[3]), pk2(o[4], o[5]), pk2(o[6], o[7]));
    }
  }
#undef BF8
}

__device__ __forceinline__ void ph_outproj(const Params& p, int l, float* sm) {
  const int bid0_ = bidx();
  pg8::Gemm g{(const pg8::bf16_t*)(p.ws + WS_Y), (const pg8::bf16_t*)(p.ws + WS_WOUT) + (size_t)l * 1024 * 1024, S, 1024, 1024};
  pg8::StaticOrder so; so.init(S, 1024, (int)gridDim.x, bid0_);
  pg8::EpiOutproj E{l == 0 ? p.in[0] : (const float*)nullptr, (const pg8::bf16_t*)(p.ws + WS_XA), (const float*)(p.ws + WS_MOD) + l * 6144 + 2 * 1024, (pg8::bf16_t*)(p.ws + WS_X1)};
  pg8::gemm_phase<pg8::EpiOutproj, pg8::StaticOrder, true, true>((PG8_LAS unsigned char*)sm, g, so, E);
}

__device__ __forceinline__ void ph_gather(const Params& p, int l, float* sm) {
  const int bid0_ = bidx();
  const int tid0_ = tidx();
  const int* cnt = (const int*)(p.ws + WS_CNT) + l * 32;
  int* ps = (int*)sm;
  __syncthreads();
  int* cl = ps + 64;
  if (tid0_ < 32) cl[tid0_] = (cnt[tid0_] + 255) & ~255;
  __syncthreads();
  if (tid0_ < 33) { int a = 0; for (int e = 0; e < tid0_; ++e) a += cl[e]; ps[tid0_] = a; }
  __syncthreads();
  int* srow = (int*)(p.ws + WS_SROW);
  if (bid0_ == 0) {
    int* texp = (int*)(p.ws + WS_TEXP);
    const int nt = ps[32] >> 8;
    if (tid0_ == 0) texp[0] = nt;
    if (tid0_ < 32) { texp[352 + tid0_] = ps[tid0_] >> 8; texp[384 + tid0_] = cl[tid0_] >> 8; }
    if (tid0_ < 320) {
      int e = 0;
      for (int k = 0; k < 32; ++k) if (tid0_ * 256 >= ps[k + 1]) e = k + 1;
      texp[1 + tid0_] = e < 32 ? e : 31;
    }
  }
  for (int e = bid0_; e < 32; e += gridDim.x)
    for (int i = cnt[e] + tid0_; i < cl[e]; i += NT) srow[ps[e] + i] = 0;
  const int* eidx = (const int*)(p.ws + WS_EIDX);
  int* rpos = (int*)(p.ws + WS_RPOS);
  for (int r = bid0_ * NT + tid0_; r < S * 4; r += gridDim.x * NT) {
    const int ei = eidx[r], e = ei & 255, rank = ei >> 8;
    const int dest = ps[e] + rank;
    srow[dest] = r >> 2;
    rpos[r] = dest;
  }
}

__device__ __forceinline__ void ph_up(const Params& p, int l, float* sm) {
  const int bid0_ = bidx();
  pg8::Gemm g{(const pg8::bf16_t*)(p.ws + WS_H), (const pg8::bf16_t*)(p.ws + WS_WUP) + (size_t)l * NE * 2048 * 1024, MOE_ROWS, 2048, 1024};
  int* tab = (int*)(sm + 33000);
  unsigned* rowoff = (unsigned*)(sm + 33104);
  const int t_ = tidx();
  const int* cnt = (const int*)(p.ws + WS_CNT) + l * 32;
  pg8::moe_build_units<8>(cnt, (int)gridDim.x, bid0_, tab, t_);
  pg8::moe_build_rowoff((const int*)(p.ws + WS_ELIST), cnt, tab, rowoff, t_);
  pg8::MoeOrder<8, 1> so{tab, (unsigned*)(p.ws + WS_RDY) + l * 320};
  pg8::EpiUp E{__builtin_amdgcn_make_buffer_rsrc((void*)(p.ws + WS_ACT), 0, (int)((size_t)MOE_ROWS * 1024 * 2), 0x00020000), p.in[30] + (size_t)l * NE * 2048};
  pg8::gemm_phase<pg8::EpiUp, pg8::MoeOrder<8, 1>, true, true, true>((PG8_LAS unsigned char*)sm, g, so, E, rowoff);
}

__device__ __forceinline__ void ph_down(const Params& p, int l, float* sm) {
  const int bid0_ = bidx();
  pg8::Gemm g{(const pg8::bf16_t*)(p.ws + WS_ACT), (const pg8::bf16_t*)(p.ws + WS_WDN) + (size_t)l * NE * 1024 * 1024, MOE_ROWS, 1024, 1024};
  int* tab = (int*)(sm + 33000);
  pg8::moe_build_units<4>((const int*)(p.ws + WS_CNT) + l * 32, (int)gridDim.x, bid0_, tab, tidx(), true);
  pg8::MoeOrder<4, 2> so{tab, (unsigned*)(p.ws + WS_RDY) + l * 320};
  pg8::EpiDown E{(pg8::bf16_t*)(p.ws + WS_YS), p.in[32] + (size_t)l * NE * 1024};
  pg8::gemm_phase<pg8::EpiDown, pg8::MoeOrder<4, 2>, true, true>((PG8_LAS unsigned char*)sm, g, so, E);
}

__device__ __forceinline__ void ph_combine(const Params& p, int l, float* sm) {
  const int bid0_ = bidx();
  const int tid0_ = tidx();
  const int lane = tid0_ & 63, wave = tid0_ >> 6;
  const bf16raw* X1 = (const bf16raw*)(p.ws + WS_X1); const bf16raw* YS = (const bf16raw*)(p.ws + WS_YS);
  const float* gatebuf = (const float*)(p.ws + WS_GATE);
  const int* eidx = (const int*)(p.ws + WS_EIDX);
  const int* cnt = (const int*)(p.ws + WS_CNT) + l * 32;
  const float* g2 = (const float*)(p.ws + WS_MOD) + l * 6144 + 5 * 1024;
  bf16raw* xa = (bf16raw*)(p.ws + WS_XA);
  const float* modn = (const float*)(p.ws + WS_MOD) + 6144;
  const float* gain = p.in[4] + 1024;
  bf16raw* H = (bf16raw*)(p.ws + WS_H);
  int* ps = (int*)sm;
  __syncthreads();
  if (tid0_ < 33) { int a = 0; for (int e = 0; e < tid0_; ++e) a += (cnt[e] + 255) & ~255; ps[tid0_] = a; }
  __syncthreads();
  float g2v[2][8], nga[2][8], ngb[2][8];
#pragma unroll
  for (int j = 0; j < 2; ++j) {
    const int c = (lane + 64 * j) * 8;
#pragma unroll
    for (int q = 0; q < 2; ++q) {
      const float4 g = *(const float4*)(g2 + c + 4 * q);
      g2v[j][4 * q] = g.x; g2v[j][4 * q + 1] = g.y; g2v[j][4 * q + 2] = g.z; g2v[j][4 * q + 3] = g.w;
      if (l == 0) {
        const float4 gn = *(const float4*)(gain + c + 4 * q), a = *(const float4*)(modn + 1024 + c + 4 * q), bsh = *(const float4*)(modn + c + 4 * q);
        nga[j][4 * q] = gn.x * (1.f + a.x); nga[j][4 * q + 1] = gn.y * (1.f + a.y); nga[j][4 * q + 2] = gn.z * (1.f + a.z); nga[j][4 * q + 3] = gn.w * (1.f + a.w);
        ngb[j][4 * q] = bsh.x; ngb[j][4 * q + 1] = bsh.y; ngb[j][4 * q + 2] = bsh.z; ngb[j][4 * q + 3] = bsh.w;
      }
    }
  }
#define BF8(W, F) do { F[0] = __builtin_bit_cast(float, W.x << 16); F[1] = __builtin_bit_cast(float, W.x & 0xffff0000u); F[2] = __builtin_bit_cast(float, W.y << 16); F[3] = __builtin_bit_cast(float, W.y & 0xffff0000u); \
                       F[4] = __builtin_bit_cast(float, W.z << 16); F[5] = __builtin_bit_cast(float, W.z & 0xffff0000u); F[6] = __builtin_bit_cast(float, W.w << 16); F[7] = __builtin_bit_cast(float, W.w & 0xffff0000u); } while (0)
#pragma unroll 2
  for (int row = bid0_ * 8 + wave; row < S; row += gridDim.x * 8) {
    const float4 gt = *(const float4*)(gatebuf + row * 4);
    const int4 ei = *(const int4*)(eidx + row * 4);
    const int4 rp = make_int4(ps[ei.x & 255] + (ei.x >> 8), ps[ei.y & 255] + (ei.y >> 8), ps[ei.z & 255] + (ei.z >> 8), ps[ei.w & 255] + (ei.w >> 8));
    float v[2][8];
    float ss = 0.f;
#pragma unroll
    for (int j = 0; j < 2; ++j) {
      const int c = (lane + 64 * j) * 8;
      const uint4 y0 = *(const uint4*)(YS + (size_t)rp.x * 1024 + c), y1 = *(const uint4*)(YS + (size_t)rp.y * 1024 + c);
      const uint4 y2 = *(const uint4*)(YS + (size_t)rp.z * 1024 + c), y3 = *(const uint4*)(YS + (size_t)rp.w * 1024 + c);
      const uint4 xw = *(const uint4*)(X1 + (size_t)row * 1024 + c);
      float f0[8], f1[8], f2[8], f3[8], x[8];
      BF8(y0, f0); BF8(y1, f1); BF8(y2, f2); BF8(y3, f3); BF8(xw, x);
#pragma unroll
      for (int i = 0; i < 8; ++i) {
        const float a = gt.x * f0[i] + gt.y * f1[i] + gt.z * f2[i] + gt.w * f3[i];
        v[j][i] = x[i] + g2v[j][i] * a;
        ss += v[j][i] * v[j][i];
      }
      if (l == 0) *(uint4*)(xa + (size_t)row * 1024 + c) = make_uint4(pk2(v[j][0], v[j][1]), pk2(v[j][2], v[j][3]), pk2(v[j][4], v[j][5]), pk2(v[j][6], v[j][7]));
      else { *(float4*)(p.out + (size_t)row * 1024 + c) = make_float4(v[j][0], v[j][1], v[j][2], v[j][3]); *(float4*)(p.out + (size_t)row * 1024 + c + 4) = make_float4(v[j][4], v[j][5], v[j][6], v[j][7]); }
    }
    if (l == 0) {
      ss = wave_sum(ss);
      const float r = rsqrtf(ss * (1.f / 1024.f) + 1e-6f);
#pragma unroll
      for (int j = 0; j < 2; ++j) {
        const int c = (lane + 64 * j) * 8;
        float y[8];
#pragma unroll
        for (int i = 0; i < 8; ++i) y[i] = v[j][i] * r * nga[j][i] + ngb[j][i];
        *(uint4*)(H + (size_t)row * 1024 + c) = make_uint4(pk2(y[0], y[1]), pk2(y[2], y[3]), pk2(y[4], y[5]), pk2(y[6], y[7]));
      }
    }
  }
#undef BF8
}

#define LAS __attribute__((address_space(3)))
#define XB_TMO      128
#define XB_XCNT(j)  (256  + 64 * (j))
#define XB_XSUB(j)  (1280 + 64 * (j))
#define XB_XGEN(j)  (2304 + 64 * (j))
#define XB_TOP      3328
#define XB_TOPGEN   3392
#define XCD_BAR_WORDS 3456
#define XB_SPIN_CAP (1u << 18)

__device__ __forceinline__ unsigned xb_ld(unsigned* p)              { return __hip_atomic_load(p, __ATOMIC_RELAXED, __HIP_MEMORY_SCOPE_AGENT); }
__device__ __forceinline__ unsigned xb_add(unsigned* p, unsigned v) { return __hip_atomic_fetch_add(p, v, __ATOMIC_RELAXED, __HIP_MEMORY_SCOPE_AGENT); }
__device__ __forceinline__ unsigned xb_xcc_id() { return (unsigned)__builtin_amdgcn_s_getreg((3 << 11) | 20) & 0xFu; }
#define XB_SPIN(cond, bar) do { unsigned _sp = 0; while (cond) { __builtin_amdgcn_s_sleep(1); \
    if ((++_sp & 255u) == 0u) { if (xb_ld(&(bar)[XB_TMO])) break; if (_sp > XB_SPIN_CAP) { atomicAdd(&(bar)[XB_TMO], 1u); break; } } } } while (0)

struct XcdBarrier {
    unsigned* bar; unsigned x;
    volatile LAS unsigned* st;
};

__device__ __forceinline__ XcdBarrier xcd_barrier_post(unsigned* bar, volatile LAS unsigned* st) {
    XcdBarrier b; b.bar = bar; b.x = xb_xcc_id(); b.st = st;
    if (threadIdx.x == 0) (void)xb_add(&bar[XB_XCNT(b.x)], 1u);
    return b;
}
__device__ __forceinline__ void xcd_barrier_complete(unsigned* bar, unsigned x, unsigned& nloc, unsigned& nx) {
    const unsigned G = gridDim.x * gridDim.y * gridDim.z;
    unsigned sum, cnt, mine, sp = 0u;
    for (;;) {
        sum = 0u; cnt = 0u; mine = 0u;
#pragma unroll
        for (unsigned j = 0; j < 16; ++j) { const unsigned c = xb_ld(&bar[XB_XCNT(j)]); sum += c; cnt += (c > 0u) ? 1u : 0u; mine = (j == x) ? c : mine; }
        if (sum == G) break;
        __builtin_amdgcn_s_sleep(1);
        if ((++sp & 255u) == 0u) { if (xb_ld(&bar[XB_TMO])) break; if (sp > XB_SPIN_CAP) { atomicAdd(&bar[XB_TMO], 1u); break; } }
    }
    nloc = mine > 0u ? mine : 1u; nx = cnt > 0u ? cnt : 1u;
}

__device__ __forceinline__ void xcd_barrier(const XcdBarrier& b) {
    asm volatile("s_waitcnt vmcnt(0)" ::: "memory");
    __syncthreads();
    if (threadIdx.x == 0) {
        unsigned* bar = b.bar; asm volatile("" : "+s"(bar));
        const unsigned bx_ = xb_xcc_id();
        __builtin_amdgcn_s_waitcnt(0);
        unsigned nloc = b.st[0], nx = b.st[1];
        if (nloc == 0u) { xcd_barrier_complete(bar, bx_, nloc, nx); b.st[0] = nloc; b.st[1] = nx; }
        const unsigned old = xb_add(&bar[XB_XSUB(bx_)], 1u);
        const unsigned gen = old / nloc;
        if (old + 1u == (gen + 1u) * nloc) {
            __builtin_amdgcn_fence(__ATOMIC_RELEASE, "agent");
            asm volatile("s_waitcnt vmcnt(0)" ::: "memory");
            const unsigned og = xb_add(&bar[XB_TOP], 1u);
            const unsigned tg = og / nx;
            if (og + 1u == (tg + 1u) * nx) xb_add(&bar[XB_TOPGEN], 1u);
            else XB_SPIN(xb_ld(&bar[XB_TOPGEN]) == tg, bar);
            __builtin_amdgcn_fence(__ATOMIC_ACQUIRE, "agent");
            xb_add(&bar[XB_XGEN(bx_)], 1u);
            asm volatile("s_waitcnt vmcnt(0)" ::: "memory");
        } else {
            XB_SPIN(xb_ld(&bar[XB_XGEN(bx_)]) == gen, bar);
            __builtin_amdgcn_fence(__ATOMIC_ACQUIRE, "agent");
            asm volatile("s_waitcnt vmcnt(0)" ::: "memory");
        }
    }
    __syncthreads();
}

template <int SUB>
__device__ __forceinline__ void run_sub(const Params& p, int l, float* sm) {
  const int bid0_ = bidx();
  asm volatile("" : "+s"(l));
  if (SUB == 0) ph_norm(p, l, 0, sm);
  else if (SUB == 1) ph_inproj(p, l, sm);
  else if (SUB == 2) ph_prep(p, l, sm);
  else if (SUB == 3) { ph_scan(p, sm); ph_scan_lru(p, sm); for (int it = bid0_; it < 256; it += gridDim.x) moba_gate_item(p, l, (it - 16) & 255, sm); }
  else if (SUB == 4) ph_mix(p, l, sm);
  else if (SUB == 5) ph_fin(p, l);
  else if (SUB == 6) ph_outproj(p, l, sm);
  else if (SUB == 7) ph_norm2(p, l, sm);
  else if (SUB == 8) ph_gather(p, l, sm);
  else if (SUB == 9) ph_up(p, l, sm);
  else if (SUB == 10) ph_down(p, l, sm);
  else if (SUB == 11) ph_combine(p, l, sm);
}

#if MK_SINGLE
__global__ void __launch_bounds__(NT, 2) mega(Params p) {
  extern __shared__ __attribute__((aligned(16))) unsigned char lds_raw[];
  float* sm = (float*)lds_raw;
  cg::grid_group grid = cg::this_grid();
  unsigned* barw = (unsigned*)(p.ws + WS_BAR);
  volatile LAS unsigned* bst = (volatile LAS unsigned*)((LAS unsigned char*)lds_raw + (LDS_BYTES - 64));
  if (threadIdx.x < 2) bst[threadIdx.x] = 0u;
  if (blockIdx.x == 0) for (int i = threadIdx.x; i < XCD_BAR_WORDS; i += NT) barw[i] = 0u;
  ph_mod(p, sm);
  ph_convert(p, sm);
  grid.sync();
  const XcdBarrier gb = xcd_barrier_post(barw, bst);
#define GSYNC() xcd_barrier(gb)
  run_sub<0>(p, 0, sm); GSYNC();
#pragma unroll 1
  for (int l = 0; l < 2; ++l) {
    run_sub<1>(p, l, sm); GSYNC();
    run_sub<2>(p, l, sm); GSYNC();
    run_sub<3>(p, l, sm); GSYNC();
    run_sub<4>(p, l, sm); GSYNC();
    run_sub<5>(p, l, sm); GSYNC();
    run_sub<6>(p, l, sm); GSYNC();
    run_sub<7>(p, l, sm); GSYNC();
    run_sub<9>(p, l, sm);
    run_sub<10>(p, l, sm); GSYNC();
    run_sub<11>(p, l, sm);
    if (l == 0) GSYNC();
  }
#undef GSYNC
}
#else
template <int SUB>
__global__ void __launch_bounds__(NT, 2) phk(Params p, int l) {
  extern __shared__ __attribute__((aligned(16))) unsigned char lds_raw[];
  float* sm = (float*)lds_raw;
  if (SUB < 0) { ph_mod(p, sm); ph_convert(p, sm); }
  else run_sub<(SUB < 0 ? 0 : SUB)>(p, l, sm);
}
template <int SUB> static void launch_ph(const Params& p, int l, hipStream_t stream) {
  static bool attr = false;
  if (!attr) { (void)hipFuncSetAttribute((const void*)phk<SUB>, hipFuncAttributeMaxDynamicSharedMemorySize, LDS_BYTES); attr = true; }
  hipLaunchKernelGGL(phk<SUB>, dim3(256), dim3(NT), LDS_BYTES, stream, p, l);
}
#endif

extern "C" void kernel_launch(void* const* d_in, const int* in_sizes, int n_in, void* d_out, int out_size, void* d_ws, size_t ws_size,
                              hipStream_t stream) {
  Params p{};
  for (int i = 0; i < 33; ++i) p.in[i] = (const float*)d_in[i];
  p.out = (float*)d_out;
  p.ws = (char*)d_ws;
#if MK_SINGLE
  static int grid_blocks = 0;
  if (!grid_blocks) {
    int dev = 0, cus = 0, per_cu = 0;
    (void)hipGetDevice(&dev);
    (void)hipDeviceGetAttribute(&cus, hipDeviceAttributeMultiprocessorCount, dev);
    (void)hipFuncSetAttribute((const void*)mega, hipFuncAttributeMaxDynamicSharedMemorySize, LDS_BYTES);
    (void)hipOccupancyMaxActiveBlocksPerMultiprocessor(&per_cu, mega, NT, LDS_BYTES);
    if (per_cu < 1) per_cu = 1;
    if (per_cu > 1) per_cu = 1;
    grid_blocks = cus * per_cu;
  }
  void* args[] = {&p};
  hipError_t e = hipLaunchCooperativeKernel((void*)mega, dim3(grid_blocks), dim3(NT), args, LDS_BYTES, stream);
  if (e != hipSuccess) fprintf(stderr, "cooperative launch failed: %s (grid %d)\n", hipGetErrorString(e), grid_blocks);
#else
  launch_ph<-1>(p, 0, stream);
  for (int l = 0; l < 2; ++l) {
    if (l == 0) launch_ph<0>(p, l, stream);
    launch_ph<1>(p, l, stream); launch_ph<2>(p, l, stream); launch_ph<3>(p, l, stream);
    launch_ph<4>(p, l, stream); launch_ph<5>(p, l, stream); launch_ph<6>(p, l, stream); launch_ph<7>(p, l, stream);
    launch_ph<9>(p, l, stream); launch_ph<10>(p, l, stream); launch_ph<11>(p, l, stream);
  }
#endif
}
```
